# Optimizing an MI355X kernel written in HIP

```python
import math
import jax, jax.numpy as jnp
from jax import lax
import numpy as np

D_MODEL = 1024
BATCH = 16
SEQ = 2048
DEPTH = 1

HEAD_DIM = 64
D_MIX = D_MODEL
MOBA_HEADS = 8
MOBA_BLOCK = 256
MOBA_TOPK = 3
DIFF_HEADS = 4
DIFF_V_DIM = 2 * HEAD_DIM
Q_BLOCK = 128
MOBA_W = MOBA_HEADS * HEAD_DIM
DIFF_QK_W = DIFF_HEADS * 2 * HEAD_DIM
DIFF_V_W = DIFF_HEADS * DIFF_V_DIM
PROJ_COLS = 3 * MOBA_W + 2 * DIFF_QK_W + DIFF_V_W
SPLITS = (MOBA_W, 2 * MOBA_W, 3 * MOBA_W, 3 * MOBA_W + DIFF_QK_W, 3 * MOBA_W + 2 * DIFF_QK_W)
PEER_HEADS = 8
PEER_N_KEYS = 128
PEER_N_EXPERTS = PEER_N_KEYS * PEER_N_KEYS
PEER_D_QUERY = 256
PEER_D_HALF = PEER_D_QUERY // 2
PEER_TOPK = 16
PEER_CHUNK = 128
RMS_EPS = 1e-6

kernel_name = 'hybrid_moba_diffattn_peer_layer'


def rms_norm(x, g):
    xf = x.astype(jnp.float32)
    y = xf * lax.rsqrt(jnp.mean(xf * xf, axis=-1, keepdims=True) + RMS_EPS)
    return (y * g.astype(jnp.float32)).astype(x.dtype)


def alibi_slopes(n):
    return jnp.asarray(2.0 ** (-8.0 * np.arange(1, n + 1) / n), dtype=jnp.float32)


def lambda_init_fn(layer):
    return 0.8 - 0.6 * math.exp(-0.3 * layer)


def split_heads(t, n, dh):
    b, s, _ = t.shape
    return t.reshape(b, s, n, dh).transpose(0, 2, 1, 3)


def moba_query_block(q_blk, idx, k_blocks, v_blocks, q_start, slopes):
    n_h, n_q, d = q_blk.shape
    kk = idx.shape[-1]
    scale = d ** -0.5
    pos_q = q_start + jnp.arange(n_q, dtype=jnp.int32)
    own = q_start // MOBA_BLOCK
    blk_off = jnp.arange(MOBA_BLOCK, dtype=jnp.int32)
    h_ix = jnp.arange(n_h)[:, None, None]
    k_sel = k_blocks[h_ix, idx]
    v_sel = v_blocks[h_ix, idx]
    pos_sel = idx[..., None] * MOBA_BLOCK + blk_off
    s_sel = jnp.einsum('hqd,hqkjd->hqkj', q_blk, k_sel).astype(jnp.float32) * scale
    s_sel = s_sel - slopes[:, None, None, None] * (pos_q[None, :, None, None] - pos_sel).astype(jnp.float32)
    s_sel = jnp.where((idx < own)[..., None], s_sel, -jnp.inf)
    k_own = lax.dynamic_index_in_dim(k_blocks, own, axis=1, keepdims=False)
    v_own = lax.dynamic_index_in_dim(v_blocks, own, axis=1, keepdims=False)
    dist_own = pos_q[:, None] - (own * MOBA_BLOCK + blk_off)[None, :]
    s_own = jnp.einsum('hqd,hjd->hqj', q_blk, k_own).astype(jnp.float32) * scale
    s_own = s_own - slopes[:, None, None] * dist_own.astype(jnp.float32)
    s_own = jnp.where(dist_own >= 0, s_own, -jnp.inf)
    s = jnp.concatenate([s_sel.reshape(n_h, n_q, kk * MOBA_BLOCK), s_own], axis=-1)
    p = jax.nn.softmax(s, axis=-1).astype(v_own.dtype)
    p_sel = p[..., :kk * MOBA_BLOCK].reshape(n_h, n_q, kk, MOBA_BLOCK)
    p_own = p[..., kk * MOBA_BLOCK:]
    return jnp.einsum('hqkj,hqkjd->hqd', p_sel, v_sel) + jnp.einsum('hqj,hjd->hqd', p_own, v_own)


def moba_attention(q, k, v):
    b, n_h, s, d = q.shape
    nb = -(-s // MOBA_BLOCK)
    kk = min(MOBA_TOPK, nb)
    pad = nb * MOBA_BLOCK - s
    k_blocks = jnp.pad(k, ((0, 0), (0, 0), (0, pad), (0, 0))).reshape(b, n_h, nb, MOBA_BLOCK, d)
    v_blocks = jnp.pad(v, ((0, 0), (0, 0), (0, pad), (0, 0))).reshape(b, n_h, nb, MOBA_BLOCK, d)
    k_mean = jnp.mean(k_blocks.astype(jnp.float32), axis=3)
    gate = jnp.einsum('bhsd,bhnd->bhsn', q.astype(jnp.float32), k_mean)
    pos = jnp.arange(s, dtype=jnp.int32)
    past = jnp.arange(nb, dtype=jnp.int32)[None, :] < (pos // MOBA_BLOCK)[:, None]
    gate = jnp.where(past, gate, -jnp.inf)
    _, sel = lax.top_k(gate, kk)
    nqb = s // Q_BLOCK
    q_r = q.reshape(b, n_h, nqb, Q_BLOCK, d).transpose(0, 2, 1, 3, 4)
    sel_r = sel.reshape(b, n_h, nqb, Q_BLOCK, kk).transpose(0, 2, 1, 3, 4)
    starts = jnp.arange(nqb, dtype=jnp.int32) * Q_BLOCK
    slopes = alibi_slopes(n_h)

    def per_batch(args):
        q_b, sel_b, kb, vb = args
        return lax.map(lambda a: moba_query_block(a[0], a[1], kb, vb, a[2], slopes), (q_b, sel_b, starts))

    out = lax.map(per_batch, (q_r, sel_r, k_blocks, v_blocks))
    return out.transpose(0, 1, 3, 2, 4).reshape(b, s, n_h * d)


def diff_attention(q1, q2, k1, k2, v, lam):
    b, n_h, s, d = q1.shape
    scale = d ** -0.5
    slopes = alibi_slopes(n_h)[:, None, None]
    outs = []
    for i in range(s // Q_BLOCK):
        s0, e = i * Q_BLOCK, (i + 1) * Q_BLOCK
        dist = (jnp.arange(s0, e)[:, None] - jnp.arange(e)[None, :]).astype(jnp.float32)
        bias = jnp.where(dist >= 0, -slopes * dist, -jnp.inf)
        a1 = jax.nn.softmax(jnp.einsum('bhqd,bhkd->bhqk', q1[:, :, s0:e], k1[:, :, :e]).astype(jnp.float32) * scale + bias, axis=-1)
        a2 = jax.nn.softmax(jnp.einsum('bhqd,bhkd->bhqk', q2[:, :, s0:e], k2[:, :, :e]).astype(jnp.float32) * scale + bias, axis=-1)
        a = (a1 - lam * a2).astype(v.dtype)
        outs.append(jnp.einsum('bhqk,bhkd->bhqd', a, v[:, :, :e]))
    return jnp.concatenate(outs, axis=2)


def peer_ffn(x, w_query, sub_keys, u, v):
    b, s, dm = x.shape
    xt = x.reshape(b * s // PEER_CHUNK, PEER_CHUNK, dm)

    def chunk(xc):
        q = (xc @ w_query).reshape(PEER_CHUNK, PEER_HEADS, 2, PEER_D_HALF)
        sc = jnp.einsum('chpd,hpnd->chpn', q, sub_keys).astype(jnp.float32)
        s1, i1 = lax.top_k(sc[:, :, 0], PEER_TOPK)
        s2, i2 = lax.top_k(sc[:, :, 1], PEER_TOPK)
        cand = (s1[..., :, None] + s2[..., None, :]).reshape(PEER_CHUNK, PEER_HEADS, PEER_TOPK * PEER_TOPK)
        cand_idx = (i1[..., :, None] * PEER_N_KEYS + i2[..., None, :]).reshape(PEER_CHUNK, PEER_HEADS, PEER_TOPK * PEER_TOPK)
        best, pos = lax.top_k(cand, PEER_TOPK)
        experts = jnp.take_along_axis(cand_idx, pos, axis=-1)
        g = jax.nn.softmax(best, axis=-1)
        u_sel = u[experts]
        v_sel = v[experts]
        h = jax.nn.gelu(jnp.einsum('cd,chkd->chk', xc, u_sel), approximate=False)
        act = (h.astype(jnp.float32) * g).astype(v_sel.dtype)
        return jnp.einsum('chk,chkd->cd', act, v_sel)

    return lax.map(chunk, xt).reshape(b, s, dm)


def setup_inputs(seed: int = 0) -> dict:
    key = jax.random.key(seed)
    ks = jax.random.split(key, 13)
    f32 = jnp.float32

    def nrm(k, shape, scale):
        return jax.random.normal(k, shape, f32) * scale

    def gain(k, shape):
        return 1.0 + 0.02 * jax.random.normal(k, shape, f32)

    return {
        'x': nrm(ks[0], (BATCH, SEQ, D_MODEL), 1.0),
        'norm1_g': gain(ks[1], (DEPTH, D_MODEL)),
        'w_in': nrm(ks[2], (DEPTH, D_MODEL, PROJ_COLS), D_MODEL ** -0.5),
        'moba_qk_norm_g': gain(ks[3], (DEPTH, 2, HEAD_DIM)),
        'diff_qk_norm_g': gain(ks[4], (DEPTH, 2, HEAD_DIM)),
        'diff_lambda': nrm(ks[5], (DEPTH, 4, HEAD_DIM), 0.1),
        'diff_subln_g': gain(ks[6], (DEPTH, DIFF_V_DIM)),
        'w_out': nrm(ks[7], (DEPTH, D_MIX, D_MODEL), D_MIX ** -0.5),
        'norm2_g': gain(ks[8], (DEPTH, D_MODEL)),
        'peer_w_query': nrm(ks[9], (DEPTH, D_MODEL, PEER_HEADS * PEER_D_QUERY), D_MODEL ** -0.5),
        'peer_sub_keys': nrm(ks[10], (DEPTH, PEER_HEADS, 2, PEER_N_KEYS, PEER_D_HALF), PEER_D_HALF ** -0.5),
        'peer_u': nrm(ks[11], (DEPTH, PEER_N_EXPERTS, D_MODEL), D_MODEL ** -0.5),
        'peer_v': nrm(ks[12], (DEPTH, PEER_N_EXPERTS, D_MODEL), 0.3),
    }


def reference(x, norm1_g, w_in, moba_qk_norm_g, diff_qk_norm_g, diff_lambda, diff_subln_g, w_out, norm2_g, peer_w_query, peer_sub_keys, peer_u, peer_v):
    b, s, _ = x.shape
    for l in range(DEPTH):
        lam_init = lambda_init_fn(l)
        h = rms_norm(x, norm1_g[l])
        proj = h @ w_in[l]
        mq, mk, mv, dq, dk, dv = jnp.split(proj, SPLITS, axis=-1)
        mq = rms_norm(split_heads(mq, MOBA_HEADS, HEAD_DIM), moba_qk_norm_g[l, 0])
        mk = rms_norm(split_heads(mk, MOBA_HEADS, HEAD_DIM), moba_qk_norm_g[l, 1])
        moba_out = moba_attention(mq, mk, split_heads(mv, MOBA_HEADS, HEAD_DIM))
        dq = rms_norm(dq.reshape(b, s, DIFF_HEADS, 2, HEAD_DIM).transpose(0, 2, 3, 1, 4), diff_qk_norm_g[l, 0])
        dk = rms_norm(dk.reshape(b, s, DIFF_HEADS, 2, HEAD_DIM).transpose(0, 2, 3, 1, 4), diff_qk_norm_g[l, 1])
        lam_p = diff_lambda[l].astype(jnp.float32)
        lam = jnp.exp(jnp.dot(lam_p[0], lam_p[1])) - jnp.exp(jnp.dot(lam_p[2], lam_p[3])) + lam_init
        diff_o = diff_attention(dq[:, :, 0], dq[:, :, 1], dk[:, :, 0], dk[:, :, 1], split_heads(dv, DIFF_HEADS, DIFF_V_DIM), lam)
        diff_o = rms_norm(diff_o, diff_subln_g[l]) * (1.0 - lam_init)
        diff_out = diff_o.transpose(0, 2, 1, 3).reshape(b, s, DIFF_V_W)
        x = x + jnp.concatenate([moba_out, diff_out], axis=-1) @ w_out[l]
        x = x + peer_ffn(rms_norm(x, norm2_g[l]), peer_w_query[l], peer_sub_keys[l], peer_u[l], peer_v[l])
    return x
```

```cpp
#include <hip/hip_runtime.h>
#include <hip/hip_bf16.h>
#include <cstdio>
#include <cstdint>
#include <cmath>
namespace pg8 {
#define PG8_LAS __attribute__((address_space(3)))
typedef unsigned short bf16_t;
typedef short bf16x8 __attribute__((ext_vector_type(8)));
typedef float f32x4 __attribute__((ext_vector_type(4)));
typedef unsigned u32x4 __attribute__((ext_vector_type(4)));
constexpr int BM = 256, BK = 64, HALF = 128, HTB = HALF * BK * 2  , STAGE_BYTES = 8 * HTB, NXCD = 8, WGM = 8;

__host__ __device__ __forceinline__ int lds_byte(int r, int c) { const int st = (r >> 4) * 2 + (c >> 5), rr = r & 15, cc = c & 31, ob = rr * 64 + cc * 2; return st * 1024 + (ob ^ (((ob >> 9) & 1) << 5)); }
__host__ __device__ __forceinline__ void stage_rc(int b, int& R, int& C) { const int st = b / 1024, sb = b % 1024, swz = sb ^ (((sb >> 9) & 1) << 5); R = (st >> 1) * 16 + swz / 64; C = (st & 1) * 32 + (swz % 64) / 2; }
__host__ __device__ __forceinline__ int perm32(int rho) { const int n = rho >> 4, i = rho & 15; return 8 * (i >> 2) + 4 * n + (i & 3); }

struct Unit { int pm, pn; };
struct Gemm { const bf16_t* A; const bf16_t* Bt; int M, N, K; };

struct StaticOrder {
    int nM, nN, nwg, G, c;
    __host__ __device__ void init(int M, int N, int G_, int c_) { nM = M / BM; nN = N / BM; nwg = nM * nN; G = G_; c = c_; }
    __host__ __device__ bool next(int i, Unit& u) const {
        const long L = (long)i * G + c; if (L >= nwg) return false;
        int wgid = (int)L; { const int q = nwg / NXCD, r = nwg % NXCD, xcd = wgid % NXCD, off = wgid / NXCD; wgid = (xcd < r ? xcd * (q + 1) : r * (q + 1) + (xcd - r) * q) + off; }
        const int nig = WGM * nN, gid = wgid / nig, fm = gid * WGM, gsz = (nM - fm) < WGM ? (nM - fm) : WGM;
        u.pm = fm + ((wgid % nig) % gsz); u.pn = (wgid % nig) / gsz; return true;
    }
    __device__ __forceinline__ void a_ready(const Unit&) const {}
    __device__ __forceinline__ void done(const Unit&) const {}
};

__device__ __forceinline__ unsigned cvt_pk_bf16(float lo, float hi) { unsigned r; asm volatile("v_cvt_pk_bf16_f32 %0, %1, %2" : "=v"(r) : "v"(lo), "v"(hi)); return r; }
typedef unsigned u32x2 __attribute__((ext_vector_type(2)));

struct EpiBf16 {
    static constexpr bool PERM = true, AFTER_DRAIN = false;
    bf16_t* O; int ldc;
    __device__ __forceinline__ void operator()(const f32x4 (&acc)[2][2][4][2], const Unit& u, int wr, int wc, int fr, int fq) const {
        const int row0 = u.pm * BM + wr * 64 + fr; const int col0 = u.pn * BM + wc * 32 + 8 * fq;
#pragma unroll
        for (int ai = 0; ai < 2; ++ai)
#pragma unroll
            for (int m = 0; m < 4; ++m) { bf16_t* rowp = O + (size_t)(row0 + ai * HALF + m * 16) * ldc + col0;
#pragma unroll
                for (int bj = 0; bj < 2; ++bj) { const f32x4 v0 = acc[ai][bj][m][0], v1 = acc[ai][bj][m][1];
                    u32x4 w; w.x = cvt_pk_bf16(v0[0], v0[1]); w.y = cvt_pk_bf16(v0[2], v0[3]); w.z = cvt_pk_bf16(v1[0], v1[1]); w.w = cvt_pk_bf16(v1[2], v1[3]);
                    *(u32x4*)(rowp + bj * HALF) = w; } }
    }
};

struct EpiProj {
    static constexpr bool PERM = true, AFTER_DRAIN = false;
    bf16_t* P; const float *gmq, *gmk, *gdq, *gdk; float* kpart; float c2;
    __device__ __forceinline__ void operator()(const f32x4 (&acc)[2][2][4][2], const Unit& u, int wr, int wc, int fr, int fq) const {
        const int type = u.pn >> 1;
        const float* g = type == 0 ? gmq : type == 1 ? gmk : type == 3 ? gdq : type == 4 ? gdk : nullptr;
        const float sc0 = (type == 0 || type == 3) ? c2 : 1.f;
        f32x4 gv[2][2];
#pragma unroll
        for (int bj = 0; bj < 2; ++bj)
#pragma unroll
            for (int n = 0; n < 2; ++n) gv[bj][n] = g ? (*(const f32x4*)(g + 32 * bj + 8 * fq + 4 * n)) * sc0 : (f32x4){1.f, 1.f, 1.f, 1.f};
        f32x4 cs[2][2];
#pragma unroll
        for (int bj = 0; bj < 2; ++bj)
#pragma unroll
            for (int n = 0; n < 2; ++n) cs[bj][n] = (f32x4){0.f, 0.f, 0.f, 0.f};
        const int row0 = u.pm * BM + wr * 64 + fr; const int col0 = u.pn * BM + wc * 64 + 8 * fq;
#pragma unroll
        for (int ai = 0; ai < 2; ++ai)
#pragma unroll
            for (int m = 0; m < 4; ++m) {
                f32x4 v[2][2];
#pragma unroll
                for (int bj = 0; bj < 2; ++bj)
#pragma unroll
                    for (int n = 0; n < 2; ++n) v[bj][n] = acc[ai][bj][m][n];
                if (g) {
                    float ss = 0.f;
#pragma unroll
                    for (int bj = 0; bj < 2; ++bj)
#pragma unroll
                        for (int n = 0; n < 2; ++n) { const f32x4 x = v[bj][n]; ss += (x[0] * x[0] + x[1] * x[1]) + (x[2] * x[2] + x[3] * x[3]); }
                    ss += __shfl_xor(ss, 16); ss += __shfl_xor(ss, 32);
                    const float r = 1.0f / sqrtf(ss * (1.0f / 64.0f) + 1e-6f);
#pragma unroll
                    for (int bj = 0; bj < 2; ++bj)
#pragma unroll
                        for (int n = 0; n < 2; ++n) { v[bj][n] = v[bj][n] * r * gv[bj][n]; cs[bj][n] += v[bj][n]; }
                }
                bf16_t* rowp = P + (size_t)(row0 + ai * HALF + m * 16) * 3072 + col0;
#pragma unroll
                for (int bj = 0; bj < 2; ++bj) { const f32x4 v0 = v[bj][0], v1 = v[bj][1];
                    u32x4 w; w.x = cvt_pk_bf16(v0[0], v0[1]); w.y = cvt_pk_bf16(v0[2], v0[3]); w.z = cvt_pk_bf16(v1[0], v1[1]); w.w = cvt_pk_bf16(v1[2], v1[3]);
                    *(u32x4*)(rowp + bj * 32) = w; }
            }
        if (type == 1) {
#pragma unroll
            for (int bj = 0; bj < 2; ++bj)
#pragma unroll
                for (int n = 0; n < 2; ++n) { f32x4 c = cs[bj][n];
#pragma unroll
                    for (int o = 1; o < 16; o <<= 1) { c[0] += __shfl_xor(c[0], o); c[1] += __shfl_xor(c[1], o); c[2] += __shfl_xor(c[2], o); c[3] += __shfl_xor(c[3], o); }
                    if (fr == 0) *(f32x4*)(kpart + (size_t)(u.pm * 2 + wr) * 512 + (u.pn - 2) * 256 + wc * 64 + bj * 32 + fq * 8 + n * 4) = c; }
        }
    }
};

struct EpiOut {
    static constexpr bool PERM = false, AFTER_DRAIN = false;
    const float* x; float* out; bf16_t* xmb; float* ssq;
    __device__ __forceinline__ void operator()(const f32x4 (&acc)[2][2][4][2], const Unit& u, int wr, int wc, int fr, int fq) const {
        const int row0 = u.pm * BM + wr * 64 + fr; const int col0 = u.pn * BM + wc * 32 + 4 * fq;
#pragma unroll
        for (int ai = 0; ai < 2; ++ai)
#pragma unroll
            for (int m = 0; m < 4; ++m) { const int row = row0 + ai * HALF + m * 16; const size_t off = (size_t)row * 1024 + col0; float s = 0.f;
#pragma unroll
                for (int bj = 0; bj < 2; ++bj)
#pragma unroll
                    for (int n = 0; n < 2; ++n) { const f32x4 xv = *(const f32x4*)(x + off + bj * HALF + n * 16); const f32x4 y = xv + acc[ai][bj][m][n];
                        *(f32x4*)(out + off + bj * HALF + n * 16) = y; u32x2 w; w.x = cvt_pk_bf16(y[0], y[1]); w.y = cvt_pk_bf16(y[2], y[3]); *(u32x2*)(xmb + off + bj * HALF + n * 16) = w;
                        s += (y[0] * y[0] + y[1] * y[1]) + (y[2] * y[2] + y[3] * y[3]); }
                s += __shfl_xor(s, 16); s += __shfl_xor(s, 32);
                if (fq == 0) ssq[(size_t)row * 16 + u.pn * 4 + wc] = s;
                if (m & 1) asm volatile("" ::: "memory"); }
    }
};
template <class Epi, class Sched, bool ALIGN_EPI = false, bool SP2 = false>
__device__ __forceinline__ void gemm_phase(PG8_LAS unsigned char* lds, const Gemm g, const Sched& S, const Epi& E) {
    const int tid = threadIdx.x, wid = __builtin_amdgcn_readfirstlane(tid >> 6), lane = tid & 63, wr = wid >> 2, wc = wid & 3, fr = lane & 15, fq = lane >> 4;
    const int K = g.K, nt = K / BK;
    unsigned voffA[2], voffB[2];
#pragma unroll
    for (int i = 0; i < 2; ++i) { int R, C; stage_rc(tid * 16 + i * 8192, R, C); const int Rb = Epi::PERM ? ((R & ~31) + perm32(R & 31)) : R;
        voffA[i] = (unsigned)(R * K + C) * 2u; voffB[i] = (unsigned)(Rb * K + C) * 2u; }
    const size_t kstep = (size_t)(BK * 2);
    const size_t hstep = (size_t)HALF * K * 2;
    const size_t tstep = 2 * hstep;
    const unsigned ldsw = (unsigned)wid * 1024u;
    const int aoff = lds_byte(wr * 64 + fr, fq * 8), boff = lds_byte(wc * 32 + fr, fq * 8);
#define PG8_SA(b, h) (((b) * 2 + (h)) * HTB)
#define PG8_SB(b, h) ((4 + (b) * 2 + (h)) * HTB)
#define PG8_STAGE(bufoff, gbase, voff) do { _Pragma("unroll") for (int _i = 0; _i < 2; ++_i) \
        __builtin_amdgcn_global_load_lds((const unsigned*)((const char*)(gbase) + (voff)[_i]), (PG8_LAS unsigned*)(lds + (bufoff) + ldsw + _i * 8192), 16, 0, 0); } while (0)
#define PG8_LDA(dst, b, h) do { _Pragma("unroll") for (int m = 0; m < 4; ++m) _Pragma("unroll") for (int k = 0; k < 2; ++k) dst[m][k] = *(const PG8_LAS bf16x8*)(lds + PG8_SA(b, h) + aoff + m * 2048 + k * 1024); } while (0)
#define PG8_LDB(dst, b, h) do { _Pragma("unroll") for (int n = 0; n < 2; ++n) _Pragma("unroll") for (int k = 0; k < 2; ++k) dst[n][k] = *(const PG8_LAS bf16x8*)(lds + PG8_SB(b, h) + boff + n * 2048 + k * 1024); } while (0)
#define PG8_MMA(ai, bj, At, Bt) do { __builtin_amdgcn_s_setprio(1); _Pragma("unroll") for (int m = 0; m < 4; ++m) _Pragma("unroll") for (int n = 0; n < 2; ++n) _Pragma("unroll") for (int k = 0; k < 2; ++k) \
        acc[ai][bj][m][n] = __builtin_amdgcn_mfma_f32_16x16x32_bf16(Bt[n][k], At[m][k], acc[ai][bj][m][n], 0, 0, 0); __builtin_amdgcn_s_setprio(0); } while (0)
#define PG8_WAIT_V(n) asm volatile("s_waitcnt vmcnt(" #n ")" ::: "memory")
#define PG8_WAIT_L(n) asm volatile("s_waitcnt lgkmcnt(" #n ")" ::: "memory")
#define PG8_BAR __builtin_amdgcn_s_barrier()
#define PG8_SCHED __builtin_amdgcn_sched_barrier(0)
    Unit cur, nxt; int ui = 0;
    if (!S.next(0, cur)) return;
    f32x4 acc[2][2][4][2];
#pragma unroll
    for (int a = 0; a < 2; ++a)
#pragma unroll
        for (int b = 0; b < 2; ++b)
#pragma unroll
            for (int m = 0; m < 4; ++m)
#pragma unroll
                for (int n = 0; n < 2; ++n) acc[a][b][m][n] = (f32x4){0.f, 0.f, 0.f, 0.f};
    bf16x8 At[4][2], B0[2][2], B1[2][2];
    const char* cA = (const char*)g.A + (size_t)cur.pm * tstep; const char* cB = (const char*)g.Bt + (size_t)cur.pn * tstep;
    S.a_ready(cur);
    if constexpr (SP2) {
        PG8_STAGE(PG8_SB(0, 0), cB, voffB); PG8_STAGE(PG8_SB(0, 1), cB + hstep, voffB); PG8_STAGE(PG8_SA(0, 0), cA, voffA); PG8_STAGE(PG8_SA(0, 1), cA + hstep, voffA);
        if (wr == 1) PG8_BAR;
        PG8_WAIT_V(2); PG8_BAR;
        PG8_STAGE(PG8_SB(1, 0), cB + kstep, voffB); PG8_STAGE(PG8_SA(1, 0), cA + kstep, voffA); PG8_STAGE(PG8_SB(1, 1), cB + hstep + kstep, voffB);
        PG8_WAIT_V(6); PG8_BAR;
    } else {
        PG8_STAGE(PG8_SB(0, 0), cB, voffB); PG8_STAGE(PG8_SA(0, 0), cA, voffA); PG8_STAGE(PG8_SB(0, 1), cB + hstep, voffB); PG8_STAGE(PG8_SA(0, 1), cA + hstep, voffA);
        if (wr == 1) PG8_BAR;
        PG8_WAIT_V(4); PG8_BAR;
        PG8_STAGE(PG8_SB(1, 0), cB + kstep, voffB); PG8_STAGE(PG8_SA(1, 0), cA + kstep, voffA); PG8_STAGE(PG8_SB(1, 1), cB + hstep + kstep, voffB);
        PG8_WAIT_V(6); PG8_BAR;
    }
    for (;;) {
        const bool has_next = S.next(ui + 1, nxt);
        const char* nA = has_next ? (const char*)g.A + (size_t)nxt.pm * tstep : cA; const char* nB = has_next ? (const char*)g.Bt + (size_t)nxt.pn * tstep : cB;
        for (int t = 0; t < nt; t += 2) {
            const bool last = (t == nt - 2);
            const char* a1 = cA + (size_t)(t + 1) * kstep;
            const char* a2 = last ? nA : cA + (size_t)(t + 2) * kstep; const char* b2 = last ? nB : cB + (size_t)(t + 2) * kstep;
            const char* a3 = a2 + kstep; const char* b3 = b2 + kstep;
            if (last && has_next) S.a_ready(nxt);
            if constexpr (SP2) {
            PG8_LDB(B0, 0, 0); PG8_LDB(B1, 0, 1); PG8_SCHED; PG8_LDA(At, 0, 0); PG8_STAGE(PG8_SA(1, 1), a1 + hstep, voffA);
            PG8_WAIT_V(8); PG8_WAIT_L(0); PG8_BAR; PG8_MMA(0, 0, At, B0); PG8_MMA(0, 1, At, B1); PG8_BAR; PG8_SCHED;
            PG8_LDA(At, 0, 1); PG8_STAGE(PG8_SB(0, 0), b2, voffB); PG8_STAGE(PG8_SB(0, 1), b2 + hstep, voffB); PG8_STAGE(PG8_SA(0, 0), a2, voffA);
            PG8_WAIT_V(8); PG8_WAIT_L(0); PG8_BAR; PG8_MMA(1, 0, At, B0); PG8_MMA(1, 1, At, B1); PG8_BAR; PG8_SCHED;
            PG8_LDB(B0, 1, 0); PG8_LDB(B1, 1, 1); PG8_SCHED; PG8_LDA(At, 1, 0); PG8_STAGE(PG8_SA(0, 1), a2 + hstep, voffA);
            PG8_WAIT_V(8); PG8_WAIT_L(0); PG8_BAR; PG8_MMA(0, 0, At, B0); PG8_MMA(0, 1, At, B1); PG8_BAR; PG8_SCHED;
            PG8_LDA(At, 1, 1); PG8_STAGE(PG8_SB(1, 0), b3, voffB); PG8_STAGE(PG8_SB(1, 1), b3 + hstep, voffB); PG8_STAGE(PG8_SA(1, 0), a3, voffA);
            PG8_WAIT_V(8); PG8_WAIT_L(0); PG8_BAR; PG8_MMA(1, 0, At, B0); PG8_MMA(1, 1, At, B1); PG8_BAR; PG8_SCHED;
            } else {
            PG8_LDB(B0, 0, 0); PG8_SCHED; PG8_LDA(At, 0, 0); PG8_STAGE(PG8_SA(1, 1), a1 + hstep, voffA);
            PG8_WAIT_L(8); PG8_BAR; PG8_WAIT_L(0); PG8_MMA(0, 0, At, B0); PG8_BAR; PG8_SCHED;
            PG8_LDB(B1, 0, 1); PG8_STAGE(PG8_SB(0, 0), b2, voffB);
            PG8_BAR; PG8_WAIT_L(0); PG8_MMA(0, 1, At, B1); PG8_BAR;
            PG8_LDA(At, 0, 1); PG8_STAGE(PG8_SA(0, 0), a2, voffA);
            PG8_BAR; PG8_WAIT_L(0); PG8_MMA(1, 0, At, B0); PG8_BAR; PG8_SCHED;
            PG8_STAGE(PG8_SB(0, 1), b2 + hstep, voffB);
            PG8_WAIT_V(6); PG8_BAR; PG8_MMA(1, 1, At, B1); PG8_BAR;
            PG8_LDB(B0, 1, 0); PG8_SCHED; PG8_LDA(At, 1, 0); PG8_STAGE(PG8_SA(0, 1), a2 + hstep, voffA);
            PG8_WAIT_L(8); PG8_BAR; PG8_WAIT_L(0); PG8_MMA(0, 0, At, B0); PG8_BAR; PG8_SCHED;
            PG8_LDB(B1, 1, 1); PG8_STAGE(PG8_SB(1, 0), b3, voffB);
            PG8_BAR; PG8_WAIT_L(0); PG8_MMA(0, 1, At, B1); PG8_BAR;
            PG8_LDA(At, 1, 1); PG8_STAGE(PG8_SA(1, 0), a3, voffA);
            PG8_BAR; PG8_WAIT_L(0); PG8_MMA(1, 0, At, B0); PG8_BAR; PG8_SCHED;
            PG8_STAGE(PG8_SB(1, 1), b3 + hstep, voffB);
            PG8_WAIT_V(6); PG8_BAR; PG8_MMA(1, 1, At, B1); PG8_BAR;
            }
        }
        if constexpr (ALIGN_EPI) { if (wr == 0) PG8_BAR; }
        if constexpr (!Epi::AFTER_DRAIN) { E(acc, cur, wr, wc, fr, fq); S.done(cur); }
        if (!has_next) break;
#pragma unroll
        for (int a = 0; a < 2; ++a)
#pragma unroll
            for (int b = 0; b < 2; ++b)
#pragma unroll
                for (int m = 0; m < 4; ++m)
#pragma unroll
                    for (int n = 0; n < 2; ++n) acc[a][b][m][n] = (f32x4){0.f, 0.f, 0.f, 0.f};
        cur = nxt; cA = nA; cB = nB; ++ui;
        if constexpr (ALIGN_EPI) { if (wr == 1) PG8_BAR; }
    }
    PG8_WAIT_V(0);
    if constexpr (!ALIGN_EPI) { if (wr == 0) PG8_BAR; }
    PG8_BAR;
    if constexpr (Epi::AFTER_DRAIN) { E.fused(acc, cur, wr, wc, fr, fq, lds, wid, lane); S.done(cur); }
#undef PG8_SA
#undef PG8_SB
#undef PG8_STAGE
#undef PG8_LDA
#undef PG8_LDB
#undef PG8_MMA
#undef PG8_WAIT_V
#undef PG8_WAIT_L
#undef PG8_BAR
#undef PG8_SCHED
}
}
namespace att {
using bf16 = __hip_bfloat16;
using bf16x8 = __attribute__((ext_vector_type(8))) short;
using s16x4 = __attribute__((ext_vector_type(4))) short;
using f32x16 = __attribute__((ext_vector_type(16))) float;
using u32x4 = __attribute__((ext_vector_type(4))) unsigned;
constexpr int PITCH = 3072, QB = 256, KVBLK = 64, NW = 8;
constexpr int SLOTB = 8192, LDS_K = 0, LDS_V = 2 * SLOTB, LDS_WS = 4 * SLOTB, LDS_OST = LDS_WS + NW * 64 * 4, LDS_BYTES = LDS_OST + NW * 4096;
__device__ __forceinline__ int crow(int r, int hi) { return (r & 3) + 8 * (r >> 2) + 4 * hi; }
typedef float f32x2_t __attribute__((ext_vector_type(2))); typedef __bf16 bf16x2_t __attribute__((ext_vector_type(2)));
__device__ __forceinline__ unsigned cvtpk_s(float lo, float hi) { f32x2_t v = {lo, hi}; bf16x2_t b = __builtin_convertvector(v, bf16x2_t); return __builtin_bit_cast(unsigned, b); }

__device__ __forceinline__ void qkt(f32x16& p0, f32x16& p1, const char* Kslot, const bf16x8* qr, int r32, int hi) {
  const char* kb = Kslot + hi * 1024 + r32 * 16;
  const f32x16 z = {};
#pragma unroll
  for (int d0 = 0; d0 < 4; ++d0) {
    const bf16x8 b0 = *reinterpret_cast<const bf16x8*>(kb + d0 * 2048);
    const bf16x8 b1 = *reinterpret_cast<const bf16x8*>(kb + d0 * 2048 + 512);
    if (d0 == 0) { p0 = __builtin_amdgcn_mfma_f32_32x32x16_bf16(b0, qr[0], z, 0, 0, 0); p1 = __builtin_amdgcn_mfma_f32_32x32x16_bf16(b1, qr[0], z, 0, 0, 0); }
    else { p0 = __builtin_amdgcn_mfma_f32_32x32x16_bf16(b0, qr[d0], p0, 0, 0, 0); p1 = __builtin_amdgcn_mfma_f32_32x32x16_bf16(b1, qr[d0], p1, 0, 0, 0); } }
}
__device__ __forceinline__ void pv(f32x16* o, int vb, bf16x8 pa0, bf16x8 pa1, bf16x8 pa2, bf16x8 pa3) {
#pragma unroll
  for (int d0 = 0; d0 < 2; ++d0) { s16x4 lo[4], hi[4];
#pragma unroll
    for (int ks = 0; ks < 4; ++ks) {
      asm volatile("ds_read_b64_tr_b16 %0,%1 offset:%c2" : "=&v"(lo[ks]) : "v"(vb), "i"(d0 * 4096 + ks * 1024) : "memory");
      asm volatile("ds_read_b64_tr_b16 %0,%1 offset:%c2" : "=&v"(hi[ks]) : "v"(vb), "i"(d0 * 4096 + ks * 1024 + 512) : "memory"); }
    asm volatile("s_waitcnt lgkmcnt(0)" ::: "memory"); __builtin_amdgcn_sched_barrier(0);
#define PK(k) (bf16x8){lo[k][0], lo[k][1], lo[k][2], lo[k][3], hi[k][0], hi[k][1], hi[k][2], hi[k][3]}
    o[d0] = __builtin_amdgcn_mfma_f32_32x32x16_bf16(pa0, PK(0), o[d0], 0, 0, 0);
    o[d0] = __builtin_amdgcn_mfma_f32_32x32x16_bf16(pa1, PK(1), o[d0], 0, 0, 0);
    o[d0] = __builtin_amdgcn_mfma_f32_32x32x16_bf16(pa2, PK(2), o[d0], 0, 0, 0);
    o[d0] = __builtin_amdgcn_mfma_f32_32x32x16_bf16(pa3, PK(3), o[d0], 0, 0, 0);
#undef PK
  }
}
struct UnitDesc { const bf16* Q; const bf16* K; const bf16* V; bf16* O; float slope2; int nb; int moba; const float* kpart; };
__device__ __forceinline__ void attn_unit(const UnitDesc& U, char* shm) {
  const int tid = threadIdx.x, lane = tid & 63, r32 = lane & 31, hi = lane >> 5; const int wid = __builtin_amdgcn_readfirstlane(tid >> 6);
  const int nb = U.nb, q0 = nb * QB;
  const bf16* Qw = U.Q + (long)(q0 + wid * 32) * PITCH;
  const unsigned lds0 = (unsigned)(uintptr_t)shm;
  float* wsf = (float*)(shm + LDS_WS) + wid * 64;
  bf16x8 qr[4];
#pragma unroll
  for (int d0 = 0; d0 < 4; ++d0) qr[d0] = *reinterpret_cast<const bf16x8*>(&Qw[(long)r32 * PITCH + d0 * 16 + hi * 8]);
  unsigned sel = 0xffu;
  if (U.moba) {
    float g[4] = {0.f, 0.f, 0.f, 0.f};
    const bf16* qrow = Qw + (long)r32 * PITCH;
    for (int c = 0; c < 8; ++c) {
      const u32x4 qv = *reinterpret_cast<const u32x4*>(qrow + c * 8);
      float qf[8];
#pragma unroll
      for (int i = 0; i < 4; ++i) { qf[2 * i] = __uint_as_float(qv[i] << 16); qf[2 * i + 1] = __uint_as_float(qv[i] & 0xffff0000u); }
#pragma unroll
      for (int j = 0; j < 4; ++j) { const int n = 4 * hi + j;
        if (n < nb) { const float* k0 = U.kpart + (size_t)(n * 2) * 512 + c * 8; const float* k1 = k0 + 512;
#pragma unroll
          for (int i = 0; i < 8; ++i) g[j] += qf[i] * (k0[i] + k1[i]); } }
    }
    float ga[8];
#pragma unroll
    for (int j = 0; j < 4; ++j) { const float o = __shfl_xor(g[j], 32); ga[j] = hi ? o : g[j]; ga[4 + j] = hi ? g[j] : o; }
    sel = 0u;
#pragma unroll
    for (int n = 0; n < 8; ++n) { int rank = 0;
#pragma unroll
      for (int m = 0; m < 8; ++m) if (m != n) rank += (m < nb && (ga[m] > ga[n] || (ga[m] == ga[n] && m < n))) ? 1 : 0;
      if (n < nb && rank < 3) sel |= (1u << n); }
  }
  const int NT = 4 * (nb + 1);
  float mrun = -30000.f, lrun = 0.f; f32x16 o[2]; o[0] = f32x16{}; o[1] = f32x16{};
  const int qrel = wid * 32 + r32;
  const bf16* ksrc = U.K + (long)lane * PITCH + wid * 8;
  const bf16* vsrc = U.V + (long)(16 * (wid & 3) + (lane >> 2)) * PITCH + (wid >> 2) * 32 + (lane & 3) * 8;
  char* kdst = shm + LDS_K + wid * 1024 + lane * 16; char* vdst = shm + LDS_V + wid * 1024 + lane * 16;
  const int vb0 = (int)(lds0 + LDS_V) + ((lane >> 4) & 1) * 32 + (lane & 3) * 8 + (4 * hi + ((lane & 15) >> 2)) * 64;
  u32x4 kreg = *reinterpret_cast<const u32x4*>(ksrc), vreg = *reinterpret_cast<const u32x4*>(vsrc);
  const float s2 = U.slope2;
  for (int t = 0; t < NT; ++t) {
    const int slot = (t & 1) * SLOTB;
    *reinterpret_cast<u32x4*>(kdst + slot) = kreg; *reinterpret_cast<u32x4*>(vdst + slot) = vreg;
    __syncthreads();
    if (t + 1 < NT) { kreg = *reinterpret_cast<const u32x4*>(ksrc + (long)(t + 1) * KVBLK * PITCH); vreg = *reinterpret_cast<const u32x4*>(vsrc + (long)(t + 1) * KVBLK * PITCH); }
    f32x16 p0, p1; qkt(p0, p1, shm + LDS_K + slot, qr, r32, hi);
    const int jb = t - (NT - 4);
    const float base = s2 * (float)(64 * t - q0 + 4 * hi);
#pragma unroll
    for (int r = 0; r < 16; ++r) { const float kr = (float)((r & 3) + 8 * (r >> 2)); p0[r] += base + s2 * kr; p1[r] += base + s2 * (kr + 32.f); }
    if (jb >= 0) { const int kb = 64 * jb + 4 * hi;
#pragma unroll
      for (int r = 0; r < 16; ++r) { const int kv = kb + (r & 3) + 8 * (r >> 2); if (kv > qrel) p0[r] = -INFINITY; if (kv + 32 > qrel) p1[r] = -INFINITY; } }
    else if (!((sel >> (t >> 2)) & 1u)) {
#pragma unroll
      for (int r = 0; r < 16; ++r) { p0[r] = -INFINITY; p1[r] = -INFINITY; } }
    float rm = fmaxf(p0[0], p1[0]);
#pragma unroll
    for (int r = 1; r < 16; ++r) rm = fmaxf(rm, fmaxf(p0[r], p1[r]));
    rm = fmaxf(rm, __shfl_xor(rm, 32));
    const float mnew = fmaxf(mrun, rm), f = __builtin_amdgcn_exp2f(mrun - mnew); mrun = mnew;
    float ps = 0.f;
#pragma unroll
    for (int r = 0; r < 16; ++r) { p0[r] = __builtin_amdgcn_exp2f(p0[r] - mnew); p1[r] = __builtin_amdgcn_exp2f(p1[r] - mnew); ps += p0[r] + p1[r]; }
    lrun = lrun * f + ps;
    if (hi == 0) wsf[r32] = f;
    u32x4 pw0, pw1, pw2, pw3;
#pragma unroll
    for (int i = 0; i < 4; ++i) { pw0[i] = cvtpk_s(p0[2 * i], p0[2 * i + 1]); pw1[i] = cvtpk_s(p0[8 + 2 * i], p0[9 + 2 * i]); pw2[i] = cvtpk_s(p1[2 * i], p1[2 * i + 1]); pw3[i] = cvtpk_s(p1[8 + 2 * i], p1[9 + 2 * i]); }
    asm volatile("s_waitcnt lgkmcnt(0)" ::: "memory");
#pragma unroll
    for (int r = 0; r < 16; ++r) { const float fr_ = wsf[crow(r, hi)]; o[0][r] *= fr_; o[1][r] *= fr_; }
    pv(o, vb0 + slot, __builtin_bit_cast(bf16x8, pw0), __builtin_bit_cast(bf16x8, pw1), __builtin_bit_cast(bf16x8, pw2), __builtin_bit_cast(bf16x8, pw3));
  }
  lrun += __shfl_xor(lrun, 32);
  if (hi == 0) wsf[32 + r32] = lrun;
  asm volatile("s_waitcnt lgkmcnt(0)" ::: "memory");
  float rli[16];
#pragma unroll
  for (int r = 0; r < 16; ++r) rli[r] = 1.0f / wsf[32 + crow(r, hi)];
  bf16* Ow = U.O + (long)(q0 + wid * 32) * 1024;
  { bf16* stg = (bf16*)(shm + LDS_OST) + wid * 2048;
#pragma unroll
    for (int r = 0; r < 16; ++r) { const int orow = crow(r, hi);
#pragma unroll
      for (int d0 = 0; d0 < 2; ++d0) stg[orow * 64 + d0 * 32 + r32] = __float2bfloat16(o[d0][r] * rli[r]); }
    asm volatile("s_waitcnt lgkmcnt(0)" ::: "memory");
#pragma unroll
    for (int i = 0; i < 4; ++i) { const int row = i * 8 + (lane >> 3), ch = lane & 7; const u32x4 v = *(const u32x4*)(stg + row * 64 + ch * 8); *(u32x4*)(Ow + (long)row * 1024 + ch * 8) = v; } }
  asm volatile("s_waitcnt lgkmcnt(0)" ::: "memory");
  __syncthreads();
}
}
namespace peer {
using bf16 = __hip_bfloat16;
using bf16x8 = __attribute__((ext_vector_type(8))) short;
using f32x16 = __attribute__((ext_vector_type(16))) float;
using u32x4 = __attribute__((ext_vector_type(4))) unsigned;
__device__ __forceinline__ int crow(int r, int hi) { return (r & 3) + 8 * (r >> 2) + 4 * hi; }
__device__ __forceinline__ int f2key(float f) { const int b = __float_as_int(f); return b ^ ((b >> 31) & 0x7fffffff); }
__device__ __forceinline__ float key2f(int k) { return __int_as_float(k ^ ((k >> 31) & 0x7fffffff)); }
__device__ __forceinline__ void ins16(int (&L)[16], int v) {
#pragma unroll
  for (int i = 0; i < 16; ++i) { const int a = L[i]; L[i] = a > v ? a : v; v = a > v ? v : a; }
}
__device__ __forceinline__ void merge16(int (&L)[16]) {
  int M[16];
#pragma unroll
  for (int i = 0; i < 16; ++i) { const int o = __shfl_xor(L[15 - i], 32); M[i] = L[i] > o ? L[i] : o; }
#pragma unroll
  for (int s = 8; s >= 1; s >>= 1)
#pragma unroll
    for (int i = 0; i < 16; ++i) if ((i & s) == 0) { const int a = M[i], b = M[i + s]; M[i] = a > b ? a : b; M[i + s] = a > b ? b : a; }
#pragma unroll
  for (int i = 0; i < 16; ++i) L[i] = M[i];
}
#define PEER_CAND_LIST(X) \
  X(0,0,0, 2,1) X(1,0,1, 2,2) X(2,0,2, 2,3) X(3,0,3, 2,4) X(4,0,4, 3,0) X(5,0,5, 3,1) X(6,0,6, 3,2) X(7,0,7, 3,3) X(8,0,8, 4,0) X(9,0,9, 4,1) X(10,0,10, 4,2) X(11,0,11, 5,0) X(12,0,12, 5,1) X(13,0,13, 6,0) X(14,0,14, 6,1) X(15,0,15, 7,0) X(16,1,0, 7,1) X(17,1,1, 8,0) X(18,1,2, 9,0) X(19,1,3, 10,0) X(20,1,4, 11,0) X(21,1,5, 12,0) X(22,1,6, 13,0) X(23,1,7, 14,0) X(24,2,0, 15,0)

__device__ __forceinline__ void topk_task(const bf16* QP, const bf16* SK, const float* ssq, int* LE, float* LG, int tg, int h, int lane) {
  const int r32 = lane & 31, hi = lane >> 5; const int t = tg * 32 + r32;
  int A[16], B[16];
#pragma unroll
  for (int p = 0; p < 2; ++p) {
    bf16x8 qf[8];
#pragma unroll
    for (int ks = 0; ks < 8; ++ks) qf[ks] = *reinterpret_cast<const bf16x8*>(QP + (size_t)t * 2048 + h * 256 + p * 128 + ks * 16 + hi * 8);
    int L[16];
#pragma unroll
    for (int i = 0; i < 16; ++i) L[i] = (int)0x80000000;
    const bf16* kb = SK + (size_t)((h * 2 + p) * 128) * 128;
#pragma unroll 1
    for (int i = 0; i < 4; ++i) {
      f32x16 acc = {};
#pragma unroll
      for (int ks = 0; ks < 8; ++ks) { const bf16x8 a = *reinterpret_cast<const bf16x8*>(kb + (size_t)(i * 32 + r32) * 128 + ks * 16 + hi * 8); acc = __builtin_amdgcn_mfma_f32_32x32x16_bf16(a, qf[ks], acc, 0, 0, 0); }
#pragma unroll
      for (int r = 0; r < 16; ++r) { const int key = i * 32 + crow(r, hi); ins16(L, (f2key(acc[r]) & ~127) | key); }
    }
    merge16(L);
#pragma unroll
    for (int i = 0; i < 16; ++i) { if (p == 0) A[i] = L[i]; else B[i] = L[i]; }
  }
  float Af[16], Bf[16];
#pragma unroll
  for (int i = 0; i < 16; ++i) { Af[i] = key2f(A[i] & ~127); Bf[i] = key2f(B[i] & ~127); }
  float C[25];
#define X(c, i0, j0, i1, j1) C[c] = hi ? (Af[i1] + Bf[j1]) : (Af[i0] + Bf[j0]);
  PEER_CAND_LIST(X)
#undef X
  int L[16];
#pragma unroll
  for (int i = 0; i < 16; ++i) L[i] = (int)0x80000000;
#pragma unroll
  for (int c = 0; c < 25; ++c) ins16(L, f2key(C[c]));
  merge16(L);
  const int tau = L[15]; const float cmax = Af[0] + Bf[0];
  float s = 0.f;
#pragma unroll
  for (int i = 0; i < 16; ++i) s += ssq[(size_t)t * 16 + i];
  const float rstd = 1.0f / sqrtf(s * (1.0f / 1024.0f) + 1e-6f);
  const float k2 = rstd * 1.4426950408889634f;
  float E[25]; float den = 0.f; int cnt = 0; unsigned selm = 0u;
#pragma unroll
  for (int c = 0; c < 25; ++c) { const bool sl = f2key(C[c]) >= tau; E[c] = sl ? __builtin_amdgcn_exp2f((C[c] - cmax) * k2) : 0.f; den += E[c]; cnt += sl ? 1 : 0; selm |= sl ? (1u << c) : 0u; }
  den += __shfl_xor(den, 32);
  const int ocnt = __shfl_xor(cnt, 32);
  int pos = hi ? ocnt : 0;
  const float rden = 1.0f / den;
  int* le = LE + (size_t)t * 128 + h * 16; float* lg = LG + (size_t)t * 128 + h * 16;
#define X(c, i0, j0, i1, j1) { if (((selm >> c) & 1u) && pos < 16) { const int ka = (hi ? A[i1] : A[i0]) & 127, kb2 = (hi ? B[j1] : B[j0]) & 127; le[pos] = ka * 128 + kb2; lg[pos] = E[c] * rden; ++pos; } }
  PEER_CAND_LIST(X)
#undef X
}

__device__ __forceinline__ float gelu_erf(float v) { return 0.5f * v * (1.0f + erff(v * 0.70710678118654752f)); }
__device__ __forceinline__ void unpack8(const u32x4 w, float (&f)[8]) {
#pragma unroll
  for (int i = 0; i < 4; ++i) { f[2 * i] = __uint_as_float(w[i] << 16); f[2 * i + 1] = __uint_as_float(w[i] & 0xffff0000u); }
}
__device__ __forceinline__ void expert_token(const bf16* XMB, const bf16* U16, const bf16* V16, const float* ssq, const int* LE, const float* LG, float* out, int t, int lane) {
  float x[16];
  { const u32x4 a = *reinterpret_cast<const u32x4*>(XMB + (size_t)t * 1024 + lane * 8), b = *reinterpret_cast<const u32x4*>(XMB + (size_t)t * 1024 + 512 + lane * 8);
    float fa[8], fb[8]; unpack8(a, fa); unpack8(b, fb);
#pragma unroll
    for (int i = 0; i < 8; ++i) { x[i] = fa[i]; x[8 + i] = fb[i]; } }
  float s = 0.f;
#pragma unroll
  for (int i = 0; i < 16; ++i) s += ssq[(size_t)t * 16 + i];
  const float rstd = 1.0f / sqrtf(s * (1.0f / 1024.0f) + 1e-6f);
  const int e0 = LE[(size_t)t * 128 + lane] & 16383, e1 = LE[(size_t)t * 128 + 64 + lane] & 16383;
  const float g0 = LG[(size_t)t * 128 + lane], g1 = LG[(size_t)t * 128 + 64 + lane];
  float acc[16];
#pragma unroll
  for (int i = 0; i < 16; ++i) acc[i] = 0.f;
#pragma unroll 1
  for (int k0 = 0; k0 < 128; k0 += 4) {
    u32x4 ua[4], ub[4], va[4], vb[4]; float gk[4];
#pragma unroll
    for (int j = 0; j < 4; ++j) { const int k = k0 + j; const int e = (k0 < 64) ? __builtin_amdgcn_readlane(e0, k & 63) : __builtin_amdgcn_readlane(e1, k & 63);
      gk[j] = (k0 < 64) ? __builtin_bit_cast(float, __builtin_amdgcn_readlane(__builtin_bit_cast(int, g0), k & 63)) : __builtin_bit_cast(float, __builtin_amdgcn_readlane(__builtin_bit_cast(int, g1), k & 63));
      const bf16* ur = U16 + (size_t)e * 1024 + lane * 8; const bf16* vr = V16 + (size_t)e * 1024 + lane * 8;
      ua[j] = *reinterpret_cast<const u32x4*>(ur); ub[j] = *reinterpret_cast<const u32x4*>(ur + 512);
      va[j] = *reinterpret_cast<const u32x4*>(vr); vb[j] = *reinterpret_cast<const u32x4*>(vr + 512); }
    float d[4];
#pragma unroll
    for (int j = 0; j < 4; ++j) { float fa[8], fb[8]; unpack8(ua[j], fa); unpack8(ub[j], fb); float q = 0.f;
#pragma unroll
      for (int i = 0; i < 8; ++i) q += x[i] * fa[i] + x[8 + i] * fb[i];
      d[j] = q; }
#pragma unroll
    for (int o = 1; o < 64; o <<= 1) {
#pragma unroll
      for (int j = 0; j < 4; ++j) d[j] += __shfl_xor(d[j], o); }
#pragma unroll
    for (int j = 0; j < 4; ++j) { const float a = gelu_erf(d[j] * rstd) * gk[j]; float fa[8], fb[8]; unpack8(va[j], fa); unpack8(vb[j], fb);
#pragma unroll
      for (int i = 0; i < 8; ++i) { acc[i] += a * fa[i]; acc[8 + i] += a * fb[i]; } }
  }
  float* o = out + (size_t)t * 1024;
  typedef float f32x4 __attribute__((ext_vector_type(4)));
#pragma unroll
  for (int hblk = 0; hblk < 2; ++hblk)
#pragma unroll
    for (int q = 0; q < 2; ++q) { f32x4* p = (f32x4*)(o + hblk * 512 + lane * 8 + q * 4); f32x4 v = *p; v[0] += acc[hblk * 8 + q * 4]; v[1] += acc[hblk * 8 + q * 4 + 1]; v[2] += acc[hblk * 8 + q * 4 + 2]; v[3] += acc[hblk * 8 + q * 4 + 3]; *p = v; }
}
}
constexpr int NWAVES = 8;
constexpr int BATCH = 16, SEQ = 2048, D = 1024, M = BATCH * SEQ, NPROJ = 3072, NQP = 2048, NEXP = 16384;
constexpr float RMS_EPS = 1e-6f;
constexpr float C2 = 0.125f * 1.4426950408889634f;
constexpr float LOG2E = 1.4426950408889634f;
constexpr size_t MiB = 1u << 20;
constexpr size_t WS_CTL = 0, CTL_ZERO_BYTES = 1 * MiB;
constexpr size_t WS_WIN = 1 * MiB;
constexpr size_t WS_WOUT = 7 * MiB;
constexpr size_t WS_WQ = 9 * MiB;
constexpr size_t WS_SK = 13 * MiB;
constexpr size_t WS_KPART = 13 * MiB + 512 * 1024;
constexpr size_t WS_SSQ = 14 * MiB;
constexpr size_t WS_MISC = 16 * MiB;
constexpr size_t WS_U16 = 17 * MiB;
constexpr size_t WS_V16 = 49 * MiB;
constexpr size_t WS_XN = 81 * MiB;
constexpr size_t WS_MIX = 145 * MiB;
constexpr size_t WS_DO = 209 * MiB;
constexpr size_t WS_PROJ = 273 * MiB;
constexpr size_t WS_QP = WS_PROJ;
constexpr size_t WS_LE = WS_PROJ + 128 * MiB;
constexpr size_t WS_LG = WS_PROJ + 144 * MiB;
constexpr size_t WS_END = 465 * MiB;
constexpr int CW_BAR = 4096;
constexpr int RING_OFF = 0, RING_BYTES = 131072;
constexpr int LDSCTL_OFF = RING_BYTES, MISC_OFF = LDSCTL_OFF + 320;
constexpr int LDS_BYTES = 147456;
static_assert(att::LDS_BYTES <= RING_BYTES, "attention scratch fits the ring region");

#define GAS __attribute__((address_space(1)))
#define LAS __attribute__((address_space(3)))
typedef unsigned short bf16;
typedef unsigned v4u __attribute__((ext_vector_type(4)));
typedef unsigned v2u __attribute__((ext_vector_type(2)));
typedef float f32x4 __attribute__((ext_vector_type(4)));
typedef GAS unsigned gu32;
#define RLX_AGENT __ATOMIC_RELAXED, __HIP_MEMORY_SCOPE_AGENT
#define LDS_WAIT() asm volatile("s_waitcnt lgkmcnt(0)" ::: "memory")
#define VM_WAIT() asm volatile("s_waitcnt vmcnt(0)" ::: "memory")
__device__ __forceinline__ unsigned f2bf(float f) { unsigned u = __builtin_bit_cast(unsigned, f); return (u + 0x7fffu + ((u >> 16) & 1u)) >> 16; }
__device__ __forceinline__ unsigned pk2(float lo, float hi) { return f2bf(lo) | (f2bf(hi) << 16); }
#define XB_TMO      128
#define XB_XCNT(j)  (256  + 64 * (j))
#define XB_XSUB(j)  (1280 + 64 * (j))
#define XB_XGEN(j)  (2304 + 64 * (j))
#define XB_TOP      3328
#define XB_TOPGEN   3392
#define XCD_BAR_WORDS 3456
#define XB_SPIN_CAP (1u << 23)

__device__ __forceinline__ unsigned xb_ld(unsigned* p)              { return __hip_atomic_load(p, __ATOMIC_RELAXED, __HIP_MEMORY_SCOPE_AGENT); }
__device__ __forceinline__ unsigned xb_add(unsigned* p, unsigned v) { return __hip_atomic_fetch_add(p, v, __ATOMIC_RELAXED, __HIP_MEMORY_SCOPE_AGENT); }
__device__ __forceinline__ unsigned xb_xcc_id() { return (unsigned)__builtin_amdgcn_s_getreg((3 << 11) | 20) & 0xFu; }
#define XB_SPIN(cond, bar) do { unsigned _sp = 0; while (cond) { __builtin_amdgcn_s_sleep(1); \
    if ((++_sp & 255u) == 0u) { if (xb_ld(&(bar)[XB_TMO])) break; if (_sp > XB_SPIN_CAP) { atomicAdd(&(bar)[XB_TMO], 1u); break; } } } } while (0)

struct XcdBarrier {
    unsigned* bar; unsigned x;
    volatile LAS unsigned* st;
};

__device__ __forceinline__ XcdBarrier xcd_barrier_post(unsigned* bar, volatile LAS unsigned* st) {
    XcdBarrier b; b.bar = bar; b.x = xb_xcc_id(); b.st = st;
    if (threadIdx.x == 0) (void)xb_add(&bar[XB_XCNT(b.x)], 1u);
    return b;
}
__device__ __forceinline__ void xcd_barrier_complete(unsigned* bar, unsigned x, unsigned& nloc, unsigned& nx) {
    const unsigned G = gridDim.x * gridDim.y * gridDim.z;
    unsigned sum, cnt, mine, sp = 0u;
    for (;;) {
        sum = 0u; cnt = 0u; mine = 0u;
#pragma unroll
        for (unsigned j = 0; j < 16; ++j) { const unsigned c = xb_ld(&bar[XB_XCNT(j)]); sum += c; cnt += (c > 0u) ? 1u : 0u; mine = (j == x) ? c : mine; }
        if (sum == G) break;
        __builtin_amdgcn_s_sleep(1);
        if ((++sp & 255u) == 0u) { if (xb_ld(&bar[XB_TMO])) break; if (sp > XB_SPIN_CAP) { atomicAdd(&bar[XB_TMO], 1u); break; } }
    }
    nloc = mine > 0u ? mine : 1u; nx = cnt > 0u ? cnt : 1u;
}

__device__ __forceinline__ void xcd_barrier(const XcdBarrier& b) {
    asm volatile("s_waitcnt vmcnt(0)" ::: "memory");
    __syncthreads();
    if (threadIdx.x == 0) {
        unsigned* bar = b.bar;
        __builtin_amdgcn_s_waitcnt(0);
        unsigned nloc = b.st[0], nx = b.st[1];
        if (nloc == 0u) { xcd_barrier_complete(bar, b.x, nloc, nx); b.st[0] = nloc; b.st[1] = nx; }
        const unsigned old = xb_add(&bar[XB_XSUB(b.x)], 1u);
        const unsigned gen = old / nloc;
        if (old + 1u == (gen + 1u) * nloc) {
            __builtin_amdgcn_fence(__ATOMIC_RELEASE, "agent");
            asm volatile("s_waitcnt vmcnt(0)" ::: "memory");
            const unsigned og = xb_add(&bar[XB_TOP], 1u);
            const unsigned tg = og / nx;
            if (og + 1u == (tg + 1u) * nx) xb_add(&bar[XB_TOPGEN], 1u);
            else XB_SPIN(xb_ld(&bar[XB_TOPGEN]) == tg, bar);
            __builtin_amdgcn_fence(__ATOMIC_ACQUIRE, "agent");
            xb_add(&bar[XB_XGEN(b.x)], 1u);
            asm volatile("s_waitcnt vmcnt(0)" ::: "memory");
        } else {
            XB_SPIN(xb_ld(&bar[XB_XGEN(b.x)]) == gen, bar);
            __builtin_amdgcn_fence(__ATOMIC_ACQUIRE, "agent");
            asm volatile("s_waitcnt vmcnt(0)" ::: "memory");
        }
    }
    __syncthreads();
}
struct Frame {
    LAS unsigned char* lds;
    volatile LAS unsigned* MISC;
    gu32* ctl;
    int tid, lane, wave;
    int vcu, G;
};
__device__ __forceinline__ float wave_sum(float v) {
#pragma unroll
    for (int o = 1; o < 64; o <<= 1) v += __shfl_xor(v, o);
    return v;
}
template <bool PERMROWS>
__device__ __forceinline__ void p0_transpose_item(const float* W, int K, int N, bf16* WT, const float* kscale, LAS float* scr, int item, int lane) {
    const int nblk = N / 32, kb = item / nblk, nb = item % nblk, k0 = 64 * kb, n0 = 32 * nb;
#pragma unroll 8
    for (int i = 0; i < 32; ++i) { const int kk = 2 * i + (lane >> 5); float w = W[(size_t)(k0 + kk) * N + n0 + (lane & 31)]; if (kscale) w *= kscale[k0 + kk]; scr[kk * 33 + (lane & 31)] = w; }
    LDS_WAIT(); asm volatile("" ::: "memory");
    int r0 = n0;
    if (PERMROWS) { const int tl = n0 >> 8, np = n0 & 255; r0 = tl * 256 + ((np >> 5) & 1) * 128 + (np >> 6) * 32; }
    const int c = lane & 7;
#pragma unroll
    for (int j = 0; j < 4; ++j) { const int n = (lane >> 3) + 8 * j; const LAS float* s = scr + (8 * c) * 33 + n;
        v4u o; o.x = pk2(s[0 * 33], s[1 * 33]); o.y = pk2(s[2 * 33], s[3 * 33]); o.z = pk2(s[4 * 33], s[5 * 33]); o.w = pk2(s[6 * 33], s[7 * 33]);
        *(GAS v4u*)(WT + (size_t)(r0 + n) * K + k0 + 8 * c) = o; }
    LDS_WAIT(); asm volatile("" ::: "memory");
}
__device__ __forceinline__ void cvt8(const float* src, bf16* dst, size_t e, const float* cscale) {
    f32x4 a = *(const GAS f32x4*)(src + e), b = *(const GAS f32x4*)(src + e + 4);
    if (cscale) { const int c = (int)(e & 1023); const f32x4 ga = *(const f32x4*)(cscale + c), gb = *(const f32x4*)(cscale + c + 4); a = a * ga; b = b * gb; }
    v4u o; o.x = pk2(a[0], a[1]); o.y = pk2(a[2], a[3]); o.z = pk2(b[0], b[1]); o.w = pk2(b[2], b[3]);
    *(GAS v4u*)(dst + e) = o;
}
__device__ __forceinline__ void rms_row_to_bf16(const float* xrow, const float* g, bf16* orow, int lane) {
    const GAS f32x4* xr = (const GAS f32x4*)xrow + lane;
    f32x4 v[4]; float s = 0.f;
#pragma unroll
    for (int j = 0; j < 4; ++j) { v[j] = xr[64 * j]; s += (v[j].x * v[j].x + v[j].y * v[j].y) + (v[j].z * v[j].z + v[j].w * v[j].w); }
    const float rstd = 1.f / sqrtf(wave_sum(s) * (1.f / 1024.f) + RMS_EPS);
    GAS unsigned long long* o8 = (GAS unsigned long long*)orow + lane;
#pragma unroll
    for (int j = 0; j < 4; ++j) { const f32x4 gg = *((const f32x4*)g + lane + 64 * j);
        o8[64 * j] = (unsigned long long)pk2(v[j].x * rstd * gg.x, v[j].y * rstd * gg.y) | ((unsigned long long)pk2(v[j].z * rstd * gg.z, v[j].w * rstd * gg.w) << 32); }
}

struct Args { const float* in[13]; float* out; unsigned char* ws; int ph_lo, ph_hi; };
__global__ void __launch_bounds__(NWAVES * 64, 2) mega_fwd(Args args) {
    extern __shared__ __attribute__((aligned(16))) unsigned char lds[];
    Frame F;
    F.lds = (LAS unsigned char*)lds;
    F.MISC = (volatile LAS unsigned*)(F.lds + MISC_OFF);
    F.tid = threadIdx.x; F.lane = F.tid & 63; F.wave = __builtin_amdgcn_readfirstlane(F.tid >> 6);
    F.G = gridDim.x; { const int bx = blockIdx.x; F.vcu = (F.G % 8 == 0) ? (bx % 8) * (F.G / 8) + bx / 8 : bx; }
    unsigned char* ws = args.ws;
    F.ctl = (gu32*)(ws + WS_CTL);
    const float* x = args.in[0]; const float* norm1_g = args.in[1]; const float* w_in = args.in[2]; const float* moba_g = args.in[3]; const float* diff_g = args.in[4];
    const float* diff_lambda = args.in[5]; const float* subln_g = args.in[6]; const float* w_out = args.in[7]; const float* norm2_g = args.in[8]; const float* w_query = args.in[9];
    const float* sub_keys = args.in[10]; const float* peer_u = args.in[11]; const float* peer_v = args.in[12];
    float* out = args.out;
    bf16* WIN = (bf16*)(ws + WS_WIN); bf16* WOUT = (bf16*)(ws + WS_WOUT); bf16* WQ = (bf16*)(ws + WS_WQ); bf16* SK = (bf16*)(ws + WS_SK);
    float* KPART = (float*)(ws + WS_KPART); float* SSQ = (float*)(ws + WS_SSQ); float* MISCG = (float*)(ws + WS_MISC);
    bf16* U16 = (bf16*)(ws + WS_U16); bf16* V16 = (bf16*)(ws + WS_V16); bf16* XN = (bf16*)(ws + WS_XN); bf16* MIX = (bf16*)(ws + WS_MIX); bf16* DOB = (bf16*)(ws + WS_DO);
    bf16* PROJ = (bf16*)(ws + WS_PROJ); bf16* QP = (bf16*)(ws + WS_QP); int* LE = (int*)(ws + WS_LE); float* LG = (float*)(ws + WS_LG);
    for (int u = F.tid; u < (LDS_BYTES - LDSCTL_OFF) / 4; u += NWAVES * 64) ((LAS unsigned*)(F.lds + LDSCTL_OFF))[u] = 0u;
    __syncthreads();
    XcdBarrier bar = xcd_barrier_post((unsigned*)(F.ctl + CW_BAR), F.MISC + 8);
    const int gw = F.vcu * NWAVES + F.wave, NGW = F.G * NWAVES;
    const int lo = args.ph_lo, hi = args.ph_hi;
#define IN(k) (lo <= (k) && (k) < hi)
#define GRID_BAR() xcd_barrier(bar)

    if (IN(0)) {
        LAS float* scr = (LAS float*)(F.lds + RING_OFF + F.wave * 16384);
        constexpr int I_IN = (D / 64) * (NPROJ / 32), I_OUT = (D / 64) * (D / 32), I_Q = (D / 64) * (NQP / 32);
        for (int it = gw; it < I_IN + I_OUT + I_Q; it += NGW) {
            int r = it;
            if (r < I_IN) { p0_transpose_item<true>(w_in, D, NPROJ, WIN, nullptr, scr, r, F.lane); continue; } r -= I_IN;
            if (r < I_OUT) { p0_transpose_item<false>(w_out, D, D, WOUT, nullptr, scr, r, F.lane); continue; } r -= I_OUT;
            p0_transpose_item<false>(w_query, D, NQP, WQ, norm2_g, scr, r, F.lane);
        }
        constexpr size_t C_SK = (size_t)16 * 128 * 128 / 8, C_T = (size_t)NEXP * 1024 / 8;
        for (size_t c = (size_t)gw * 64 + F.lane; c < C_SK + 2 * C_T; c += (size_t)NGW * 64) {
            if (c < C_SK) cvt8(sub_keys, SK, c * 8, nullptr);
            else if (c < C_SK + C_T) cvt8(peer_u, U16, (c - C_SK) * 8, norm2_g);
            else cvt8(peer_v, V16, (c - C_SK - C_T) * 8, nullptr);
        }
        for (int m = gw; m < M; m += NGW) rms_row_to_bf16(x + (size_t)m * D, norm1_g, XN + (size_t)m * D, F.lane);
        if (gw == 0) { const float a = wave_sum(diff_lambda[F.lane] * diff_lambda[64 + F.lane]), b = wave_sum(diff_lambda[128 + F.lane] * diff_lambda[192 + F.lane]);
            if (F.lane == 0) MISCG[0] = expf(a) - expf(b) + 0.2f; }
        GRID_BAR();
    }
    if (IN(1)) {
        pg8::Gemm g{XN, WIN, M, NPROJ, D}; pg8::StaticOrder S; S.init(M, NPROJ, F.G, (int)blockIdx.x);
        pg8::EpiProj E{PROJ, moba_g, moba_g + 64, diff_g, diff_g + 64, KPART, C2};
        pg8::gemm_phase<pg8::EpiProj, pg8::StaticOrder, true, true>(F.lds + RING_OFF, g, S, E);
        GRID_BAR();
    }
    if (IN(2)) {
        for (int p = F.vcu; p < 1536; p += F.G) {
            const int bvh = p >> 2, s = p & 3, b = bvh / 24, vh = bvh % 24;
            att::UnitDesc U; const bf16* pb = PROJ + (size_t)b * SEQ * NPROJ;
            if (vh < 8) { U.Q = (const att::bf16*)(pb + vh * 64); U.K = (const att::bf16*)(pb + 512 + vh * 64); U.V = (const att::bf16*)(pb + 1024 + vh * 64);
                U.O = (att::bf16*)(MIX + (size_t)b * SEQ * 1024 + vh * 64); U.slope2 = LOG2E * exp2f(-(float)(vh + 1)); U.moba = 1; U.kpart = KPART + (size_t)(b * 8) * 1024 + vh * 64; }
            else { const int dvh = vh - 8, dh = dvh >> 2, j = (dvh >> 1) & 1, c = dvh & 1;
                U.Q = (const att::bf16*)(pb + 1536 + dh * 128 + j * 64); U.K = (const att::bf16*)(pb + 2048 + dh * 128 + j * 64); U.V = (const att::bf16*)(pb + 2560 + dh * 128 + c * 64);
                U.O = (att::bf16*)(DOB + (size_t)b * SEQ * 1024 + (dh * 2 + j) * 128 + c * 64); U.slope2 = LOG2E * exp2f(-2.0f * (float)(dh + 1)); U.moba = 0; U.kpart = KPART; }
            U.nb = 7 - s; att::attn_unit(U, (char*)lds + RING_OFF);
            U.nb = s; att::attn_unit(U, (char*)lds + RING_OFF);
        }
        GRID_BAR();
    }
    if (IN(3)) {
        const float lam = MISCG[0];
        const int hh = F.lane >> 4, cc = (F.lane & 15) * 8;
        float gs[8];
#pragma unroll
        for (int i = 0; i < 8; ++i) gs[i] = subln_g[cc + i] * 0.8f;
        for (int t = gw; t < M; t += NGW) {
            const v4u a = *(const GAS v4u*)(DOB + (size_t)t * 1024 + hh * 256 + cc), b = *(const GAS v4u*)(DOB + (size_t)t * 1024 + hh * 256 + 128 + cc);
            float d[8]; float ss = 0.f;
#pragma unroll
            for (int i = 0; i < 4; ++i) { d[2 * i] = __uint_as_float(a[i] << 16) - lam * __uint_as_float(b[i] << 16); d[2 * i + 1] = __uint_as_float(a[i] & 0xffff0000u) - lam * __uint_as_float(b[i] & 0xffff0000u);
                ss += d[2 * i] * d[2 * i] + d[2 * i + 1] * d[2 * i + 1]; }
#pragma unroll
            for (int o = 1; o < 16; o <<= 1) ss += __shfl_xor(ss, o);
            const float r = 1.0f / sqrtf(ss * (1.0f / 128.0f) + RMS_EPS);
            v4u w; w.x = pk2(d[0] * r * gs[0], d[1] * r * gs[1]); w.y = pk2(d[2] * r * gs[2], d[3] * r * gs[3]); w.z = pk2(d[4] * r * gs[4], d[5] * r * gs[5]); w.w = pk2(d[6] * r * gs[6], d[7] * r * gs[7]);
            *(GAS v4u*)(MIX + (size_t)t * 1024 + 512 + hh * 128 + cc) = w;
        }
        GRID_BAR();
    }
    if (IN(4)) {
        pg8::Gemm g{MIX, WOUT, M, D, D}; pg8::StaticOrder S; S.init(M, D, F.G, (int)blockIdx.x);
        pg8::EpiOut E{x, out, XN, SSQ};
        pg8::gemm_phase<pg8::EpiOut, pg8::StaticOrder, true, true>(F.lds + RING_OFF, g, S, E);
        GRID_BAR();
    }
    if (IN(5)) {
        pg8::Gemm g{XN, WQ, M, NQP, D}; pg8::StaticOrder S; S.init(M, NQP, F.G, (int)blockIdx.x);
        pg8::EpiBf16 E{QP, NQP};
        pg8::gemm_phase<pg8::EpiBf16, pg8::StaticOrder, true, true>(F.lds + RING_OFF, g, S, E);
        GRID_BAR();
    }
    if (IN(6)) {
        for (int task = gw; task < (M / 32) * 8; task += NGW) peer::topk_task((const peer::bf16*)QP, (const peer::bf16*)SK, SSQ, LE, LG, task >> 3, task & 7, F.lane);
        GRID_BAR();
    }
    if (IN(7)) {
        for (int t = gw; t < M; t += NGW) peer::expert_token((const peer::bf16*)XN, (const peer::bf16*)U16, (const peer::bf16*)V16, SSQ, LE, LG, out, t, F.lane);
    }
#undef IN
#undef GRID_BAR
}

extern "C" void kernel_launch(void* const* d_in, const int* in_sizes, int n_in, void* d_out, int out_size, void* d_ws, size_t ws_size, hipStream_t stream) {
    static int grid = 0;
    if (grid == 0) {
        if (n_in != 13 || in_sizes[0] != M * D || out_size != M * D || ws_size < WS_END) { fprintf(stderr, "kernel_launch: unexpected shapes (n_in %d, in0 %d, out %d, ws %zu); nothing launched\n", n_in, n_in > 0 ? in_sizes[0] : -1, out_size, ws_size); grid = -1; return; }
        int dev = 0, cus = 0, per_cu = 0;
        if (hipGetDevice(&dev) != hipSuccess || hipDeviceGetAttribute(&cus, hipDeviceAttributeMultiprocessorCount, dev) != hipSuccess) { grid = -1; return; }
        if (hipFuncSetAttribute((const void*)mega_fwd, hipFuncAttributeMaxDynamicSharedMemorySize, LDS_BYTES) != hipSuccess) { fprintf(stderr, "kernel_launch: hipFuncSetAttribute failed\n"); grid = -1; return; }
        if (hipOccupancyMaxActiveBlocksPerMultiprocessor(&per_cu, (const void*)mega_fwd, NWAVES * 64, LDS_BYTES) != hipSuccess || per_cu < 1) { fprintf(stderr, "kernel_launch: occupancy query reports %d workgroups per CU\n", per_cu); }
        (void)hipGetLastError();
        grid = cus;
    }
    if (grid < 0) return;
    if (hipMemsetAsync((char*)d_ws + WS_CTL, 0, CTL_ZERO_BYTES, stream) != hipSuccess) return;
    Args a{};
    for (int i = 0; i < 13; ++i) a.in[i] = (const float*)d_in[i];
    a.out = (float*)d_out; a.ws = (unsigned char*)d_ws; a.ph_lo = 0; a.ph_hi = 8;
    hipLaunchKernelGGL(mega_fwd, dim3(grid), dim3(NWAVES * 64), LDS_BYTES, stream, a);
}
```

```cpp
#include <hip/hip_runtime.h>
#include <hip/hip_bf16.h>
#include <cstdio>
#include <cstdint>
#include <cmath>
namespace pg8 {
#define PG8_LAS __attribute__((address_space(3)))
typedef unsigned short bf16_t;
typedef short bf16x8 __attribute__((ext_vector_type(8)));
typedef float f32x4 __attribute__((ext_vector_type(4)));
typedef unsigned u32x4 __attribute__((ext_vector_type(4)));
constexpr int BM = 256, BK = 64, HALF = 128, HTB = HALF * BK * 2  , STAGE_BYTES = 8 * HTB, NXCD = 8, WGM = 8;

__host__ __device__ __forceinline__ int lds_byte(int r, int c) { const int st = (r >> 4) * 2 + (c >> 5), rr = r & 15, cc = c & 31, ob = rr * 64 + cc * 2; return st * 1024 + (ob ^ (((ob >> 9) & 1) << 5)); }
__host__ __device__ __forceinline__ void stage_rc(int b, int& R, int& C) { const int st = b / 1024, sb = b % 1024, swz = sb ^ (((sb >> 9) & 1) << 5); R = (st >> 1) * 16 + swz / 64; C = (st & 1) * 32 + (swz % 64) / 2; }
__host__ __device__ __forceinline__ int perm32(int rho) { const int n = rho >> 4, i = rho & 15; return 8 * (i >> 2) + 4 * n + (i & 3); }

struct Unit { int pm, pn; };
struct Gemm { const bf16_t* A; const bf16_t* Bt; int M, N, K; };

struct StaticOrder {
    int nM, nN, nwg, G, c;
    __host__ __device__ void init(int M, int N, int G_, int c_) { nM = M / BM; nN = N / BM; nwg = nM * nN; G = G_; c = c_; }
    __host__ __device__ bool next(int i, Unit& u) const {
        const long L = (long)i * G + c; if (L >= nwg) return false;
        int wgid = (int)L; { const int q = nwg / NXCD, r = nwg % NXCD, xcd = wgid % NXCD, off = wgid / NXCD; wgid = (xcd < r ? xcd * (q + 1) : r * (q + 1) + (xcd - r) * q) + off; }
        const int nig = WGM * nN, gid = wgid / nig, fm = gid * WGM, gsz = (nM - fm) < WGM ? (nM - fm) : WGM;
        u.pm = fm + ((wgid % nig) % gsz); u.pn = (wgid % nig) / gsz; return true;
    }
    __device__ __forceinline__ void a_ready(const Unit&) const {}
    __device__ __forceinline__ void done(const Unit&) const {}
};

__device__ __forceinline__ unsigned cvt_pk_bf16(float lo, float hi) { unsigned r; asm volatile("v_cvt_pk_bf16_f32 %0, %1, %2" : "=v"(r) : "v"(lo), "v"(hi)); return r; }
typedef unsigned u32x2 __attribute__((ext_vector_type(2)));

struct EpiBf16 {
    static constexpr bool PERM = true, AFTER_DRAIN = false;
    bf16_t* O; int ldc;
    __device__ __forceinline__ void operator()(const f32x4 (&acc)[2][2][4][2], const Unit& u, int wr, int wc, int fr, int fq) const {
        const int row0 = u.pm * BM + wr * 64 + fr; const int col0 = u.pn * BM + wc * 32 + 8 * fq;
#pragma unroll
        for (int ai = 0; ai < 2; ++ai)
#pragma unroll
            for (int m = 0; m < 4; ++m) { bf16_t* rowp = O + (size_t)(row0 + ai * HALF + m * 16) * ldc + col0;
#pragma unroll
                for (int bj = 0; bj < 2; ++bj) { const f32x4 v0 = acc[ai][bj][m][0], v1 = acc[ai][bj][m][1];
                    u32x4 w; w.x = cvt_pk_bf16(v0[0], v0[1]); w.y = cvt_pk_bf16(v0[2], v0[3]); w.z = cvt_pk_bf16(v1[0], v1[1]); w.w = cvt_pk_bf16(v1[2], v1[3]);
                    *(u32x4*)(rowp + bj * HALF) = w; } }
    }
};

struct EpiProj {
    static constexpr bool PERM = true, AFTER_DRAIN = false;
    bf16_t* P; const float *gmq, *gmk, *gdq, *gdk; float* kpart; float c2;
    __device__ __forceinline__ void operator()(const f32x4 (&acc)[2][2][4][2], const Unit& u, int wr, int wc, int fr, int fq) const {
        const int type = u.pn >> 1;
        const float* g = type == 0 ? gmq : type == 1 ? gmk : type == 3 ? gdq : type == 4 ? gdk : nullptr;
        const float sc0 = (type == 0 || type == 3) ? c2 : 1.f;
        f32x4 gv[2][2];
#pragma unroll
        for (int bj = 0; bj < 2; ++bj)
#pragma unroll
            for (int n = 0; n < 2; ++n) gv[bj][n] = g ? (*(const f32x4*)(g + 32 * bj + 8 * fq + 4 * n)) * sc0 : (f32x4){1.f, 1.f, 1.f, 1.f};
        f32x4 cs[2][2];
#pragma unroll
        for (int bj = 0; bj < 2; ++bj)
#pragma unroll
            for (int n = 0; n < 2; ++n) cs[bj][n] = (f32x4){0.f, 0.f, 0.f, 0.f};
        const int row0 = u.pm * BM + wr * 64 + fr; const int col0 = u.pn * BM + wc * 64 + 8 * fq;
#pragma unroll
        for (int ai = 0; ai < 2; ++ai)
#pragma unroll
            for (int m = 0; m < 4; ++m) {
                f32x4 v[2][2];
#pragma unroll
                for (int bj = 0; bj < 2; ++bj)
#pragma unroll
                    for (int n = 0; n < 2; ++n) v[bj][n] = acc[ai][bj][m][n];
                if (g) {
                    float ss = 0.f;
#pragma unroll
                    for (int bj = 0; bj < 2; ++bj)
#pragma unroll
                        for (int n = 0; n < 2; ++n) { const f32x4 x = v[bj][n]; ss += (x[0] * x[0] + x[1] * x[1]) + (x[2] * x[2] + x[3] * x[3]); }
                    ss += __shfl_xor(ss, 16); ss += __shfl_xor(ss, 32);
                    const float r = 1.0f / sqrtf(ss * (1.0f / 64.0f) + 1e-6f);
#pragma unroll
                    for (int bj = 0; bj < 2; ++bj)
#pragma unroll
                        for (int n = 0; n < 2; ++n) { v[bj][n] = v[bj][n] * r * gv[bj][n]; cs[bj][n] += v[bj][n]; }
                }
                bf16_t* rowp = P + (size_t)(row0 + ai * HALF + m * 16) * 3072 + col0;
#pragma unroll
                for (int bj = 0; bj < 2; ++bj) { const f32x4 v0 = v[bj][0], v1 = v[bj][1];
                    u32x4 w; w.x = cvt_pk_bf16(v0[0], v0[1]); w.y = cvt_pk_bf16(v0[2], v0[3]); w.z = cvt_pk_bf16(v1[0], v1[1]); w.w = cvt_pk_bf16(v1[2], v1[3]);
                    *(u32x4*)(rowp + bj * 32) = w; }
            }
        if (type == 1) {
#pragma unroll
            for (int bj = 0; bj < 2; ++bj)
#pragma unroll
                for (int n = 0; n < 2; ++n) { f32x4 c = cs[bj][n];
#pragma unroll
                    for (int o = 1; o < 16; o <<= 1) { c[0] += __shfl_xor(c[0], o); c[1] += __shfl_xor(c[1], o); c[2] += __shfl_xor(c[2], o); c[3] += __shfl_xor(c[3], o); }
                    if (fr == 0) *(f32x4*)(kpart + (size_t)(u.pm * 2 + wr) * 512 + (u.pn - 2) * 256 + wc * 64 + bj * 32 + fq * 8 + n * 4) = c; }
        }
    }
};

struct EpiOut {
    static constexpr bool PERM = false, AFTER_DRAIN = false;
    const float* x; float* out; bf16_t* xmb; float* ssq;
    __device__ __forceinline__ void operator()(const f32x4 (&acc)[2][2][4][2], const Unit& u, int wr, int wc, int fr, int fq) const {
        const int row0 = u.pm * BM + wr * 64 + fr; const int col0 = u.pn * BM + wc * 32 + 4 * fq;
#pragma unroll
        for (int ai = 0; ai < 2; ++ai)
#pragma unroll
            for (int m = 0; m < 4; ++m) { const int row = row0 + ai * HALF + m * 16; const size_t off = (size_t)row * 1024 + col0; float s = 0.f;
#pragma unroll
                for (int bj = 0; bj < 2; ++bj)
#pragma unroll
                    for (int n = 0; n < 2; ++n) { const f32x4 xv = *(const f32x4*)(x + off + bj * HALF + n * 16); const f32x4 y = xv + acc[ai][bj][m][n];
                        *(f32x4*)(out + off + bj * HALF + n * 16) = y; u32x2 w; w.x = cvt_pk_bf16(y[0], y[1]); w.y = cvt_pk_bf16(y[2], y[3]); *(u32x2*)(xmb + off + bj * HALF + n * 16) = w;
                        s += (y[0] * y[0] + y[1] * y[1]) + (y[2] * y[2] + y[3] * y[3]); }
                s += __shfl_xor(s, 16); s += __shfl_xor(s, 32);
                if (fq == 0) ssq[(size_t)row * 16 + u.pn * 4 + wc] = s;
                if (m & 1) asm volatile("" ::: "memory"); }
    }
};
template <class Epi, class Sched, bool ALIGN_EPI = false, bool SP2 = false>
__device__ __forceinline__ void gemm_phase(PG8_LAS unsigned char* lds, const Gemm g, const Sched& S, const Epi& E) {
    const int tid = threadIdx.x, wid = __builtin_amdgcn_readfirstlane(tid >> 6), lane = tid & 63, wr = wid >> 2, wc = wid & 3, fr = lane & 15, fq = lane >> 4;
    const int K = g.K, nt = K / BK;
    unsigned voffA[2], voffB[2];
#pragma unroll
    for (int i = 0; i < 2; ++i) { int R, C; stage_rc(tid * 16 + i * 8192, R, C); const int Rb = Epi::PERM ? ((R & ~31) + perm32(R & 31)) : R;
        voffA[i] = (unsigned)(R * K + C) * 2u; voffB[i] = (unsigned)(Rb * K + C) * 2u; }
    const size_t kstep = (size_t)(BK * 2);
    const size_t hstep = (size_t)HALF * K * 2;
    const size_t tstep = 2 * hstep;
    const unsigned ldsw = (unsigned)wid * 1024u;
    const int aoff = lds_byte(wr * 64 + fr, fq * 8), boff = lds_byte(wc * 32 + fr, fq * 8);
#define PG8_SA(b, h) (((b) * 2 + (h)) * HTB)
#define PG8_SB(b, h) ((4 + (b) * 2 + (h)) * HTB)
#define PG8_STAGE(bufoff, gbase, voff) do { _Pragma("unroll") for (int _i = 0; _i < 2; ++_i) \
        __builtin_amdgcn_global_load_lds((const unsigned*)((const char*)(gbase) + (voff)[_i]), (PG8_LAS unsigned*)(lds + (bufoff) + ldsw + _i * 8192), 16, 0, 0); } while (0)
#define PG8_LDA(dst, b, h) do { _Pragma("unroll") for (int m = 0; m < 4; ++m) _Pragma("unroll") for (int k = 0; k < 2; ++k) dst[m][k] = *(const PG8_LAS bf16x8*)(lds + PG8_SA(b, h) + aoff + m * 2048 + k * 1024); } while (0)
#define PG8_LDB(dst, b, h) do { _Pragma("unroll") for (int n = 0; n < 2; ++n) _Pragma("unroll") for (int k = 0; k < 2; ++k) dst[n][k] = *(const PG8_LAS bf16x8*)(lds + PG8_SB(b, h) + boff + n * 2048 + k * 1024); } while (0)
#define PG8_MMA(ai, bj, At, Bt) do { __builtin_amdgcn_s_setprio(1); _Pragma("unroll") for (int m = 0; m < 4; ++m) _Pragma("unroll") for (int n = 0; n < 2; ++n) _Pragma("unroll") for (int k = 0; k < 2; ++k) \
        acc[ai][bj][m][n] = __builtin_amdgcn_mfma_f32_16x16x32_bf16(Bt[n][k], At[m][k], acc[ai][bj][m][n], 0, 0, 0); __builtin_amdgcn_s_setprio(0); } while (0)
#define PG8_WAIT_V(n) asm volatile("s_waitcnt vmcnt(" #n ")" ::: "memory")
#define PG8_WAIT_L(n) asm volatile("s_waitcnt lgkmcnt(" #n ")" ::: "memory")
#define PG8_BAR __builtin_amdgcn_s_barrier()
#define PG8_SCHED __builtin_amdgcn_sched_barrier(0)
    Unit cur, nxt; int ui = 0;
    if (!S.next(0, cur)) return;
    f32x4 acc[2][2][4][2];
#pragma unroll
    for (int a = 0; a < 2; ++a)
#pragma unroll
        for (int b = 0; b < 2; ++b)
#pragma unroll
            for (int m = 0; m < 4; ++m)
#pragma unroll
                for (int n = 0; n < 2; ++n) acc[a][b][m][n] = (f32x4){0.f, 0.f, 0.f, 0.f};
    bf16x8 At[4][2], B0[2][2], B1[2][2];
    const char* cA = (const char*)g.A + (size_t)cur.pm * tstep; const char* cB = (const char*)g.Bt + (size_t)cur.pn * tstep;
    S.a_ready(cur);
    if constexpr (SP2) {
        PG8_STAGE(PG8_SB(0, 0), cB, voffB); PG8_STAGE(PG8_SB(0, 1), cB + hstep, voffB); PG8_STAGE(PG8_SA(0, 0), cA, voffA); PG8_STAGE(PG8_SA(0, 1), cA + hstep, voffA);
        if (wr == 1) PG8_BAR;
        PG8_WAIT_V(2); PG8_BAR;
        PG8_STAGE(PG8_SB(1, 0), cB + kstep, voffB); PG8_STAGE(PG8_SA(1, 0), cA + kstep, voffA); PG8_STAGE(PG8_SB(1, 1), cB + hstep + kstep, voffB);
        PG8_WAIT_V(6); PG8_BAR;
    } else {
        PG8_STAGE(PG8_SB(0, 0), cB, voffB); PG8_STAGE(PG8_SA(0, 0), cA, voffA); PG8_STAGE(PG8_SB(0, 1), cB + hstep, voffB); PG8_STAGE(PG8_SA(0, 1), cA + hstep, voffA);
        if (wr == 1) PG8_BAR;
        PG8_WAIT_V(4); PG8_BAR;
        PG8_STAGE(PG8_SB(1, 0), cB + kstep, voffB); PG8_STAGE(PG8_SA(1, 0), cA + kstep, voffA); PG8_STAGE(PG8_SB(1, 1), cB + hstep + kstep, voffB);
        PG8_WAIT_V(6); PG8_BAR;
    }
    for (;;) {
        const bool has_next = S.next(ui + 1, nxt);
        const char* nA = has_next ? (const char*)g.A + (size_t)nxt.pm * tstep : cA; const char* nB = has_next ? (const char*)g.Bt + (size_t)nxt.pn * tstep : cB;
        for (int t = 0; t < nt; t += 2) {
            const bool last = (t == nt - 2);
            const char* a1 = cA + (size_t)(t + 1) * kstep;
            const char* a2 = last ? nA : cA + (size_t)(t + 2) * kstep; const char* b2 = last ? nB : cB + (size_t)(t + 2) * kstep;
            const char* a3 = a2 + kstep; const char* b3 = b2 + kstep;
            if (last && has_next) S.a_ready(nxt);
            if constexpr (SP2) {
            PG8_LDB(B0, 0, 0); PG8_LDB(B1, 0, 1); PG8_SCHED; PG8_LDA(At, 0, 0); PG8_STAGE(PG8_SA(1, 1), a1 + hstep, voffA);
            PG8_WAIT_V(8); PG8_WAIT_L(0); PG8_BAR; PG8_MMA(0, 0, At, B0); PG8_MMA(0, 1, At, B1); PG8_BAR; PG8_SCHED;
            PG8_LDA(At, 0, 1); PG8_STAGE(PG8_SB(0, 0), b2, voffB); PG8_STAGE(PG8_SB(0, 1), b2 + hstep, voffB); PG8_STAGE(PG8_SA(0, 0), a2, voffA);
            PG8_WAIT_V(8); PG8_WAIT_L(0); PG8_BAR; PG8_MMA(1, 0, At, B0); PG8_MMA(1, 1, At, B1); PG8_BAR; PG8_SCHED;
            PG8_LDB(B0, 1, 0); PG8_LDB(B1, 1, 1); PG8_SCHED; PG8_LDA(At, 1, 0); PG8_STAGE(PG8_SA(0, 1), a2 + hstep, voffA);
            PG8_WAIT_V(8); PG8_WAIT_L(0); PG8_BAR; PG8_MMA(0, 0, At, B0); PG8_MMA(0, 1, At, B1); PG8_BAR; PG8_SCHED;
            PG8_LDA(At, 1, 1); PG8_STAGE(PG8_SB(1, 0), b3, voffB); PG8_STAGE(PG8_SB(1, 1), b3 + hstep, voffB); PG8_STAGE(PG8_SA(1, 0), a3, voffA);
            PG8_WAIT_V(8); PG8_WAIT_L(0); PG8_BAR; PG8_MMA(1, 0, At, B0); PG8_MMA(1, 1, At, B1); PG8_BAR; PG8_SCHED;
            } else {
            PG8_LDB(B0, 0, 0); PG8_SCHED; PG8_LDA(At, 0, 0); PG8_STAGE(PG8_SA(1, 1), a1 + hstep, voffA);
            PG8_WAIT_L(8); PG8_BAR; PG8_WAIT_L(0); PG8_MMA(0, 0, At, B0); PG8_BAR; PG8_SCHED;
            PG8_LDB(B1, 0, 1); PG8_STAGE(PG8_SB(0, 0), b2, voffB);
            PG8_BAR; PG8_WAIT_L(0); PG8_MMA(0, 1, At, B1); PG8_BAR;
            PG8_LDA(At, 0, 1); PG8_STAGE(PG8_SA(0, 0), a2, voffA);
            PG8_BAR; PG8_WAIT_L(0); PG8_MMA(1, 0, At, B0); PG8_BAR; PG8_SCHED;
            PG8_STAGE(PG8_SB(0, 1), b2 + hstep, voffB);
            PG8_WAIT_V(6); PG8_BAR; PG8_MMA(1, 1, At, B1); PG8_BAR;
            PG8_LDB(B0, 1, 0); PG8_SCHED; PG8_LDA(At, 1, 0); PG8_STAGE(PG8_SA(0, 1), a2 + hstep, voffA);
            PG8_WAIT_L(8); PG8_BAR; PG8_WAIT_L(0); PG8_MMA(0, 0, At, B0); PG8_BAR; PG8_SCHED;
            PG8_LDB(B1, 1, 1); PG8_STAGE(PG8_SB(1, 0), b3, voffB);
            PG8_BAR; PG8_WAIT_L(0); PG8_MMA(0, 1, At, B1); PG8_BAR;
            PG8_LDA(At, 1, 1); PG8_STAGE(PG8_SA(1, 0), a3, voffA);
            PG8_BAR; PG8_WAIT_L(0); PG8_MMA(1, 0, At, B0); PG8_BAR; PG8_SCHED;
            PG8_STAGE(PG8_SB(1, 1), b3 + hstep, voffB);
            PG8_WAIT_V(6); PG8_BAR; PG8_MMA(1, 1, At, B1); PG8_BAR;
            }
        }
        if constexpr (ALIGN_EPI) { if (wr == 0) PG8_BAR; }
        if constexpr (!Epi::AFTER_DRAIN) { E(acc, cur, wr, wc, fr, fq); S.done(cur); }
        if (!has_next) break;
#pragma unroll
        for (int a = 0; a < 2; ++a)
#pragma unroll
            for (int b = 0; b < 2; ++b)
#pragma unroll
                for (int m = 0; m < 4; ++m)
#pragma unroll
                    for (int n = 0; n < 2; ++n) acc[a][b][m][n] = (f32x4){0.f, 0.f, 0.f, 0.f};
        cur = nxt; cA = nA; cB = nB; ++ui;
        if constexpr (ALIGN_EPI) { if (wr == 1) PG8_BAR; }
    }
    PG8_WAIT_V(0);
    if constexpr (!ALIGN_EPI) { if (wr == 0) PG8_BAR; }
    PG8_BAR;
    if constexpr (Epi::AFTER_DRAIN) { E.fused(acc, cur, wr, wc, fr, fq, lds, wid, lane); S.done(cur); }
#undef PG8_SA
#undef PG8_SB
#undef PG8_STAGE
#undef PG8_LDA
#undef PG8_LDB
#undef PG8_MMA
#undef PG8_WAIT_V
#undef PG8_WAIT_L
#undef PG8_BAR
#undef PG8_SCHED
}
}
namespace att {
using bf16 = __hip_bfloat16;
using bf16x8 = __attribute__((ext_vector_type(8))) short;
using s16x4 = __attribute__((ext_vector_type(4))) short;
using f32x16 = __attribute__((ext_vector_type(16))) float;
using u32x4 = __attribute__((ext_vector_type(4))) unsigned;
constexpr int PITCH = 3072, QB = 256, KVBLK = 64, NW = 8;
constexpr int SLOTB = 8192, LDS_K = 0, LDS_V = 2 * SLOTB, LDS_WS = 4 * SLOTB, LDS_OST = LDS_WS + NW * 64 * 4, LDS_BYTES = LDS_OST + NW * 4096;
__device__ __forceinline__ int crow(int r, int hi) { return (r & 3) + 8 * (r >> 2) + 4 * hi; }
typedef float f32x2_t __attribute__((ext_vector_type(2))); typedef __bf16 bf16x2_t __attribute__((ext_vector_type(2)));
__device__ __forceinline__ unsigned cvtpk_s(float lo, float hi) { f32x2_t v = {lo, hi}; bf16x2_t b = __builtin_convertvector(v, bf16x2_t); return __builtin_bit_cast(unsigned, b); }

__device__ __forceinline__ void qkt(f32x16& p0, f32x16& p1, const char* Kslot, const bf16x8* qr, int r32, int hi) {
  const char* kb = Kslot + hi * 1024 + r32 * 16;
  const f32x16 z = {};
#pragma unroll
  for (int d0 = 0; d0 < 4; ++d0) {
    const bf16x8 b0 = *reinterpret_cast<const bf16x8*>(kb + d0 * 2048);
    const bf16x8 b1 = *reinterpret_cast<const bf16x8*>(kb + d0 * 2048 + 512);
    if (d0 == 0) { p0 = __builtin_amdgcn_mfma_f32_32x32x16_bf16(b0, qr[0], z, 0, 0, 0); p1 = __builtin_amdgcn_mfma_f32_32x32x16_bf16(b1, qr[0], z, 0, 0, 0); }
    else { p0 = __builtin_amdgcn_mfma_f32_32x32x16_bf16(b0, qr[d0], p0, 0, 0, 0); p1 = __builtin_amdgcn_mfma_f32_32x32x16_bf16(b1, qr[d0], p1, 0, 0, 0); } }
}
__device__ __forceinline__ void pv(f32x16* o, int vb, bf16x8 pa0, bf16x8 pa1, bf16x8 pa2, bf16x8 pa3) {
#pragma unroll
  for (int d0 = 0; d0 < 2; ++d0) { s16x4 lo[4], hi[4];
#pragma unroll
    for (int ks = 0; ks < 4; ++ks) {
      asm volatile("ds_read_b64_tr_b16 %0,%1 offset:%c2" : "=&v"(lo[ks]) : "v"(vb), "i"(d0 * 4096 + ks * 1024) : "memory");
      asm volatile("ds_read_b64_tr_b16 %0,%1 offset:%c2" : "=&v"(hi[ks]) : "v"(vb), "i"(d0 * 4096 + ks * 1024 + 512) : "memory"); }
    asm volatile("s_waitcnt lgkmcnt(0)" ::: "memory"); __builtin_amdgcn_sched_barrier(0);
#define PK(k) (bf16x8){lo[k][0], lo[k][1], lo[k][2], lo[k][3], hi[k][0], hi[k][1], hi[k][2], hi[k][3]}
    o[d0] = __builtin_amdgcn_mfma_f32_32x32x16_bf16(pa0, PK(0), o[d0], 0, 0, 0);
    o[d0] = __builtin_amdgcn_mfma_f32_32x32x16_bf16(pa1, PK(1), o[d0], 0, 0, 0);
    o[d0] = __builtin_amdgcn_mfma_f32_32x32x16_bf16(pa2, PK(2), o[d0], 0, 0, 0);
    o[d0] = __builtin_amdgcn_mfma_f32_32x32x16_bf16(pa3, PK(3), o[d0], 0, 0, 0);
#undef PK
  }
}
struct UnitDesc { const bf16* Q; const bf16* K; const bf16* V; bf16* O; float slope2; int nb; int moba; const float* kpart; };
__device__ __forceinline__ void attn_unit(const UnitDesc& U, char* shm) {
  const int tid = threadIdx.x, lane = tid & 63, r32 = lane & 31, hi = lane >> 5; const int wid = __builtin_amdgcn_readfirstlane(tid >> 6);
  const int nb = U.nb, q0 = nb * QB;
  const bf16* Qw = U.Q + (long)(q0 + wid * 32) * PITCH;
  const unsigned lds0 = (unsigned)(uintptr_t)shm;
  float* wsf = (float*)(shm + LDS_WS) + wid * 64;
  bf16x8 qr[4];
#pragma unroll
  for (int d0 = 0; d0 < 4; ++d0) qr[d0] = *reinterpret_cast<const bf16x8*>(&Qw[(long)r32 * PITCH + d0 * 16 + hi * 8]);
  unsigned sel = 0xffu;
  if (U.moba) {
    float g[4] = {0.f, 0.f, 0.f, 0.f};
    const bf16* qrow = Qw + (long)r32 * PITCH;
    for (int c = 0; c < 8; ++c) {
      const u32x4 qv = *reinterpret_cast<const u32x4*>(qrow + c * 8);
      float qf[8];
#pragma unroll
      for (int i = 0; i < 4; ++i) { qf[2 * i] = __uint_as_float(qv[i] << 16); qf[2 * i + 1] = __uint_as_float(qv[i] & 0xffff0000u); }
#pragma unroll
      for (int j = 0; j < 4; ++j) { const int n = 4 * hi + j;
        if (n < nb) { const float* k0 = U.kpart + (size_t)(n * 2) * 512 + c * 8; const float* k1 = k0 + 512;
#pragma unroll
          for (int i = 0; i < 8; ++i) g[j] += qf[i] * (k0[i] + k1[i]); } }
    }
    float ga[8];
#pragma unroll
    for (int j = 0; j < 4; ++j) { const float o = __shfl_xor(g[j], 32); ga[j] = hi ? o : g[j]; ga[4 + j] = hi ? g[j] : o; }
    sel = 0u;
#pragma unroll
    for (int n = 0; n < 8; ++n) { int rank = 0;
#pragma unroll
      for (int m = 0; m < 8; ++m) if (m != n) rank += (m < nb && (ga[m] > ga[n] || (ga[m] == ga[n] && m < n))) ? 1 : 0;
      if (n < nb && rank < 3) sel |= (1u << n); }
  }
  const int NT = 4 * (nb + 1);
  float mrun = -30000.f, lrun = 0.f; f32x16 o[2]; o[0] = f32x16{}; o[1] = f32x16{};
  const int qrel = wid * 32 + r32;
  const bf16* ksrc = U.K + (long)lane * PITCH + wid * 8;
  const bf16* vsrc = U.V + (long)(16 * (wid & 3) + (lane >> 2)) * PITCH + (wid >> 2) * 32 + (lane & 3) * 8;
  char* kdst = shm + LDS_K + wid * 1024 + lane * 16; char* vdst = shm + LDS_V + wid * 1024 + lane * 16;
  const int vb0 = (int)(lds0 + LDS_V) + ((lane >> 4) & 1) * 32 + (lane & 3) * 8 + (4 * hi + ((lane & 15) >> 2)) * 64;
  u32x4 kreg = *reinterpret_cast<const u32x4*>(ksrc), vreg = *reinterpret_cast<const u32x4*>(vsrc);
  const float s2 = U.slope2;
  for (int t = 0; t < NT; ++t) {
    const int slot = (t & 1) * SLOTB;
    *reinterpret_cast<u32x4*>(kdst + slot) = kreg; *reinterpret_cast<u32x4*>(vdst + slot) = vreg;
    __syncthreads();
    if (t + 1 < NT) { kreg = *reinterpret_cast<const u32x4*>(ksrc + (long)(t + 1) * KVBLK * PITCH); vreg = *reinterpret_cast<const u32x4*>(vsrc + (long)(t + 1) * KVBLK * PITCH); }
    f32x16 p0, p1; qkt(p0, p1, shm + LDS_K + slot, qr, r32, hi);
    const int jb = t - (NT - 4);
    const float base = s2 * (float)(64 * t - q0 + 4 * hi);
#pragma unroll
    for (int r = 0; r < 16; ++r) { const float kr = (float)((r & 3) + 8 * (r >> 2)); p0[r] += base + s2 * kr; p1[r] += base + s2 * (kr + 32.f); }
    if (jb >= 0) { const int kb = 64 * jb + 4 * hi;
#pragma unroll
      for (int r = 0; r < 16; ++r) { const int kv = kb + (r & 3) + 8 * (r >> 2); if (kv > qrel) p0[r] = -INFINITY; if (kv + 32 > qrel) p1[r] = -INFINITY; } }
    else if (!((sel >> (t >> 2)) & 1u)) {
#pragma unroll
      for (int r = 0; r < 16; ++r) { p0[r] = -INFINITY; p1[r] = -INFINITY; } }
    float rm = fmaxf(p0[0], p1[0]);
#pragma unroll
    for (int r = 1; r < 16; ++r) rm = fmaxf(rm, fmaxf(p0[r], p1[r]));
    rm = fmaxf(rm, __shfl_xor(rm, 32));
    const float mnew = fmaxf(mrun, rm), f = __builtin_amdgcn_exp2f(mrun - mnew); mrun = mnew;
    float ps = 0.f;
#pragma unroll
    for (int r = 0; r < 16; ++r) { p0[r] = __builtin_amdgcn_exp2f(p0[r] - mnew); p1[r] = __builtin_amdgcn_exp2f(p1[r] - mnew); ps += p0[r] + p1[r]; }
    lrun = lrun * f + ps;
    if (hi == 0) wsf[r32] = f;
    u32x4 pw0, pw1, pw2, pw3;
#pragma unroll
    for (int i = 0; i < 4; ++i) { pw0[i] = cvtpk_s(p0[2 * i], p0[2 * i + 1]); pw1[i] = cvtpk_s(p0[8 + 2 * i], p0[9 + 2 * i]); pw2[i] = cvtpk_s(p1[2 * i], p1[2 * i + 1]); pw3[i] = cvtpk_s(p1[8 + 2 * i], p1[9 + 2 * i]); }
    asm volatile("s_waitcnt lgkmcnt(0)" ::: "memory");
#pragma unroll
    for (int r = 0; r < 16; ++r) { const float fr_ = wsf[crow(r, hi)]; o[0][r] *= fr_; o[1][r] *= fr_; }
    pv(o, vb0 + slot, __builtin_bit_cast(bf16x8, pw0), __builtin_bit_cast(bf16x8, pw1), __builtin_bit_cast(bf16x8, pw2), __builtin_bit_cast(bf16x8, pw3));
  }
  lrun += __shfl_xor(lrun, 32);
  if (hi == 0) wsf[32 + r32] = lrun;
  asm volatile("s_waitcnt lgkmcnt(0)" ::: "memory");
  float rli[16];
#pragma unroll
  for (int r = 0; r < 16; ++r) rli[r] = 1.0f / wsf[32 + crow(r, hi)];
  bf16* Ow = U.O + (long)(q0 + wid * 32) * 1024;
  { bf16* stg = (bf16*)(shm + LDS_OST) + wid * 2048;
#pragma unroll
    for (int r = 0; r < 16; ++r) { const int orow = crow(r, hi);
#pragma unroll
      for (int d0 = 0; d0 < 2; ++d0) stg[orow * 64 + d0 * 32 + r32] = __float2bfloat16(o[d0][r] * rli[r]); }
    asm volatile("s_waitcnt lgkmcnt(0)" ::: "memory");
#pragma unroll
    for (int i = 0; i < 4; ++i) { const int row = i * 8 + (lane >> 3), ch = lane & 7; const u32x4 v = *(const u32x4*)(stg + row * 64 + ch * 8); *(u32x4*)(Ow + (long)row * 1024 + ch * 8) = v; } }
  asm volatile("s_waitcnt lgkmcnt(0)" ::: "memory");
  __syncthreads();
}
}
namespace peer {
using bf16 = __hip_bfloat16;
using bf16x8 = __attribute__((ext_vector_type(8))) short;
using f32x16 = __attribute__((ext_vector_type(16))) float;
using u32x4 = __attribute__((ext_vector_type(4))) unsigned;
__device__ __forceinline__ int crow(int r, int hi) { return (r & 3) + 8 * (r >> 2) + 4 * hi; }
__device__ __forceinline__ int f2key(float f) { const int b = __float_as_int(f); return b ^ ((b >> 31) & 0x7fffffff); }
__device__ __forceinline__ float key2f(int k) { return __int_as_float(k ^ ((k >> 31) & 0x7fffffff)); }
__device__ __forceinline__ void ins16(int (&L)[16], int v) {
#pragma unroll
  for (int i = 0; i < 16; ++i) { const int a = L[i]; L[i] = a > v ? a : v; v = a > v ? v : a; }
}
__device__ __forceinline__ void merge16(int (&L)[16]) {
  int M[16];
#pragma unroll
  for (int i = 0; i < 16; ++i) { const int o = __shfl_xor(L[15 - i], 32); M[i] = L[i] > o ? L[i] : o; }
#pragma unroll
  for (int s = 8; s >= 1; s >>= 1)
#pragma unroll
    for (int i = 0; i < 16; ++i) if ((i & s) == 0) { const int a = M[i], b = M[i + s]; M[i] = a > b ? a : b; M[i + s] = a > b ? b : a; }
#pragma unroll
  for (int i = 0; i < 16; ++i) L[i] = M[i];
}
#define PEER_CAND_LIST(X) \
  X(0,0,0, 2,1) X(1,0,1, 2,2) X(2,0,2, 2,3) X(3,0,3, 2,4) X(4,0,4, 3,0) X(5,0,5, 3,1) X(6,0,6, 3,2) X(7,0,7, 3,3) X(8,0,8, 4,0) X(9,0,9, 4,1) X(10,0,10, 4,2) X(11,0,11, 5,0) X(12,0,12, 5,1) X(13,0,13, 6,0) X(14,0,14, 6,1) X(15,0,15, 7,0) X(16,1,0, 7,1) X(17,1,1, 8,0) X(18,1,2, 9,0) X(19,1,3, 10,0) X(20,1,4, 11,0) X(21,1,5, 12,0) X(22,1,6, 13,0) X(23,1,7, 14,0) X(24,2,0, 15,0)

__device__ __forceinline__ void topk_task(const bf16* QP, const bf16* SK, const float* ssq, float* RSTD, int* LE, float* LG, int tg, int h, int lane) {
  const int r32 = lane & 31, hi = lane >> 5; const int t = tg * 32 + r32;
  int A[16], B[16];
#pragma unroll
  for (int p = 0; p < 2; ++p) {
    bf16x8 qf[8];
#pragma unroll
    for (int ks = 0; ks < 8; ++ks) qf[ks] = *reinterpret_cast<const bf16x8*>(QP + (size_t)t * 2048 + h * 256 + p * 128 + ks * 16 + hi * 8);
    int L[16];
#pragma unroll
    for (int i = 0; i < 16; ++i) L[i] = (int)0x80000000;
    const bf16* kb = SK + (size_t)((h * 2 + p) * 128) * 128;
#pragma unroll 1
    for (int i = 0; i < 4; ++i) {
      f32x16 acc = {};
#pragma unroll
      for (int ks = 0; ks < 8; ++ks) { const bf16x8 a = *reinterpret_cast<const bf16x8*>(kb + (size_t)(i * 32 + r32) * 128 + ks * 16 + hi * 8); acc = __builtin_amdgcn_mfma_f32_32x32x16_bf16(a, qf[ks], acc, 0, 0, 0); }
#pragma unroll
      for (int r = 0; r < 16; ++r) { const int key = i * 32 + crow(r, hi); ins16(L, (f2key(acc[r]) & ~127) | key); }
    }
    merge16(L);
#pragma unroll
    for (int i = 0; i < 16; ++i) { if (p == 0) A[i] = L[i]; else B[i] = L[i]; }
  }
  float Af[16], Bf[16];
#pragma unroll
  for (int i = 0; i < 16; ++i) { Af[i] = key2f(A[i] & ~127); Bf[i] = key2f(B[i] & ~127); }
  float C[25];
#define X(c, i0, j0, i1, j1) C[c] = hi ? (Af[i1] + Bf[j1]) : (Af[i0] + Bf[j0]);
  PEER_CAND_LIST(X)
#undef X
  int L[16];
#pragma unroll
  for (int i = 0; i < 16; ++i) L[i] = (int)0x80000000;
#pragma unroll
  for (int c = 0; c < 25; ++c) ins16(L, f2key(C[c]));
  merge16(L);
  const int tau = L[15]; const float cmax = Af[0] + Bf[0];
  float s = 0.f;
#pragma unroll
  for (int i = 0; i < 16; ++i) s += ssq[(size_t)t * 16 + i];
  const float rstd = 1.0f / sqrtf(s * (1.0f / 1024.0f) + 1e-6f);
  const float k2 = rstd * 1.4426950408889634f;
  if (h == 0 && hi == 0) RSTD[t] = rstd;
  float E[25]; float den = 0.f; int cnt = 0; unsigned selm = 0u;
#pragma unroll
  for (int c = 0; c < 25; ++c) { const bool sl = f2key(C[c]) >= tau; E[c] = sl ? __builtin_amdgcn_exp2f((C[c] - cmax) * k2) : 0.f; den += E[c]; cnt += sl ? 1 : 0; selm |= sl ? (1u << c) : 0u; }
  den += __shfl_xor(den, 32);
  const int ocnt = __shfl_xor(cnt, 32);
  int pos = hi ? ocnt : 0;
  const float rden = 1.0f / den;
  int* le = LE + (size_t)t * 128 + h * 16; float* lg = LG + (size_t)t * 128 + h * 16;
#define X(c, i0, j0, i1, j1) { if (((selm >> c) & 1u) && pos < 16) { const int ka = (hi ? A[i1] : A[i0]) & 127, kb2 = (hi ? B[j1] : B[j0]) & 127; le[pos] = ka * 128 + kb2; lg[pos] = E[c] * rden; ++pos; } }
  PEER_CAND_LIST(X)
#undef X
}

__device__ __forceinline__ float gelu_erf(float v) { return 0.5f * v * (1.0f + erff(v * 0.70710678118654752f)); }
__device__ __forceinline__ void unpack8(const u32x4 w, float (&f)[8]) {
#pragma unroll
  for (int i = 0; i < 4; ++i) { f[2 * i] = __uint_as_float(w[i] << 16); f[2 * i + 1] = __uint_as_float(w[i] & 0xffff0000u); }
}
#define PEER_DPP(v, ctrl, rmask) __int_as_float(__builtin_amdgcn_update_dpp(0, __float_as_int(v), ctrl, rmask, 0xf, false))
__device__ __forceinline__ float wave_total(float v) {
  v += PEER_DPP(v, 0xB1, 0xf);
  v += PEER_DPP(v, 0x4E, 0xf);
  v += PEER_DPP(v, 0x141, 0xf);
  v += PEER_DPP(v, 0x140, 0xf);
  v += PEER_DPP(v, 0x142, 0xa);
  v += PEER_DPP(v, 0x143, 0xc);
  return __int_as_float(__builtin_amdgcn_readlane(__float_as_int(v), 63));
}
__device__ __forceinline__ void expert_u_pass(const bf16* XMB, const bf16* U16, const float* RSTD, const int* LE, const float* LG, unsigned* PACK, int slice, int wx, int nwx, int lane) {
  for (int t = wx; t < 32768; t += nwx) {
    const int e0 = LE[(size_t)t * 128 + lane] & 16383, e1 = LE[(size_t)t * 128 + 64 + lane] & 16383;
    unsigned long long m0 = __ballot((e0 >> 10) == slice), m1 = __ballot((e1 >> 10) == slice);
    if ((m0 | m1) == 0ull) continue;
    const float g0 = LG[(size_t)t * 128 + lane], g1 = LG[(size_t)t * 128 + 64 + lane];
    float x[16];
    { const u32x4 a = *reinterpret_cast<const u32x4*>(XMB + (size_t)t * 1024 + lane * 8), b = *reinterpret_cast<const u32x4*>(XMB + (size_t)t * 1024 + 512 + lane * 8);
      float fa[8], fb[8]; unpack8(a, fa); unpack8(b, fb);
#pragma unroll
      for (int i = 0; i < 8; ++i) { x[i] = fa[i]; x[8 + i] = fb[i]; } }
    const float rstd = RSTD[t];
    while ((m0 | m1) != 0ull) {
      int e[4], kk[4]; float gk[4]; bool valid[4];
#pragma unroll
      for (int j = 0; j < 4; ++j) {
        if (m0) { const int k = __builtin_ctzll(m0); m0 &= m0 - 1; e[j] = __builtin_amdgcn_readlane(e0, k); gk[j] = __int_as_float(__builtin_amdgcn_readlane(__float_as_int(g0), k)); kk[j] = k; valid[j] = true; }
        else if (m1) { const int k = __builtin_ctzll(m1); m1 &= m1 - 1; e[j] = __builtin_amdgcn_readlane(e1, k); gk[j] = __int_as_float(__builtin_amdgcn_readlane(__float_as_int(g1), k)); kk[j] = 64 + k; valid[j] = true; }
        else { e[j] = e[0]; gk[j] = 0.f; kk[j] = 0; valid[j] = false; }
      }
      u32x4 ua[4], ub[4];
#pragma unroll
      for (int j = 0; j < 4; ++j) { const bf16* ur = U16 + (size_t)e[j] * 1024 + lane * 8; ua[j] = *reinterpret_cast<const u32x4*>(ur); ub[j] = *reinterpret_cast<const u32x4*>(ur + 512); }
      float d[4];
#pragma unroll
      for (int j = 0; j < 4; ++j) { float fa[8], fb[8]; unpack8(ua[j], fa); unpack8(ub[j], fb); float q = 0.f;
#pragma unroll
        for (int i = 0; i < 8; ++i) q += x[i] * fa[i] + x[8 + i] * fb[i];
        d[j] = wave_total(q); }
      const float hv = (lane == 0 ? d[0] : lane == 1 ? d[1] : lane == 2 ? d[2] : d[3]) * rstd;
      const float gv = lane == 0 ? gk[0] : lane == 1 ? gk[1] : lane == 2 ? gk[2] : gk[3];
      const int ev = lane == 0 ? e[0] : lane == 1 ? e[1] : lane == 2 ? e[2] : e[3];
      const int kv = lane == 0 ? kk[0] : lane == 1 ? kk[1] : lane == 2 ? kk[2] : kk[3];
      const bool vv = lane == 0 ? valid[0] : lane == 1 ? valid[1] : lane == 2 ? valid[2] : (lane == 3 && valid[3]);
      if (lane < 4 && vv) { const float a = gelu_erf(hv) * gv; const unsigned ab = __float_as_uint(a); const unsigned r = (ab + 0x7fffu + ((ab >> 16) & 1u)) & 0xffff0000u;
        PACK[(size_t)t * 128 + kv] = r | (unsigned)ev; }
    }
  }
}
__device__ __forceinline__ void expert_v_pass(const bf16* V16, const unsigned* PACK, float* out, int slice, int wx, int nwx, int lane) {
  const int g = lane >> 3, c = lane & 7;
  for (int t = wx; t < 32768; t += nwx) {
    const unsigned p0 = PACK[(size_t)t * 128 + lane], p1 = PACK[(size_t)t * 128 + 64 + lane];
    u32x4 seg[16]; float a[16];
#pragma unroll
    for (int i = 0; i < 16; ++i) { const unsigned pk = (unsigned)__builtin_amdgcn_ds_bpermute(((8 * i + g) & 63) << 2, (int)(i < 8 ? p0 : p1));
      a[i] = __uint_as_float(pk & 0xffff0000u); seg[i] = *reinterpret_cast<const u32x4*>(V16 + (size_t)(pk & 16383u) * 1024 + slice * 64 + c * 8); }
    float acc[8];
#pragma unroll
    for (int i = 0; i < 8; ++i) acc[i] = 0.f;
#pragma unroll
    for (int i = 0; i < 16; ++i) { float f[8]; unpack8(seg[i], f);
#pragma unroll
      for (int q = 0; q < 8; ++q) acc[q] += a[i] * f[q]; }
    float m4[4], m2[2], m1;
    { const bool b = (g & 4) != 0;
#pragma unroll
      for (int i = 0; i < 4; ++i) { const float keep = b ? acc[4 + i] : acc[i], send = b ? acc[i] : acc[4 + i]; m4[i] = keep + __shfl_xor(send, 32); } }
    { const bool b = (g & 2) != 0;
#pragma unroll
      for (int i = 0; i < 2; ++i) { const float keep = b ? m4[2 + i] : m4[i], send = b ? m4[i] : m4[2 + i]; m2[i] = keep + __shfl_xor(send, 16); } }
    { const bool b = (g & 1) != 0; const float keep = b ? m2[1] : m2[0], send = b ? m2[0] : m2[1]; m1 = keep + __shfl_xor(send, 8); }
    float* o = out + (size_t)t * 1024 + slice * 64 + 8 * c + g;
    *o = *o + m1;
  }
}
}
constexpr int NWAVES = 8;
constexpr int BATCH = 16, SEQ = 2048, D = 1024, M = BATCH * SEQ, NPROJ = 3072, NQP = 2048, NEXP = 16384;
constexpr float RMS_EPS = 1e-6f;
constexpr float C2 = 0.125f * 1.4426950408889634f;
constexpr float LOG2E = 1.4426950408889634f;
constexpr size_t MiB = 1u << 20;
constexpr size_t WS_CTL = 0, CTL_ZERO_BYTES = 1 * MiB;
constexpr size_t WS_WIN = 1 * MiB;
constexpr size_t WS_WOUT = 7 * MiB;
constexpr size_t WS_WQ = 9 * MiB;
constexpr size_t WS_SK = 13 * MiB;
constexpr size_t WS_KPART = 13 * MiB + 512 * 1024;
constexpr size_t WS_SSQ = 14 * MiB;
constexpr size_t WS_MISC = 16 * MiB;
constexpr size_t WS_U16 = 17 * MiB;
constexpr size_t WS_V16 = 49 * MiB;
constexpr size_t WS_XN = 81 * MiB;
constexpr size_t WS_MIX = 145 * MiB;
constexpr size_t WS_DO = 209 * MiB;
constexpr size_t WS_PROJ = 273 * MiB;
constexpr size_t WS_QP = WS_PROJ;
constexpr size_t WS_LE = WS_PROJ + 128 * MiB;
constexpr size_t WS_LG = WS_PROJ + 144 * MiB;
constexpr size_t WS_PACK = WS_PROJ + 160 * MiB;
constexpr size_t WS_RSTD = WS_PROJ + 176 * MiB;
constexpr size_t WS_END = 465 * MiB;
constexpr int CW_BAR = 4096;
constexpr int RING_OFF = 0, RING_BYTES = 131072;
constexpr int LDSCTL_OFF = RING_BYTES, MISC_OFF = LDSCTL_OFF + 320;
constexpr int LDS_BYTES = 147456;
static_assert(att::LDS_BYTES <= RING_BYTES, "attention scratch fits the ring region");

#define GAS __attribute__((address_space(1)))
#define LAS __attribute__((address_space(3)))
typedef unsigned short bf16;
typedef unsigned v4u __attribute__((ext_vector_type(4)));
typedef unsigned v2u __attribute__((ext_vector_type(2)));
typedef float f32x4 __attribute__((ext_vector_type(4)));
typedef GAS unsigned gu32;
#define RLX_AGENT __ATOMIC_RELAXED, __HIP_MEMORY_SCOPE_AGENT
#define LDS_WAIT() asm volatile("s_waitcnt lgkmcnt(0)" ::: "memory")
#define VM_WAIT() asm volatile("s_waitcnt vmcnt(0)" ::: "memory")
__device__ __forceinline__ unsigned f2bf(float f) { unsigned u = __builtin_bit_cast(unsigned, f); return (u + 0x7fffu + ((u >> 16) & 1u)) >> 16; }
__device__ __forceinline__ unsigned pk2(float lo, float hi) { return f2bf(lo) | (f2bf(hi) << 16); }
#define XB_TMO      128
#define XB_XCNT(j)  (256  + 64 * (j))
#define XB_XSUB(j)  (1280 + 64 * (j))
#define XB_XGEN(j)  (2304 + 64 * (j))
#define XB_TOP      3328
#define XB_TOPGEN   3392
#define XCD_BAR_WORDS 3456
#define XB_SPIN_CAP (1u << 23)

__device__ __forceinline__ unsigned xb_ld(unsigned* p)              { return __hip_atomic_load(p, __ATOMIC_RELAXED, __HIP_MEMORY_SCOPE_AGENT); }
__device__ __forceinline__ unsigned xb_add(unsigned* p, unsigned v) { return __hip_atomic_fetch_add(p, v, __ATOMIC_RELAXED, __HIP_MEMORY_SCOPE_AGENT); }
__device__ __forceinline__ unsigned xb_xcc_id() { return (unsigned)__builtin_amdgcn_s_getreg((3 << 11) | 20) & 0xFu; }
#define XB_SPIN(cond, bar) do { unsigned _sp = 0; while (cond) { __builtin_amdgcn_s_sleep(1); \
    if ((++_sp & 255u) == 0u) { if (xb_ld(&(bar)[XB_TMO])) break; if (_sp > XB_SPIN_CAP) { atomicAdd(&(bar)[XB_TMO], 1u); break; } } } } while (0)

struct XcdBarrier {
    unsigned* bar; unsigned x;
    volatile LAS unsigned* st;
};

__device__ __forceinline__ XcdBarrier xcd_barrier_post(unsigned* bar, volatile LAS unsigned* st) {
    XcdBarrier b; b.bar = bar; b.x = xb_xcc_id(); b.st = st;
    if (threadIdx.x == 0) (void)xb_add(&bar[XB_XCNT(b.x)], 1u);
    return b;
}
__device__ __forceinline__ void xcd_barrier_complete(unsigned* bar, unsigned x, unsigned& nloc, unsigned& nx) {
    const unsigned G = gridDim.x * gridDim.y * gridDim.z;
    unsigned sum, cnt, mine, sp = 0u;
    for (;;) {
        sum = 0u; cnt = 0u; mine = 0u;
#pragma unroll
        for (unsigned j = 0; j < 16; ++j) { const unsigned c = xb_ld(&bar[XB_XCNT(j)]); sum += c; cnt += (c > 0u) ? 1u : 0u; mine = (j == x) ? c : mine; }
        if (sum == G) break;
        __builtin_amdgcn_s_sleep(1);
        if ((++sp & 255u) == 0u) { if (xb_ld(&bar[XB_TMO])) break; if (sp > XB_SPIN_CAP) { atomicAdd(&bar[XB_TMO], 1u); break; } }
    }
    nloc = mine > 0u ? mine : 1u; nx = cnt > 0u ? cnt : 1u;
}

__device__ __forceinline__ void xcd_barrier(const XcdBarrier& b) {
    asm volatile("s_waitcnt vmcnt(0)" ::: "memory");
    __syncthreads();
    if (threadIdx.x == 0) {
        unsigned* bar = b.bar;
        __builtin_amdgcn_s_waitcnt(0);
        unsigned nloc = b.st[0], nx = b.st[1];
        if (nloc == 0u) { xcd_barrier_complete(bar, b.x, nloc, nx); b.st[0] = nloc; b.st[1] = nx; }
        const unsigned old = xb_add(&bar[XB_XSUB(b.x)], 1u);
        const unsigned gen = old / nloc;
        if (old + 1u == (gen + 1u) * nloc) {
            __builtin_amdgcn_fence(__ATOMIC_RELEASE, "agent");
            asm volatile("s_waitcnt vmcnt(0)" ::: "memory");
            const unsigned og = xb_add(&bar[XB_TOP], 1u);
            const unsigned tg = og / nx;
            if (og + 1u == (tg + 1u) * nx) xb_add(&bar[XB_TOPGEN], 1u);
            else XB_SPIN(xb_ld(&bar[XB_TOPGEN]) == tg, bar);
            __builtin_amdgcn_fence(__ATOMIC_ACQUIRE, "agent");
            xb_add(&bar[XB_XGEN(b.x)], 1u);
            asm volatile("s_waitcnt vmcnt(0)" ::: "memory");
        } else {
            XB_SPIN(xb_ld(&bar[XB_XGEN(b.x)]) == gen, bar);
            __builtin_amdgcn_fence(__ATOMIC_ACQUIRE, "agent");
            asm volatile("s_waitcnt vmcnt(0)" ::: "memory");
        }
    }
    __syncthreads();
}
struct Frame {
    LAS unsigned char* lds;
    volatile LAS unsigned* MISC;
    gu32* ctl;
    int tid, lane, wave;
    int vcu, G;
};
__device__ __forceinline__ float wave_sum(float v) {
#pragma unroll
    for (int o = 1; o < 64; o <<= 1) v += __shfl_xor(v, o);
    return v;
}
template <bool PERMROWS>
__device__ __forceinline__ void p0_transpose_item(const float* W, int K, int N, bf16* WT, const float* kscale, LAS float* scr, int item, int lane) {
    const int nblk = N / 32, kb = item / nblk, nb = item % nblk, k0 = 64 * kb, n0 = 32 * nb;
#pragma unroll 8
    for (int i = 0; i < 32; ++i) { const int kk = 2 * i + (lane >> 5); float w = W[(size_t)(k0 + kk) * N + n0 + (lane & 31)]; if (kscale) w *= kscale[k0 + kk]; scr[kk * 33 + (lane & 31)] = w; }
    LDS_WAIT(); asm volatile("" ::: "memory");
    int r0 = n0;
    if (PERMROWS) { const int tl = n0 >> 8, np = n0 & 255; r0 = tl * 256 + ((np >> 5) & 1) * 128 + (np >> 6) * 32; }
    const int c = lane & 7;
#pragma unroll
    for (int j = 0; j < 4; ++j) { const int n = (lane >> 3) + 8 * j; const LAS float* s = scr + (8 * c) * 33 + n;
        v4u o; o.x = pk2(s[0 * 33], s[1 * 33]); o.y = pk2(s[2 * 33], s[3 * 33]); o.z = pk2(s[4 * 33], s[5 * 33]); o.w = pk2(s[6 * 33], s[7 * 33]);
        *(GAS v4u*)(WT + (size_t)(r0 + n) * K + k0 + 8 * c) = o; }
    LDS_WAIT(); asm volatile("" ::: "memory");
}
__device__ __forceinline__ void cvt8(const float* src, bf16* dst, size_t e, const float* cscale) {
    f32x4 a = *(const GAS f32x4*)(src + e), b = *(const GAS f32x4*)(src + e + 4);
    if (cscale) { const int c = (int)(e & 1023); const f32x4 ga = *(const f32x4*)(cscale + c), gb = *(const f32x4*)(cscale + c + 4); a = a * ga; b = b * gb; }
    v4u o; o.x = pk2(a[0], a[1]); o.y = pk2(a[2], a[3]); o.z = pk2(b[0], b[1]); o.w = pk2(b[2], b[3]);
    *(GAS v4u*)(dst + e) = o;
}
__device__ __forceinline__ void rms_row_to_bf16(const float* xrow, const float* g, bf16* orow, int lane) {
    const GAS f32x4* xr = (const GAS f32x4*)xrow + lane;
    f32x4 v[4]; float s = 0.f;
#pragma unroll
    for (int j = 0; j < 4; ++j) { v[j] = xr[64 * j]; s += (v[j].x * v[j].x + v[j].y * v[j].y) + (v[j].z * v[j].z + v[j].w * v[j].w); }
    const float rstd = 1.f / sqrtf(wave_sum(s) * (1.f / 1024.f) + RMS_EPS);
    GAS unsigned long long* o8 = (GAS unsigned long long*)orow + lane;
#pragma unroll
    for (int j = 0; j < 4; ++j) { const f32x4 gg = *((const f32x4*)g + lane + 64 * j);
        o8[64 * j] = (unsigned long long)pk2(v[j].x * rstd * gg.x, v[j].y * rstd * gg.y) | ((unsigned long long)pk2(v[j].z * rstd * gg.z, v[j].w * rstd * gg.w) << 32); }
}

struct Args { const float* in[13]; float* out; unsigned char* ws; int ph_lo, ph_hi; };
__global__ void __launch_bounds__(NWAVES * 64, 2) mega_fwd(Args args) {
    extern __shared__ __attribute__((aligned(16))) unsigned char lds[];
    Frame F;
    F.lds = (LAS unsigned char*)lds;
    F.MISC = (volatile LAS unsigned*)(F.lds + MISC_OFF);
    F.tid = threadIdx.x; F.lane = F.tid & 63; F.wave = __builtin_amdgcn_readfirstlane(F.tid >> 6);
    F.G = gridDim.x; { const int bx = blockIdx.x; F.vcu = (F.G % 8 == 0) ? (bx % 8) * (F.G / 8) + bx / 8 : bx; }
    unsigned char* ws = args.ws;
    F.ctl = (gu32*)(ws + WS_CTL);
    const float* x = args.in[0]; const float* norm1_g = args.in[1]; const float* w_in = args.in[2]; const float* moba_g = args.in[3]; const float* diff_g = args.in[4];
    const float* diff_lambda = args.in[5]; const float* subln_g = args.in[6]; const float* w_out = args.in[7]; const float* norm2_g = args.in[8]; const float* w_query = args.in[9];
    const float* sub_keys = args.in[10]; const float* peer_u = args.in[11]; const float* peer_v = args.in[12];
    float* out = args.out;
    bf16* WIN = (bf16*)(ws + WS_WIN); bf16* WOUT = (bf16*)(ws + WS_WOUT); bf16* WQ = (bf16*)(ws + WS_WQ); bf16* SK = (bf16*)(ws + WS_SK);
    float* KPART = (float*)(ws + WS_KPART); float* SSQ = (float*)(ws + WS_SSQ); float* MISCG = (float*)(ws + WS_MISC);
    bf16* U16 = (bf16*)(ws + WS_U16); bf16* V16 = (bf16*)(ws + WS_V16); bf16* XN = (bf16*)(ws + WS_XN); bf16* MIX = (bf16*)(ws + WS_MIX); bf16* DOB = (bf16*)(ws + WS_DO);
    bf16* PROJ = (bf16*)(ws + WS_PROJ); bf16* QP = (bf16*)(ws + WS_QP); int* LE = (int*)(ws + WS_LE); float* LG = (float*)(ws + WS_LG); unsigned* PACK = (unsigned*)(ws + WS_PACK); float* RSTD = (float*)(ws + WS_RSTD);
    for (int u = F.tid; u < (LDS_BYTES - LDSCTL_OFF) / 4; u += NWAVES * 64) ((LAS unsigned*)(F.lds + LDSCTL_OFF))[u] = 0u;
    __syncthreads();
    XcdBarrier bar = xcd_barrier_post((unsigned*)(F.ctl + CW_BAR), F.MISC + 8);
    const int gw = F.vcu * NWAVES + F.wave, NGW = F.G * NWAVES;
    const int lo = args.ph_lo, hi = args.ph_hi;
#define IN(k) (lo <= (k) && (k) < hi)
#define GRID_BAR() xcd_barrier(bar)

    if (IN(0)) {
        LAS float* scr = (LAS float*)(F.lds + RING_OFF + F.wave * 16384);
        constexpr int I_IN = (D / 64) * (NPROJ / 32), I_OUT = (D / 64) * (D / 32), I_Q = (D / 64) * (NQP / 32);
        for (int it = gw; it < I_IN + I_OUT + I_Q; it += NGW) {
            int r = it;
            if (r < I_IN) { p0_transpose_item<true>(w_in, D, NPROJ, WIN, nullptr, scr, r, F.lane); continue; } r -= I_IN;
            if (r < I_OUT) { p0_transpose_item<false>(w_out, D, D, WOUT, nullptr, scr, r, F.lane); continue; } r -= I_OUT;
            p0_transpose_item<false>(w_query, D, NQP, WQ, norm2_g, scr, r, F.lane);
        }
        constexpr size_t C_SK = (size_t)16 * 128 * 128 / 8, C_T = (size_t)NEXP * 1024 / 8;
        for (size_t c = (size_t)gw * 64 + F.lane; c < C_SK + 2 * C_T; c += (size_t)NGW * 64) {
            if (c < C_SK) cvt8(sub_keys, SK, c * 8, nullptr);
            else if (c < C_SK + C_T) cvt8(peer_u, U16, (c - C_SK) * 8, norm2_g);
            else cvt8(peer_v, V16, (c - C_SK - C_T) * 8, nullptr);
        }
        for (int m = gw; m < M; m += NGW) rms_row_to_bf16(x + (size_t)m * D, norm1_g, XN + (size_t)m * D, F.lane);
        if (gw == 0) { const float a = wave_sum(diff_lambda[F.lane] * diff_lambda[64 + F.lane]), b = wave_sum(diff_lambda[128 + F.lane] * diff_lambda[192 + F.lane]);
            if (F.lane == 0) MISCG[0] = expf(a) - expf(b) + 0.2f; }
        GRID_BAR();
    }
    if (IN(1)) {
        pg8::Gemm g{XN, WIN, M, NPROJ, D}; pg8::StaticOrder S; S.init(M, NPROJ, F.G, (int)blockIdx.x);
        pg8::EpiProj E{PROJ, moba_g, moba_g + 64, diff_g, diff_g + 64, KPART, C2};
        pg8::gemm_phase<pg8::EpiProj, pg8::StaticOrder, true, true>(F.lds + RING_OFF, g, S, E);
        GRID_BAR();
    }
    if (IN(2)) {
        for (int p = F.vcu; p < 1536; p += F.G) {
            const int bvh = p >> 2, s = p & 3, b = bvh / 24, vh = bvh % 24;
            att::UnitDesc U; const bf16* pb = PROJ + (size_t)b * SEQ * NPROJ;
            if (vh < 8) { U.Q = (const att::bf16*)(pb + vh * 64); U.K = (const att::bf16*)(pb + 512 + vh * 64); U.V = (const att::bf16*)(pb + 1024 + vh * 64);
                U.O = (att::bf16*)(MIX + (size_t)b * SEQ * 1024 + vh * 64); U.slope2 = LOG2E * exp2f(-(float)(vh + 1)); U.moba = 1; U.kpart = KPART + (size_t)(b * 8) * 1024 + vh * 64; }
            else { const int dvh = vh - 8, dh = dvh >> 2, j = (dvh >> 1) & 1, c = dvh & 1;
                U.Q = (const att::bf16*)(pb + 1536 + dh * 128 + j * 64); U.K = (const att::bf16*)(pb + 2048 + dh * 128 + j * 64); U.V = (const att::bf16*)(pb + 2560 + dh * 128 + c * 64);
                U.O = (att::bf16*)(DOB + (size_t)b * SEQ * 1024 + (dh * 2 + j) * 128 + c * 64); U.slope2 = LOG2E * exp2f(-2.0f * (float)(dh + 1)); U.moba = 0; U.kpart = KPART; }
            U.nb = 7 - s; att::attn_unit(U, (char*)lds + RING_OFF);
            U.nb = s; att::attn_unit(U, (char*)lds + RING_OFF);
        }
        GRID_BAR();
    }
    if (IN(3)) {
        const float lam = MISCG[0];
        const int hh = F.lane >> 4, cc = (F.lane & 15) * 8;
        float gs[8];
#pragma unroll
        for (int i = 0; i < 8; ++i) gs[i] = subln_g[cc + i] * 0.8f;
        for (int t = gw; t < M; t += NGW) {
            const v4u a = *(const GAS v4u*)(DOB + (size_t)t * 1024 + hh * 256 + cc), b = *(const GAS v4u*)(DOB + (size_t)t * 1024 + hh * 256 + 128 + cc);
            float d[8]; float ss = 0.f;
#pragma unroll
            for (int i = 0; i < 4; ++i) { d[2 * i] = __uint_as_float(a[i] << 16) - lam * __uint_as_float(b[i] << 16); d[2 * i + 1] = __uint_as_float(a[i] & 0xffff0000u) - lam * __uint_as_float(b[i] & 0xffff0000u);
                ss += d[2 * i] * d[2 * i] + d[2 * i + 1] * d[2 * i + 1]; }
#pragma unroll
            for (int o = 1; o < 16; o <<= 1) ss += __shfl_xor(ss, o);
            const float r = 1.0f / sqrtf(ss * (1.0f / 128.0f) + RMS_EPS);
            v4u w; w.x = pk2(d[0] * r * gs[0], d[1] * r * gs[1]); w.y = pk2(d[2] * r * gs[2], d[3] * r * gs[3]); w.z = pk2(d[4] * r * gs[4], d[5] * r * gs[5]); w.w = pk2(d[6] * r * gs[6], d[7] * r * gs[7]);
            *(GAS v4u*)(MIX + (size_t)t * 1024 + 512 + hh * 128 + cc) = w;
        }
        GRID_BAR();
    }
    if (IN(4)) {
        pg8::Gemm g{MIX, WOUT, M, D, D}; pg8::StaticOrder S; S.init(M, D, F.G, (int)blockIdx.x);
        pg8::EpiOut E{x, out, XN, SSQ};
        pg8::gemm_phase<pg8::EpiOut, pg8::StaticOrder, true, true>(F.lds + RING_OFF, g, S, E);
        GRID_BAR();
    }
    if (IN(5)) {
        pg8::Gemm g{XN, WQ, M, NQP, D}; pg8::StaticOrder S; S.init(M, NQP, F.G, (int)blockIdx.x);
        pg8::EpiBf16 E{QP, NQP};
        pg8::gemm_phase<pg8::EpiBf16, pg8::StaticOrder, true, true>(F.lds + RING_OFF, g, S, E);
        GRID_BAR();
    }
    if (IN(6)) {
        for (int task = gw; task < (M / 32) * 8; task += NGW) peer::topk_task((const peer::bf16*)QP, (const peer::bf16*)SK, SSQ, RSTD, LE, LG, task >> 3, task & 7, F.lane);
        GRID_BAR();
    }
    if (IN(7)) {
        const int xl = (int)blockIdx.x & 7, nwx = (F.G >> 3) * NWAVES, wx = ((int)blockIdx.x >> 3) * NWAVES + F.wave;
        for (int pass = 0; pass < 2; ++pass) peer::expert_u_pass((const peer::bf16*)XN, (const peer::bf16*)U16, RSTD, LE, LG, PACK, xl + 8 * pass, wx, nwx, F.lane);
        GRID_BAR();
        for (int pass = 0; pass < 2; ++pass) peer::expert_v_pass((const peer::bf16*)V16, PACK, out, xl + 8 * pass, wx, nwx, F.lane);
    }
#undef IN
#undef GRID_BAR
}

extern "C" void kernel_launch(void* const* d_in, const int* in_sizes, int n_in, void* d_out, int out_size, void* d_ws, size_t ws_size, hipStream_t stream) {
    static int grid = 0;
    if (grid == 0) {
        if (n_in != 13 || in_sizes[0] != M * D || out_size != M * D || ws_size < WS_END) { fprintf(stderr, "kernel_launch: unexpected shapes (n_in %d, in0 %d, out %d, ws %zu); nothing launched\n", n_in, n_in > 0 ? in_sizes[0] : -1, out_size, ws_size); grid = -1; return; }
        int dev = 0, cus = 0, per_cu = 0;
        if (hipGetDevice(&dev) != hipSuccess || hipDeviceGetAttribute(&cus, hipDeviceAttributeMultiprocessorCount, dev) != hipSuccess) { grid = -1; return; }
        if (hipFuncSetAttribute((const void*)mega_fwd, hipFuncAttributeMaxDynamicSharedMemorySize, LDS_BYTES) != hipSuccess) { fprintf(stderr, "kernel_launch: hipFuncSetAttribute failed\n"); grid = -1; return; }
        if (hipOccupancyMaxActiveBlocksPerMultiprocessor(&per_cu, (const void*)mega_fwd, NWAVES * 64, LDS_BYTES) != hipSuccess || per_cu < 1) { fprintf(stderr, "kernel_launch: occupancy query reports %d workgroups per CU\n", per_cu); }
        (void)hipGetLastError();
        grid = cus;
    }
    if (grid < 0) return;
    if (hipMemsetAsync((char*)d_ws + WS_CTL, 0, CTL_ZERO_BYTES, stream) != hipSuccess) return;
    Args a{};
    for (int i = 0; i < 13; ++i) a.in[i] = (const float*)d_in[i];
    a.out = (float*)d_out; a.ws = (unsigned char*)d_ws; a.ph_lo = 0; a.ph_hi = 8;
    hipLaunchKernelGGL(mega_fwd, dim3(grid), dim3(NWAVES * 64), LDS_BYTES, stream, a);
}
```

```cpp
#include <hip/hip_runtime.h>
#include <hip/hip_bf16.h>
#include <cstdio>
#include <cstdint>
#include <cmath>
namespace pg8 {
#define PG8_LAS __attribute__((address_space(3)))
typedef unsigned short bf16_t;
typedef short bf16x8 __attribute__((ext_vector_type(8)));
typedef float f32x4 __attribute__((ext_vector_type(4)));
typedef unsigned u32x4 __attribute__((ext_vector_type(4)));
constexpr int BM = 256, BK = 64, HALF = 128, HTB = HALF * BK * 2  , STAGE_BYTES = 8 * HTB, NXCD = 8, WGM = 8;

__host__ __device__ __forceinline__ int lds_byte(int r, int c) { const int st = (r >> 4) * 2 + (c >> 5), rr = r & 15, cc = c & 31, ob = rr * 64 + cc * 2; return st * 1024 + (ob ^ (((ob >> 9) & 1) << 5)); }
__host__ __device__ __forceinline__ void stage_rc(int b, int& R, int& C) { const int st = b / 1024, sb = b % 1024, swz = sb ^ (((sb >> 9) & 1) << 5); R = (st >> 1) * 16 + swz / 64; C = (st & 1) * 32 + (swz % 64) / 2; }
__host__ __device__ __forceinline__ int perm32(int rho) { const int n = rho >> 4, i = rho & 15; return 8 * (i >> 2) + 4 * n + (i & 3); }

struct Unit { int pm, pn; };
struct Gemm { const bf16_t* A; const bf16_t* Bt; int M, N, K; };

struct StaticOrder {
    int nM, nN, nwg, G, c;
    __host__ __device__ void init(int M, int N, int G_, int c_) { nM = M / BM; nN = N / BM; nwg = nM * nN; G = G_; c = c_; }
    __host__ __device__ bool next(int i, Unit& u) const {
        const long L = (long)i * G + c; if (L >= nwg) return false;
        int wgid = (int)L; { const int q = nwg / NXCD, r = nwg % NXCD, xcd = wgid % NXCD, off = wgid / NXCD; wgid = (xcd < r ? xcd * (q + 1) : r * (q + 1) + (xcd - r) * q) + off; }
        const int nig = WGM * nN, gid = wgid / nig, fm = gid * WGM, gsz = (nM - fm) < WGM ? (nM - fm) : WGM;
        u.pm = fm + ((wgid % nig) % gsz); u.pn = (wgid % nig) / gsz; return true;
    }
    __device__ __forceinline__ void a_ready(const Unit&) const {}
    __device__ __forceinline__ void done(const Unit&) const {}
};

__device__ __forceinline__ unsigned cvt_pk_bf16(float lo, float hi) { unsigned r; asm volatile("v_cvt_pk_bf16_f32 %0, %1, %2" : "=v"(r) : "v"(lo), "v"(hi)); return r; }
typedef unsigned u32x2 __attribute__((ext_vector_type(2)));

struct EpiBf16 {
    static constexpr bool PERM = true, AFTER_DRAIN = false;
    bf16_t* O; int ldc;
    __device__ __forceinline__ void operator()(const f32x4 (&acc)[2][2][4][2], const Unit& u, int wr, int wc, int fr, int fq) const {
        const int row0 = u.pm * BM + wr * 64 + fr; const int col0 = u.pn * BM + wc * 32 + 8 * fq;
#pragma unroll
        for (int ai = 0; ai < 2; ++ai)
#pragma unroll
            for (int m = 0; m < 4; ++m) { bf16_t* rowp = O + (size_t)(row0 + ai * HALF + m * 16) * ldc + col0;
#pragma unroll
                for (int bj = 0; bj < 2; ++bj) { const f32x4 v0 = acc[ai][bj][m][0], v1 = acc[ai][bj][m][1];
                    u32x4 w; w.x = cvt_pk_bf16(v0[0], v0[1]); w.y = cvt_pk_bf16(v0[2], v0[3]); w.z = cvt_pk_bf16(v1[0], v1[1]); w.w = cvt_pk_bf16(v1[2], v1[3]);
                    *(u32x4*)(rowp + bj * HALF) = w; } }
    }
};

struct EpiProj {
    static constexpr bool PERM = true, AFTER_DRAIN = false;
    bf16_t* P; const float *gmq, *gmk, *gdq, *gdk; float* kpart; float c2;
    __device__ __forceinline__ void operator()(const f32x4 (&acc)[2][2][4][2], const Unit& u, int wr, int wc, int fr, int fq) const {
        const int type = u.pn >> 1;
        const float* g = type == 0 ? gmq : type == 1 ? gmk : type == 3 ? gdq : type == 4 ? gdk : nullptr;
        const float sc0 = (type == 0 || type == 3) ? c2 : 1.f;
        f32x4 gv[2][2];
#pragma unroll
        for (int bj = 0; bj < 2; ++bj)
#pragma unroll
            for (int n = 0; n < 2; ++n) gv[bj][n] = g ? (*(const f32x4*)(g + 32 * bj + 8 * fq + 4 * n)) * sc0 : (f32x4){1.f, 1.f, 1.f, 1.f};
        f32x4 cs[2][2];
#pragma unroll
        for (int bj = 0; bj < 2; ++bj)
#pragma unroll
            for (int n = 0; n < 2; ++n) cs[bj][n] = (f32x4){0.f, 0.f, 0.f, 0.f};
        const int row0 = u.pm * BM + wr * 64 + fr; const int col0 = u.pn * BM + wc * 64 + 8 * fq;
#pragma unroll
        for (int ai = 0; ai < 2; ++ai)
#pragma unroll
            for (int m = 0; m < 4; ++m) {
                f32x4 v[2][2];
#pragma unroll
                for (int bj = 0; bj < 2; ++bj)
#pragma unroll
                    for (int n = 0; n < 2; ++n) v[bj][n] = acc[ai][bj][m][n];
                if (g) {
                    float ss = 0.f;
#pragma unroll
                    for (int bj = 0; bj < 2; ++bj)
#pragma unroll
                        for (int n = 0; n < 2; ++n) { const f32x4 x = v[bj][n]; ss += (x[0] * x[0] + x[1] * x[1]) + (x[2] * x[2] + x[3] * x[3]); }
                    ss += __shfl_xor(ss, 16); ss += __shfl_xor(ss, 32);
                    const float r = 1.0f / sqrtf(ss * (1.0f / 64.0f) + 1e-6f);
#pragma unroll
                    for (int bj = 0; bj < 2; ++bj)
#pragma unroll
                        for (int n = 0; n < 2; ++n) { v[bj][n] = v[bj][n] * r * gv[bj][n]; cs[bj][n] += v[bj][n]; }
                }
                bf16_t* rowp = P + (size_t)(row0 + ai * HALF + m * 16) * 3072 + col0;
#pragma unroll
                for (int bj = 0; bj < 2; ++bj) { const f32x4 v0 = v[bj][0], v1 = v[bj][1];
                    u32x4 w; w.x = cvt_pk_bf16(v0[0], v0[1]); w.y = cvt_pk_bf16(v0[2], v0[3]); w.z = cvt_pk_bf16(v1[0], v1[1]); w.w = cvt_pk_bf16(v1[2], v1[3]);
                    *(u32x4*)(rowp + bj * 32) = w; }
            }
        if (type == 1) {
#pragma unroll
            for (int bj = 0; bj < 2; ++bj)
#pragma unroll
                for (int n = 0; n < 2; ++n) { f32x4 c = cs[bj][n];
#pragma unroll
                    for (int o = 1; o < 16; o <<= 1) { c[0] += __shfl_xor(c[0], o); c[1] += __shfl_xor(c[1], o); c[2] += __shfl_xor(c[2], o); c[3] += __shfl_xor(c[3], o); }
                    if (fr == 0) *(f32x4*)(kpart + (size_t)(u.pm * 2 + wr) * 512 + (u.pn - 2) * 256 + wc * 64 + bj * 32 + fq * 8 + n * 4) = c; }
        }
    }
};

struct EpiOut {
    static constexpr bool PERM = false, AFTER_DRAIN = false;
    const float* x; float* out; bf16_t* xmb; float* ssq;
    __device__ __forceinline__ void operator()(const f32x4 (&acc)[2][2][4][2], const Unit& u, int wr, int wc, int fr, int fq) const {
        const int row0 = u.pm * BM + wr * 64 + fr; const int col0 = u.pn * BM + wc * 32 + 4 * fq;
#pragma unroll
        for (int ai = 0; ai < 2; ++ai)
#pragma unroll
            for (int m = 0; m < 4; ++m) { const int row = row0 + ai * HALF + m * 16; const size_t off = (size_t)row * 1024 + col0; float s = 0.f;
#pragma unroll
                for (int bj = 0; bj < 2; ++bj)
#pragma unroll
                    for (int n = 0; n < 2; ++n) { const f32x4 xv = *(const f32x4*)(x + off + bj * HALF + n * 16); const f32x4 y = xv + acc[ai][bj][m][n];
                        *(f32x4*)(out + off + bj * HALF + n * 16) = y; u32x2 w; w.x = cvt_pk_bf16(y[0], y[1]); w.y = cvt_pk_bf16(y[2], y[3]); *(u32x2*)(xmb + off + bj * HALF + n * 16) = w;
                        s += (y[0] * y[0] + y[1] * y[1]) + (y[2] * y[2] + y[3] * y[3]); }
                s += __shfl_xor(s, 16); s += __shfl_xor(s, 32);
                if (fq == 0) ssq[(size_t)row * 16 + u.pn * 4 + wc] = s;
                if (m & 1) asm volatile("" ::: "memory"); }
    }
};
template <class Epi, class Sched, bool ALIGN_EPI = false, bool SP2 = false>
__device__ __forceinline__ void gemm_phase(PG8_LAS unsigned char* lds, const Gemm g, const Sched& S, const Epi& E) {
    const int tid = threadIdx.x, wid = __builtin_amdgcn_readfirstlane(tid >> 6), lane = tid & 63, wr = wid >> 2, wc = wid & 3, fr = lane & 15, fq = lane >> 4;
    const int K = g.K, nt = K / BK;
    unsigned voffA[2], voffB[2];
#pragma unroll
    for (int i = 0; i < 2; ++i) { int R, C; stage_rc(tid * 16 + i * 8192, R, C); const int Rb = Epi::PERM ? ((R & ~31) + perm32(R & 31)) : R;
        voffA[i] = (unsigned)(R * K + C) * 2u; voffB[i] = (unsigned)(Rb * K + C) * 2u; }
    const size_t kstep = (size_t)(BK * 2);
    const size_t hstep = (size_t)HALF * K * 2;
    const size_t tstep = 2 * hstep;
    const unsigned ldsw = (unsigned)wid * 1024u;
    const int aoff = lds_byte(wr * 64 + fr, fq * 8), boff = lds_byte(wc * 32 + fr, fq * 8);
#define PG8_SA(b, h) (((b) * 2 + (h)) * HTB)
#define PG8_SB(b, h) ((4 + (b) * 2 + (h)) * HTB)
#define PG8_STAGE(bufoff, gbase, voff) do { _Pragma("unroll") for (int _i = 0; _i < 2; ++_i) \
        __builtin_amdgcn_global_load_lds((const unsigned*)((const char*)(gbase) + (voff)[_i]), (PG8_LAS unsigned*)(lds + (bufoff) + ldsw + _i * 8192), 16, 0, 0); } while (0)
#define PG8_LDA(dst, b, h) do { _Pragma("unroll") for (int m = 0; m < 4; ++m) _Pragma("unroll") for (int k = 0; k < 2; ++k) dst[m][k] = *(const PG8_LAS bf16x8*)(lds + PG8_SA(b, h) + aoff + m * 2048 + k * 1024); } while (0)
#define PG8_LDB(dst, b, h) do { _Pragma("unroll") for (int n = 0; n < 2; ++n) _Pragma("unroll") for (int k = 0; k < 2; ++k) dst[n][k] = *(const PG8_LAS bf16x8*)(lds + PG8_SB(b, h) + boff + n * 2048 + k * 1024); } while (0)
#define PG8_MMA(ai, bj, At, Bt) do { __builtin_amdgcn_s_setprio(1); _Pragma("unroll") for (int m = 0; m < 4; ++m) _Pragma("unroll") for (int n = 0; n < 2; ++n) _Pragma("unroll") for (int k = 0; k < 2; ++k) \
        acc[ai][bj][m][n] = __builtin_amdgcn_mfma_f32_16x16x32_bf16(Bt[n][k], At[m][k], acc[ai][bj][m][n], 0, 0, 0); __builtin_amdgcn_s_setprio(0); } while (0)
#define PG8_WAIT_V(n) asm volatile("s_waitcnt vmcnt(" #n ")" ::: "memory")
#define PG8_WAIT_L(n) asm volatile("s_waitcnt lgkmcnt(" #n ")" ::: "memory")
#define PG8_BAR __builtin_amdgcn_s_barrier()
#define PG8_SCHED __builtin_amdgcn_sched_barrier(0)
    Unit cur, nxt; int ui = 0;
    if (!S.next(0, cur)) return;
    f32x4 acc[2][2][4][2];
#pragma unroll
    for (int a = 0; a < 2; ++a)
#pragma unroll
        for (int b = 0; b < 2; ++b)
#pragma unroll
            for (int m = 0; m < 4; ++m)
#pragma unroll
                for (int n = 0; n < 2; ++n) acc[a][b][m][n] = (f32x4){0.f, 0.f, 0.f, 0.f};
    bf16x8 At[4][2], B0[2][2], B1[2][2];
    const char* cA = (const char*)g.A + (size_t)cur.pm * tstep; const char* cB = (const char*)g.Bt + (size_t)cur.pn * tstep;
    S.a_ready(cur);
    if constexpr (SP2) {
        PG8_STAGE(PG8_SB(0, 0), cB, voffB); PG8_STAGE(PG8_SB(0, 1), cB + hstep, voffB); PG8_STAGE(PG8_SA(0, 0), cA, voffA); PG8_STAGE(PG8_SA(0, 1), cA + hstep, voffA);
        if (wr == 1) PG8_BAR;
        PG8_WAIT_V(2); PG8_BAR;
        PG8_STAGE(PG8_SB(1, 0), cB + kstep, voffB); PG8_STAGE(PG8_SA(1, 0), cA + kstep, voffA); PG8_STAGE(PG8_SB(1, 1), cB + hstep + kstep, voffB);
        PG8_WAIT_V(6); PG8_BAR;
    } else {
        PG8_STAGE(PG8_SB(0, 0), cB, voffB); PG8_STAGE(PG8_SA(0, 0), cA, voffA); PG8_STAGE(PG8_SB(0, 1), cB + hstep, voffB); PG8_STAGE(PG8_SA(0, 1), cA + hstep, voffA);
        if (wr == 1) PG8_BAR;
        PG8_WAIT_V(4); PG8_BAR;
        PG8_STAGE(PG8_SB(1, 0), cB + kstep, voffB); PG8_STAGE(PG8_SA(1, 0), cA + kstep, voffA); PG8_STAGE(PG8_SB(1, 1), cB + hstep + kstep, voffB);
        PG8_WAIT_V(6); PG8_BAR;
    }
    for (;;) {
        const bool has_next = S.next(ui + 1, nxt);
        const char* nA = has_next ? (const char*)g.A + (size_t)nxt.pm * tstep : cA; const char* nB = has_next ? (const char*)g.Bt + (size_t)nxt.pn * tstep : cB;
        for (int t = 0; t < nt; t += 2) {
            const bool last = (t == nt - 2);
            const char* a1 = cA + (size_t)(t + 1) * kstep;
            const char* a2 = last ? nA : cA + (size_t)(t + 2) * kstep; const char* b2 = last ? nB : cB + (size_t)(t + 2) * kstep;
            const char* a3 = a2 + kstep; const char* b3 = b2 + kstep;
            if (last && has_next) S.a_ready(nxt);
            if constexpr (SP2) {
            PG8_LDB(B0, 0, 0); PG8_LDB(B1, 0, 1); PG8_SCHED; PG8_LDA(At, 0, 0); PG8_STAGE(PG8_SA(1, 1), a1 + hstep, voffA);
            PG8_WAIT_V(8); PG8_WAIT_L(0); PG8_BAR; PG8_MMA(0, 0, At, B0); PG8_MMA(0, 1, At, B1); PG8_BAR; PG8_SCHED;
            PG8_LDA(At, 0, 1); PG8_STAGE(PG8_SB(0, 0), b2, voffB); PG8_STAGE(PG8_SB(0, 1), b2 + hstep, voffB); PG8_STAGE(PG8_SA(0, 0), a2, voffA);
            PG8_WAIT_V(8); PG8_WAIT_L(0); PG8_BAR; PG8_MMA(1, 0, At, B0); PG8_MMA(1, 1, At, B1); PG8_BAR; PG8_SCHED;
            PG8_LDB(B0, 1, 0); PG8_LDB(B1, 1, 1); PG8_SCHED; PG8_LDA(At, 1, 0); PG8_STAGE(PG8_SA(0, 1), a2 + hstep, voffA);
            PG8_WAIT_V(8); PG8_WAIT_L(0); PG8_BAR; PG8_MMA(0, 0, At, B0); PG8_MMA(0, 1, At, B1); PG8_BAR; PG8_SCHED;
            PG8_LDA(At, 1, 1); PG8_STAGE(PG8_SB(1, 0), b3, voffB); PG8_STAGE(PG8_SB(1, 1), b3 + hstep, voffB); PG8_STAGE(PG8_SA(1, 0), a3, voffA);
            PG8_WAIT_V(8); PG8_WAIT_L(0); PG8_BAR; PG8_MMA(1, 0, At, B0); PG8_MMA(1, 1, At, B1); PG8_BAR; PG8_SCHED;
            } else {
            PG8_LDB(B0, 0, 0); PG8_SCHED; PG8_LDA(At, 0, 0); PG8_STAGE(PG8_SA(1, 1), a1 + hstep, voffA);
            PG8_WAIT_L(8); PG8_BAR; PG8_WAIT_L(0); PG8_MMA(0, 0, At, B0); PG8_BAR; PG8_SCHED;
            PG8_LDB(B1, 0, 1); PG8_STAGE(PG8_SB(0, 0), b2, voffB);
            PG8_BAR; PG8_WAIT_L(0); PG8_MMA(0, 1, At, B1); PG8_BAR;
            PG8_LDA(At, 0, 1); PG8_STAGE(PG8_SA(0, 0), a2, voffA);
            PG8_BAR; PG8_WAIT_L(0); PG8_MMA(1, 0, At, B0); PG8_BAR; PG8_SCHED;
            PG8_STAGE(PG8_SB(0, 1), b2 + hstep, voffB);
            PG8_WAIT_V(6); PG8_BAR; PG8_MMA(1, 1, At, B1); PG8_BAR;
            PG8_LDB(B0, 1, 0); PG8_SCHED; PG8_LDA(At, 1, 0); PG8_STAGE(PG8_SA(0, 1), a2 + hstep, voffA);
            PG8_WAIT_L(8); PG8_BAR; PG8_WAIT_L(0); PG8_MMA(0, 0, At, B0); PG8_BAR; PG8_SCHED;
            PG8_LDB(B1, 1, 1); PG8_STAGE(PG8_SB(1, 0), b3, voffB);
            PG8_BAR; PG8_WAIT_L(0); PG8_MMA(0, 1, At, B1); PG8_BAR;
            PG8_LDA(At, 1, 1); PG8_STAGE(PG8_SA(1, 0), a3, voffA);
            PG8_BAR; PG8_WAIT_L(0); PG8_MMA(1, 0, At, B0); PG8_BAR; PG8_SCHED;
            PG8_STAGE(PG8_SB(1, 1), b3 + hstep, voffB);
            PG8_WAIT_V(6); PG8_BAR; PG8_MMA(1, 1, At, B1); PG8_BAR;
            }
        }
        if constexpr (ALIGN_EPI) { if (wr == 0) PG8_BAR; }
        if constexpr (!Epi::AFTER_DRAIN) { E(acc, cur, wr, wc, fr, fq); S.done(cur); }
        if (!has_next) break;
#pragma unroll
        for (int a = 0; a < 2; ++a)
#pragma unroll
            for (int b = 0; b < 2; ++b)
#pragma unroll
                for (int m = 0; m < 4; ++m)
#pragma unroll
                    for (int n = 0; n < 2; ++n) acc[a][b][m][n] = (f32x4){0.f, 0.f, 0.f, 0.f};
        cur = nxt; cA = nA; cB = nB; ++ui;
        if constexpr (ALIGN_EPI) { if (wr == 1) PG8_BAR; }
    }
    PG8_WAIT_V(0);
    if constexpr (!ALIGN_EPI) { if (wr == 0) PG8_BAR; }
    PG8_BAR;
    if constexpr (Epi::AFTER_DRAIN) { E.fused(acc, cur, wr, wc, fr, fq, lds, wid, lane); S.done(cur); }
#undef PG8_SA
#undef PG8_SB
#undef PG8_STAGE
#undef PG8_LDA
#undef PG8_LDB
#undef PG8_MMA
#undef PG8_WAIT_V
#undef PG8_WAIT_L
#undef PG8_BAR
#undef PG8_SCHED
}
}
namespace att {
using bf16 = __hip_bfloat16;
using bf16x8 = __attribute__((ext_vector_type(8))) short;
using s16x4 = __attribute__((ext_vector_type(4))) short;
using f32x16 = __attribute__((ext_vector_type(16))) float;
using u32x4 = __attribute__((ext_vector_type(4))) unsigned;
constexpr int PITCH = 3072, QB = 256, KVBLK = 64, NW = 8;
constexpr int SLOTB = 8192, LDS_K = 0, LDS_V = 2 * SLOTB, LDS_WS = 4 * SLOTB, LDS_OST = LDS_WS + NW * 64 * 4, LDS_BYTES = LDS_OST + NW * 4096;
__device__ __forceinline__ int crow(int r, int hi) { return (r & 3) + 8 * (r >> 2) + 4 * hi; }
typedef float f32x2_t __attribute__((ext_vector_type(2))); typedef __bf16 bf16x2_t __attribute__((ext_vector_type(2)));
__device__ __forceinline__ unsigned cvtpk_s(float lo, float hi) { f32x2_t v = {lo, hi}; bf16x2_t b = __builtin_convertvector(v, bf16x2_t); return __builtin_bit_cast(unsigned, b); }

__device__ __forceinline__ void qkt(f32x16& p0, f32x16& p1, const char* Kslot, const bf16x8* qr, int r32, int hi) {
  const char* kb = Kslot + hi * 1024 + r32 * 16;
  const f32x16 z = {};
#pragma unroll
  for (int d0 = 0; d0 < 4; ++d0) {
    const bf16x8 b0 = *reinterpret_cast<const bf16x8*>(kb + d0 * 2048);
    const bf16x8 b1 = *reinterpret_cast<const bf16x8*>(kb + d0 * 2048 + 512);
    if (d0 == 0) { p0 = __builtin_amdgcn_mfma_f32_32x32x16_bf16(b0, qr[0], z, 0, 0, 0); p1 = __builtin_amdgcn_mfma_f32_32x32x16_bf16(b1, qr[0], z, 0, 0, 0); }
    else { p0 = __builtin_amdgcn_mfma_f32_32x32x16_bf16(b0, qr[d0], p0, 0, 0, 0); p1 = __builtin_amdgcn_mfma_f32_32x32x16_bf16(b1, qr[d0], p1, 0, 0, 0); } }
}
__device__ __forceinline__ void pv(f32x16* o, int vb, bf16x8 pa0, bf16x8 pa1, bf16x8 pa2, bf16x8 pa3) {
#pragma unroll
  for (int d0 = 0; d0 < 2; ++d0) { s16x4 lo[4], hi[4];
#pragma unroll
    for (int ks = 0; ks < 4; ++ks) {
      asm volatile("ds_read_b64_tr_b16 %0,%1 offset:%c2" : "=&v"(lo[ks]) : "v"(vb), "i"(d0 * 4096 + ks * 1024) : "memory");
      asm volatile("ds_read_b64_tr_b16 %0,%1 offset:%c2" : "=&v"(hi[ks]) : "v"(vb), "i"(d0 * 4096 + ks * 1024 + 512) : "memory"); }
    asm volatile("s_waitcnt lgkmcnt(0)" ::: "memory"); __builtin_amdgcn_sched_barrier(0);
#define PK(k) (bf16x8){lo[k][0], lo[k][1], lo[k][2], lo[k][3], hi[k][0], hi[k][1], hi[k][2], hi[k][3]}
    o[d0] = __builtin_amdgcn_mfma_f32_32x32x16_bf16(pa0, PK(0), o[d0], 0, 0, 0);
    o[d0] = __builtin_amdgcn_mfma_f32_32x32x16_bf16(pa1, PK(1), o[d0], 0, 0, 0);
    o[d0] = __builtin_amdgcn_mfma_f32_32x32x16_bf16(pa2, PK(2), o[d0], 0, 0, 0);
    o[d0] = __builtin_amdgcn_mfma_f32_32x32x16_bf16(pa3, PK(3), o[d0], 0, 0, 0);
#undef PK
  }
}
struct UnitDesc { const bf16* Q; const bf16* K; const bf16* V; bf16* O; float slope2; int nb; int moba; const float* kpart; };
__device__ __forceinline__ void attn_unit(const UnitDesc& U, char* shm) {
  const int tid = threadIdx.x, lane = tid & 63, r32 = lane & 31, hi = lane >> 5; const int wid = __builtin_amdgcn_readfirstlane(tid >> 6);
  const int nb = U.nb, q0 = nb * QB;
  const bf16* Qw = U.Q + (long)(q0 + wid * 32) * PITCH;
  const unsigned lds0 = (unsigned)(uintptr_t)shm;
  float* wsf = (float*)(shm + LDS_WS) + wid * 64;
  bf16x8 qr[4];
#pragma unroll
  for (int d0 = 0; d0 < 4; ++d0) qr[d0] = *reinterpret_cast<const bf16x8*>(&Qw[(long)r32 * PITCH + d0 * 16 + hi * 8]);
  unsigned sel = 0xffu;
  if (U.moba) {
    float g[4] = {0.f, 0.f, 0.f, 0.f};
    const bf16* qrow = Qw + (long)r32 * PITCH;
    for (int c = 0; c < 8; ++c) {
      const u32x4 qv = *reinterpret_cast<const u32x4*>(qrow + c * 8);
      float qf[8];
#pragma unroll
      for (int i = 0; i < 4; ++i) { qf[2 * i] = __uint_as_float(qv[i] << 16); qf[2 * i + 1] = __uint_as_float(qv[i] & 0xffff0000u); }
#pragma unroll
      for (int j = 0; j < 4; ++j) { const int n = 4 * hi + j;
        if (n < nb) { const float* k0 = U.kpart + (size_t)(n * 2) * 512 + c * 8; const float* k1 = k0 + 512;
#pragma unroll
          for (int i = 0; i < 8; ++i) g[j] += qf[i] * (k0[i] + k1[i]); } }
    }
    float ga[8];
#pragma unroll
    for (int j = 0; j < 4; ++j) { const float o = __shfl_xor(g[j], 32); ga[j] = hi ? o : g[j]; ga[4 + j] = hi ? g[j] : o; }
    sel = 0u;
#pragma unroll
    for (int n = 0; n < 8; ++n) { int rank = 0;
#pragma unroll
      for (int m = 0; m < 8; ++m) if (m != n) rank += (m < nb && (ga[m] > ga[n] || (ga[m] == ga[n] && m < n))) ? 1 : 0;
      if (n < nb && rank < 3) sel |= (1u << n); }
  }
  const int NT = 4 * (nb + 1);
  float mrun = -30000.f, lrun = 0.f; f32x16 o[2]; o[0] = f32x16{}; o[1] = f32x16{};
  const int qrel = wid * 32 + r32;
  const bf16* ksrc = U.K + (long)lane * PITCH + wid * 8;
  const bf16* vsrc = U.V + (long)(16 * (wid & 3) + (lane >> 2)) * PITCH + (wid >> 2) * 32 + (lane & 3) * 8;
  char* kdst = shm + LDS_K + wid * 1024 + lane * 16; char* vdst = shm + LDS_V + wid * 1024 + lane * 16;
  const int vb0 = (int)(lds0 + LDS_V) + ((lane >> 4) & 1) * 32 + (lane & 3) * 8 + (4 * hi + ((lane & 15) >> 2)) * 64;
  u32x4 kreg = *reinterpret_cast<const u32x4*>(ksrc), vreg = *reinterpret_cast<const u32x4*>(vsrc);
  const float s2 = U.slope2;
  for (int t = 0; t < NT; ++t) {
    const int slot = (t & 1) * SLOTB;
    *reinterpret_cast<u32x4*>(kdst + slot) = kreg; *reinterpret_cast<u32x4*>(vdst + slot) = vreg;
    __syncthreads();
    if (t + 1 < NT) { kreg = *reinterpret_cast<const u32x4*>(ksrc + (long)(t + 1) * KVBLK * PITCH); vreg = *reinterpret_cast<const u32x4*>(vsrc + (long)(t + 1) * KVBLK * PITCH); }
    f32x16 p0, p1; qkt(p0, p1, shm + LDS_K + slot, qr, r32, hi);
    const int jb = t - (NT - 4);
    const float base = s2 * (float)(64 * t - q0 + 4 * hi);
#pragma unroll
    for (int r = 0; r < 16; ++r) { const float kr = (float)((r & 3) + 8 * (r >> 2)); p0[r] += base + s2 * kr; p1[r] += base + s2 * (kr + 32.f); }
    if (jb >= 0) { const int kb = 64 * jb + 4 * hi;
#pragma unroll
      for (int r = 0; r < 16; ++r) { const int kv = kb + (r & 3) + 8 * (r >> 2); if (kv > qrel) p0[r] = -INFINITY; if (kv + 32 > qrel) p1[r] = -INFINITY; } }
    else if (!((sel >> (t >> 2)) & 1u)) {
#pragma unroll
      for (int r = 0; r < 16; ++r) { p0[r] = -INFINITY; p1[r] = -INFINITY; } }
    float rm = fmaxf(p0[0], p1[0]);
#pragma unroll
    for (int r = 1; r < 16; ++r) rm = fmaxf(rm, fmaxf(p0[r], p1[r]));
    rm = fmaxf(rm, __shfl_xor(rm, 32));
    const float mnew = fmaxf(mrun, rm), f = __builtin_amdgcn_exp2f(mrun - mnew); mrun = mnew;
    float ps = 0.f;
#pragma unroll
    for (int r = 0; r < 16; ++r) { p0[r] = __builtin_amdgcn_exp2f(p0[r] - mnew); p1[r] = __builtin_amdgcn_exp2f(p1[r] - mnew); ps += p0[r] + p1[r]; }
    lrun = lrun * f + ps;
    if (hi == 0) wsf[r32] = f;
    u32x4 pw0, pw1, pw2, pw3;
#pragma unroll
    for (int i = 0; i < 4; ++i) { pw0[i] = cvtpk_s(p0[2 * i], p0[2 * i + 1]); pw1[i] = cvtpk_s(p0[8 + 2 * i], p0[9 + 2 * i]); pw2[i] = cvtpk_s(p1[2 * i], p1[2 * i + 1]); pw3[i] = cvtpk_s(p1[8 + 2 * i], p1[9 + 2 * i]); }
    asm volatile("s_waitcnt lgkmcnt(0)" ::: "memory");
#pragma unroll
    for (int r = 0; r < 16; ++r) { const float fr_ = wsf[crow(r, hi)]; o[0][r] *= fr_; o[1][r] *= fr_; }
    pv(o, vb0 + slot, __builtin_bit_cast(bf16x8, pw0), __builtin_bit_cast(bf16x8, pw1), __builtin_bit_cast(bf16x8, pw2), __builtin_bit_cast(bf16x8, pw3));
  }
  lrun += __shfl_xor(lrun, 32);
  if (hi == 0) wsf[32 + r32] = lrun;
  asm volatile("s_waitcnt lgkmcnt(0)" ::: "memory");
  float rli[16];
#pragma unroll
  for (int r = 0; r < 16; ++r) rli[r] = 1.0f / wsf[32 + crow(r, hi)];
  bf16* Ow = U.O + (long)(q0 + wid * 32) * 1024;
  { bf16* stg = (bf16*)(shm + LDS_OST) + wid * 2048;
#pragma unroll
    for (int r = 0; r < 16; ++r) { const int orow = crow(r, hi);
#pragma unroll
      for (int d0 = 0; d0 < 2; ++d0) stg[orow * 64 + d0 * 32 + r32] = __float2bfloat16(o[d0][r] * rli[r]); }
    asm volatile("s_waitcnt lgkmcnt(0)" ::: "memory");
#pragma unroll
    for (int i = 0; i < 4; ++i) { const int row = i * 8 + (lane >> 3), ch = lane & 7; const u32x4 v = *(const u32x4*)(stg + row * 64 + ch * 8); *(u32x4*)(Ow + (long)row * 1024 + ch * 8) = v; } }
  asm volatile("s_waitcnt lgkmcnt(0)" ::: "memory");
  __syncthreads();
}
}
namespace peer {
using bf16 = __hip_bfloat16;
using bf16x8 = __attribute__((ext_vector_type(8))) short;
using f32x16 = __attribute__((ext_vector_type(16))) float;
using u32x4 = __attribute__((ext_vector_type(4))) unsigned;
__device__ __forceinline__ int crow(int r, int hi) { return (r & 3) + 8 * (r >> 2) + 4 * hi; }
__device__ __forceinline__ int f2key(float f) { const int b = __float_as_int(f); return b ^ ((b >> 31) & 0x7fffffff); }
__device__ __forceinline__ float key2f(int k) { return __int_as_float(k ^ ((k >> 31) & 0x7fffffff)); }
__device__ __forceinline__ void ins16(int (&L)[16], int v) {
#pragma unroll
  for (int i = 0; i < 16; ++i) { const int a = L[i]; L[i] = a > v ? a : v; v = a > v ? v : a; }
}
__device__ __forceinline__ void merge16(int (&L)[16]) {
  int M[16];
#pragma unroll
  for (int i = 0; i < 16; ++i) { const int o = __shfl_xor(L[15 - i], 32); M[i] = L[i] > o ? L[i] : o; }
#pragma unroll
  for (int s = 8; s >= 1; s >>= 1)
#pragma unroll
    for (int i = 0; i < 16; ++i) if ((i & s) == 0) { const int a = M[i], b = M[i + s]; M[i] = a > b ? a : b; M[i + s] = a > b ? b : a; }
#pragma unroll
  for (int i = 0; i < 16; ++i) L[i] = M[i];
}
#define PEER_CAND_LIST(X) \
  X(0,0,0, 2,1) X(1,0,1, 2,2) X(2,0,2, 2,3) X(3,0,3, 2,4) X(4,0,4, 3,0) X(5,0,5, 3,1) X(6,0,6, 3,2) X(7,0,7, 3,3) X(8,0,8, 4,0) X(9,0,9, 4,1) X(10,0,10, 4,2) X(11,0,11, 5,0) X(12,0,12, 5,1) X(13,0,13, 6,0) X(14,0,14, 6,1) X(15,0,15, 7,0) X(16,1,0, 7,1) X(17,1,1, 8,0) X(18,1,2, 9,0) X(19,1,3, 10,0) X(20,1,4, 11,0) X(21,1,5, 12,0) X(22,1,6, 13,0) X(23,1,7, 14,0) X(24,2,0, 15,0)

__device__ __forceinline__ void topk_task(const bf16* QP, const bf16* SK, const float* ssq, float* RSTD, int* LE, float* LG, int tg, int h, int lane) {
  const int r32 = lane & 31, hi = lane >> 5; const int t = tg * 32 + r32;
  int A[16], B[16];
#pragma unroll
  for (int p = 0; p < 2; ++p) {
    bf16x8 qf[8];
#pragma unroll
    for (int ks = 0; ks < 8; ++ks) qf[ks] = *reinterpret_cast<const bf16x8*>(QP + (size_t)t * 2048 + h * 256 + p * 128 + ks * 16 + hi * 8);
    int L[16];
#pragma unroll
    for (int i = 0; i < 16; ++i) L[i] = (int)0x80000000;
    const bf16* kb = SK + (size_t)((h * 2 + p) * 128) * 128;
#pragma unroll 1
    for (int i = 0; i < 4; ++i) {
      f32x16 acc = {};
#pragma unroll
      for (int ks = 0; ks < 8; ++ks) { const bf16x8 a = *reinterpret_cast<const bf16x8*>(kb + (size_t)(i * 32 + r32) * 128 + ks * 16 + hi * 8); acc = __builtin_amdgcn_mfma_f32_32x32x16_bf16(a, qf[ks], acc, 0, 0, 0); }
#pragma unroll
      for (int r = 0; r < 16; ++r) { const int key = i * 32 + crow(r, hi); ins16(L, (f2key(acc[r]) & ~127) | key); }
    }
    merge16(L);
#pragma unroll
    for (int i = 0; i < 16; ++i) { if (p == 0) A[i] = L[i]; else B[i] = L[i]; }
  }
  float Af[16], Bf[16];
#pragma unroll
  for (int i = 0; i < 16; ++i) { Af[i] = key2f(A[i] & ~127); Bf[i] = key2f(B[i] & ~127); }
  float C[25];
#define X(c, i0, j0, i1, j1) C[c] = hi ? (Af[i1] + Bf[j1]) : (Af[i0] + Bf[j0]);
  PEER_CAND_LIST(X)
#undef X
  int L[16];
#pragma unroll
  for (int i = 0; i < 16; ++i) L[i] = (int)0x80000000;
#pragma unroll
  for (int c = 0; c < 25; ++c) ins16(L, f2key(C[c]));
  merge16(L);
  const int tau = L[15]; const float cmax = Af[0] + Bf[0];
  float s = 0.f;
#pragma unroll
  for (int i = 0; i < 16; ++i) s += ssq[(size_t)t * 16 + i];
  const float rstd = 1.0f / sqrtf(s * (1.0f / 1024.0f) + 1e-6f);
  const float k2 = rstd * 1.4426950408889634f;
  if (h == 0 && hi == 0) RSTD[t] = rstd;
  float E[25]; float den = 0.f; int cnt = 0; unsigned selm = 0u;
#pragma unroll
  for (int c = 0; c < 25; ++c) { const bool sl = f2key(C[c]) >= tau; E[c] = sl ? __builtin_amdgcn_exp2f((C[c] - cmax) * k2) : 0.f; den += E[c]; cnt += sl ? 1 : 0; selm |= sl ? (1u << c) : 0u; }
  den += __shfl_xor(den, 32);
  const int ocnt = __shfl_xor(cnt, 32);
  int pos = hi ? ocnt : 0;
  const float rden = 1.0f / den;
  int* le = LE + (size_t)t * 128 + h * 16; float* lg = LG + (size_t)t * 128 + h * 16;
#define X(c, i0, j0, i1, j1) { if (((selm >> c) & 1u) && pos < 16) { const int ka = (hi ? A[i1] : A[i0]) & 127, kb2 = (hi ? B[j1] : B[j0]) & 127; le[pos] = ka * 128 + kb2; lg[pos] = E[c] * rden; ++pos; } }
  PEER_CAND_LIST(X)
#undef X
}

__device__ __forceinline__ float gelu_erf(float v) { return 0.5f * v * (1.0f + erff(v * 0.70710678118654752f)); }
__device__ __forceinline__ void unpack8(const u32x4 w, float (&f)[8]) {
#pragma unroll
  for (int i = 0; i < 4; ++i) { f[2 * i] = __uint_as_float(w[i] << 16); f[2 * i + 1] = __uint_as_float(w[i] & 0xffff0000u); }
}
#define PEER_DPP(v, ctrl, rmask) __int_as_float(__builtin_amdgcn_update_dpp(0, __float_as_int(v), ctrl, rmask, 0xf, false))
__device__ __forceinline__ float wave_total(float v) {
  v += PEER_DPP(v, 0xB1, 0xf);
  v += PEER_DPP(v, 0x4E, 0xf);
  v += PEER_DPP(v, 0x141, 0xf);
  v += PEER_DPP(v, 0x140, 0xf);
  v += PEER_DPP(v, 0x142, 0xa);
  v += PEER_DPP(v, 0x143, 0xc);
  return __int_as_float(__builtin_amdgcn_readlane(__float_as_int(v), 63));
}
typedef __bf16 bf16x2_t __attribute__((ext_vector_type(2)));
__device__ __forceinline__ float dot2(unsigned a, unsigned b, float acc) { return __builtin_amdgcn_fdot2_f32_bf16(__builtin_bit_cast(bf16x2_t, a), __builtin_bit_cast(bf16x2_t, b), acc, false); }
#define PEER_UFETCH(G_) do { const size_t tb_ = (size_t)(G_) * 4; _Pragma("unroll") for (int j = 0; j < 4; ++j) { \
    e0[j] = LE[(tb_ + j) * 128 + lane] & 16383; e1[j] = LE[(tb_ + j) * 128 + 64 + lane] & 16383; g0[j] = LG[(tb_ + j) * 128 + lane]; g1[j] = LG[(tb_ + j) * 128 + 64 + lane]; \
    xa[j] = *reinterpret_cast<const u32x4*>(XMB + (tb_ + j) * 1024 + lane * 8); xb[j] = *reinterpret_cast<const u32x4*>(XMB + (tb_ + j) * 1024 + 512 + lane * 8); } \
    rs4 = *reinterpret_cast<const f32x4_t*>(RSTD + tb_); } while (0)
typedef float f32x4_t __attribute__((ext_vector_type(4)));
__device__ __forceinline__ void expert_u_pass(const bf16* XMB, const bf16* U16, const float* RSTD, const int* LE, const float* LG, unsigned* PACK, int slice, int wx, int nwx, int lane, char* wl) {
  unsigned* list = (unsigned*)(wl + 8192);
  int e0[4], e1[4]; float g0[4], g1[4]; u32x4 xa[4], xb[4]; f32x4_t rs4;
  int gi = wx;
  if (gi < 8192) PEER_UFETCH(gi);
  for (; gi < 8192; gi += nwx) {
    int n = 0;
    const f32x4_t rs = rs4;
#pragma unroll
    for (int j = 0; j < 4; ++j) {
      *reinterpret_cast<u32x4*>(wl + j * 2048 + lane * 16) = xa[j]; *reinterpret_cast<u32x4*>(wl + j * 2048 + 1024 + lane * 16) = xb[j];
      { const bool in = (e0[j] >> 10) == slice; const unsigned long long m = __ballot(in);
        if (in) { const int pos = n + (int)__builtin_amdgcn_mbcnt_hi((unsigned)(m >> 32), __builtin_amdgcn_mbcnt_lo((unsigned)m, 0u)); list[2 * pos] = (unsigned)e0[j] | ((unsigned)lane << 14) | ((unsigned)j << 21); list[2 * pos + 1] = __float_as_uint(g0[j]); }
        n += __builtin_popcountll(m); }
      { const bool in = (e1[j] >> 10) == slice; const unsigned long long m = __ballot(in);
        if (in) { const int pos = n + (int)__builtin_amdgcn_mbcnt_hi((unsigned)(m >> 32), __builtin_amdgcn_mbcnt_lo((unsigned)m, 0u)); list[2 * pos] = (unsigned)e1[j] | ((unsigned)(64 + lane) << 14) | ((unsigned)j << 21); list[2 * pos + 1] = __float_as_uint(g1[j]); }
        n += __builtin_popcountll(m); }
    }
    n = __builtin_amdgcn_readfirstlane(n);
    const int gnext = gi + nwx;
    if (gnext < 8192) PEER_UFETCH(gnext);
    for (int b = 0; b < n; b += 12) {
      u32x4 ua[12], ub[12]; unsigned jj[12];
#pragma unroll
      for (int s = 0; s < 12; ++s) { const int i = (b + s < n) ? (b + s) : (n - 1); const unsigned w = (unsigned)__builtin_amdgcn_readfirstlane((int)list[2 * i]);
        jj[s] = (w >> 21) & 3u; const bf16* ur = U16 + (size_t)(w & 16383u) * 1024 + lane * 8; ua[s] = *reinterpret_cast<const u32x4*>(ur); ub[s] = *reinterpret_cast<const u32x4*>(ur + 512); }
      float hv = 0.f;
#pragma unroll
      for (int s = 0; s < 12; ++s) { const u32x4 xl = *reinterpret_cast<const u32x4*>(wl + jj[s] * 2048 + lane * 16), xh = *reinterpret_cast<const u32x4*>(wl + jj[s] * 2048 + 1024 + lane * 16);
        float q = 0.f;
#pragma unroll
        for (int i = 0; i < 4; ++i) { q = dot2(ua[s][i], xl[i], q); q = dot2(ub[s][i], xh[i], q); }
        const float tot = wave_total(q);
        asm volatile("v_writelane_b32 %0, %1, %2" : "+v"(hv) : "s"(__builtin_amdgcn_readfirstlane(__float_as_int(tot))), "i"(s)); }
      if (lane < 12 && b + lane < n) { const unsigned w = list[2 * (b + lane)]; const float gk = __uint_as_float(list[2 * (b + lane) + 1]); const unsigned j = (w >> 21) & 3u;
        const float r = j == 0 ? rs[0] : j == 1 ? rs[1] : j == 2 ? rs[2] : rs[3];
        const float a = gelu_erf(hv * r) * gk; const unsigned ab = __float_as_uint(a); const unsigned rb = (ab + 0x7fffu + ((ab >> 16) & 1u)) & 0xffff0000u;
        PACK[((size_t)gi * 4 + j) * 128 + ((w >> 14) & 127u)] = rb | (w & 16383u); }
    }
  }
}
#define PEER_VISSUE(S_, A_, P0_, P1_) do { _Pragma("unroll") for (int i = 0; i < 16; ++i) { const unsigned pk = (unsigned)__builtin_amdgcn_ds_bpermute(((8 * i + g) & 63) << 2, (int)(i < 8 ? P0_ : P1_)); \
    A_[i] = __uint_as_float(pk & 0xffff0000u); S_[i] = *reinterpret_cast<const u32x4*>(V16 + (size_t)(pk & 16383u) * 1024 + slice * 64 + c * 8); } } while (0)
#define PEER_VFINISH(S_, A_, T_, O_) do { float acc[8]; _Pragma("unroll") for (int i = 0; i < 8; ++i) acc[i] = 0.f; \
    _Pragma("unroll") for (int i = 0; i < 16; ++i) { float f[8]; unpack8(S_[i], f); _Pragma("unroll") for (int q = 0; q < 8; ++q) acc[q] += A_[i] * f[q]; } \
    float m4[4], m2[2], m1; \
    { const bool bb = (g & 4) != 0; _Pragma("unroll") for (int i = 0; i < 4; ++i) { const float keep = bb ? acc[4 + i] : acc[i], send = bb ? acc[i] : acc[4 + i]; m4[i] = keep + __shfl_xor(send, 32); } } \
    { const bool bb = (g & 2) != 0; _Pragma("unroll") for (int i = 0; i < 2; ++i) { const float keep = bb ? m4[2 + i] : m4[i], send = bb ? m4[i] : m4[2 + i]; m2[i] = keep + __shfl_xor(send, 16); } } \
    { const bool bb = (g & 1) != 0; const float keep = bb ? m2[1] : m2[0], send = bb ? m2[0] : m2[1]; m1 = keep + __shfl_xor(send, 8); } \
    out[(size_t)(T_) * 1024 + slice * 64 + 8 * c + g] = (O_) + m1; } while (0)
__device__ __forceinline__ void expert_v_pass(const bf16* V16, const unsigned* PACK, float* out, int slice, int wx, int nwx, int lane) {
  const int g = lane >> 3, c = lane & 7;
  const int MT = 32768;
  u32x4 sA[16], sB[16]; float aA[16], aB[16];
  int t = wx;
  unsigned p0 = 0, p1 = 0; float oc = 0.f, on = 0.f;
  if (t < MT) { p0 = PACK[(size_t)t * 128 + lane]; p1 = PACK[(size_t)t * 128 + 64 + lane]; oc = out[(size_t)t * 1024 + slice * 64 + 8 * c + g]; }
  if (t < MT) PEER_VISSUE(sA, aA, p0, p1);
  if (t + nwx < MT) { const int t1 = t + nwx; p0 = PACK[(size_t)t1 * 128 + lane]; p1 = PACK[(size_t)t1 * 128 + 64 + lane]; on = out[(size_t)t1 * 1024 + slice * 64 + 8 * c + g]; }
  for (; t < MT; t += 2 * nwx) {
    const int t1 = t + nwx, t2 = t + 2 * nwx, t3 = t + 3 * nwx;
    if (t1 < MT) PEER_VISSUE(sB, aB, p0, p1);
    float o2 = 0.f;
    if (t2 < MT) { p0 = PACK[(size_t)t2 * 128 + lane]; p1 = PACK[(size_t)t2 * 128 + 64 + lane]; o2 = out[(size_t)t2 * 1024 + slice * 64 + 8 * c + g]; }
    PEER_VFINISH(sA, aA, t, oc);
    if (t1 >= MT) break;
    if (t2 < MT) PEER_VISSUE(sA, aA, p0, p1);
    float o3 = 0.f;
    if (t3 < MT) { p0 = PACK[(size_t)t3 * 128 + lane]; p1 = PACK[(size_t)t3 * 128 + 64 + lane]; o3 = out[(size_t)t3 * 1024 + slice * 64 + 8 * c + g]; }
    PEER_VFINISH(sB, aB, t1, on);
    oc = o2; on = o3;
  }
}
}
constexpr int NWAVES = 8;
constexpr int BATCH = 16, SEQ = 2048, D = 1024, M = BATCH * SEQ, NPROJ = 3072, NQP = 2048, NEXP = 16384;
constexpr float RMS_EPS = 1e-6f;
constexpr float C2 = 0.125f * 1.4426950408889634f;
constexpr float LOG2E = 1.4426950408889634f;
constexpr size_t MiB = 1u << 20;
constexpr size_t WS_CTL = 0, CTL_ZERO_BYTES = 1 * MiB;
constexpr size_t WS_WIN = 1 * MiB;
constexpr size_t WS_WOUT = 7 * MiB;
constexpr size_t WS_WQ = 9 * MiB;
constexpr size_t WS_SK = 13 * MiB;
constexpr size_t WS_KPART = 13 * MiB + 512 * 1024;
constexpr size_t WS_SSQ = 14 * MiB;
constexpr size_t WS_MISC = 16 * MiB;
constexpr size_t WS_U16 = 17 * MiB;
constexpr size_t WS_V16 = 49 * MiB;
constexpr size_t WS_XN = 81 * MiB;
constexpr size_t WS_MIX = 145 * MiB;
constexpr size_t WS_DO = 209 * MiB;
constexpr size_t WS_PROJ = 273 * MiB;
constexpr size_t WS_QP = WS_PROJ;
constexpr size_t WS_LE = WS_PROJ + 128 * MiB;
constexpr size_t WS_LG = WS_PROJ + 144 * MiB;
constexpr size_t WS_PACK = WS_PROJ + 160 * MiB;
constexpr size_t WS_RSTD = WS_PROJ + 176 * MiB;
constexpr size_t WS_END = 465 * MiB;
constexpr int CW_BAR = 4096;
constexpr int RING_OFF = 0, RING_BYTES = 131072;
constexpr int LDSCTL_OFF = RING_BYTES, MISC_OFF = LDSCTL_OFF + 320;
constexpr int LDS_BYTES = 147456;
static_assert(att::LDS_BYTES <= RING_BYTES, "attention scratch fits the ring region");

#define GAS __attribute__((address_space(1)))
#define LAS __attribute__((address_space(3)))
typedef unsigned short bf16;
typedef unsigned v4u __attribute__((ext_vector_type(4)));
typedef unsigned v2u __attribute__((ext_vector_type(2)));
typedef float f32x4 __attribute__((ext_vector_type(4)));
typedef GAS unsigned gu32;
#define RLX_AGENT __ATOMIC_RELAXED, __HIP_MEMORY_SCOPE_AGENT
#define LDS_WAIT() asm volatile("s_waitcnt lgkmcnt(0)" ::: "memory")
#define VM_WAIT() asm volatile("s_waitcnt vmcnt(0)" ::: "memory")
__device__ __forceinline__ unsigned f2bf(float f) { unsigned u = __builtin_bit_cast(unsigned, f); return (u + 0x7fffu + ((u >> 16) & 1u)) >> 16; }
__device__ __forceinline__ unsigned pk2(float lo, float hi) { return f2bf(lo) | (f2bf(hi) << 16); }
#define XB_TMO      128
#define XB_XCNT(j)  (256  + 64 * (j))
#define XB_XSUB(j)  (1280 + 64 * (j))
#define XB_XGEN(j)  (2304 + 64 * (j))
#define XB_TOP      3328
#define XB_TOPGEN   3392
#define XCD_BAR_WORDS 3456
#define XB_SPIN_CAP (1u << 23)

__device__ __forceinline__ unsigned xb_ld(unsigned* p)              { return __hip_atomic_load(p, __ATOMIC_RELAXED, __HIP_MEMORY_SCOPE_AGENT); }
__device__ __forceinline__ unsigned xb_add(unsigned* p, unsigned v) { return __hip_atomic_fetch_add(p, v, __ATOMIC_RELAXED, __HIP_MEMORY_SCOPE_AGENT); }
__device__ __forceinline__ unsigned xb_xcc_id() { return (unsigned)__builtin_amdgcn_s_getreg((3 << 11) | 20) & 0xFu; }
#define XB_SPIN(cond, bar) do { unsigned _sp = 0; while (cond) { __builtin_amdgcn_s_sleep(1); \
    if ((++_sp & 255u) == 0u) { if (xb_ld(&(bar)[XB_TMO])) break; if (_sp > XB_SPIN_CAP) { atomicAdd(&(bar)[XB_TMO], 1u); break; } } } } while (0)

struct XcdBarrier {
    unsigned* bar; unsigned x;
    volatile LAS unsigned* st;
};

__device__ __forceinline__ XcdBarrier xcd_barrier_post(unsigned* bar, volatile LAS unsigned* st) {
    XcdBarrier b; b.bar = bar; b.x = xb_xcc_id(); b.st = st;
    if (threadIdx.x == 0) (void)xb_add(&bar[XB_XCNT(b.x)], 1u);
    return b;
}
__device__ __forceinline__ void xcd_barrier_complete(unsigned* bar, unsigned x, unsigned& nloc, unsigned& nx) {
    const unsigned G = gridDim.x * gridDim.y * gridDim.z;
    unsigned sum, cnt, mine, sp = 0u;
    for (;;) {
        sum = 0u; cnt = 0u; mine = 0u;
#pragma unroll
        for (unsigned j = 0; j < 16; ++j) { const unsigned c = xb_ld(&bar[XB_XCNT(j)]); sum += c; cnt += (c > 0u) ? 1u : 0u; mine = (j == x) ? c : mine; }
        if (sum == G) break;
        __builtin_amdgcn_s_sleep(1);
        if ((++sp & 255u) == 0u) { if (xb_ld(&bar[XB_TMO])) break; if (sp > XB_SPIN_CAP) { atomicAdd(&bar[XB_TMO], 1u); break; } }
    }
    nloc = mine > 0u ? mine : 1u; nx = cnt > 0u ? cnt : 1u;
}

__device__ __forceinline__ void xcd_barrier(const XcdBarrier& b) {
    asm volatile("s_waitcnt vmcnt(0)" ::: "memory");
    __syncthreads();
    if (threadIdx.x == 0) {
        unsigned* bar = b.bar;
        __builtin_amdgcn_s_waitcnt(0);
        unsigned nloc = b.st[0], nx = b.st[1];
        if (nloc == 0u) { xcd_barrier_complete(bar, b.x, nloc, nx); b.st[0] = nloc; b.st[1] = nx; }
        const unsigned old = xb_add(&bar[XB_XSUB(b.x)], 1u);
        const unsigned gen = old / nloc;
        if (old + 1u == (gen + 1u) * nloc) {
            __builtin_amdgcn_fence(__ATOMIC_RELEASE, "agent");
            asm volatile("s_waitcnt vmcnt(0)" ::: "memory");
            const unsigned og = xb_add(&bar[XB_TOP], 1u);
            const unsigned tg = og / nx;
            if (og + 1u == (tg + 1u) * nx) xb_add(&bar[XB_TOPGEN], 1u);
            else XB_SPIN(xb_ld(&bar[XB_TOPGEN]) == tg, bar);
            __builtin_amdgcn_fence(__ATOMIC_ACQUIRE, "agent");
            xb_add(&bar[XB_XGEN(b.x)], 1u);
            asm volatile("s_waitcnt vmcnt(0)" ::: "memory");
        } else {
            XB_SPIN(xb_ld(&bar[XB_XGEN(b.x)]) == gen, bar);
            __builtin_amdgcn_fence(__ATOMIC_ACQUIRE, "agent");
            asm volatile("s_waitcnt vmcnt(0)" ::: "memory");
        }
    }
    __syncthreads();
}
struct Frame {
    LAS unsigned char* lds;
    volatile LAS unsigned* MISC;
    gu32* ctl;
    int tid, lane, wave;
    int vcu, G;
};
__device__ __forceinline__ float wave_sum(float v) {
#pragma unroll
    for (int o = 1; o < 64; o <<= 1) v += __shfl_xor(v, o);
    return v;
}
template <bool PERMROWS>
__device__ __forceinline__ void p0_transpose_item(const float* W, int K, int N, bf16* WT, const float* kscale, LAS float* scr, int item, int lane) {
    const int nblk = N / 32, kb = item / nblk, nb = item % nblk, k0 = 64 * kb, n0 = 32 * nb;
#pragma unroll 8
    for (int i = 0; i < 32; ++i) { const int kk = 2 * i + (lane >> 5); float w = W[(size_t)(k0 + kk) * N + n0 + (lane & 31)]; if (kscale) w *= kscale[k0 + kk]; scr[kk * 33 + (lane & 31)] = w; }
    LDS_WAIT(); asm volatile("" ::: "memory");
    int r0 = n0;
    if (PERMROWS) { const int tl = n0 >> 8, np = n0 & 255; r0 = tl * 256 + ((np >> 5) & 1) * 128 + (np >> 6) * 32; }
    const int c = lane & 7;
#pragma unroll
    for (int j = 0; j < 4; ++j) { const int n = (lane >> 3) + 8 * j; const LAS float* s = scr + (8 * c) * 33 + n;
        v4u o; o.x = pk2(s[0 * 33], s[1 * 33]); o.y = pk2(s[2 * 33], s[3 * 33]); o.z = pk2(s[4 * 33], s[5 * 33]); o.w = pk2(s[6 * 33], s[7 * 33]);
        *(GAS v4u*)(WT + (size_t)(r0 + n) * K + k0 + 8 * c) = o; }
    LDS_WAIT(); asm volatile("" ::: "memory");
}
__device__ __forceinline__ void cvt8(const float* src, bf16* dst, size_t e, const float* cscale) {
    f32x4 a = *(const GAS f32x4*)(src + e), b = *(const GAS f32x4*)(src + e + 4);
    if (cscale) { const int c = (int)(e & 1023); const f32x4 ga = *(const f32x4*)(cscale + c), gb = *(const f32x4*)(cscale + c + 4); a = a * ga; b = b * gb; }
    v4u o; o.x = pk2(a[0], a[1]); o.y = pk2(a[2], a[3]); o.z = pk2(b[0], b[1]); o.w = pk2(b[2], b[3]);
    *(GAS v4u*)(dst + e) = o;
}
__device__ __forceinline__ void rms_row_to_bf16(const float* xrow, const float* g, bf16* orow, int lane) {
    const GAS f32x4* xr = (const GAS f32x4*)xrow + lane;
    f32x4 v[4]; float s = 0.f;
#pragma unroll
    for (int j = 0; j < 4; ++j) { v[j] = xr[64 * j]; s += (v[j].x * v[j].x + v[j].y * v[j].y) + (v[j].z * v[j].z + v[j].w * v[j].w); }
    const float rstd = 1.f / sqrtf(wave_sum(s) * (1.f / 1024.f) + RMS_EPS);
    GAS unsigned long long* o8 = (GAS unsigned long long*)orow + lane;
#pragma unroll
    for (int j = 0; j < 4; ++j) { const f32x4 gg = *((const f32x4*)g + lane + 64 * j);
        o8[64 * j] = (unsigned long long)pk2(v[j].x * rstd * gg.x, v[j].y * rstd * gg.y) | ((unsigned long long)pk2(v[j].z * rstd * gg.z, v[j].w * rstd * gg.w) << 32); }
}

struct Args { const float* in[13]; float* out; unsigned char* ws; int ph_lo, ph_hi; };
__global__ void __launch_bounds__(NWAVES * 64, 2) mega_fwd(Args args) {
    extern __shared__ __attribute__((aligned(16))) unsigned char lds[];
    Frame F;
    F.lds = (LAS unsigned char*)lds;
    F.MISC = (volatile LAS unsigned*)(F.lds + MISC_OFF);
    F.tid = threadIdx.x; F.lane = F.tid & 63; F.wave = __builtin_amdgcn_readfirstlane(F.tid >> 6);
    F.G = gridDim.x; { const int bx = blockIdx.x; F.vcu = (F.G % 8 == 0) ? (bx % 8) * (F.G / 8) + bx / 8 : bx; }
    unsigned char* ws = args.ws;
    F.ctl = (gu32*)(ws + WS_CTL);
    const float* x = args.in[0]; const float* norm1_g = args.in[1]; const float* w_in = args.in[2]; const float* moba_g = args.in[3]; const float* diff_g = args.in[4];
    const float* diff_lambda = args.in[5]; const float* subln_g = args.in[6]; const float* w_out = args.in[7]; const float* norm2_g = args.in[8]; const float* w_query = args.in[9];
    const float* sub_keys = args.in[10]; const float* peer_u = args.in[11]; const float* peer_v = args.in[12];
    float* out = args.out;
    bf16* WIN = (bf16*)(ws + WS_WIN); bf16* WOUT = (bf16*)(ws + WS_WOUT); bf16* WQ = (bf16*)(ws + WS_WQ); bf16* SK = (bf16*)(ws + WS_SK);
    float* KPART = (float*)(ws + WS_KPART); float* SSQ = (float*)(ws + WS_SSQ); float* MISCG = (float*)(ws + WS_MISC);
    bf16* U16 = (bf16*)(ws + WS_U16); bf16* V16 = (bf16*)(ws + WS_V16); bf16* XN = (bf16*)(ws + WS_XN); bf16* MIX = (bf16*)(ws + WS_MIX); bf16* DOB = (bf16*)(ws + WS_DO);
    bf16* PROJ = (bf16*)(ws + WS_PROJ); bf16* QP = (bf16*)(ws + WS_QP); int* LE = (int*)(ws + WS_LE); float* LG = (float*)(ws + WS_LG); unsigned* PACK = (unsigned*)(ws + WS_PACK); float* RSTD = (float*)(ws + WS_RSTD);
    for (int u = F.tid; u < (LDS_BYTES - LDSCTL_OFF) / 4; u += NWAVES * 64) ((LAS unsigned*)(F.lds + LDSCTL_OFF))[u] = 0u;
    __syncthreads();
    XcdBarrier bar = xcd_barrier_post((unsigned*)(F.ctl + CW_BAR), F.MISC + 8);
    const int gw = F.vcu * NWAVES + F.wave, NGW = F.G * NWAVES;
    const int lo = args.ph_lo, hi = args.ph_hi;
#define IN(k) (lo <= (k) && (k) < hi)
#ifndef PROBE_DUP
#define PROBE_DUP -1
#endif
#define REP(k) for (int rep_ = 0; rep_ < ((PROBE_DUP == (k)) ? 2 : 1); ++rep_)
#define GRID_BAR() xcd_barrier(bar)

    if (IN(0)) {
        LAS float* scr = (LAS float*)(F.lds + RING_OFF + F.wave * 16384);
        constexpr int I_IN = (D / 64) * (NPROJ / 32), I_OUT = (D / 64) * (D / 32), I_Q = (D / 64) * (NQP / 32);
        for (int it = gw; it < I_IN + I_OUT + I_Q; it += NGW) {
            int r = it;
            if (r < I_IN) { p0_transpose_item<true>(w_in, D, NPROJ, WIN, nullptr, scr, r, F.lane); continue; } r -= I_IN;
            if (r < I_OUT) { p0_transpose_item<false>(w_out, D, D, WOUT, nullptr, scr, r, F.lane); continue; } r -= I_OUT;
            p0_transpose_item<false>(w_query, D, NQP, WQ, norm2_g, scr, r, F.lane);
        }
        constexpr size_t C_SK = (size_t)16 * 128 * 128 / 8, C_T = (size_t)NEXP * 1024 / 8;
        for (size_t c = (size_t)gw * 64 + F.lane; c < C_SK + 2 * C_T; c += (size_t)NGW * 64) {
            if (c < C_SK) cvt8(sub_keys, SK, c * 8, nullptr);
            else if (c < C_SK + C_T) cvt8(peer_u, U16, (c - C_SK) * 8, norm2_g);
            else cvt8(peer_v, V16, (c - C_SK - C_T) * 8, nullptr);
        }
        for (int m = gw; m < M; m += NGW) rms_row_to_bf16(x + (size_t)m * D, norm1_g, XN + (size_t)m * D, F.lane);
        if (gw == 0) { const float a = wave_sum(diff_lambda[F.lane] * diff_lambda[64 + F.lane]), b = wave_sum(diff_lambda[128 + F.lane] * diff_lambda[192 + F.lane]);
            if (F.lane == 0) MISCG[0] = expf(a) - expf(b) + 0.2f; }
        GRID_BAR();
    }
    if (IN(1)) {
        pg8::Gemm g{XN, WIN, M, NPROJ, D}; pg8::StaticOrder S; S.init(M, NPROJ, F.G, (int)blockIdx.x);
        pg8::EpiProj E{PROJ, moba_g, moba_g + 64, diff_g, diff_g + 64, KPART, C2};
        pg8::gemm_phase<pg8::EpiProj, pg8::StaticOrder, true, true>(F.lds + RING_OFF, g, S, E);
        GRID_BAR();
    }
    if (IN(2)) {
        REP(2) for (int p = F.vcu; p < 1536; p += F.G) {
            const int bvh = p >> 2, s = p & 3, b = bvh / 24, vh = bvh % 24;
            att::UnitDesc U; const bf16* pb = PROJ + (size_t)b * SEQ * NPROJ;
            if (vh < 8) { U.Q = (const att::bf16*)(pb + vh * 64); U.K = (const att::bf16*)(pb + 512 + vh * 64); U.V = (const att::bf16*)(pb + 1024 + vh * 64);
                U.O = (att::bf16*)(MIX + (size_t)b * SEQ * 1024 + vh * 64); U.slope2 = LOG2E * exp2f(-(float)(vh + 1)); U.moba = 1; U.kpart = KPART + (size_t)(b * 8) * 1024 + vh * 64; }
            else { const int dvh = vh - 8, dh = dvh >> 2, j = (dvh >> 1) & 1, c = dvh & 1;
                U.Q = (const att::bf16*)(pb + 1536 + dh * 128 + j * 64); U.K = (const att::bf16*)(pb + 2048 + dh * 128 + j * 64); U.V = (const att::bf16*)(pb + 2560 + dh * 128 + c * 64);
                U.O = (att::bf16*)(DOB + (size_t)b * SEQ * 1024 + (dh * 2 + j) * 128 + c * 64); U.slope2 = LOG2E * exp2f(-2.0f * (float)(dh + 1)); U.moba = 0; U.kpart = KPART; }
            U.nb = 7 - s; att::attn_unit(U, (char*)lds + RING_OFF);
            U.nb = s; att::attn_unit(U, (char*)lds + RING_OFF);
        }
        GRID_BAR();
    }
    if (IN(3)) {
        const float lam = MISCG[0];
        const int hh = F.lane >> 4, cc = (F.lane & 15) * 8;
        float gs[8];
#pragma unroll
        for (int i = 0; i < 8; ++i) gs[i] = subln_g[cc + i] * 0.8f;
        for (int t = gw; t < M; t += NGW) {
            const v4u a = *(const GAS v4u*)(DOB + (size_t)t * 1024 + hh * 256 + cc), b = *(const GAS v4u*)(DOB + (size_t)t * 1024 + hh * 256 + 128 + cc);
            float d[8]; float ss = 0.f;
#pragma unroll
            for (int i = 0; i < 4; ++i) { d[2 * i] = __uint_as_float(a[i] << 16) - lam * __uint_as_float(b[i] << 16); d[2 * i + 1] = __uint_as_float(a[i] & 0xffff0000u) - lam * __uint_as_float(b[i] & 0xffff0000u);
                ss += d[2 * i] * d[2 * i] + d[2 * i + 1] * d[2 * i + 1]; }
#pragma unroll
            for (int o = 1; o < 16; o <<= 1) ss += __shfl_xor(ss, o);
            const float r = 1.0f / sqrtf(ss * (1.0f / 128.0f) + RMS_EPS);
            v4u w; w.x = pk2(d[0] * r * gs[0], d[1] * r * gs[1]); w.y = pk2(d[2] * r * gs[2], d[3] * r * gs[3]); w.z = pk2(d[4] * r * gs[4], d[5] * r * gs[5]); w.w = pk2(d[6] * r * gs[6], d[7] * r * gs[7]);
            *(GAS v4u*)(MIX + (size_t)t * 1024 + 512 + hh * 128 + cc) = w;
        }
        GRID_BAR();
    }
    if (IN(4)) {
        pg8::Gemm g{MIX, WOUT, M, D, D}; pg8::StaticOrder S; S.init(M, D, F.G, (int)blockIdx.x);
        pg8::EpiOut E{x, out, XN, SSQ};
        pg8::gemm_phase<pg8::EpiOut, pg8::StaticOrder, true, true>(F.lds + RING_OFF, g, S, E);
        GRID_BAR();
    }
    if (IN(5)) {
        pg8::Gemm g{XN, WQ, M, NQP, D}; pg8::StaticOrder S; S.init(M, NQP, F.G, (int)blockIdx.x);
        pg8::EpiBf16 E{QP, NQP};
        pg8::gemm_phase<pg8::EpiBf16, pg8::StaticOrder, true, true>(F.lds + RING_OFF, g, S, E);
        GRID_BAR();
    }
    if (IN(6)) {
        REP(6) for (int task = gw; task < (M / 32) * 8; task += NGW) peer::topk_task((const peer::bf16*)QP, (const peer::bf16*)SK, SSQ, RSTD, LE, LG, task >> 3, task & 7, F.lane);
        GRID_BAR();
    }
    if (IN(7)) {
        const int xl = (int)blockIdx.x & 7, nwx = (F.G >> 3) * NWAVES, wx = ((int)blockIdx.x >> 3) * NWAVES + F.wave;
        REP(70) for (int pass = 0; pass < 2; ++pass) peer::expert_u_pass((const peer::bf16*)XN, (const peer::bf16*)U16, RSTD, LE, LG, PACK, xl + 8 * pass, wx, nwx, F.lane, (char*)lds + RING_OFF + F.wave * 12288);
        GRID_BAR();
        if (PROBE_DUP == 71) for (int pass = 0; pass < 2; ++pass) peer::expert_v_pass((const peer::bf16*)V16, PACK, (float*)QP, xl + 8 * pass, wx, nwx, F.lane);
        for (int pass = 0; pass < 2; ++pass) peer::expert_v_pass((const peer::bf16*)V16, PACK, out, xl + 8 * pass, wx, nwx, F.lane);
    }
#undef IN
#undef GRID_BAR
}

extern "C" void kernel_launch(void* const* d_in, const int* in_sizes, int n_in, void* d_out, int out_size, void* d_ws, size_t ws_size, hipStream_t stream) {
    static int grid = 0;
    if (grid == 0) {
        if (n_in != 13 || in_sizes[0] != M * D || out_size != M * D || ws_size < WS_END) { fprintf(stderr, "kernel_launch: unexpected shapes (n_in %d, in0 %d, out %d, ws %zu); nothing launched\n", n_in, n_in > 0 ? in_sizes[0] : -1, out_size, ws_size); grid = -1; return; }
        int dev = 0, cus = 0, per_cu = 0;
        if (hipGetDevice(&dev) != hipSuccess || hipDeviceGetAttribute(&cus, hipDeviceAttributeMultiprocessorCount, dev) != hipSuccess) { grid = -1; return; }
        if (hipFuncSetAttribute((const void*)mega_fwd, hipFuncAttributeMaxDynamicSharedMemorySize, LDS_BYTES) != hipSuccess) { fprintf(stderr, "kernel_launch: hipFuncSetAttribute failed\n"); grid = -1; return; }
        if (hipOccupancyMaxActiveBlocksPerMultiprocessor(&per_cu, (const void*)mega_fwd, NWAVES * 64, LDS_BYTES) != hipSuccess || per_cu < 1) { fprintf(stderr, "kernel_launch: occupancy query reports %d workgroups per CU\n", per_cu); }
        (void)hipGetLastError();
        grid = cus;
    }
    if (grid < 0) return;
    if (hipMemsetAsync((char*)d_ws + WS_CTL, 0, CTL_ZERO_BYTES, stream) != hipSuccess) return;
    Args a{};
    for (int i = 0; i < 13; ++i) a.in[i] = (const float*)d_in[i];
    a.out = (float*)d_out; a.ws = (unsigned char*)d_ws; a.ph_lo = 0; a.ph_hi = 8;
    hipLaunchKernelGGL(mega_fwd, dim3(grid), dim3(NWAVES * 64), LDS_BYTES, stream, a);
}
```

```cpp
#include <hip/hip_runtime.h>
#include <hip/hip_bf16.h>
#include <cstdio>
#include <cstdint>
#include <cmath>
namespace pg8 {
#define PG8_LAS __attribute__((address_space(3)))
typedef unsigned short bf16_t;
typedef short bf16x8 __attribute__((ext_vector_type(8)));
typedef float f32x4 __attribute__((ext_vector_type(4)));
typedef unsigned u32x4 __attribute__((ext_vector_type(4)));
constexpr int BM = 256, BK = 64, HALF = 128, HTB = HALF * BK * 2  , STAGE_BYTES = 8 * HTB, NXCD = 8, WGM = 8;

__host__ __device__ __forceinline__ int lds_byte(int r, int c) { const int st = (r >> 4) * 2 + (c >> 5), rr = r & 15, cc = c & 31, ob = rr * 64 + cc * 2; return st * 1024 + (ob ^ (((ob >> 9) & 1) << 5)); }
__host__ __device__ __forceinline__ void stage_rc(int b, int& R, int& C) { const int st = b / 1024, sb = b % 1024, swz = sb ^ (((sb >> 9) & 1) << 5); R = (st >> 1) * 16 + swz / 64; C = (st & 1) * 32 + (swz % 64) / 2; }
__host__ __device__ __forceinline__ int perm32(int rho) { const int n = rho >> 4, i = rho & 15; return 8 * (i >> 2) + 4 * n + (i & 3); }

struct Unit { int pm, pn; };
struct Gemm { const bf16_t* A; const bf16_t* Bt; int M, N, K; };

struct StaticOrder {
    int nM, nN, nwg, G, c;
    __host__ __device__ void init(int M, int N, int G_, int c_) { nM = M / BM; nN = N / BM; nwg = nM * nN; G = G_; c = c_; }
    __host__ __device__ bool next(int i, Unit& u) const {
        const long L = (long)i * G + c; if (L >= nwg) return false;
        int wgid = (int)L; { const int q = nwg / NXCD, r = nwg % NXCD, xcd = wgid % NXCD, off = wgid / NXCD; wgid = (xcd < r ? xcd * (q + 1) : r * (q + 1) + (xcd - r) * q) + off; }
        const int nig = WGM * nN, gid = wgid / nig, fm = gid * WGM, gsz = (nM - fm) < WGM ? (nM - fm) : WGM;
        u.pm = fm + ((wgid % nig) % gsz); u.pn = (wgid % nig) / gsz; return true;
    }
    __device__ __forceinline__ void a_ready(const Unit&) const {}
    __device__ __forceinline__ void done(const Unit&) const {}
};

__device__ __forceinline__ unsigned cvt_pk_bf16(float lo, float hi) { unsigned r; asm volatile("v_cvt_pk_bf16_f32 %0, %1, %2" : "=v"(r) : "v"(lo), "v"(hi)); return r; }
typedef unsigned u32x2 __attribute__((ext_vector_type(2)));

struct EpiBf16 {
    static constexpr bool PERM = true, AFTER_DRAIN = false;
    bf16_t* O; int ldc;
    __device__ __forceinline__ void operator()(const f32x4 (&acc)[2][2][4][2], const Unit& u, int wr, int wc, int fr, int fq) const {
        const int row0 = u.pm * BM + wr * 64 + fr; const int col0 = u.pn * BM + wc * 32 + 8 * fq;
#pragma unroll
        for (int ai = 0; ai < 2; ++ai)
#pragma unroll
            for (int m = 0; m < 4; ++m) { bf16_t* rowp = O + (size_t)(row0 + ai * HALF + m * 16) * ldc + col0;
#pragma unroll
                for (int bj = 0; bj < 2; ++bj) { const f32x4 v0 = acc[ai][bj][m][0], v1 = acc[ai][bj][m][1];
                    u32x4 w; w.x = cvt_pk_bf16(v0[0], v0[1]); w.y = cvt_pk_bf16(v0[2], v0[3]); w.z = cvt_pk_bf16(v1[0], v1[1]); w.w = cvt_pk_bf16(v1[2], v1[3]);
                    *(u32x4*)(rowp + bj * HALF) = w; } }
    }
};

struct EpiProj {
    static constexpr bool PERM = true, AFTER_DRAIN = false;
    bf16_t* P; const float *gmq, *gmk, *gdq, *gdk; float* kpart; float c2;
    __device__ __forceinline__ void operator()(const f32x4 (&acc)[2][2][4][2], const Unit& u, int wr, int wc, int fr, int fq) const {
        const int type = u.pn >> 1;
        const float* g = type == 0 ? gmq : type == 1 ? gmk : type == 3 ? gdq : type == 4 ? gdk : nullptr;
        const float sc0 = (type == 0 || type == 3) ? c2 : 1.f;
        f32x4 gv[2][2];
#pragma unroll
        for (int bj = 0; bj < 2; ++bj)
#pragma unroll
            for (int n = 0; n < 2; ++n) gv[bj][n] = g ? (*(const f32x4*)(g + 32 * bj + 8 * fq + 4 * n)) * sc0 : (f32x4){1.f, 1.f, 1.f, 1.f};
        f32x4 cs[2][2];
#pragma unroll
        for (int bj = 0; bj < 2; ++bj)
#pragma unroll
            for (int n = 0; n < 2; ++n) cs[bj][n] = (f32x4){0.f, 0.f, 0.f, 0.f};
        const int row0 = u.pm * BM + wr * 64 + fr; const int col0 = u.pn * BM + wc * 64 + 8 * fq;
#pragma unroll
        for (int ai = 0; ai < 2; ++ai)
#pragma unroll
            for (int m = 0; m < 4; ++m) {
                f32x4 v[2][2];
#pragma unroll
                for (int bj = 0; bj < 2; ++bj)
#pragma unroll
                    for (int n = 0; n < 2; ++n) v[bj][n] = acc[ai][bj][m][n];
                if (g) {
                    float ss = 0.f;
#pragma unroll
                    for (int bj = 0; bj < 2; ++bj)
#pragma unroll
                        for (int n = 0; n < 2; ++n) { const f32x4 x = v[bj][n]; ss += (x[0] * x[0] + x[1] * x[1]) + (x[2] * x[2] + x[3] * x[3]); }
                    ss += __shfl_xor(ss, 16); ss += __shfl_xor(ss, 32);
                    const float r = 1.0f / sqrtf(ss * (1.0f / 64.0f) + 1e-6f);
#pragma unroll
                    for (int bj = 0; bj < 2; ++bj)
#pragma unroll
                        for (int n = 0; n < 2; ++n) { v[bj][n] = v[bj][n] * r * gv[bj][n]; cs[bj][n] += v[bj][n]; }
                }
                bf16_t* rowp = P + (size_t)(row0 + ai * HALF + m * 16) * 3072 + col0;
#pragma unroll
                for (int bj = 0; bj < 2; ++bj) { const f32x4 v0 = v[bj][0], v1 = v[bj][1];
                    u32x4 w; w.x = cvt_pk_bf16(v0[0], v0[1]); w.y = cvt_pk_bf16(v0[2], v0[3]); w.z = cvt_pk_bf16(v1[0], v1[1]); w.w = cvt_pk_bf16(v1[2], v1[3]);
                    *(u32x4*)(rowp + bj * 32) = w; }
            }
        if (type == 1) {
#pragma unroll
            for (int bj = 0; bj < 2; ++bj)
#pragma unroll
                for (int n = 0; n < 2; ++n) { f32x4 c = cs[bj][n];
#pragma unroll
                    for (int o = 1; o < 16; o <<= 1) { c[0] += __shfl_xor(c[0], o); c[1] += __shfl_xor(c[1], o); c[2] += __shfl_xor(c[2], o); c[3] += __shfl_xor(c[3], o); }
                    if (fr == 0) *(f32x4*)(kpart + (size_t)(u.pm * 2 + wr) * 512 + (u.pn - 2) * 256 + wc * 64 + bj * 32 + fq * 8 + n * 4) = c; }
        }
    }
};

struct EpiOut {
    static constexpr bool PERM = false, AFTER_DRAIN = false;
    const float* x; float* out; bf16_t* xmb; float* ssq;
    __device__ __forceinline__ void operator()(const f32x4 (&acc)[2][2][4][2], const Unit& u, int wr, int wc, int fr, int fq) const {
        const int row0 = u.pm * BM + wr * 64 + fr; const int col0 = u.pn * BM + wc * 32 + 4 * fq;
#pragma unroll
        for (int ai = 0; ai < 2; ++ai)
#pragma unroll
            for (int m = 0; m < 4; ++m) { const int row = row0 + ai * HALF + m * 16; const size_t off = (size_t)row * 1024 + col0; float s = 0.f;
#pragma unroll
                for (int bj = 0; bj < 2; ++bj)
#pragma unroll
                    for (int n = 0; n < 2; ++n) { const f32x4 xv = *(const f32x4*)(x + off + bj * HALF + n * 16); const f32x4 y = xv + acc[ai][bj][m][n];
                        *(f32x4*)(out + off + bj * HALF + n * 16) = y; u32x2 w; w.x = cvt_pk_bf16(y[0], y[1]); w.y = cvt_pk_bf16(y[2], y[3]); *(u32x2*)(xmb + off + bj * HALF + n * 16) = w;
                        s += (y[0] * y[0] + y[1] * y[1]) + (y[2] * y[2] + y[3] * y[3]); }
                s += __shfl_xor(s, 16); s += __shfl_xor(s, 32);
                if (fq == 0) ssq[(size_t)row * 16 + u.pn * 4 + wc] = s;
                if (m & 1) asm volatile("" ::: "memory"); }
    }
};
template <class Epi, class Sched, bool ALIGN_EPI = false, bool SP2 = false>
__device__ __forceinline__ void gemm_phase(PG8_LAS unsigned char* lds, const Gemm g, const Sched& S, const Epi& E) {
    const int tid = threadIdx.x, wid = __builtin_amdgcn_readfirstlane(tid >> 6), lane = tid & 63, wr = wid >> 2, wc = wid & 3, fr = lane & 15, fq = lane >> 4;
    const int K = g.K, nt = K / BK;
    unsigned voffA[2], voffB[2];
#pragma unroll
    for (int i = 0; i < 2; ++i) { int R, C; stage_rc(tid * 16 + i * 8192, R, C); const int Rb = Epi::PERM ? ((R & ~31) + perm32(R & 31)) : R;
        voffA[i] = (unsigned)(R * K + C) * 2u; voffB[i] = (unsigned)(Rb * K + C) * 2u; }
    const size_t kstep = (size_t)(BK * 2);
    const size_t hstep = (size_t)HALF * K * 2;
    const size_t tstep = 2 * hstep;
    const unsigned ldsw = (unsigned)wid * 1024u;
    const int aoff = lds_byte(wr * 64 + fr, fq * 8), boff = lds_byte(wc * 32 + fr, fq * 8);
#define PG8_SA(b, h) (((b) * 2 + (h)) * HTB)
#define PG8_SB(b, h) ((4 + (b) * 2 + (h)) * HTB)
#define PG8_STAGE(bufoff, gbase, voff) do { _Pragma("unroll") for (int _i = 0; _i < 2; ++_i) \
        __builtin_amdgcn_global_load_lds((const unsigned*)((const char*)(gbase) + (voff)[_i]), (PG8_LAS unsigned*)(lds + (bufoff) + ldsw + _i * 8192), 16, 0, 0); } while (0)
#define PG8_LDA(dst, b, h) do { _Pragma("unroll") for (int m = 0; m < 4; ++m) _Pragma("unroll") for (int k = 0; k < 2; ++k) dst[m][k] = *(const PG8_LAS bf16x8*)(lds + PG8_SA(b, h) + aoff + m * 2048 + k * 1024); } while (0)
#define PG8_LDB(dst, b, h) do { _Pragma("unroll") for (int n = 0; n < 2; ++n) _Pragma("unroll") for (int k = 0; k < 2; ++k) dst[n][k] = *(const PG8_LAS bf16x8*)(lds + PG8_SB(b, h) + boff + n * 2048 + k * 1024); } while (0)
#define PG8_MMA(ai, bj, At, Bt) do { __builtin_amdgcn_s_setprio(1); _Pragma("unroll") for (int m = 0; m < 4; ++m) _Pragma("unroll") for (int n = 0; n < 2; ++n) _Pragma("unroll") for (int k = 0; k < 2; ++k) \
        acc[ai][bj][m][n] = __builtin_amdgcn_mfma_f32_16x16x32_bf16(Bt[n][k], At[m][k], acc[ai][bj][m][n], 0, 0, 0); __builtin_amdgcn_s_setprio(0); } while (0)
#define PG8_WAIT_V(n) asm volatile("s_waitcnt vmcnt(" #n ")" ::: "memory")
#define PG8_WAIT_L(n) asm volatile("s_waitcnt lgkmcnt(" #n ")" ::: "memory")
#define PG8_BAR __builtin_amdgcn_s_barrier()
#define PG8_SCHED __builtin_amdgcn_sched_barrier(0)
    Unit cur, nxt; int ui = 0;
    if (!S.next(0, cur)) return;
    f32x4 acc[2][2][4][2];
#pragma unroll
    for (int a = 0; a < 2; ++a)
#pragma unroll
        for (int b = 0; b < 2; ++b)
#pragma unroll
            for (int m = 0; m < 4; ++m)
#pragma unroll
                for (int n = 0; n < 2; ++n) acc[a][b][m][n] = (f32x4){0.f, 0.f, 0.f, 0.f};
    bf16x8 At[4][2], B0[2][2], B1[2][2];
    const char* cA = (const char*)g.A + (size_t)cur.pm * tstep; const char* cB = (const char*)g.Bt + (size_t)cur.pn * tstep;
    S.a_ready(cur);
    if constexpr (SP2) {
        PG8_STAGE(PG8_SB(0, 0), cB, voffB); PG8_STAGE(PG8_SB(0, 1), cB + hstep, voffB); PG8_STAGE(PG8_SA(0, 0), cA, voffA); PG8_STAGE(PG8_SA(0, 1), cA + hstep, voffA);
        if (wr == 1) PG8_BAR;
        PG8_WAIT_V(2); PG8_BAR;
        PG8_STAGE(PG8_SB(1, 0), cB + kstep, voffB); PG8_STAGE(PG8_SA(1, 0), cA + kstep, voffA); PG8_STAGE(PG8_SB(1, 1), cB + hstep + kstep, voffB);
        PG8_WAIT_V(6); PG8_BAR;
    } else {
        PG8_STAGE(PG8_SB(0, 0), cB, voffB); PG8_STAGE(PG8_SA(0, 0), cA, voffA); PG8_STAGE(PG8_SB(0, 1), cB + hstep, voffB); PG8_STAGE(PG8_SA(0, 1), cA + hstep, voffA);
        if (wr == 1) PG8_BAR;
        PG8_WAIT_V(4); PG8_BAR;
        PG8_STAGE(PG8_SB(1, 0), cB + kstep, voffB); PG8_STAGE(PG8_SA(1, 0), cA + kstep, voffA); PG8_STAGE(PG8_SB(1, 1), cB + hstep + kstep, voffB);
        PG8_WAIT_V(6); PG8_BAR;
    }
    for (;;) {
        const bool has_next = S.next(ui + 1, nxt);
        const char* nA = has_next ? (const char*)g.A + (size_t)nxt.pm * tstep : cA; const char* nB = has_next ? (const char*)g.Bt + (size_t)nxt.pn * tstep : cB;
        for (int t = 0; t < nt; t += 2) {
            const bool last = (t == nt - 2);
            const char* a1 = cA + (size_t)(t + 1) * kstep;
            const char* a2 = last ? nA : cA + (size_t)(t + 2) * kstep; const char* b2 = last ? nB : cB + (size_t)(t + 2) * kstep;
            const char* a3 = a2 + kstep; const char* b3 = b2 + kstep;
            if (last && has_next) S.a_ready(nxt);
            if constexpr (SP2) {
            PG8_LDB(B0, 0, 0); PG8_LDB(B1, 0, 1); PG8_SCHED; PG8_LDA(At, 0, 0); PG8_STAGE(PG8_SA(1, 1), a1 + hstep, voffA);
            PG8_WAIT_V(8); PG8_WAIT_L(0); PG8_BAR; PG8_MMA(0, 0, At, B0); PG8_MMA(0, 1, At, B1); PG8_BAR; PG8_SCHED;
            PG8_LDA(At, 0, 1); PG8_STAGE(PG8_SB(0, 0), b2, voffB); PG8_STAGE(PG8_SB(0, 1), b2 + hstep, voffB); PG8_STAGE(PG8_SA(0, 0), a2, voffA);
            PG8_WAIT_V(8); PG8_WAIT_L(0); PG8_BAR; PG8_MMA(1, 0, At, B0); PG8_MMA(1, 1, At, B1); PG8_BAR; PG8_SCHED;
            PG8_LDB(B0, 1, 0); PG8_LDB(B1, 1, 1); PG8_SCHED; PG8_LDA(At, 1, 0); PG8_STAGE(PG8_SA(0, 1), a2 + hstep, voffA);
            PG8_WAIT_V(8); PG8_WAIT_L(0); PG8_BAR; PG8_MMA(0, 0, At, B0); PG8_MMA(0, 1, At, B1); PG8_BAR; PG8_SCHED;
            PG8_LDA(At, 1, 1); PG8_STAGE(PG8_SB(1, 0), b3, voffB); PG8_STAGE(PG8_SB(1, 1), b3 + hstep, voffB); PG8_STAGE(PG8_SA(1, 0), a3, voffA);
            PG8_WAIT_V(8); PG8_WAIT_L(0); PG8_BAR; PG8_MMA(1, 0, At, B0); PG8_MMA(1, 1, At, B1); PG8_BAR; PG8_SCHED;
            } else {
            PG8_LDB(B0, 0, 0); PG8_SCHED; PG8_LDA(At, 0, 0); PG8_STAGE(PG8_SA(1, 1), a1 + hstep, voffA);
            PG8_WAIT_L(8); PG8_BAR; PG8_WAIT_L(0); PG8_MMA(0, 0, At, B0); PG8_BAR; PG8_SCHED;
            PG8_LDB(B1, 0, 1); PG8_STAGE(PG8_SB(0, 0), b2, voffB);
            PG8_BAR; PG8_WAIT_L(0); PG8_MMA(0, 1, At, B1); PG8_BAR;
            PG8_LDA(At, 0, 1); PG8_STAGE(PG8_SA(0, 0), a2, voffA);
            PG8_BAR; PG8_WAIT_L(0); PG8_MMA(1, 0, At, B0); PG8_BAR; PG8_SCHED;
            PG8_STAGE(PG8_SB(0, 1), b2 + hstep, voffB);
            PG8_WAIT_V(6); PG8_BAR; PG8_MMA(1, 1, At, B1); PG8_BAR;
            PG8_LDB(B0, 1, 0); PG8_SCHED; PG8_LDA(At, 1, 0); PG8_STAGE(PG8_SA(0, 1), a2 + hstep, voffA);
            PG8_WAIT_L(8); PG8_BAR; PG8_WAIT_L(0); PG8_MMA(0, 0, At, B0); PG8_BAR; PG8_SCHED;
            PG8_LDB(B1, 1, 1); PG8_STAGE(PG8_SB(1, 0), b3, voffB);
            PG8_BAR; PG8_WAIT_L(0); PG8_MMA(0, 1, At, B1); PG8_BAR;
            PG8_LDA(At, 1, 1); PG8_STAGE(PG8_SA(1, 0), a3, voffA);
            PG8_BAR; PG8_WAIT_L(0); PG8_MMA(1, 0, At, B0); PG8_BAR; PG8_SCHED;
            PG8_STAGE(PG8_SB(1, 1), b3 + hstep, voffB);
            PG8_WAIT_V(6); PG8_BAR; PG8_MMA(1, 1, At, B1); PG8_BAR;
            }
        }
        if constexpr (ALIGN_EPI) { if (wr == 0) PG8_BAR; }
        if constexpr (!Epi::AFTER_DRAIN) { E(acc, cur, wr, wc, fr, fq); S.done(cur); }
        if (!has_next) break;
#pragma unroll
        for (int a = 0; a < 2; ++a)
#pragma unroll
            for (int b = 0; b < 2; ++b)
#pragma unroll
                for (int m = 0; m < 4; ++m)
#pragma unroll
                    for (int n = 0; n < 2; ++n) acc[a][b][m][n] = (f32x4){0.f, 0.f, 0.f, 0.f};
        cur = nxt; cA = nA; cB = nB; ++ui;
        if constexpr (ALIGN_EPI) { if (wr == 1) PG8_BAR; }
    }
    PG8_WAIT_V(0);
    if constexpr (!ALIGN_EPI) { if (wr == 0) PG8_BAR; }
    PG8_BAR;
    if constexpr (Epi::AFTER_DRAIN) { E.fused(acc, cur, wr, wc, fr, fq, lds, wid, lane); S.done(cur); }
#undef PG8_SA
#undef PG8_SB
#undef PG8_STAGE
#undef PG8_LDA
#undef PG8_LDB
#undef PG8_MMA
#undef PG8_WAIT_V
#undef PG8_WAIT_L
#undef PG8_BAR
#undef PG8_SCHED
}
}
namespace att {
using bf16 = __hip_bfloat16;
using bf16x8 = __attribute__((ext_vector_type(8))) short;
using s16x4 = __attribute__((ext_vector_type(4))) short;
using f32x16 = __attribute__((ext_vector_type(16))) float;
using u32x4 = __attribute__((ext_vector_type(4))) unsigned;
constexpr int PITCH = 3072, QB = 256, KVBLK = 64, NW = 8;
constexpr int SLOTB = 8192, LDS_K = 0, LDS_V = 2 * SLOTB, LDS_WS = 4 * SLOTB, LDS_OST = LDS_WS + NW * 64 * 4, LDS_BYTES = LDS_OST + NW * 4096;
__device__ __forceinline__ int crow(int r, int hi) { return (r & 3) + 8 * (r >> 2) + 4 * hi; }
typedef float f32x2_t __attribute__((ext_vector_type(2))); typedef __bf16 bf16x2_t __attribute__((ext_vector_type(2)));
__device__ __forceinline__ unsigned cvtpk_s(float lo, float hi) { f32x2_t v = {lo, hi}; bf16x2_t b = __builtin_convertvector(v, bf16x2_t); return __builtin_bit_cast(unsigned, b); }

__device__ __forceinline__ void qkt(f32x16& p0, f32x16& p1, const char* Kslot, const bf16x8* qr, int r32, int hi) {
  const char* kb = Kslot + hi * 1024 + r32 * 16;
  const f32x16 z = {};
#pragma unroll
  for (int d0 = 0; d0 < 4; ++d0) {
    const bf16x8 b0 = *reinterpret_cast<const bf16x8*>(kb + d0 * 2048);
    const bf16x8 b1 = *reinterpret_cast<const bf16x8*>(kb + d0 * 2048 + 512);
    if (d0 == 0) { p0 = __builtin_amdgcn_mfma_f32_32x32x16_bf16(b0, qr[0], z, 0, 0, 0); p1 = __builtin_amdgcn_mfma_f32_32x32x16_bf16(b1, qr[0], z, 0, 0, 0); }
    else { p0 = __builtin_amdgcn_mfma_f32_32x32x16_bf16(b0, qr[d0], p0, 0, 0, 0); p1 = __builtin_amdgcn_mfma_f32_32x32x16_bf16(b1, qr[d0], p1, 0, 0, 0); } }
}
__device__ __forceinline__ void pv(f32x16* o, int vb, bf16x8 pa0, bf16x8 pa1, bf16x8 pa2, bf16x8 pa3) {
#pragma unroll
  for (int d0 = 0; d0 < 2; ++d0) { s16x4 lo[4], hi[4];
#pragma unroll
    for (int ks = 0; ks < 4; ++ks) {
      asm volatile("ds_read_b64_tr_b16 %0,%1 offset:%c2" : "=&v"(lo[ks]) : "v"(vb), "i"(d0 * 4096 + ks * 1024) : "memory");
      asm volatile("ds_read_b64_tr_b16 %0,%1 offset:%c2" : "=&v"(hi[ks]) : "v"(vb), "i"(d0 * 4096 + ks * 1024 + 512) : "memory"); }
    asm volatile("s_waitcnt lgkmcnt(0)" ::: "memory"); __builtin_amdgcn_sched_barrier(0);
#define PK(k) (bf16x8){lo[k][0], lo[k][1], lo[k][2], lo[k][3], hi[k][0], hi[k][1], hi[k][2], hi[k][3]}
    o[d0] = __builtin_amdgcn_mfma_f32_32x32x16_bf16(pa0, PK(0), o[d0], 0, 0, 0);
    o[d0] = __builtin_amdgcn_mfma_f32_32x32x16_bf16(pa1, PK(1), o[d0], 0, 0, 0);
    o[d0] = __builtin_amdgcn_mfma_f32_32x32x16_bf16(pa2, PK(2), o[d0], 0, 0, 0);
    o[d0] = __builtin_amdgcn_mfma_f32_32x32x16_bf16(pa3, PK(3), o[d0], 0, 0, 0);
#undef PK
  }
}
struct UnitDesc { const bf16* Q; const bf16* K; const bf16* V; bf16* O; float slope2; int nb; int moba; const float* kpart; };
__device__ __forceinline__ void attn_unit(const UnitDesc& U, char* shm) {
  const int tid = threadIdx.x, lane = tid & 63, r32 = lane & 31, hi = lane >> 5; const int wid = __builtin_amdgcn_readfirstlane(tid >> 6);
  const int nb = U.nb, q0 = nb * QB;
  const bf16* Qw = U.Q + (long)(q0 + wid * 32) * PITCH;
  const unsigned lds0 = (unsigned)(uintptr_t)shm;
  float* wsf = (float*)(shm + LDS_WS) + wid * 64;
  bf16x8 qr[4];
#pragma unroll
  for (int d0 = 0; d0 < 4; ++d0) qr[d0] = *reinterpret_cast<const bf16x8*>(&Qw[(long)r32 * PITCH + d0 * 16 + hi * 8]);
  unsigned sel = 0xffu;
  if (U.moba) {
    float g[4] = {0.f, 0.f, 0.f, 0.f};
    const bf16* qrow = Qw + (long)r32 * PITCH;
    for (int c = 0; c < 8; ++c) {
      const u32x4 qv = *reinterpret_cast<const u32x4*>(qrow + c * 8);
      float qf[8];
#pragma unroll
      for (int i = 0; i < 4; ++i) { qf[2 * i] = __uint_as_float(qv[i] << 16); qf[2 * i + 1] = __uint_as_float(qv[i] & 0xffff0000u); }
#pragma unroll
      for (int j = 0; j < 4; ++j) { const int n = 4 * hi + j;
        if (n < nb) { const float* k0 = U.kpart + (size_t)(n * 2) * 512 + c * 8; const float* k1 = k0 + 512;
#pragma unroll
          for (int i = 0; i < 8; ++i) g[j] += qf[i] * (k0[i] + k1[i]); } }
    }
    float ga[8];
#pragma unroll
    for (int j = 0; j < 4; ++j) { const float o = __shfl_xor(g[j], 32); ga[j] = hi ? o : g[j]; ga[4 + j] = hi ? g[j] : o; }
    sel = 0u;
#pragma unroll
    for (int n = 0; n < 8; ++n) { int rank = 0;
#pragma unroll
      for (int m = 0; m < 8; ++m) if (m != n) rank += (m < nb && (ga[m] > ga[n] || (ga[m] == ga[n] && m < n))) ? 1 : 0;
      if (n < nb && rank < 3) sel |= (1u << n); }
  }
  const int NT = 4 * (nb + 1);
  float mrun = -30000.f, lrun = 0.f; f32x16 o[2]; o[0] = f32x16{}; o[1] = f32x16{};
  const int qrel = wid * 32 + r32;
  const bf16* ksrc = U.K + (long)lane * PITCH + wid * 8;
  const bf16* vsrc = U.V + (long)(16 * (wid & 3) + (lane >> 2)) * PITCH + (wid >> 2) * 32 + (lane & 3) * 8;
  char* kdst = shm + LDS_K + wid * 1024 + lane * 16; char* vdst = shm + LDS_V + wid * 1024 + lane * 16;
  const int vb0 = (int)(lds0 + LDS_V) + ((lane >> 4) & 1) * 32 + (lane & 3) * 8 + (4 * hi + ((lane & 15) >> 2)) * 64;
  u32x4 kreg = *reinterpret_cast<const u32x4*>(ksrc), vreg = *reinterpret_cast<const u32x4*>(vsrc);
  const float s2 = U.slope2;
  for (int t = 0; t < NT; ++t) {
    const int slot = (t & 1) * SLOTB;
    *reinterpret_cast<u32x4*>(kdst + slot) = kreg; *reinterpret_cast<u32x4*>(vdst + slot) = vreg;
    __syncthreads();
    if (t + 1 < NT) { kreg = *reinterpret_cast<const u32x4*>(ksrc + (long)(t + 1) * KVBLK * PITCH); vreg = *reinterpret_cast<const u32x4*>(vsrc + (long)(t + 1) * KVBLK * PITCH); }
    f32x16 p0, p1; qkt(p0, p1, shm + LDS_K + slot, qr, r32, hi);
    const int jb = t - (NT - 4);
    const float base = s2 * (float)(64 * t - q0 + 4 * hi);
#pragma unroll
    for (int r = 0; r < 16; ++r) { const float kr = (float)((r & 3) + 8 * (r >> 2)); p0[r] += base + s2 * kr; p1[r] += base + s2 * (kr + 32.f); }
    if (jb >= 0) { const int kb = 64 * jb + 4 * hi;
#pragma unroll
      for (int r = 0; r < 16; ++r) { const int kv = kb + (r & 3) + 8 * (r >> 2); if (kv > qrel) p0[r] = -INFINITY; if (kv + 32 > qrel) p1[r] = -INFINITY; } }
    else if (!((sel >> (t >> 2)) & 1u)) {
#pragma unroll
      for (int r = 0; r < 16; ++r) { p0[r] = -INFINITY; p1[r] = -INFINITY; } }
    float rm = fmaxf(p0[0], p1[0]);
#pragma unroll
    for (int r = 1; r < 16; ++r) rm = fmaxf(rm, fmaxf(p0[r], p1[r]));
    rm = fmaxf(rm, __shfl_xor(rm, 32));
    const float mnew = fmaxf(mrun, rm), f = __builtin_amdgcn_exp2f(mrun - mnew); mrun = mnew;
    float ps = 0.f;
#pragma unroll
    for (int r = 0; r < 16; ++r) { p0[r] = __builtin_amdgcn_exp2f(p0[r] - mnew); p1[r] = __builtin_amdgcn_exp2f(p1[r] - mnew); ps += p0[r] + p1[r]; }
    lrun = lrun * f + ps;
    if (hi == 0) wsf[r32] = f;
    u32x4 pw0, pw1, pw2, pw3;
#pragma unroll
    for (int i = 0; i < 4; ++i) { pw0[i] = cvtpk_s(p0[2 * i], p0[2 * i + 1]); pw1[i] = cvtpk_s(p0[8 + 2 * i], p0[9 + 2 * i]); pw2[i] = cvtpk_s(p1[2 * i], p1[2 * i + 1]); pw3[i] = cvtpk_s(p1[8 + 2 * i], p1[9 + 2 * i]); }
    asm volatile("s_waitcnt lgkmcnt(0)" ::: "memory");
#pragma unroll
    for (int r = 0; r < 16; ++r) { const float fr_ = wsf[crow(r, hi)]; o[0][r] *= fr_; o[1][r] *= fr_; }
    pv(o, vb0 + slot, __builtin_bit_cast(bf16x8, pw0), __builtin_bit_cast(bf16x8, pw1), __builtin_bit_cast(bf16x8, pw2), __builtin_bit_cast(bf16x8, pw3));
  }
  lrun += __shfl_xor(lrun, 32);
  if (hi == 0) wsf[32 + r32] = lrun;
  asm volatile("s_waitcnt lgkmcnt(0)" ::: "memory");
  float rli[16];
#pragma unroll
  for (int r = 0; r < 16; ++r) rli[r] = 1.0f / wsf[32 + crow(r, hi)];
  bf16* Ow = U.O + (long)(q0 + wid * 32) * 1024;
  { bf16* stg = (bf16*)(shm + LDS_OST) + wid * 2048;
#pragma unroll
    for (int r = 0; r < 16; ++r) { const int orow = crow(r, hi);
#pragma unroll
      for (int d0 = 0; d0 < 2; ++d0) stg[orow * 64 + d0 * 32 + r32] = __float2bfloat16(o[d0][r] * rli[r]); }
    asm volatile("s_waitcnt lgkmcnt(0)" ::: "memory");
#pragma unroll
    for (int i = 0; i < 4; ++i) { const int row = i * 8 + (lane >> 3), ch = lane & 7; const u32x4 v = *(const u32x4*)(stg + row * 64 + ch * 8); *(u32x4*)(Ow + (long)row * 1024 + ch * 8) = v; } }
  asm volatile("s_waitcnt lgkmcnt(0)" ::: "memory");
  __syncthreads();
}
}
namespace peer {
using bf16 = __hip_bfloat16;
using bf16x8 = __attribute__((ext_vector_type(8))) short;
using f32x16 = __attribute__((ext_vector_type(16))) float;
using u32x4 = __attribute__((ext_vector_type(4))) unsigned;
__device__ __forceinline__ int crow(int r, int hi) { return (r & 3) + 8 * (r >> 2) + 4 * hi; }
__device__ __forceinline__ int f2key(float f) { const int b = __float_as_int(f); return b ^ ((b >> 31) & 0x7fffffff); }
__device__ __forceinline__ float key2f(int k) { return __int_as_float(k ^ ((k >> 31) & 0x7fffffff)); }
__device__ __forceinline__ void ins16(int (&L)[16], int v) {
#pragma unroll
  for (int i = 0; i < 16; ++i) { const int a = L[i]; L[i] = a > v ? a : v; v = a > v ? v : a; }
}
__device__ __forceinline__ void merge16(int (&L)[16]) {
  int M[16];
#pragma unroll
  for (int i = 0; i < 16; ++i) { const int o = __shfl_xor(L[15 - i], 32); M[i] = L[i] > o ? L[i] : o; }
#pragma unroll
  for (int s = 8; s >= 1; s >>= 1)
#pragma unroll
    for (int i = 0; i < 16; ++i) if ((i & s) == 0) { const int a = M[i], b = M[i + s]; M[i] = a > b ? a : b; M[i + s] = a > b ? b : a; }
#pragma unroll
  for (int i = 0; i < 16; ++i) L[i] = M[i];
}
#define PEER_CAND_LIST(X) \
  X(0,0,0, 2,1) X(1,0,1, 2,2) X(2,0,2, 2,3) X(3,0,3, 2,4) X(4,0,4, 3,0) X(5,0,5, 3,1) X(6,0,6, 3,2) X(7,0,7, 3,3) X(8,0,8, 4,0) X(9,0,9, 4,1) X(10,0,10, 4,2) X(11,0,11, 5,0) X(12,0,12, 5,1) X(13,0,13, 6,0) X(14,0,14, 6,1) X(15,0,15, 7,0) X(16,1,0, 7,1) X(17,1,1, 8,0) X(18,1,2, 9,0) X(19,1,3, 10,0) X(20,1,4, 11,0) X(21,1,5, 12,0) X(22,1,6, 13,0) X(23,1,7, 14,0) X(24,2,0, 15,0)

__device__ __forceinline__ void topk_task(const bf16* QP, const bf16* SK, const float* ssq, float* RSTD, int* LE, float* LG, int tg, int h, int lane) {
  const int r32 = lane & 31, hi = lane >> 5; const int t = tg * 32 + r32;
  int A[16], B[16];
#pragma unroll
  for (int p = 0; p < 2; ++p) {
    bf16x8 qf[8];
#pragma unroll
    for (int ks = 0; ks < 8; ++ks) qf[ks] = *reinterpret_cast<const bf16x8*>(QP + (size_t)t * 2048 + h * 256 + p * 128 + ks * 16 + hi * 8);
    int L[16];
#pragma unroll
    for (int i = 0; i < 16; ++i) L[i] = (int)0x80000000;
    const bf16* kb = SK + (size_t)((h * 2 + p) * 128) * 128;
#pragma unroll 1
    for (int i = 0; i < 4; ++i) {
      f32x16 acc = {};
#pragma unroll
      for (int ks = 0; ks < 8; ++ks) { const bf16x8 a = *reinterpret_cast<const bf16x8*>(kb + (size_t)(i * 32 + r32) * 128 + ks * 16 + hi * 8); acc = __builtin_amdgcn_mfma_f32_32x32x16_bf16(a, qf[ks], acc, 0, 0, 0); }
#pragma unroll
      for (int r = 0; r < 16; ++r) { const int key = i * 32 + crow(r, hi); ins16(L, (f2key(acc[r]) & ~127) | key); }
    }
    merge16(L);
#pragma unroll
    for (int i = 0; i < 16; ++i) { if (p == 0) A[i] = L[i]; else B[i] = L[i]; }
  }
  float Af[16], Bf[16];
#pragma unroll
  for (int i = 0; i < 16; ++i) { Af[i] = key2f(A[i] & ~127); Bf[i] = key2f(B[i] & ~127); }
  float C[25];
#define X(c, i0, j0, i1, j1) C[c] = hi ? (Af[i1] + Bf[j1]) : (Af[i0] + Bf[j0]);
  PEER_CAND_LIST(X)
#undef X
  int L[16];
#pragma unroll
  for (int i = 0; i < 16; ++i) L[i] = (int)0x80000000;
#pragma unroll
  for (int c = 0; c < 25; ++c) ins16(L, f2key(C[c]));
  merge16(L);
  const int tau = L[15]; const float cmax = Af[0] + Bf[0];
  float s = 0.f;
#pragma unroll
  for (int i = 0; i < 16; ++i) s += ssq[(size_t)t * 16 + i];
  const float rstd = 1.0f / sqrtf(s * (1.0f / 1024.0f) + 1e-6f);
  const float k2 = rstd * 1.4426950408889634f;
  if (h == 0 && hi == 0) RSTD[t] = rstd;
  float E[25]; float den = 0.f; int cnt = 0; unsigned selm = 0u;
#pragma unroll
  for (int c = 0; c < 25; ++c) { const bool sl = f2key(C[c]) >= tau; E[c] = sl ? __builtin_amdgcn_exp2f((C[c] - cmax) * k2) : 0.f; den += E[c]; cnt += sl ? 1 : 0; selm |= sl ? (1u << c) : 0u; }
  den += __shfl_xor(den, 32);
  const int ocnt = __shfl_xor(cnt, 32);
  int pos = hi ? ocnt : 0;
  const float rden = 1.0f / den;
  int* le = LE + (size_t)t * 128 + h * 16; float* lg = LG + (size_t)t * 128 + h * 16;
#define X(c, i0, j0, i1, j1) { if (((selm >> c) & 1u) && pos < 16) { const int ka = (hi ? A[i1] : A[i0]) & 127, kb2 = (hi ? B[j1] : B[j0]) & 127; le[pos] = ka * 128 + kb2; lg[pos] = E[c] * rden; ++pos; } }
  PEER_CAND_LIST(X)
#undef X
}

__device__ __forceinline__ float gelu_erf(float v) { return 0.5f * v * (1.0f + erff(v * 0.70710678118654752f)); }
__device__ __forceinline__ void unpack8(const u32x4 w, float (&f)[8]) {
#pragma unroll
  for (int i = 0; i < 4; ++i) { f[2 * i] = __uint_as_float(w[i] << 16); f[2 * i + 1] = __uint_as_float(w[i] & 0xffff0000u); }
}
#define PEER_DPP(v, ctrl, rmask) __int_as_float(__builtin_amdgcn_update_dpp(0, __float_as_int(v), ctrl, rmask, 0xf, false))
__device__ __forceinline__ float wave_total(float v) {
  v += PEER_DPP(v, 0xB1, 0xf);
  v += PEER_DPP(v, 0x4E, 0xf);
  v += PEER_DPP(v, 0x141, 0xf);
  v += PEER_DPP(v, 0x140, 0xf);
  v += PEER_DPP(v, 0x142, 0xa);
  v += PEER_DPP(v, 0x143, 0xc);
  return __int_as_float(__builtin_amdgcn_readlane(__float_as_int(v), 63));
}
typedef float f32x4_t __attribute__((ext_vector_type(4)));
typedef float f32x2_t __attribute__((ext_vector_type(2)));
__device__ __forceinline__ float ub0(unsigned w) { return (float)(w & 255u); }
__device__ __forceinline__ float ub1(unsigned w) { return (float)((w >> 8) & 255u); }
__device__ __forceinline__ float ub2(unsigned w) { return (float)((w >> 16) & 255u); }
__device__ __forceinline__ float ub3(unsigned w) { return (float)(w >> 24); }
#define PEER_DPPI(v, ctrl, rmask) __builtin_amdgcn_update_dpp(0, v, ctrl, rmask, 0xf, false)
__device__ __forceinline__ int wave_total_i(int v) {
  v += PEER_DPPI(v, 0xB1, 0xf); v += PEER_DPPI(v, 0x4E, 0xf); v += PEER_DPPI(v, 0x141, 0xf); v += PEER_DPPI(v, 0x140, 0xf); v += PEER_DPPI(v, 0x142, 0xa); v += PEER_DPPI(v, 0x143, 0xc);
  return __builtin_amdgcn_readlane(v, 63);
}
__device__ __forceinline__ float quant_row16(const float (&v)[16], unsigned char* dst_row, int lane, int bias) {
  float m = 0.f;
#pragma unroll
  for (int i = 0; i < 16; ++i) m = fmaxf(m, fabsf(v[i]));
#pragma unroll
  for (int o = 1; o < 64; o <<= 1) m = fmaxf(m, __shfl_xor(m, o));
  const float inv = m > 0.f ? 127.0f / m : 0.f;
  u32x4 w;
#pragma unroll
  for (int q = 0; q < 4; ++q) { unsigned x = 0u;
#pragma unroll
    for (int i = 0; i < 4; ++i) { const int qi = (int)rintf(v[4 * q + i] * inv) + bias; x |= ((unsigned)qi & 255u) << (8 * i); }
    w[q] = x; }
  *reinterpret_cast<u32x4*>(dst_row + lane * 16) = w;
  return m * (1.0f / 127.0f);
}
#define PEER_UFETCH(G_) do { const size_t tb_ = (size_t)(G_) * 4; _Pragma("unroll") for (int j = 0; j < 4; ++j) { \
    e0[j] = LE[(tb_ + j) * 128 + lane] & 16383; e1[j] = LE[(tb_ + j) * 128 + 64 + lane] & 16383; g0[j] = LG[(tb_ + j) * 128 + lane]; g1[j] = LG[(tb_ + j) * 128 + 64 + lane]; \
    xa[j] = *reinterpret_cast<const u32x4*>(XQ + (tb_ + j) * 1024 + lane * 16); } \
    rs4 = *reinterpret_cast<const f32x4_t*>(HS + tb_); } while (0)
__device__ __forceinline__ void expert_u_pass(const unsigned char* XQ, const unsigned char* U8, const float* HS, const float* SU, const float* SV, const int* LE, const float* LG, unsigned* PACK, int slice, int wx, int nwx, int lane, char* wl) {
  unsigned* list = (unsigned*)(wl + 4096);
  int e0[4], e1[4]; float g0[4], g1[4]; u32x4 xa[4]; f32x4_t rs4;
  int gi = wx;
  if (gi < 8192) PEER_UFETCH(gi);
  for (; gi < 8192; gi += nwx) {
    int n = 0;
    const f32x4_t rs = rs4;
#pragma unroll
    for (int j = 0; j < 4; ++j) {
      *reinterpret_cast<u32x4*>(wl + j * 1024 + lane * 16) = xa[j];
      { const bool in = (e0[j] >> 11) == slice; const unsigned long long m = __ballot(in);
        if (in) { const int pos = n + (int)__builtin_amdgcn_mbcnt_hi((unsigned)(m >> 32), __builtin_amdgcn_mbcnt_lo((unsigned)m, 0u)); list[2 * pos] = (unsigned)e0[j] | ((unsigned)lane << 14) | ((unsigned)j << 21); list[2 * pos + 1] = __float_as_uint(g0[j]); }
        n += __builtin_popcountll(m); }
      { const bool in = (e1[j] >> 11) == slice; const unsigned long long m = __ballot(in);
        if (in) { const int pos = n + (int)__builtin_amdgcn_mbcnt_hi((unsigned)(m >> 32), __builtin_amdgcn_mbcnt_lo((unsigned)m, 0u)); list[2 * pos] = (unsigned)e1[j] | ((unsigned)(64 + lane) << 14) | ((unsigned)j << 21); list[2 * pos + 1] = __float_as_uint(g1[j]); }
        n += __builtin_popcountll(m); }
    }
    n = __builtin_amdgcn_readfirstlane(n);
    const int gnext = gi + nwx;
    if (gnext < 8192) PEER_UFETCH(gnext);
    for (int b = 0; b < n; b += 16) {
      u32x4 ua[16]; unsigned jj[16];
#pragma unroll
      for (int s = 0; s < 16; ++s) { const int i = (b + s < n) ? (b + s) : (n - 1); const unsigned w = (unsigned)__builtin_amdgcn_readfirstlane((int)list[2 * i]);
        jj[s] = (w >> 21) & 3u; ua[s] = *reinterpret_cast<const u32x4*>(U8 + (size_t)(w & 16383u) * 1024 + lane * 16); }
      int hv = 0;
#pragma unroll
      for (int s = 0; s < 16; ++s) { const u32x4 xl = *reinterpret_cast<const u32x4*>(wl + jj[s] * 1024 + lane * 16);
        int q = 0;
#pragma unroll
        for (int i = 0; i < 4; ++i) q = __builtin_amdgcn_sdot4((int)ua[s][i], (int)xl[i], q, false);
        const int tot = wave_total_i(q);
        asm volatile("v_writelane_b32 %0, %1, %2" : "+v"(hv) : "s"(tot), "i"(s)); }
      if (lane < 16 && b + lane < n) { const unsigned w = list[2 * (b + lane)]; const float gk = __uint_as_float(list[2 * (b + lane) + 1]); const unsigned j = (w >> 21) & 3u; const unsigned e = w & 16383u;
        const float r = j == 0 ? rs[0] : j == 1 ? rs[1] : j == 2 ? rs[2] : rs[3];
        const float a = gelu_erf((float)hv * r * SU[e]) * gk * SV[e]; const unsigned ab = __float_as_uint(a); const unsigned rb = (ab + 0x7fffu + ((ab >> 16) & 1u)) & 0xffff0000u;
        PACK[((size_t)gi * 4 + j) * 128 + ((w >> 14) & 127u)] = rb | e; }
    }
  }
}
#define PEER_VISSUE(S_, A_, P0_, P1_) do { _Pragma("unroll") for (int i = 0; i < 16; ++i) { const unsigned pk = (unsigned)__builtin_amdgcn_ds_bpermute(((8 * i + g) & 63) << 2, (int)(i < 8 ? P0_ : P1_)); \
    A_[i] = __uint_as_float(pk & 0xffff0000u); S_[i] = *reinterpret_cast<const u32x4*>(V8 + (size_t)(pk & 16383u) * 1024 + slice * 128 + c * 16); } } while (0)
#define PEER_VFINISH(S_, A_, T_, O_) do { float acc[16]; float asum = 0.f; _Pragma("unroll") for (int i = 0; i < 16; ++i) acc[i] = 0.f; \
    _Pragma("unroll") for (int i = 0; i < 16; ++i) { const float a_ = A_[i]; asum += a_; _Pragma("unroll") for (int q = 0; q < 4; ++q) { const unsigned w_ = S_[i][q]; \
        acc[4 * q] += a_ * ub0(w_); acc[4 * q + 1] += a_ * ub1(w_); acc[4 * q + 2] += a_ * ub2(w_); acc[4 * q + 3] += a_ * ub3(w_); } } \
    _Pragma("unroll") for (int i = 0; i < 16; ++i) acc[i] -= 128.f * asum; \
    float m8[8], m4[4], m2[2]; \
    { const bool bb = (g & 4) != 0; _Pragma("unroll") for (int i = 0; i < 8; ++i) { const float keep = bb ? acc[8 + i] : acc[i], send = bb ? acc[i] : acc[8 + i]; m8[i] = keep + __shfl_xor(send, 32); } } \
    { const bool bb = (g & 2) != 0; _Pragma("unroll") for (int i = 0; i < 4; ++i) { const float keep = bb ? m8[4 + i] : m8[i], send = bb ? m8[i] : m8[4 + i]; m4[i] = keep + __shfl_xor(send, 16); } } \
    { const bool bb = (g & 1) != 0; _Pragma("unroll") for (int i = 0; i < 2; ++i) { const float keep = bb ? m4[2 + i] : m4[i], send = bb ? m4[i] : m4[2 + i]; m2[i] = keep + __shfl_xor(send, 8); } } \
    f32x2_t r_ = (O_); r_[0] += m2[0]; r_[1] += m2[1]; *reinterpret_cast<f32x2_t*>(out + (size_t)(T_) * 1024 + slice * 128 + 16 * c + 2 * g) = r_; } while (0)
__device__ __forceinline__ void expert_v_pass(const unsigned char* V8, const unsigned* PACK, float* out, int slice, int wx, int nwx, int lane) {
  const int g = lane >> 3, c = lane & 7;
  const int MT = 32768;
  u32x4 sA[16], sB[16]; float aA[16], aB[16];
  int t = wx;
  unsigned p0 = 0, p1 = 0; f32x2_t oc = {0.f, 0.f}, on = {0.f, 0.f};
#define PEER_OLD(T_) (*reinterpret_cast<const f32x2_t*>(out + (size_t)(T_) * 1024 + slice * 128 + 16 * c + 2 * g))
  if (t < MT) { p0 = PACK[(size_t)t * 128 + lane]; p1 = PACK[(size_t)t * 128 + 64 + lane]; oc = PEER_OLD(t); }
  if (t < MT) PEER_VISSUE(sA, aA, p0, p1);
  if (t + nwx < MT) { const int t1 = t + nwx; p0 = PACK[(size_t)t1 * 128 + lane]; p1 = PACK[(size_t)t1 * 128 + 64 + lane]; on = PEER_OLD(t1); }
  for (; t < MT; t += 2 * nwx) {
    const int t1 = t + nwx, t2 = t + 2 * nwx, t3 = t + 3 * nwx;
    if (t1 < MT) PEER_VISSUE(sB, aB, p0, p1);
    f32x2_t o2 = {0.f, 0.f};
    if (t2 < MT) { p0 = PACK[(size_t)t2 * 128 + lane]; p1 = PACK[(size_t)t2 * 128 + 64 + lane]; o2 = PEER_OLD(t2); }
    PEER_VFINISH(sA, aA, t, oc);
    if (t1 >= MT) break;
    if (t2 < MT) PEER_VISSUE(sA, aA, p0, p1);
    f32x2_t o3 = {0.f, 0.f};
    if (t3 < MT) { p0 = PACK[(size_t)t3 * 128 + lane]; p1 = PACK[(size_t)t3 * 128 + 64 + lane]; o3 = PEER_OLD(t3); }
    PEER_VFINISH(sB, aB, t1, on);
    oc = o2; on = o3;
  }
#undef PEER_OLD
}
__device__ __forceinline__ void quant_token(const bf16* XMB, const float* ssq, unsigned char* XQ, float* HS, int t, int lane) {
  const u32x4 a = *reinterpret_cast<const u32x4*>(XMB + (size_t)t * 1024 + lane * 16), b = *reinterpret_cast<const u32x4*>(XMB + (size_t)t * 1024 + lane * 16 + 8);
  float fa[8], fb[8], v[16]; unpack8(a, fa); unpack8(b, fb);
#pragma unroll
  for (int i = 0; i < 8; ++i) { v[i] = fa[i]; v[8 + i] = fb[i]; }
  const float sx = quant_row16(v, XQ + (size_t)t * 1024, lane, 0);
  float s = 0.f;
#pragma unroll
  for (int i = 0; i < 16; ++i) s += ssq[(size_t)t * 16 + i];
  if (lane == 0) HS[t] = sx / sqrtf(s * (1.0f / 1024.0f) + 1e-6f);
}
}
constexpr int NWAVES = 8;
constexpr int BATCH = 16, SEQ = 2048, D = 1024, M = BATCH * SEQ, NPROJ = 3072, NQP = 2048, NEXP = 16384;
constexpr float RMS_EPS = 1e-6f;
constexpr float C2 = 0.125f * 1.4426950408889634f;
constexpr float LOG2E = 1.4426950408889634f;
constexpr size_t MiB = 1u << 20;
constexpr size_t WS_CTL = 0, CTL_ZERO_BYTES = 1 * MiB;
constexpr size_t WS_WIN = 1 * MiB;
constexpr size_t WS_WOUT = 7 * MiB;
constexpr size_t WS_WQ = 9 * MiB;
constexpr size_t WS_SK = 13 * MiB;
constexpr size_t WS_KPART = 13 * MiB + 512 * 1024;
constexpr size_t WS_SSQ = 14 * MiB;
constexpr size_t WS_MISC = 16 * MiB;
constexpr size_t WS_SU = WS_MISC + 65536, WS_SV = WS_MISC + 131072, WS_HS = WS_MISC + 262144;
constexpr size_t WS_U8 = 17 * MiB;
constexpr size_t WS_V8 = 33 * MiB;
constexpr size_t WS_XQ = 49 * MiB;
constexpr size_t WS_XN = 81 * MiB;
constexpr size_t WS_MIX = 145 * MiB;
constexpr size_t WS_DO = 209 * MiB;
constexpr size_t WS_PROJ = 273 * MiB;
constexpr size_t WS_QP = WS_PROJ;
constexpr size_t WS_LE = WS_PROJ + 128 * MiB;
constexpr size_t WS_LG = WS_PROJ + 144 * MiB;
constexpr size_t WS_PACK = WS_PROJ + 160 * MiB;
constexpr size_t WS_RSTD = WS_PROJ + 176 * MiB;
constexpr size_t WS_END = 465 * MiB;
constexpr int CW_BAR = 4096;
constexpr int RING_OFF = 0, RING_BYTES = 131072;
constexpr int LDSCTL_OFF = RING_BYTES, MISC_OFF = LDSCTL_OFF + 320;
constexpr int LDS_BYTES = 147456;
static_assert(att::LDS_BYTES <= RING_BYTES, "attention scratch fits the ring region");

#define GAS __attribute__((address_space(1)))
#define LAS __attribute__((address_space(3)))
typedef unsigned short bf16;
typedef unsigned v4u __attribute__((ext_vector_type(4)));
typedef unsigned v2u __attribute__((ext_vector_type(2)));
typedef float f32x4 __attribute__((ext_vector_type(4)));
typedef GAS unsigned gu32;
#define RLX_AGENT __ATOMIC_RELAXED, __HIP_MEMORY_SCOPE_AGENT
#define LDS_WAIT() asm volatile("s_waitcnt lgkmcnt(0)" ::: "memory")
#define VM_WAIT() asm volatile("s_waitcnt vmcnt(0)" ::: "memory")
__device__ __forceinline__ unsigned f2bf(float f) { unsigned u = __builtin_bit_cast(unsigned, f); return (u + 0x7fffu + ((u >> 16) & 1u)) >> 16; }
__device__ __forceinline__ unsigned pk2(float lo, float hi) { return f2bf(lo) | (f2bf(hi) << 16); }
#define XB_TMO      128
#define XB_XCNT(j)  (256  + 64 * (j))
#define XB_XSUB(j)  (1280 + 64 * (j))
#define XB_XGEN(j)  (2304 + 64 * (j))
#define XB_TOP      3328
#define XB_TOPGEN   3392
#define XCD_BAR_WORDS 3456
#define XB_SPIN_CAP (1u << 23)

__device__ __forceinline__ unsigned xb_ld(unsigned* p)              { return __hip_atomic_load(p, __ATOMIC_RELAXED, __HIP_MEMORY_SCOPE_AGENT); }
__device__ __forceinline__ unsigned xb_add(unsigned* p, unsigned v) { return __hip_atomic_fetch_add(p, v, __ATOMIC_RELAXED, __HIP_MEMORY_SCOPE_AGENT); }
__device__ __forceinline__ unsigned xb_xcc_id() { return (unsigned)__builtin_amdgcn_s_getreg((3 << 11) | 20) & 0xFu; }
#define XB_SPIN(cond, bar) do { unsigned _sp = 0; while (cond) { __builtin_amdgcn_s_sleep(1); \
    if ((++_sp & 255u) == 0u) { if (xb_ld(&(bar)[XB_TMO])) break; if (_sp > XB_SPIN_CAP) { atomicAdd(&(bar)[XB_TMO], 1u); break; } } } } while (0)

struct XcdBarrier {
    unsigned* bar; unsigned x;
    volatile LAS unsigned* st;
};

__device__ __forceinline__ XcdBarrier xcd_barrier_post(unsigned* bar, volatile LAS unsigned* st) {
    XcdBarrier b; b.bar = bar; b.x = xb_xcc_id(); b.st = st;
    if (threadIdx.x == 0) (void)xb_add(&bar[XB_XCNT(b.x)], 1u);
    return b;
}
__device__ __forceinline__ void xcd_barrier_complete(unsigned* bar, unsigned x, unsigned& nloc, unsigned& nx) {
    const unsigned G = gridDim.x * gridDim.y * gridDim.z;
    unsigned sum, cnt, mine, sp = 0u;
    for (;;) {
        sum = 0u; cnt = 0u; mine = 0u;
#pragma unroll
        for (unsigned j = 0; j < 16; ++j) { const unsigned c = xb_ld(&bar[XB_XCNT(j)]); sum += c; cnt += (c > 0u) ? 1u : 0u; mine = (j == x) ? c : mine; }
        if (sum == G) break;
        __builtin_amdgcn_s_sleep(1);
        if ((++sp & 255u) == 0u) { if (xb_ld(&bar[XB_TMO])) break; if (sp > XB_SPIN_CAP) { atomicAdd(&bar[XB_TMO], 1u); break; } }
    }
    nloc = mine > 0u ? mine : 1u; nx = cnt > 0u ? cnt : 1u;
}

__device__ __forceinline__ void xcd_barrier(const XcdBarrier& b) {
    asm volatile("s_waitcnt vmcnt(0)" ::: "memory");
    __syncthreads();
    if (threadIdx.x == 0) {
        unsigned* bar = b.bar;
        __builtin_amdgcn_s_waitcnt(0);
        unsigned nloc = b.st[0], nx = b.st[1];
        if (nloc == 0u) { xcd_barrier_complete(bar, b.x, nloc, nx); b.st[0] = nloc; b.st[1] = nx; }
        const unsigned old = xb_add(&bar[XB_XSUB(b.x)], 1u);
        const unsigned gen = old / nloc;
        if (old + 1u == (gen + 1u) * nloc) {
            __builtin_amdgcn_fence(__ATOMIC_RELEASE, "agent");
            asm volatile("s_waitcnt vmcnt(0)" ::: "memory");
            const unsigned og = xb_add(&bar[XB_TOP], 1u);
            const unsigned tg = og / nx;
            if (og + 1u == (tg + 1u) * nx) xb_add(&bar[XB_TOPGEN], 1u);
            else XB_SPIN(xb_ld(&bar[XB_TOPGEN]) == tg, bar);
            __builtin_amdgcn_fence(__ATOMIC_ACQUIRE, "agent");
            xb_add(&bar[XB_XGEN(b.x)], 1u);
            asm volatile("s_waitcnt vmcnt(0)" ::: "memory");
        } else {
            XB_SPIN(xb_ld(&bar[XB_XGEN(b.x)]) == gen, bar);
            __builtin_amdgcn_fence(__ATOMIC_ACQUIRE, "agent");
            asm volatile("s_waitcnt vmcnt(0)" ::: "memory");
        }
    }
    __syncthreads();
}
struct Frame {
    LAS unsigned char* lds;
    volatile LAS unsigned* MISC;
    gu32* ctl;
    int tid, lane, wave;
    int vcu, G;
};
__device__ __forceinline__ float wave_sum(float v) {
#pragma unroll
    for (int o = 1; o < 64; o <<= 1) v += __shfl_xor(v, o);
    return v;
}
template <bool PERMROWS>
__device__ __forceinline__ void p0_transpose_item(const float* W, int K, int N, bf16* WT, const float* kscale, LAS float* scr, int item, int lane) {
    const int nblk = N / 32, kb = item / nblk, nb = item % nblk, k0 = 64 * kb, n0 = 32 * nb;
#pragma unroll 8
    for (int i = 0; i < 32; ++i) { const int kk = 2 * i + (lane >> 5); float w = W[(size_t)(k0 + kk) * N + n0 + (lane & 31)]; if (kscale) w *= kscale[k0 + kk]; scr[kk * 33 + (lane & 31)] = w; }
    LDS_WAIT(); asm volatile("" ::: "memory");
    int r0 = n0;
    if (PERMROWS) { const int tl = n0 >> 8, np = n0 & 255; r0 = tl * 256 + ((np >> 5) & 1) * 128 + (np >> 6) * 32; }
    const int c = lane & 7;
#pragma unroll
    for (int j = 0; j < 4; ++j) { const int n = (lane >> 3) + 8 * j; const LAS float* s = scr + (8 * c) * 33 + n;
        v4u o; o.x = pk2(s[0 * 33], s[1 * 33]); o.y = pk2(s[2 * 33], s[3 * 33]); o.z = pk2(s[4 * 33], s[5 * 33]); o.w = pk2(s[6 * 33], s[7 * 33]);
        *(GAS v4u*)(WT + (size_t)(r0 + n) * K + k0 + 8 * c) = o; }
    LDS_WAIT(); asm volatile("" ::: "memory");
}
__device__ __forceinline__ void cvt8(const float* src, bf16* dst, size_t e, const float* cscale) {
    f32x4 a = *(const GAS f32x4*)(src + e), b = *(const GAS f32x4*)(src + e + 4);
    if (cscale) { const int c = (int)(e & 1023); const f32x4 ga = *(const f32x4*)(cscale + c), gb = *(const f32x4*)(cscale + c + 4); a = a * ga; b = b * gb; }
    v4u o; o.x = pk2(a[0], a[1]); o.y = pk2(a[2], a[3]); o.z = pk2(b[0], b[1]); o.w = pk2(b[2], b[3]);
    *(GAS v4u*)(dst + e) = o;
}
__device__ __forceinline__ void rms_row_to_bf16(const float* xrow, const float* g, bf16* orow, int lane) {
    const GAS f32x4* xr = (const GAS f32x4*)xrow + lane;
    f32x4 v[4]; float s = 0.f;
#pragma unroll
    for (int j = 0; j < 4; ++j) { v[j] = xr[64 * j]; s += (v[j].x * v[j].x + v[j].y * v[j].y) + (v[j].z * v[j].z + v[j].w * v[j].w); }
    const float rstd = 1.f / sqrtf(wave_sum(s) * (1.f / 1024.f) + RMS_EPS);
    GAS unsigned long long* o8 = (GAS unsigned long long*)orow + lane;
#pragma unroll
    for (int j = 0; j < 4; ++j) { const f32x4 gg = *((const f32x4*)g + lane + 64 * j);
        o8[64 * j] = (unsigned long long)pk2(v[j].x * rstd * gg.x, v[j].y * rstd * gg.y) | ((unsigned long long)pk2(v[j].z * rstd * gg.z, v[j].w * rstd * gg.w) << 32); }
}

struct Args { const float* in[13]; float* out; unsigned char* ws; int ph_lo, ph_hi; };
__global__ void __launch_bounds__(NWAVES * 64, 2) mega_fwd(Args args) {
    extern __shared__ __attribute__((aligned(16))) unsigned char lds[];
    Frame F;
    F.lds = (LAS unsigned char*)lds;
    F.MISC = (volatile LAS unsigned*)(F.lds + MISC_OFF);
    F.tid = threadIdx.x; F.lane = F.tid & 63; F.wave = __builtin_amdgcn_readfirstlane(F.tid >> 6);
    F.G = gridDim.x; { const int bx = blockIdx.x; F.vcu = (F.G % 8 == 0) ? (bx % 8) * (F.G / 8) + bx / 8 : bx; }
    unsigned char* ws = args.ws;
    F.ctl = (gu32*)(ws + WS_CTL);
    const float* x = args.in[0]; const float* norm1_g = args.in[1]; const float* w_in = args.in[2]; const float* moba_g = args.in[3]; const float* diff_g = args.in[4];
    const float* diff_lambda = args.in[5]; const float* subln_g = args.in[6]; const float* w_out = args.in[7]; const float* norm2_g = args.in[8]; const float* w_query = args.in[9];
    const float* sub_keys = args.in[10]; const float* peer_u = args.in[11]; const float* peer_v = args.in[12];
    float* out = args.out;
    bf16* WIN = (bf16*)(ws + WS_WIN); bf16* WOUT = (bf16*)(ws + WS_WOUT); bf16* WQ = (bf16*)(ws + WS_WQ); bf16* SK = (bf16*)(ws + WS_SK);
    float* KPART = (float*)(ws + WS_KPART); float* SSQ = (float*)(ws + WS_SSQ); float* MISCG = (float*)(ws + WS_MISC);
    unsigned char* U8 = ws + WS_U8; unsigned char* V8 = ws + WS_V8; float* SU = (float*)(ws + WS_SU); float* SV = (float*)(ws + WS_SV); unsigned char* XQ = ws + WS_XQ; float* HS = (float*)(ws + WS_HS); bf16* XN = (bf16*)(ws + WS_XN); bf16* MIX = (bf16*)(ws + WS_MIX); bf16* DOB = (bf16*)(ws + WS_DO);
    bf16* PROJ = (bf16*)(ws + WS_PROJ); bf16* QP = (bf16*)(ws + WS_QP); int* LE = (int*)(ws + WS_LE); float* LG = (float*)(ws + WS_LG); unsigned* PACK = (unsigned*)(ws + WS_PACK); float* RSTD = (float*)(ws + WS_RSTD);
    for (int u = F.tid; u < (LDS_BYTES - LDSCTL_OFF) / 4; u += NWAVES * 64) ((LAS unsigned*)(F.lds + LDSCTL_OFF))[u] = 0u;
    __syncthreads();
    XcdBarrier bar = xcd_barrier_post((unsigned*)(F.ctl + CW_BAR), F.MISC + 8);
    const int gw = F.vcu * NWAVES + F.wave, NGW = F.G * NWAVES;
    const int lo = args.ph_lo, hi = args.ph_hi;
#define IN(k) (lo <= (k) && (k) < hi)
#ifndef PROBE_DUP
#define PROBE_DUP -1
#endif
#define REP(k) for (int rep_ = 0; rep_ < ((PROBE_DUP == (k)) ? 2 : 1); ++rep_)
#define GRID_BAR() xcd_barrier(bar)

    if (IN(0)) {
        LAS float* scr = (LAS float*)(F.lds + RING_OFF + F.wave * 16384);
        constexpr int I_IN = (D / 64) * (NPROJ / 32), I_OUT = (D / 64) * (D / 32), I_Q = (D / 64) * (NQP / 32);
        for (int it = gw; it < I_IN + I_OUT + I_Q; it += NGW) {
            int r = it;
            if (r < I_IN) { p0_transpose_item<true>(w_in, D, NPROJ, WIN, nullptr, scr, r, F.lane); continue; } r -= I_IN;
            if (r < I_OUT) { p0_transpose_item<false>(w_out, D, D, WOUT, nullptr, scr, r, F.lane); continue; } r -= I_OUT;
            p0_transpose_item<false>(w_query, D, NQP, WQ, norm2_g, scr, r, F.lane);
        }
        constexpr size_t C_SK = (size_t)16 * 128 * 128 / 8;
        for (size_t c = (size_t)gw * 64 + F.lane; c < C_SK; c += (size_t)NGW * 64) cvt8(sub_keys, SK, c * 8, nullptr);
        for (int r = gw; r < 2 * NEXP; r += NGW) {
            const bool isu = r < NEXP; const int e = isu ? r : r - NEXP; const float* srow = (isu ? peer_u : peer_v) + (size_t)e * 1024 + F.lane * 16;
            float v[16];
#pragma unroll
            for (int q = 0; q < 4; ++q) { f32x4 a = *(const GAS f32x4*)(srow + 4 * q); if (isu) a = a * *(const f32x4*)(norm2_g + F.lane * 16 + 4 * q); v[4 * q] = a[0]; v[4 * q + 1] = a[1]; v[4 * q + 2] = a[2]; v[4 * q + 3] = a[3]; }
            const float sc = peer::quant_row16(v, (isu ? U8 : V8) + (size_t)e * 1024, F.lane, isu ? 0 : 128);
            if (F.lane == 0) (isu ? SU : SV)[e] = sc;
        }
        for (int m = gw; m < M; m += NGW) rms_row_to_bf16(x + (size_t)m * D, norm1_g, XN + (size_t)m * D, F.lane);
        if (gw == 0) { const float a = wave_sum(diff_lambda[F.lane] * diff_lambda[64 + F.lane]), b = wave_sum(diff_lambda[128 + F.lane] * diff_lambda[192 + F.lane]);
            if (F.lane == 0) MISCG[0] = expf(a) - expf(b) + 0.2f; }
        GRID_BAR();
    }
    if (IN(1)) {
        pg8::Gemm g{XN, WIN, M, NPROJ, D}; pg8::StaticOrder S; S.init(M, NPROJ, F.G, (int)blockIdx.x);
        pg8::EpiProj E{PROJ, moba_g, moba_g + 64, diff_g, diff_g + 64, KPART, C2};
        pg8::gemm_phase<pg8::EpiProj, pg8::StaticOrder, true, true>(F.lds + RING_OFF, g, S, E);
        GRID_BAR();
    }
    if (IN(2)) {
        REP(2) for (int p = F.vcu; p < 1536; p += F.G) {
            const int bvh = p >> 2, s = p & 3, b = bvh / 24, vh = bvh % 24;
            att::UnitDesc U; const bf16* pb = PROJ + (size_t)b * SEQ * NPROJ;
            if (vh < 8) { U.Q = (const att::bf16*)(pb + vh * 64); U.K = (const att::bf16*)(pb + 512 + vh * 64); U.V = (const att::bf16*)(pb + 1024 + vh * 64);
                U.O = (att::bf16*)(MIX + (size_t)b * SEQ * 1024 + vh * 64); U.slope2 = LOG2E * exp2f(-(float)(vh + 1)); U.moba = 1; U.kpart = KPART + (size_t)(b * 8) * 1024 + vh * 64; }
            else { const int dvh = vh - 8, dh = dvh >> 2, j = (dvh >> 1) & 1, c = dvh & 1;
                U.Q = (const att::bf16*)(pb + 1536 + dh * 128 + j * 64); U.K = (const att::bf16*)(pb + 2048 + dh * 128 + j * 64); U.V = (const att::bf16*)(pb + 2560 + dh * 128 + c * 64);
                U.O = (att::bf16*)(DOB + (size_t)b * SEQ * 1024 + (dh * 2 + j) * 128 + c * 64); U.slope2 = LOG2E * exp2f(-2.0f * (float)(dh + 1)); U.moba = 0; U.kpart = KPART; }
            U.nb = 7 - s; att::attn_unit(U, (char*)lds + RING_OFF);
            U.nb = s; att::attn_unit(U, (char*)lds + RING_OFF);
        }
        GRID_BAR();
    }
    if (IN(3)) {
        const float lam = MISCG[0];
        const int hh = F.lane >> 4, cc = (F.lane & 15) * 8;
        float gs[8];
#pragma unroll
        for (int i = 0; i < 8; ++i) gs[i] = subln_g[cc + i] * 0.8f;
        for (int t = gw; t < M; t += NGW) {
            const v4u a = *(const GAS v4u*)(DOB + (size_t)t * 1024 + hh * 256 + cc), b = *(const GAS v4u*)(DOB + (size_t)t * 1024 + hh * 256 + 128 + cc);
            float d[8]; float ss = 0.f;
#pragma unroll
            for (int i = 0; i < 4; ++i) { d[2 * i] = __uint_as_float(a[i] << 16) - lam * __uint_as_float(b[i] << 16); d[2 * i + 1] = __uint_as_float(a[i] & 0xffff0000u) - lam * __uint_as_float(b[i] & 0xffff0000u);
                ss += d[2 * i] * d[2 * i] + d[2 * i + 1] * d[2 * i + 1]; }
#pragma unroll
            for (int o = 1; o < 16; o <<= 1) ss += __shfl_xor(ss, o);
            const float r = 1.0f / sqrtf(ss * (1.0f / 128.0f) + RMS_EPS);
            v4u w; w.x = pk2(d[0] * r * gs[0], d[1] * r * gs[1]); w.y = pk2(d[2] * r * gs[2], d[3] * r * gs[3]); w.z = pk2(d[4] * r * gs[4], d[5] * r * gs[5]); w.w = pk2(d[6] * r * gs[6], d[7] * r * gs[7]);
            *(GAS v4u*)(MIX + (size_t)t * 1024 + 512 + hh * 128 + cc) = w;
        }
        GRID_BAR();
    }
    if (IN(4)) {
        pg8::Gemm g{MIX, WOUT, M, D, D}; pg8::StaticOrder S; S.init(M, D, F.G, (int)blockIdx.x);
        pg8::EpiOut E{x, out, XN, SSQ};
        pg8::gemm_phase<pg8::EpiOut, pg8::StaticOrder, true, true>(F.lds + RING_OFF, g, S, E);
        GRID_BAR();
    }
    if (IN(5)) {
        pg8::Gemm g{XN, WQ, M, NQP, D}; pg8::StaticOrder S; S.init(M, NQP, F.G, (int)blockIdx.x);
        pg8::EpiBf16 E{QP, NQP};
        pg8::gemm_phase<pg8::EpiBf16, pg8::StaticOrder, true, true>(F.lds + RING_OFF, g, S, E);
        GRID_BAR();
    }
    if (IN(6)) {
        REP(6) for (int task = gw; task < (M / 32) * 8; task += NGW) peer::topk_task((const peer::bf16*)QP, (const peer::bf16*)SK, SSQ, RSTD, LE, LG, task >> 3, task & 7, F.lane);
        for (int t = gw; t < M; t += NGW) peer::quant_token((const peer::bf16*)XN, SSQ, XQ, HS, t, F.lane);
        GRID_BAR();
    }
    if (IN(7)) {
        const int xl = (int)blockIdx.x & 7, nwx = (F.G >> 3) * NWAVES, wx = ((int)blockIdx.x >> 3) * NWAVES + F.wave;
        REP(70) peer::expert_u_pass(XQ, U8, HS, SU, SV, LE, LG, PACK, xl, wx, nwx, F.lane, (char*)lds + RING_OFF + F.wave * 8192);
        GRID_BAR();
        if (PROBE_DUP == 71) peer::expert_v_pass(V8, PACK, (float*)QP, xl, wx, nwx, F.lane);
        peer::expert_v_pass(V8, PACK, out, xl, wx, nwx, F.lane);
    }
#undef IN
#undef GRID_BAR
}

extern "C" void kernel_launch(void* const* d_in, const int* in_sizes, int n_in, void* d_out, int out_size, void* d_ws, size_t ws_size, hipStream_t stream) {
    static int grid = 0;
    if (grid == 0) {
        if (n_in != 13 || in_sizes[0] != M * D || out_size != M * D || ws_size < WS_END) { fprintf(stderr, "kernel_launch: unexpected shapes (n_in %d, in0 %d, out %d, ws %zu); nothing launched\n", n_in, n_in > 0 ? in_sizes[0] : -1, out_size, ws_size); grid = -1; return; }
        int dev = 0, cus = 0, per_cu = 0;
        if (hipGetDevice(&dev) != hipSuccess || hipDeviceGetAttribute(&cus, hipDeviceAttributeMultiprocessorCount, dev) != hipSuccess) { grid = -1; return; }
        if (hipFuncSetAttribute((const void*)mega_fwd, hipFuncAttributeMaxDynamicSharedMemorySize, LDS_BYTES) != hipSuccess) { fprintf(stderr, "kernel_launch: hipFuncSetAttribute failed\n"); grid = -1; return; }
        if (hipOccupancyMaxActiveBlocksPerMultiprocessor(&per_cu, (const void*)mega_fwd, NWAVES * 64, LDS_BYTES) != hipSuccess || per_cu < 1) { fprintf(stderr, "kernel_launch: occupancy query reports %d workgroups per CU\n", per_cu); }
        (void)hipGetLastError();
        grid = cus;
    }
    if (grid < 0) return;
    if (hipMemsetAsync((char*)d_ws + WS_CTL, 0, CTL_ZERO_BYTES, stream) != hipSuccess) return;
    Args a{};
    for (int i = 0; i < 13; ++i) a.in[i] = (const float*)d_in[i];
    a.out = (float*)d_out; a.ws = (unsigned char*)d_ws; a.ph_lo = 0; a.ph_hi = 8;
    hipLaunchKernelGGL(mega_fwd, dim3(grid), dim3(NWAVES * 64), LDS_BYTES, stream, a);
}
```

```cpp
#include <hip/hip_runtime.h>
#include <hip/hip_bf16.h>
#include <cstdio>
#include <cstdint>
#include <cmath>
namespace pg8 {
#define PG8_LAS __attribute__((address_space(3)))
typedef unsigned short bf16_t;
typedef short bf16x8 __attribute__((ext_vector_type(8)));
typedef float f32x4 __attribute__((ext_vector_type(4)));
typedef unsigned u32x4 __attribute__((ext_vector_type(4)));
constexpr int BM = 256, BK = 64, HALF = 128, HTB = HALF * BK * 2  , STAGE_BYTES = 8 * HTB, NXCD = 8, WGM = 8;

__host__ __device__ __forceinline__ int lds_byte(int r, int c) { const int st = (r >> 4) * 2 + (c >> 5), rr = r & 15, cc = c & 31, ob = rr * 64 + cc * 2; return st * 1024 + (ob ^ (((ob >> 9) & 1) << 5)); }
__host__ __device__ __forceinline__ void stage_rc(int b, int& R, int& C) { const int st = b / 1024, sb = b % 1024, swz = sb ^ (((sb >> 9) & 1) << 5); R = (st >> 1) * 16 + swz / 64; C = (st & 1) * 32 + (swz % 64) / 2; }
__host__ __device__ __forceinline__ int perm32(int rho) { const int n = rho >> 4, i = rho & 15; return 8 * (i >> 2) + 4 * n + (i & 3); }

struct Unit { int pm, pn; };
struct Gemm { const bf16_t* A; const bf16_t* Bt; int M, N, K; };

struct StaticOrder {
    int nM, nN, nwg, G, c;
    __host__ __device__ void init(int M, int N, int G_, int c_) { nM = M / BM; nN = N / BM; nwg = nM * nN; G = G_; c = c_; }
    __host__ __device__ bool next(int i, Unit& u) const {
        const long L = (long)i * G + c; if (L >= nwg) return false;
        int wgid = (int)L; { const int q = nwg / NXCD, r = nwg % NXCD, xcd = wgid % NXCD, off = wgid / NXCD; wgid = (xcd < r ? xcd * (q + 1) : r * (q + 1) + (xcd - r) * q) + off; }
        const int nig = WGM * nN, gid = wgid / nig, fm = gid * WGM, gsz = (nM - fm) < WGM ? (nM - fm) : WGM;
        u.pm = fm + ((wgid % nig) % gsz); u.pn = (wgid % nig) / gsz; return true;
    }
    __device__ __forceinline__ void a_ready(const Unit&) const {}
    __device__ __forceinline__ void done(const Unit&) const {}
};

__device__ __forceinline__ unsigned cvt_pk_bf16(float lo, float hi) { unsigned r; asm volatile("v_cvt_pk_bf16_f32 %0, %1, %2" : "=v"(r) : "v"(lo), "v"(hi)); return r; }
typedef unsigned u32x2 __attribute__((ext_vector_type(2)));

struct EpiBf16 {
    static constexpr bool PERM = true, AFTER_DRAIN = false;
    bf16_t* O; int ldc;
    __device__ __forceinline__ void operator()(const f32x4 (&acc)[2][2][4][2], const Unit& u, int wr, int wc, int fr, int fq) const {
        const int row0 = u.pm * BM + wr * 64 + fr; const int col0 = u.pn * BM + wc * 32 + 8 * fq;
#pragma unroll
        for (int ai = 0; ai < 2; ++ai)
#pragma unroll
            for (int m = 0; m < 4; ++m) { bf16_t* rowp = O + (size_t)(row0 + ai * HALF + m * 16) * ldc + col0;
#pragma unroll
                for (int bj = 0; bj < 2; ++bj) { const f32x4 v0 = acc[ai][bj][m][0], v1 = acc[ai][bj][m][1];
                    u32x4 w; w.x = cvt_pk_bf16(v0[0], v0[1]); w.y = cvt_pk_bf16(v0[2], v0[3]); w.z = cvt_pk_bf16(v1[0], v1[1]); w.w = cvt_pk_bf16(v1[2], v1[3]);
                    *(u32x4*)(rowp + bj * HALF) = w; } }
    }
};

struct EpiProj {
    static constexpr bool PERM = true, AFTER_DRAIN = false;
    bf16_t* P; const float *gmq, *gmk, *gdq, *gdk; float* kpart; float c2;
    __device__ __forceinline__ void operator()(const f32x4 (&acc)[2][2][4][2], const Unit& u, int wr, int wc, int fr, int fq) const {
        const int type = u.pn >> 1;
        const float* g = type == 0 ? gmq : type == 1 ? gmk : type == 3 ? gdq : type == 4 ? gdk : nullptr;
        const float sc0 = (type == 0 || type == 3) ? c2 : 1.f;
        f32x4 gv[2][2];
#pragma unroll
        for (int bj = 0; bj < 2; ++bj)
#pragma unroll
            for (int n = 0; n < 2; ++n) gv[bj][n] = g ? (*(const f32x4*)(g + 32 * bj + 8 * fq + 4 * n)) * sc0 : (f32x4){1.f, 1.f, 1.f, 1.f};
        f32x4 cs[2][2];
#pragma unroll
        for (int bj = 0; bj < 2; ++bj)
#pragma unroll
            for (int n = 0; n < 2; ++n) cs[bj][n] = (f32x4){0.f, 0.f, 0.f, 0.f};
        const int row0 = u.pm * BM + wr * 64 + fr; const int col0 = u.pn * BM + wc * 64 + 8 * fq;
#pragma unroll
        for (int ai = 0; ai < 2; ++ai)
#pragma unroll
            for (int m = 0; m < 4; ++m) {
                f32x4 v[2][2];
#pragma unroll
                for (int bj = 0; bj < 2; ++bj)
#pragma unroll
                    for (int n = 0; n < 2; ++n) v[bj][n] = acc[ai][bj][m][n];
                if (g) {
                    float ss = 0.f;
#pragma unroll
                    for (int bj = 0; bj < 2; ++bj)
#pragma unroll
                        for (int n = 0; n < 2; ++n) { const f32x4 x = v[bj][n]; ss += (x[0] * x[0] + x[1] * x[1]) + (x[2] * x[2] + x[3] * x[3]); }
                    ss += __shfl_xor(ss, 16); ss += __shfl_xor(ss, 32);
                    const float r = 1.0f / sqrtf(ss * (1.0f / 64.0f) + 1e-6f);
#pragma unroll
                    for (int bj = 0; bj < 2; ++bj)
#pragma unroll
                        for (int n = 0; n < 2; ++n) { v[bj][n] = v[bj][n] * r * gv[bj][n]; cs[bj][n] += v[bj][n]; }
                }
                bf16_t* rowp = P + (size_t)(row0 + ai * HALF + m * 16) * 3072 + col0;
#pragma unroll
                for (int bj = 0; bj < 2; ++bj) { const f32x4 v0 = v[bj][0], v1 = v[bj][1];
                    u32x4 w; w.x = cvt_pk_bf16(v0[0], v0[1]); w.y = cvt_pk_bf16(v0[2], v0[3]); w.z = cvt_pk_bf16(v1[0], v1[1]); w.w = cvt_pk_bf16(v1[2], v1[3]);
                    *(u32x4*)(rowp + bj * 32) = w; }
            }
        if (type == 1) {
#pragma unroll
            for (int bj = 0; bj < 2; ++bj)
#pragma unroll
                for (int n = 0; n < 2; ++n) { f32x4 c = cs[bj][n];
#pragma unroll
                    for (int o = 1; o < 16; o <<= 1) { c[0] += __shfl_xor(c[0], o); c[1] += __shfl_xor(c[1], o); c[2] += __shfl_xor(c[2], o); c[3] += __shfl_xor(c[3], o); }
                    if (fr == 0) *(f32x4*)(kpart + (size_t)(u.pm * 2 + wr) * 512 + (u.pn - 2) * 256 + wc * 64 + bj * 32 + fq * 8 + n * 4) = c; }
        }
    }
};

struct EpiOut {
    static constexpr bool PERM = false, AFTER_DRAIN = false;
    const float* x; float* out; bf16_t* xmb; float* ssq;
    __device__ __forceinline__ void operator()(const f32x4 (&acc)[2][2][4][2], const Unit& u, int wr, int wc, int fr, int fq) const {
        const int row0 = u.pm * BM + wr * 64 + fr; const int col0 = u.pn * BM + wc * 32 + 4 * fq;
#pragma unroll
        for (int ai = 0; ai < 2; ++ai)
#pragma unroll
            for (int m = 0; m < 4; ++m) { const int row = row0 + ai * HALF + m * 16; const size_t off = (size_t)row * 1024 + col0; float s = 0.f;
#pragma unroll
                for (int bj = 0; bj < 2; ++bj)
#pragma unroll
                    for (int n = 0; n < 2; ++n) { const f32x4 xv = *(const f32x4*)(x + off + bj * HALF + n * 16); const f32x4 y = xv + acc[ai][bj][m][n];
                        *(f32x4*)(out + off + bj * HALF + n * 16) = y; u32x2 w; w.x = cvt_pk_bf16(y[0], y[1]); w.y = cvt_pk_bf16(y[2], y[3]); *(u32x2*)(xmb + off + bj * HALF + n * 16) = w;
                        s += (y[0] * y[0] + y[1] * y[1]) + (y[2] * y[2] + y[3] * y[3]); }
                s += __shfl_xor(s, 16); s += __shfl_xor(s, 32);
                if (fq == 0) ssq[(size_t)row * 16 + u.pn * 4 + wc] = s;
                if (m & 1) asm volatile("" ::: "memory"); }
    }
};
template <class Epi, class Sched, bool ALIGN_EPI = false, bool SP2 = false>
__device__ __forceinline__ void gemm_phase(PG8_LAS unsigned char* lds, const Gemm g, const Sched& S, const Epi& E) {
    const int tid = threadIdx.x, wid = __builtin_amdgcn_readfirstlane(tid >> 6), lane = tid & 63, wr = wid >> 2, wc = wid & 3, fr = lane & 15, fq = lane >> 4;
    const int K = g.K, nt = K / BK;
    unsigned voffA[2], voffB[2];
#pragma unroll
    for (int i = 0; i < 2; ++i) { int R, C; stage_rc(tid * 16 + i * 8192, R, C); const int Rb = Epi::PERM ? ((R & ~31) + perm32(R & 31)) : R;
        voffA[i] = (unsigned)(R * K + C) * 2u; voffB[i] = (unsigned)(Rb * K + C) * 2u; }
    const size_t kstep = (size_t)(BK * 2);
    const size_t hstep = (size_t)HALF * K * 2;
    const size_t tstep = 2 * hstep;
    const unsigned ldsw = (unsigned)wid * 1024u;
    const int aoff = lds_byte(wr * 64 + fr, fq * 8), boff = lds_byte(wc * 32 + fr, fq * 8);
#define PG8_SA(b, h) (((b) * 2 + (h)) * HTB)
#define PG8_SB(b, h) ((4 + (b) * 2 + (h)) * HTB)
#define PG8_STAGE(bufoff, gbase, voff) do { _Pragma("unroll") for (int _i = 0; _i < 2; ++_i) \
        __builtin_amdgcn_global_load_lds((const unsigned*)((const char*)(gbase) + (voff)[_i]), (PG8_LAS unsigned*)(lds + (bufoff) + ldsw + _i * 8192), 16, 0, 0); } while (0)
#define PG8_LDA(dst, b, h) do { _Pragma("unroll") for (int m = 0; m < 4; ++m) _Pragma("unroll") for (int k = 0; k < 2; ++k) dst[m][k] = *(const PG8_LAS bf16x8*)(lds + PG8_SA(b, h) + aoff + m * 2048 + k * 1024); } while (0)
#define PG8_LDB(dst, b, h) do { _Pragma("unroll") for (int n = 0; n < 2; ++n) _Pragma("unroll") for (int k = 0; k < 2; ++k) dst[n][k] = *(const PG8_LAS bf16x8*)(lds + PG8_SB(b, h) + boff + n * 2048 + k * 1024); } while (0)
#define PG8_MMA(ai, bj, At, Bt) do { __builtin_amdgcn_s_setprio(1); _Pragma("unroll") for (int m = 0; m < 4; ++m) _Pragma("unroll") for (int n = 0; n < 2; ++n) _Pragma("unroll") for (int k = 0; k < 2; ++k) \
        acc[ai][bj][m][n] = __builtin_amdgcn_mfma_f32_16x16x32_bf16(Bt[n][k], At[m][k], acc[ai][bj][m][n], 0, 0, 0); __builtin_amdgcn_s_setprio(0); } while (0)
#define PG8_WAIT_V(n) asm volatile("s_waitcnt vmcnt(" #n ")" ::: "memory")
#define PG8_WAIT_L(n) asm volatile("s_waitcnt lgkmcnt(" #n ")" ::: "memory")
#define PG8_BAR __builtin_amdgcn_s_barrier()
#define PG8_SCHED __builtin_amdgcn_sched_barrier(0)
    Unit cur, nxt; int ui = 0;
    if (!S.next(0, cur)) return;
    f32x4 acc[2][2][4][2];
#pragma unroll
    for (int a = 0; a < 2; ++a)
#pragma unroll
        for (int b = 0; b < 2; ++b)
#pragma unroll
            for (int m = 0; m < 4; ++m)
#pragma unroll
                for (int n = 0; n < 2; ++n) acc[a][b][m][n] = (f32x4){0.f, 0.f, 0.f, 0.f};
    bf16x8 At[4][2], B0[2][2], B1[2][2];
    const char* cA = (const char*)g.A + (size_t)cur.pm * tstep; const char* cB = (const char*)g.Bt + (size_t)cur.pn * tstep;
    S.a_ready(cur);
    if constexpr (SP2) {
        PG8_STAGE(PG8_SB(0, 0), cB, voffB); PG8_STAGE(PG8_SB(0, 1), cB + hstep, voffB); PG8_STAGE(PG8_SA(0, 0), cA, voffA); PG8_STAGE(PG8_SA(0, 1), cA + hstep, voffA);
        if (wr == 1) PG8_BAR;
        PG8_WAIT_V(2); PG8_BAR;
        PG8_STAGE(PG8_SB(1, 0), cB + kstep, voffB); PG8_STAGE(PG8_SA(1, 0), cA + kstep, voffA); PG8_STAGE(PG8_SB(1, 1), cB + hstep + kstep, voffB);
        PG8_WAIT_V(6); PG8_BAR;
    } else {
        PG8_STAGE(PG8_SB(0, 0), cB, voffB); PG8_STAGE(PG8_SA(0, 0), cA, voffA); PG8_STAGE(PG8_SB(0, 1), cB + hstep, voffB); PG8_STAGE(PG8_SA(0, 1), cA + hstep, voffA);
        if (wr == 1) PG8_BAR;
        PG8_WAIT_V(4); PG8_BAR;
        PG8_STAGE(PG8_SB(1, 0), cB + kstep, voffB); PG8_STAGE(PG8_SA(1, 0), cA + kstep, voffA); PG8_STAGE(PG8_SB(1, 1), cB + hstep + kstep, voffB);
        PG8_WAIT_V(6); PG8_BAR;
    }
    for (;;) {
        const bool has_next = S.next(ui + 1, nxt);
        const char* nA = has_next ? (const char*)g.A + (size_t)nxt.pm * tstep : cA; const char* nB = has_next ? (const char*)g.Bt + (size_t)nxt.pn * tstep : cB;
        for (int t = 0; t < nt; t += 2) {
            const bool last = (t == nt - 2);
            const char* a1 = cA + (size_t)(t + 1) * kstep;
            const char* a2 = last ? nA : cA + (size_t)(t + 2) * kstep; const char* b2 = last ? nB : cB + (size_t)(t + 2) * kstep;
            const char* a3 = a2 + kstep; const char* b3 = b2 + kstep;
            if (last && has_next) S.a_ready(nxt);
            if constexpr (SP2) {
            PG8_LDB(B0, 0, 0); PG8_LDB(B1, 0, 1); PG8_SCHED; PG8_LDA(At, 0, 0); PG8_STAGE(PG8_SA(1, 1), a1 + hstep, voffA);
            PG8_WAIT_V(8); PG8_WAIT_L(0); PG8_BAR; PG8_MMA(0, 0, At, B0); PG8_MMA(0, 1, At, B1); PG8_BAR; PG8_SCHED;
            PG8_LDA(At, 0, 1); PG8_STAGE(PG8_SB(0, 0), b2, voffB); PG8_STAGE(PG8_SB(0, 1), b2 + hstep, voffB); PG8_STAGE(PG8_SA(0, 0), a2, voffA);
            PG8_WAIT_V(8); PG8_WAIT_L(0); PG8_BAR; PG8_MMA(1, 0, At, B0); PG8_MMA(1, 1, At, B1); PG8_BAR; PG8_SCHED;
            PG8_LDB(B0, 1, 0); PG8_LDB(B1, 1, 1); PG8_SCHED; PG8_LDA(At, 1, 0); PG8_STAGE(PG8_SA(0, 1), a2 + hstep, voffA);
            PG8_WAIT_V(8); PG8_WAIT_L(0); PG8_BAR; PG8_MMA(0, 0, At, B0); PG8_MMA(0, 1, At, B1); PG8_BAR; PG8_SCHED;
            PG8_LDA(At, 1, 1); PG8_STAGE(PG8_SB(1, 0), b3, voffB); PG8_STAGE(PG8_SB(1, 1), b3 + hstep, voffB); PG8_STAGE(PG8_SA(1, 0), a3, voffA);
            PG8_WAIT_V(8); PG8_WAIT_L(0); PG8_BAR; PG8_MMA(1, 0, At, B0); PG8_MMA(1, 1, At, B1); PG8_BAR; PG8_SCHED;
            } else {
            PG8_LDB(B0, 0, 0); PG8_SCHED; PG8_LDA(At, 0, 0); PG8_STAGE(PG8_SA(1, 1), a1 + hstep, voffA);
            PG8_WAIT_L(8); PG8_BAR; PG8_WAIT_L(0); PG8_MMA(0, 0, At, B0); PG8_BAR; PG8_SCHED;
            PG8_LDB(B1, 0, 1); PG8_STAGE(PG8_SB(0, 0), b2, voffB);
            PG8_BAR; PG8_WAIT_L(0); PG8_MMA(0, 1, At, B1); PG8_BAR;
            PG8_LDA(At, 0, 1); PG8_STAGE(PG8_SA(0, 0), a2, voffA);
            PG8_BAR; PG8_WAIT_L(0); PG8_MMA(1, 0, At, B0); PG8_BAR; PG8_SCHED;
            PG8_STAGE(PG8_SB(0, 1), b2 + hstep, voffB);
            PG8_WAIT_V(6); PG8_BAR; PG8_MMA(1, 1, At, B1); PG8_BAR;
            PG8_LDB(B0, 1, 0); PG8_SCHED; PG8_LDA(At, 1, 0); PG8_STAGE(PG8_SA(0, 1), a2 + hstep, voffA);
            PG8_WAIT_L(8); PG8_BAR; PG8_WAIT_L(0); PG8_MMA(0, 0, At, B0); PG8_BAR; PG8_SCHED;
            PG8_LDB(B1, 1, 1); PG8_STAGE(PG8_SB(1, 0), b3, voffB);
            PG8_BAR; PG8_WAIT_L(0); PG8_MMA(0, 1, At, B1); PG8_BAR;
            PG8_LDA(At, 1, 1); PG8_STAGE(PG8_SA(1, 0), a3, voffA);
            PG8_BAR; PG8_WAIT_L(0); PG8_MMA(1, 0, At, B0); PG8_BAR; PG8_SCHED;
            PG8_STAGE(PG8_SB(1, 1), b3 + hstep, voffB);
            PG8_WAIT_V(6); PG8_BAR; PG8_MMA(1, 1, At, B1); PG8_BAR;
            }
        }
        if constexpr (ALIGN_EPI) { if (wr == 0) PG8_BAR; }
        if constexpr (!Epi::AFTER_DRAIN) { E(acc, cur, wr, wc, fr, fq); S.done(cur); }
        if (!has_next) break;
#pragma unroll
        for (int a = 0; a < 2; ++a)
#pragma unroll
            for (int b = 0; b < 2; ++b)
#pragma unroll
                for (int m = 0; m < 4; ++m)
#pragma unroll
                    for (int n = 0; n < 2; ++n) acc[a][b][m][n] = (f32x4){0.f, 0.f, 0.f, 0.f};
        cur = nxt; cA = nA; cB = nB; ++ui;
        if constexpr (ALIGN_EPI) { if (wr == 1) PG8_BAR; }
    }
    PG8_WAIT_V(0);
    if constexpr (!ALIGN_EPI) { if (wr == 0) PG8_BAR; }
    PG8_BAR;
    if constexpr (Epi::AFTER_DRAIN) { E.fused(acc, cur, wr, wc, fr, fq, lds, wid, lane); S.done(cur); }
#undef PG8_SA
#undef PG8_SB
#undef PG8_STAGE
#undef PG8_LDA
#undef PG8_LDB
#undef PG8_MMA
#undef PG8_WAIT_V
#undef PG8_WAIT_L
#undef PG8_BAR
#undef PG8_SCHED
}
}
namespace att {
using bf16 = __hip_bfloat16;
using bf16x8 = __attribute__((ext_vector_type(8))) short;
using s16x4 = __attribute__((ext_vector_type(4))) short;
using f32x16 = __attribute__((ext_vector_type(16))) float;
using u32x4 = __attribute__((ext_vector_type(4))) unsigned;
constexpr int PITCH = 3072, QB = 256, KVBLK = 64, NW = 8;
constexpr int SLOTB = 8192, LDS_K = 0, LDS_V = 2 * SLOTB, LDS_WS = 4 * SLOTB, LDS_OST = LDS_WS + NW * 64 * 4, LDS_BYTES = LDS_OST + NW * 4096;
__device__ __forceinline__ int crow(int r, int hi) { return (r & 3) + 8 * (r >> 2) + 4 * hi; }
typedef float f32x2_t __attribute__((ext_vector_type(2))); typedef __bf16 bf16x2_t __attribute__((ext_vector_type(2)));
__device__ __forceinline__ unsigned cvtpk_s(float lo, float hi) { f32x2_t v = {lo, hi}; bf16x2_t b = __builtin_convertvector(v, bf16x2_t); return __builtin_bit_cast(unsigned, b); }

__device__ __forceinline__ void qkt(f32x16& p0, f32x16& p1, const char* Kslot, const bf16x8* qr, int r32, int hi) {
  const char* kb = Kslot + hi * 1024 + r32 * 16;
  const f32x16 z = {};
#pragma unroll
  for (int d0 = 0; d0 < 4; ++d0) {
    const bf16x8 b0 = *reinterpret_cast<const bf16x8*>(kb + d0 * 2048);
    const bf16x8 b1 = *reinterpret_cast<const bf16x8*>(kb + d0 * 2048 + 512);
    if (d0 == 0) { p0 = __builtin_amdgcn_mfma_f32_32x32x16_bf16(b0, qr[0], z, 0, 0, 0); p1 = __builtin_amdgcn_mfma_f32_32x32x16_bf16(b1, qr[0], z, 0, 0, 0); }
    else { p0 = __builtin_amdgcn_mfma_f32_32x32x16_bf16(b0, qr[d0], p0, 0, 0, 0); p1 = __builtin_amdgcn_mfma_f32_32x32x16_bf16(b1, qr[d0], p1, 0, 0, 0); } }
}
__device__ __forceinline__ void pv(f32x16* o, int vb, bf16x8 pa0, bf16x8 pa1, bf16x8 pa2, bf16x8 pa3) {
#pragma unroll
  for (int d0 = 0; d0 < 2; ++d0) { s16x4 lo[4], hi[4];
#pragma unroll
    for (int ks = 0; ks < 4; ++ks) {
      asm volatile("ds_read_b64_tr_b16 %0,%1 offset:%c2" : "=&v"(lo[ks]) : "v"(vb), "i"(d0 * 4096 + ks * 1024) : "memory");
      asm volatile("ds_read_b64_tr_b16 %0,%1 offset:%c2" : "=&v"(hi[ks]) : "v"(vb), "i"(d0 * 4096 + ks * 1024 + 512) : "memory"); }
    asm volatile("s_waitcnt lgkmcnt(0)" ::: "memory"); __builtin_amdgcn_sched_barrier(0);
#define PK(k) (bf16x8){lo[k][0], lo[k][1], lo[k][2], lo[k][3], hi[k][0], hi[k][1], hi[k][2], hi[k][3]}
    o[d0] = __builtin_amdgcn_mfma_f32_32x32x16_bf16(pa0, PK(0), o[d0], 0, 0, 0);
    o[d0] = __builtin_amdgcn_mfma_f32_32x32x16_bf16(pa1, PK(1), o[d0], 0, 0, 0);
    o[d0] = __builtin_amdgcn_mfma_f32_32x32x16_bf16(pa2, PK(2), o[d0], 0, 0, 0);
    o[d0] = __builtin_amdgcn_mfma_f32_32x32x16_bf16(pa3, PK(3), o[d0], 0, 0, 0);
#undef PK
  }
}
struct UnitDesc { const bf16* Q; const bf16* K; const bf16* V; bf16* O; float slope2; int nb; int moba; const float* kpart; };
__device__ __forceinline__ void attn_unit(const UnitDesc& U, char* shm) {
  const int tid = threadIdx.x, lane = tid & 63, r32 = lane & 31, hi = lane >> 5; const int wid = __builtin_amdgcn_readfirstlane(tid >> 6);
  const int nb = U.nb, q0 = nb * QB;
  const bf16* Qw = U.Q + (long)(q0 + wid * 32) * PITCH;
  const unsigned lds0 = (unsigned)(uintptr_t)shm;
  float* wsf = (float*)(shm + LDS_WS) + wid * 64;
  bf16x8 qr[4];
#pragma unroll
  for (int d0 = 0; d0 < 4; ++d0) qr[d0] = *reinterpret_cast<const bf16x8*>(&Qw[(long)r32 * PITCH + d0 * 16 + hi * 8]);
  unsigned sel = 0xffu;
  if (U.moba) {
    float g[4] = {0.f, 0.f, 0.f, 0.f};
    const bf16* qrow = Qw + (long)r32 * PITCH;
    for (int c = 0; c < 8; ++c) {
      const u32x4 qv = *reinterpret_cast<const u32x4*>(qrow + c * 8);
      float qf[8];
#pragma unroll
      for (int i = 0; i < 4; ++i) { qf[2 * i] = __uint_as_float(qv[i] << 16); qf[2 * i + 1] = __uint_as_float(qv[i] & 0xffff0000u); }
#pragma unroll
      for (int j = 0; j < 4; ++j) { const int n = 4 * hi + j;
        if (n < nb) { const float* k0 = U.kpart + (size_t)(n * 2) * 512 + c * 8; const float* k1 = k0 + 512;
#pragma unroll
          for (int i = 0; i < 8; ++i) g[j] += qf[i] * (k0[i] + k1[i]); } }
    }
    float ga[8];
#pragma unroll
    for (int j = 0; j < 4; ++j) { const float o = __shfl_xor(g[j], 32); ga[j] = hi ? o : g[j]; ga[4 + j] = hi ? g[j] : o; }
    sel = 0u;
#pragma unroll
    for (int n = 0; n < 8; ++n) { int rank = 0;
#pragma unroll
      for (int m = 0; m < 8; ++m) if (m != n) rank += (m < nb && (ga[m] > ga[n] || (ga[m] == ga[n] && m < n))) ? 1 : 0;
      if (n < nb && rank < 3) sel |= (1u << n); }
  }
  const int NT = 4 * (nb + 1);
  float mrun = -30000.f, lrun = 0.f; f32x16 o[2]; o[0] = f32x16{}; o[1] = f32x16{};
  const int qrel = wid * 32 + r32;
  const bf16* ksrc = U.K + (long)lane * PITCH + wid * 8;
  const bf16* vsrc = U.V + (long)(16 * (wid & 3) + (lane >> 2)) * PITCH + (wid >> 2) * 32 + (lane & 3) * 8;
  char* kdst = shm + LDS_K + wid * 1024 + lane * 16; char* vdst = shm + LDS_V + wid * 1024 + lane * 16;
  const int vb0 = (int)(lds0 + LDS_V) + ((lane >> 4) & 1) * 32 + (lane & 3) * 8 + (4 * hi + ((lane & 15) >> 2)) * 64;
  u32x4 kreg = *reinterpret_cast<const u32x4*>(ksrc), vreg = *reinterpret_cast<const u32x4*>(vsrc);
  const float s2 = U.slope2;
  for (int t = 0; t < NT; ++t) {
    const int slot = (t & 1) * SLOTB;
    *reinterpret_cast<u32x4*>(kdst + slot) = kreg; *reinterpret_cast<u32x4*>(vdst + slot) = vreg;
    __syncthreads();
    if (t + 1 < NT) { kreg = *reinterpret_cast<const u32x4*>(ksrc + (long)(t + 1) * KVBLK * PITCH); vreg = *reinterpret_cast<const u32x4*>(vsrc + (long)(t + 1) * KVBLK * PITCH); }
    f32x16 p0, p1; qkt(p0, p1, shm + LDS_K + slot, qr, r32, hi);
    const int jb = t - (NT - 4);
    const float base = s2 * (float)(64 * t - q0 + 4 * hi);
#pragma unroll
    for (int r = 0; r < 16; ++r) { const float kr = (float)((r & 3) + 8 * (r >> 2)); p0[r] += base + s2 * kr; p1[r] += base + s2 * (kr + 32.f); }
    if (jb >= 0) { const int kb = 64 * jb + 4 * hi;
#pragma unroll
      for (int r = 0; r < 16; ++r) { const int kv = kb + (r & 3) + 8 * (r >> 2); if (kv > qrel) p0[r] = -INFINITY; if (kv + 32 > qrel) p1[r] = -INFINITY; } }
    else if (!((sel >> (t >> 2)) & 1u)) {
#pragma unroll
      for (int r = 0; r < 16; ++r) { p0[r] = -INFINITY; p1[r] = -INFINITY; } }
    float rm = fmaxf(p0[0], p1[0]);
#pragma unroll
    for (int r = 1; r < 16; ++r) rm = fmaxf(rm, fmaxf(p0[r], p1[r]));
    rm = fmaxf(rm, __shfl_xor(rm, 32));
    const float mnew = fmaxf(mrun, rm), f = __builtin_amdgcn_exp2f(mrun - mnew); mrun = mnew;
    float ps = 0.f;
#pragma unroll
    for (int r = 0; r < 16; ++r) { p0[r] = __builtin_amdgcn_exp2f(p0[r] - mnew); p1[r] = __builtin_amdgcn_exp2f(p1[r] - mnew); ps += p0[r] + p1[r]; }
    lrun = lrun * f + ps;
    if (hi == 0) wsf[r32] = f;
    u32x4 pw0, pw1, pw2, pw3;
#pragma unroll
    for (int i = 0; i < 4; ++i) { pw0[i] = cvtpk_s(p0[2 * i], p0[2 * i + 1]); pw1[i] = cvtpk_s(p0[8 + 2 * i], p0[9 + 2 * i]); pw2[i] = cvtpk_s(p1[2 * i], p1[2 * i + 1]); pw3[i] = cvtpk_s(p1[8 + 2 * i], p1[9 + 2 * i]); }
    asm volatile("s_waitcnt lgkmcnt(0)" ::: "memory");
#pragma unroll
    for (int r = 0; r < 16; ++r) { const float fr_ = wsf[crow(r, hi)]; o[0][r] *= fr_; o[1][r] *= fr_; }
    pv(o, vb0 + slot, __builtin_bit_cast(bf16x8, pw0), __builtin_bit_cast(bf16x8, pw1), __builtin_bit_cast(bf16x8, pw2), __builtin_bit_cast(bf16x8, pw3));
  }
  lrun += __shfl_xor(lrun, 32);
  if (hi == 0) wsf[32 + r32] = lrun;
  asm volatile("s_waitcnt lgkmcnt(0)" ::: "memory");
  float rli[16];
#pragma unroll
  for (int r = 0; r < 16; ++r) rli[r] = 1.0f / wsf[32 + crow(r, hi)];
  bf16* Ow = U.O + (long)(q0 + wid * 32) * 1024;
  { bf16* stg = (bf16*)(shm + LDS_OST) + wid * 2048;
#pragma unroll
    for (int r = 0; r < 16; ++r) { const int orow = crow(r, hi);
#pragma unroll
      for (int d0 = 0; d0 < 2; ++d0) stg[orow * 64 + d0 * 32 + r32] = __float2bfloat16(o[d0][r] * rli[r]); }
    asm volatile("s_waitcnt lgkmcnt(0)" ::: "memory");
#pragma unroll
    for (int i = 0; i < 4; ++i) { const int row = i * 8 + (lane >> 3), ch = lane & 7; const u32x4 v = *(const u32x4*)(stg + row * 64 + ch * 8); *(u32x4*)(Ow + (long)row * 1024 + ch * 8) = v; } }
  asm volatile("s_waitcnt lgkmcnt(0)" ::: "memory");
  __syncthreads();
}
}
namespace peer {
using bf16 = __hip_bfloat16;
using bf16x8 = __attribute__((ext_vector_type(8))) short;
using f32x16 = __attribute__((ext_vector_type(16))) float;
using u32x4 = __attribute__((ext_vector_type(4))) unsigned;
__device__ __forceinline__ int crow(int r, int hi) { return (r & 3) + 8 * (r >> 2) + 4 * hi; }
__device__ __forceinline__ int f2key(float f) { const int b = __float_as_int(f); return b ^ ((b >> 31) & 0x7fffffff); }
__device__ __forceinline__ float key2f(int k) { return __int_as_float(k ^ ((k >> 31) & 0x7fffffff)); }
__device__ __forceinline__ void ins16(int (&L)[16], int v) {
#pragma unroll
  for (int i = 0; i < 16; ++i) { const int a = L[i]; L[i] = a > v ? a : v; v = a > v ? v : a; }
}
__device__ __forceinline__ void merge16(int (&L)[16]) {
  int M[16];
#pragma unroll
  for (int i = 0; i < 16; ++i) { const int o = __shfl_xor(L[15 - i], 32); M[i] = L[i] > o ? L[i] : o; }
#pragma unroll
  for (int s = 8; s >= 1; s >>= 1)
#pragma unroll
    for (int i = 0; i < 16; ++i) if ((i & s) == 0) { const int a = M[i], b = M[i + s]; M[i] = a > b ? a : b; M[i + s] = a > b ? b : a; }
#pragma unroll
  for (int i = 0; i < 16; ++i) L[i] = M[i];
}
#define PEER_CAND_LIST(X) \
  X(0,0,0, 2,1) X(1,0,1, 2,2) X(2,0,2, 2,3) X(3,0,3, 2,4) X(4,0,4, 3,0) X(5,0,5, 3,1) X(6,0,6, 3,2) X(7,0,7, 3,3) X(8,0,8, 4,0) X(9,0,9, 4,1) X(10,0,10, 4,2) X(11,0,11, 5,0) X(12,0,12, 5,1) X(13,0,13, 6,0) X(14,0,14, 6,1) X(15,0,15, 7,0) X(16,1,0, 7,1) X(17,1,1, 8,0) X(18,1,2, 9,0) X(19,1,3, 10,0) X(20,1,4, 11,0) X(21,1,5, 12,0) X(22,1,6, 13,0) X(23,1,7, 14,0) X(24,2,0, 15,0)

__device__ __forceinline__ void topk_task(const bf16* QP, const bf16* SK, const float* ssq, float* RSTD, int* LE, float* LG, int tg, int h, int lane) {
  const int r32 = lane & 31, hi = lane >> 5; const int t = tg * 32 + r32;
  int A[16], B[16];
#pragma unroll
  for (int p = 0; p < 2; ++p) {
    bf16x8 qf[8];
#pragma unroll
    for (int ks = 0; ks < 8; ++ks) qf[ks] = *reinterpret_cast<const bf16x8*>(QP + (size_t)t * 2048 + h * 256 + p * 128 + ks * 16 + hi * 8);
    int L[16];
#pragma unroll
    for (int i = 0; i < 16; ++i) L[i] = (int)0x80000000;
    const bf16* kb = SK + (size_t)((h * 2 + p) * 128) * 128;
#pragma unroll 1
    for (int i = 0; i < 4; ++i) {
      f32x16 acc = {};
#pragma unroll
      for (int ks = 0; ks < 8; ++ks) { const bf16x8 a = *reinterpret_cast<const bf16x8*>(kb + (size_t)(i * 32 + r32) * 128 + ks * 16 + hi * 8); acc = __builtin_amdgcn_mfma_f32_32x32x16_bf16(a, qf[ks], acc, 0, 0, 0); }
#pragma unroll
      for (int r = 0; r < 16; ++r) { const int key = i * 32 + crow(r, hi); ins16(L, (f2key(acc[r]) & ~127) | key); }
    }
    merge16(L);
#pragma unroll
    for (int i = 0; i < 16; ++i) { if (p == 0) A[i] = L[i]; else B[i] = L[i]; }
  }
  float Af[16], Bf[16];
#pragma unroll
  for (int i = 0; i < 16; ++i) { Af[i] = key2f(A[i] & ~127); Bf[i] = key2f(B[i] & ~127); }
  float C[25];
#define X(c, i0, j0, i1, j1) C[c] = hi ? (Af[i1] + Bf[j1]) : (Af[i0] + Bf[j0]);
  PEER_CAND_LIST(X)
#undef X
  int L[16];
#pragma unroll
  for (int i = 0; i < 16; ++i) L[i] = (int)0x80000000;
#pragma unroll
  for (int c = 0; c < 25; ++c) ins16(L, f2key(C[c]));
  merge16(L);
  const int tau = L[15]; const float cmax = Af[0] + Bf[0];
  float s = 0.f;
#pragma unroll
  for (int i = 0; i < 16; ++i) s += ssq[(size_t)t * 16 + i];
  const float rstd = 1.0f / sqrtf(s * (1.0f / 1024.0f) + 1e-6f);
  const float k2 = rstd * 1.4426950408889634f;
  if (h == 0 && hi == 0) RSTD[t] = rstd;
  float E[25]; float den = 0.f; int cnt = 0; unsigned selm = 0u;
#pragma unroll
  for (int c = 0; c < 25; ++c) { const bool sl = f2key(C[c]) >= tau; E[c] = sl ? __builtin_amdgcn_exp2f((C[c] - cmax) * k2) : 0.f; den += E[c]; cnt += sl ? 1 : 0; selm |= sl ? (1u << c) : 0u; }
  den += __shfl_xor(den, 32);
  const int ocnt = __shfl_xor(cnt, 32);
  int pos = hi ? ocnt : 0;
  const float rden = 1.0f / den;
  int* le = LE + (size_t)t * 128 + h * 16; float* lg = LG + (size_t)t * 128 + h * 16;
#define X(c, i0, j0, i1, j1) { if (((selm >> c) & 1u) && pos < 16) { const int ka = (hi ? A[i1] : A[i0]) & 127, kb2 = (hi ? B[j1] : B[j0]) & 127; le[pos] = ka * 128 + kb2; lg[pos] = E[c] * rden; ++pos; } }
  PEER_CAND_LIST(X)
#undef X
}

__device__ __forceinline__ float gelu_erf(float v) { return 0.5f * v * (1.0f + erff(v * 0.70710678118654752f)); }
__device__ __forceinline__ void unpack8(const u32x4 w, float (&f)[8]) {
#pragma unroll
  for (int i = 0; i < 4; ++i) { f[2 * i] = __uint_as_float(w[i] << 16); f[2 * i + 1] = __uint_as_float(w[i] & 0xffff0000u); }
}
#define PEER_DPP(v, ctrl, rmask) __int_as_float(__builtin_amdgcn_update_dpp(0, __float_as_int(v), ctrl, rmask, 0xf, false))
__device__ __forceinline__ float wave_total(float v) {
  v += PEER_DPP(v, 0xB1, 0xf);
  v += PEER_DPP(v, 0x4E, 0xf);
  v += PEER_DPP(v, 0x141, 0xf);
  v += PEER_DPP(v, 0x140, 0xf);
  v += PEER_DPP(v, 0x142, 0xa);
  v += PEER_DPP(v, 0x143, 0xc);
  return __int_as_float(__builtin_amdgcn_readlane(__float_as_int(v), 63));
}
typedef float f32x4_t __attribute__((ext_vector_type(4)));
typedef float f32x2_t __attribute__((ext_vector_type(2)));
__device__ __forceinline__ float ub0(unsigned w) { return (float)(w & 255u); }
__device__ __forceinline__ float ub1(unsigned w) { return (float)((w >> 8) & 255u); }
__device__ __forceinline__ float ub2(unsigned w) { return (float)((w >> 16) & 255u); }
__device__ __forceinline__ float ub3(unsigned w) { return (float)(w >> 24); }
#define PEER_DPPI(v, ctrl, rmask) __builtin_amdgcn_update_dpp(0, v, ctrl, rmask, 0xf, false)
__device__ __forceinline__ int wave_total_i(int v) {
  v += PEER_DPPI(v, 0xB1, 0xf); v += PEER_DPPI(v, 0x4E, 0xf); v += PEER_DPPI(v, 0x141, 0xf); v += PEER_DPPI(v, 0x140, 0xf); v += PEER_DPPI(v, 0x142, 0xa); v += PEER_DPPI(v, 0x143, 0xc);
  return __builtin_amdgcn_readlane(v, 63);
}
__device__ __forceinline__ float quant_row16(const float (&v)[16], unsigned char* dst_row, int lane, int bias) {
  float m = 0.f;
#pragma unroll
  for (int i = 0; i < 16; ++i) m = fmaxf(m, fabsf(v[i]));
#pragma unroll
  for (int o = 1; o < 64; o <<= 1) m = fmaxf(m, __shfl_xor(m, o));
  const float inv = m > 0.f ? 127.0f / m : 0.f;
  u32x4 w;
#pragma unroll
  for (int q = 0; q < 4; ++q) { unsigned x = 0u;
#pragma unroll
    for (int i = 0; i < 4; ++i) { const int qi = (int)rintf(v[4 * q + i] * inv) + bias; x |= ((unsigned)qi & 255u) << (8 * i); }
    w[q] = x; }
  *reinterpret_cast<u32x4*>(dst_row + lane * 16) = w;
  return m * (1.0f / 127.0f);
}
#define PEER_UFETCH(G_) do { const size_t tb_ = (size_t)(G_) * 4; _Pragma("unroll") for (int j = 0; j < 4; ++j) { \
    e0[j] = LE[(tb_ + j) * 128 + lane] & 16383; e1[j] = LE[(tb_ + j) * 128 + 64 + lane] & 16383; g0[j] = LG[(tb_ + j) * 128 + lane]; g1[j] = LG[(tb_ + j) * 128 + 64 + lane]; \
    xa[j] = *reinterpret_cast<const u32x4*>(XQ + (tb_ + j) * 1024 + lane * 16); } \
    rs4 = *reinterpret_cast<const f32x4_t*>(HS + tb_); } while (0)
__device__ __forceinline__ void expert_u_pass(const unsigned char* XQ, const unsigned char* U8, const float* HS, const float* SU, const float* SV, const int* LE, const float* LG, unsigned* PACK, int slice, int wx, int nwx, int lane, char* wl) {
  unsigned* list = (unsigned*)(wl + 4096);
  int e0[4], e1[4]; float g0[4], g1[4]; u32x4 xa[4]; f32x4_t rs4;
  int gi = wx;
  if (gi < 8192) PEER_UFETCH(gi);
  for (; gi < 8192; gi += nwx) {
    int n = 0;
    const f32x4_t rs = rs4;
#pragma unroll
    for (int j = 0; j < 4; ++j) {
      *reinterpret_cast<u32x4*>(wl + j * 1024 + lane * 16) = xa[j];
      { const bool in = (e0[j] >> 11) == slice; const unsigned long long m = __ballot(in);
        if (in) { const int pos = n + (int)__builtin_amdgcn_mbcnt_hi((unsigned)(m >> 32), __builtin_amdgcn_mbcnt_lo((unsigned)m, 0u)); list[2 * pos] = (unsigned)e0[j] | ((unsigned)lane << 14) | ((unsigned)j << 21); list[2 * pos + 1] = __float_as_uint(g0[j]); }
        n += __builtin_popcountll(m); }
      { const bool in = (e1[j] >> 11) == slice; const unsigned long long m = __ballot(in);
        if (in) { const int pos = n + (int)__builtin_amdgcn_mbcnt_hi((unsigned)(m >> 32), __builtin_amdgcn_mbcnt_lo((unsigned)m, 0u)); list[2 * pos] = (unsigned)e1[j] | ((unsigned)(64 + lane) << 14) | ((unsigned)j << 21); list[2 * pos + 1] = __float_as_uint(g1[j]); }
        n += __builtin_popcountll(m); }
    }
    n = __builtin_amdgcn_readfirstlane(n);
    const int gnext = gi + nwx;
    if (gnext < 8192) PEER_UFETCH(gnext);
#define PEER_UISSUE(UA_, JJ_, WL_, SU_, SV_, B_) do { _Pragma("unroll") for (int s = 0; s < 16; ++s) { const int i = ((B_) + s < n) ? ((B_) + s) : (n - 1); const unsigned w = (unsigned)__builtin_amdgcn_readfirstlane((int)list[2 * i]); \
        JJ_[s] = (w >> 21) & 3u; UA_[s] = *reinterpret_cast<const u32x4*>(U8 + (size_t)(w & 16383u) * 1024 + lane * 16); } \
      { const int i = ((B_) + (lane >> 2) < n) ? ((B_) + (lane >> 2)) : (n - 1); WL_ = list[2 * i]; SU_ = SU[WL_ & 16383u]; SV_ = SV[WL_ & 16383u]; } } while (0)
#define PEER_UCOMP(UA_, JJ_, WL_, SU_, SV_, B_) do { int q[16]; \
      _Pragma("unroll") for (int s = 0; s < 16; ++s) { const u32x4 xl = *reinterpret_cast<const u32x4*>(wl + JJ_[s] * 1024 + lane * 16); int q_ = 0; \
        _Pragma("unroll") for (int i = 0; i < 4; ++i) q_ = __builtin_amdgcn_sdot4((int)UA_[s][i], (int)xl[i], q_, false); q[s] = q_; } \
        \
      int r8[8], r4[4], r2[2], r1; \
      { const bool bb = (lane & 32) != 0; _Pragma("unroll") for (int i = 0; i < 8; ++i) { const int keep = bb ? q[8 + i] : q[i], send = bb ? q[i] : q[8 + i]; r8[i] = keep + __shfl_xor(send, 32); } } \
      { const bool bb = (lane & 16) != 0; _Pragma("unroll") for (int i = 0; i < 4; ++i) { const int keep = bb ? r8[4 + i] : r8[i], send = bb ? r8[i] : r8[4 + i]; r4[i] = keep + __shfl_xor(send, 16); } } \
      { const bool bb = (lane & 8) != 0; _Pragma("unroll") for (int i = 0; i < 2; ++i) { const int keep = bb ? r4[2 + i] : r4[i], send = bb ? r4[i] : r4[2 + i]; r2[i] = keep + __shfl_xor(send, 8); } } \
      { const bool bb = (lane & 4) != 0; const int keep = bb ? r2[1] : r2[0], send = bb ? r2[0] : r2[1]; r1 = keep + __shfl_xor(send, 4); } \
      r1 += PEER_DPPI(r1, 0xB1, 0xf); r1 += PEER_DPPI(r1, 0x4E, 0xf); \
      if ((lane & 3) == 0 && (B_) + (lane >> 2) < n) { const unsigned w = WL_; const float gk = __uint_as_float(list[2 * ((B_) + (lane >> 2)) + 1]); const unsigned j = (w >> 21) & 3u; const unsigned e = w & 16383u; \
        const float r = j == 0 ? rs[0] : j == 1 ? rs[1] : j == 2 ? rs[2] : rs[3]; \
        const float a = gelu_erf((float)r1 * r * SU_) * gk * SV_; const unsigned ab = __float_as_uint(a); const unsigned rb = (ab + 0x7fffu + ((ab >> 16) & 1u)) & 0xffff0000u; \
        PACK[((size_t)gi * 4 + j) * 128 + ((w >> 14) & 127u)] = rb | e; } } while (0)
    if (n > 0) {
      u32x4 uA[16], uB[16]; unsigned jA[16], jB[16]; unsigned wA, wB; float suA, svA, suB, svB;
      PEER_UISSUE(uA, jA, wA, suA, svA, 0);
      for (int b = 0; b < n; b += 32) {
        if (b + 16 < n) PEER_UISSUE(uB, jB, wB, suB, svB, b + 16);
        PEER_UCOMP(uA, jA, wA, suA, svA, b);
        if (b + 16 >= n) break;
        if (b + 32 < n) PEER_UISSUE(uA, jA, wA, suA, svA, b + 32);
        PEER_UCOMP(uB, jB, wB, suB, svB, b + 16);
      }
    }
  }
}
#define PEER_VISSUE(S_, A_, P0_, P1_) do { _Pragma("unroll") for (int i = 0; i < 16; ++i) { const unsigned pk = (unsigned)__builtin_amdgcn_ds_bpermute(((8 * i + g) & 63) << 2, (int)(i < 8 ? P0_ : P1_)); \
    A_[i] = __uint_as_float(pk & 0xffff0000u); S_[i] = *reinterpret_cast<const u32x4*>(V8 + (size_t)(pk & 16383u) * 1024 + slice * 128 + c * 16); } } while (0)
#define PEER_VFINISH(S_, A_, T_, O_) do { float acc[16]; float asum = 0.f; _Pragma("unroll") for (int i = 0; i < 16; ++i) acc[i] = 0.f; \
    _Pragma("unroll") for (int i = 0; i < 16; ++i) { const float a_ = A_[i]; asum += a_; _Pragma("unroll") for (int q = 0; q < 4; ++q) { const unsigned w_ = S_[i][q]; \
        acc[4 * q] += a_ * ub0(w_); acc[4 * q + 1] += a_ * ub1(w_); acc[4 * q + 2] += a_ * ub2(w_); acc[4 * q + 3] += a_ * ub3(w_); } } \
    _Pragma("unroll") for (int i = 0; i < 16; ++i) acc[i] -= 128.f * asum; \
    float m8[8], m4[4], m2[2]; \
    { const bool bb = (g & 4) != 0; _Pragma("unroll") for (int i = 0; i < 8; ++i) { const float keep = bb ? acc[8 + i] : acc[i], send = bb ? acc[i] : acc[8 + i]; m8[i] = keep + __shfl_xor(send, 32); } } \
    { const bool bb = (g & 2) != 0; _Pragma("unroll") for (int i = 0; i < 4; ++i) { const float keep = bb ? m8[4 + i] : m8[i], send = bb ? m8[i] : m8[4 + i]; m4[i] = keep + __shfl_xor(send, 16); } } \
    { const bool bb = (g & 1) != 0; _Pragma("unroll") for (int i = 0; i < 2; ++i) { const float keep = bb ? m4[2 + i] : m4[i], send = bb ? m4[i] : m4[2 + i]; m2[i] = keep + __shfl_xor(send, 8); } } \
    f32x2_t r_ = (O_); r_[0] += m2[0]; r_[1] += m2[1]; *reinterpret_cast<f32x2_t*>(out + (size_t)(T_) * 1024 + slice * 128 + 16 * c + 2 * g) = r_; } while (0)
__device__ __forceinline__ void expert_v_pass(const unsigned char* V8, const unsigned* PACK, float* out, int slice, int wx, int nwx, int lane) {
  const int g = lane >> 3, c = lane & 7;
  const int MT = 32768;
  u32x4 sA[16], sB[16]; float aA[16], aB[16];
  int t = wx;
  unsigned p0 = 0, p1 = 0; f32x2_t oc = {0.f, 0.f}, on = {0.f, 0.f};
#define PEER_OLD(T_) (*reinterpret_cast<const f32x2_t*>(out + (size_t)(T_) * 1024 + slice * 128 + 16 * c + 2 * g))
  if (t < MT) { p0 = PACK[(size_t)t * 128 + lane]; p1 = PACK[(size_t)t * 128 + 64 + lane]; oc = PEER_OLD(t); }
  if (t < MT) PEER_VISSUE(sA, aA, p0, p1);
  if (t + nwx < MT) { const int t1 = t + nwx; p0 = PACK[(size_t)t1 * 128 + lane]; p1 = PACK[(size_t)t1 * 128 + 64 + lane]; on = PEER_OLD(t1); }
  for (; t < MT; t += 2 * nwx) {
    const int t1 = t + nwx, t2 = t + 2 * nwx, t3 = t + 3 * nwx;
    if (t1 < MT) PEER_VISSUE(sB, aB, p0, p1);
    f32x2_t o2 = {0.f, 0.f};
    if (t2 < MT) { p0 = PACK[(size_t)t2 * 128 + lane]; p1 = PACK[(size_t)t2 * 128 + 64 + lane]; o2 = PEER_OLD(t2); }
    PEER_VFINISH(sA, aA, t, oc);
    if (t1 >= MT) break;
    if (t2 < MT) PEER_VISSUE(sA, aA, p0, p1);
    f32x2_t o3 = {0.f, 0.f};
    if (t3 < MT) { p0 = PACK[(size_t)t3 * 128 + lane]; p1 = PACK[(size_t)t3 * 128 + 64 + lane]; o3 = PEER_OLD(t3); }
    PEER_VFINISH(sB, aB, t1, on);
    oc = o2; on = o3;
  }
#undef PEER_OLD
}
__device__ __forceinline__ void quant_token(const bf16* XMB, const float* ssq, unsigned char* XQ, float* HS, int t, int lane) {
  const u32x4 a = *reinterpret_cast<const u32x4*>(XMB + (size_t)t * 1024 + lane * 16), b = *reinterpret_cast<const u32x4*>(XMB + (size_t)t * 1024 + lane * 16 + 8);
  float fa[8], fb[8], v[16]; unpack8(a, fa); unpack8(b, fb);
#pragma unroll
  for (int i = 0; i < 8; ++i) { v[i] = fa[i]; v[8 + i] = fb[i]; }
  const float sx = quant_row16(v, XQ + (size_t)t * 1024, lane, 0);
  float s = 0.f;
#pragma unroll
  for (int i = 0; i < 16; ++i) s += ssq[(size_t)t * 16 + i];
  if (lane == 0) HS[t] = sx / sqrtf(s * (1.0f / 1024.0f) + 1e-6f);
}
}
constexpr int NWAVES = 8;
constexpr int BATCH = 16, SEQ = 2048, D = 1024, M = BATCH * SEQ, NPROJ = 3072, NQP = 2048, NEXP = 16384;
constexpr float RMS_EPS = 1e-6f;
constexpr float C2 = 0.125f * 1.4426950408889634f;
constexpr float LOG2E = 1.4426950408889634f;
constexpr size_t MiB = 1u << 20;
constexpr size_t WS_CTL = 0, CTL_ZERO_BYTES = 1 * MiB;
constexpr size_t WS_WIN = 1 * MiB;
constexpr size_t WS_WOUT = 7 * MiB;
constexpr size_t WS_WQ = 9 * MiB;
constexpr size_t WS_SK = 13 * MiB;
constexpr size_t WS_KPART = 13 * MiB + 512 * 1024;
constexpr size_t WS_SSQ = 14 * MiB;
constexpr size_t WS_MISC = 16 * MiB;
constexpr size_t WS_SU = WS_MISC + 65536, WS_SV = WS_MISC + 131072, WS_HS = WS_MISC + 262144;
constexpr size_t WS_U8 = 17 * MiB;
constexpr size_t WS_V8 = 33 * MiB;
constexpr size_t WS_XQ = 49 * MiB;
constexpr size_t WS_XN = 81 * MiB;
constexpr size_t WS_MIX = 145 * MiB;
constexpr size_t WS_DO = 209 * MiB;
constexpr size_t WS_PROJ = 273 * MiB;
constexpr size_t WS_QP = WS_PROJ;
constexpr size_t WS_LE = WS_PROJ + 128 * MiB;
constexpr size_t WS_LG = WS_PROJ + 144 * MiB;
constexpr size_t WS_PACK = WS_PROJ + 160 * MiB;
constexpr size_t WS_RSTD = WS_PROJ + 176 * MiB;
constexpr size_t WS_END = 465 * MiB;
constexpr int CW_BAR = 4096;
constexpr int RING_OFF = 0, RING_BYTES = 131072;
constexpr int LDSCTL_OFF = RING_BYTES, MISC_OFF = LDSCTL_OFF + 320;
constexpr int LDS_BYTES = 147456;
static_assert(att::LDS_BYTES <= RING_BYTES, "attention scratch fits the ring region");

#define GAS __attribute__((address_space(1)))
#define LAS __attribute__((address_space(3)))
typedef unsigned short bf16;
typedef unsigned v4u __attribute__((ext_vector_type(4)));
typedef unsigned v2u __attribute__((ext_vector_type(2)));
typedef float f32x4 __attribute__((ext_vector_type(4)));
typedef GAS unsigned gu32;
#define RLX_AGENT __ATOMIC_RELAXED, __HIP_MEMORY_SCOPE_AGENT
#define LDS_WAIT() asm volatile("s_waitcnt lgkmcnt(0)" ::: "memory")
#define VM_WAIT() asm volatile("s_waitcnt vmcnt(0)" ::: "memory")
__device__ __forceinline__ unsigned f2bf(float f) { unsigned u = __builtin_bit_cast(unsigned, f); return (u + 0x7fffu + ((u >> 16) & 1u)) >> 16; }
__device__ __forceinline__ unsigned pk2(float lo, float hi) { return f2bf(lo) | (f2bf(hi) << 16); }
#define XB_TMO      128
#define XB_XCNT(j)  (256  + 64 * (j))
#define XB_XSUB(j)  (1280 + 64 * (j))
#define XB_XGEN(j)  (2304 + 64 * (j))
#define XB_TOP      3328
#define XB_TOPGEN   3392
#define XCD_BAR_WORDS 3456
#define XB_SPIN_CAP (1u << 23)

__device__ __forceinline__ unsigned xb_ld(unsigned* p)              { return __hip_atomic_load(p, __ATOMIC_RELAXED, __HIP_MEMORY_SCOPE_AGENT); }
__device__ __forceinline__ unsigned xb_add(unsigned* p, unsigned v) { return __hip_atomic_fetch_add(p, v, __ATOMIC_RELAXED, __HIP_MEMORY_SCOPE_AGENT); }
__device__ __forceinline__ unsigned xb_xcc_id() { return (unsigned)__builtin_amdgcn_s_getreg((3 << 11) | 20) & 0xFu; }
#define XB_SPIN(cond, bar) do { unsigned _sp = 0; while (cond) { __builtin_amdgcn_s_sleep(1); \
    if ((++_sp & 255u) == 0u) { if (xb_ld(&(bar)[XB_TMO])) break; if (_sp > XB_SPIN_CAP) { atomicAdd(&(bar)[XB_TMO], 1u); break; } } } } while (0)

struct XcdBarrier {
    unsigned* bar; unsigned x;
    volatile LAS unsigned* st;
};

__device__ __forceinline__ XcdBarrier xcd_barrier_post(unsigned* bar, volatile LAS unsigned* st) {
    XcdBarrier b; b.bar = bar; b.x = xb_xcc_id(); b.st = st;
    if (threadIdx.x == 0) (void)xb_add(&bar[XB_XCNT(b.x)], 1u);
    return b;
}
__device__ __forceinline__ void xcd_barrier_complete(unsigned* bar, unsigned x, unsigned& nloc, unsigned& nx) {
    const unsigned G = gridDim.x * gridDim.y * gridDim.z;
    unsigned sum, cnt, mine, sp = 0u;
    for (;;) {
        sum = 0u; cnt = 0u; mine = 0u;
#pragma unroll
        for (unsigned j = 0; j < 16; ++j) { const unsigned c = xb_ld(&bar[XB_XCNT(j)]); sum += c; cnt += (c > 0u) ? 1u : 0u; mine = (j == x) ? c : mine; }
        if (sum == G) break;
        __builtin_amdgcn_s_sleep(1);
        if ((++sp & 255u) == 0u) { if (xb_ld(&bar[XB_TMO])) break; if (sp > XB_SPIN_CAP) { atomicAdd(&bar[XB_TMO], 1u); break; } }
    }
    nloc = mine > 0u ? mine : 1u; nx = cnt > 0u ? cnt : 1u;
}

__device__ __forceinline__ void xcd_barrier(const XcdBarrier& b) {
    asm volatile("s_waitcnt vmcnt(0)" ::: "memory");
    __syncthreads();
    if (threadIdx.x == 0) {
        unsigned* bar = b.bar;
        __builtin_amdgcn_s_waitcnt(0);
        unsigned nloc = b.st[0], nx = b.st[1];
        if (nloc == 0u) { xcd_barrier_complete(bar, b.x, nloc, nx); b.st[0] = nloc; b.st[1] = nx; }
        const unsigned old = xb_add(&bar[XB_XSUB(b.x)], 1u);
        const unsigned gen = old / nloc;
        if (old + 1u == (gen + 1u) * nloc) {
            __builtin_amdgcn_fence(__ATOMIC_RELEASE, "agent");
            asm volatile("s_waitcnt vmcnt(0)" ::: "memory");
            const unsigned og = xb_add(&bar[XB_TOP], 1u);
            const unsigned tg = og / nx;
            if (og + 1u == (tg + 1u) * nx) xb_add(&bar[XB_TOPGEN], 1u);
            else XB_SPIN(xb_ld(&bar[XB_TOPGEN]) == tg, bar);
            __builtin_amdgcn_fence(__ATOMIC_ACQUIRE, "agent");
            xb_add(&bar[XB_XGEN(b.x)], 1u);
            asm volatile("s_waitcnt vmcnt(0)" ::: "memory");
        } else {
            XB_SPIN(xb_ld(&bar[XB_XGEN(b.x)]) == gen, bar);
            __builtin_amdgcn_fence(__ATOMIC_ACQUIRE, "agent");
            asm volatile("s_waitcnt vmcnt(0)" ::: "memory");
        }
    }
    __syncthreads();
}
struct Frame {
    LAS unsigned char* lds;
    volatile LAS unsigned* MISC;
    gu32* ctl;
    int tid, lane, wave;
    int vcu, G;
};
__device__ __forceinline__ float wave_sum(float v) {
#pragma unroll
    for (int o = 1; o < 64; o <<= 1) v += __shfl_xor(v, o);
    return v;
}
template <bool PERMROWS>
__device__ __forceinline__ void p0_transpose_item(const float* W, int K, int N, bf16* WT, const float* kscale, LAS float* scr, int item, int lane) {
    const int nblk = N / 32, kb = item / nblk, nb = item % nblk, k0 = 64 * kb, n0 = 32 * nb;
#pragma unroll 8
    for (int i = 0; i < 32; ++i) { const int kk = 2 * i + (lane >> 5); float w = W[(size_t)(k0 + kk) * N + n0 + (lane & 31)]; if (kscale) w *= kscale[k0 + kk]; scr[kk * 33 + (lane & 31)] = w; }
    LDS_WAIT(); asm volatile("" ::: "memory");
    int r0 = n0;
    if (PERMROWS) { const int tl = n0 >> 8, np = n0 & 255; r0 = tl * 256 + ((np >> 5) & 1) * 128 + (np >> 6) * 32; }
    const int c = lane & 7;
#pragma unroll
    for (int j = 0; j < 4; ++j) { const int n = (lane >> 3) + 8 * j; const LAS float* s = scr + (8 * c) * 33 + n;
        v4u o; o.x = pk2(s[0 * 33], s[1 * 33]); o.y = pk2(s[2 * 33], s[3 * 33]); o.z = pk2(s[4 * 33], s[5 * 33]); o.w = pk2(s[6 * 33], s[7 * 33]);
        *(GAS v4u*)(WT + (size_t)(r0 + n) * K + k0 + 8 * c) = o; }
    LDS_WAIT(); asm volatile("" ::: "memory");
}
__device__ __forceinline__ void cvt8(const float* src, bf16* dst, size_t e, const float* cscale) {
    f32x4 a = *(const GAS f32x4*)(src + e), b = *(const GAS f32x4*)(src + e + 4);
    if (cscale) { const int c = (int)(e & 1023); const f32x4 ga = *(const f32x4*)(cscale + c), gb = *(const f32x4*)(cscale + c + 4); a = a * ga; b = b * gb; }
    v4u o; o.x = pk2(a[0], a[1]); o.y = pk2(a[2], a[3]); o.z = pk2(b[0], b[1]); o.w = pk2(b[2], b[3]);
    *(GAS v4u*)(dst + e) = o;
}
__device__ __forceinline__ void rms_row_to_bf16(const float* xrow, const float* g, bf16* orow, int lane) {
    const GAS f32x4* xr = (const GAS f32x4*)xrow + lane;
    f32x4 v[4]; float s = 0.f;
#pragma unroll
    for (int j = 0; j < 4; ++j) { v[j] = xr[64 * j]; s += (v[j].x * v[j].x + v[j].y * v[j].y) + (v[j].z * v[j].z + v[j].w * v[j].w); }
    const float rstd = 1.f / sqrtf(wave_sum(s) * (1.f / 1024.f) + RMS_EPS);
    GAS unsigned long long* o8 = (GAS unsigned long long*)orow + lane;
#pragma unroll
    for (int j = 0; j < 4; ++j) { const f32x4 gg = *((const f32x4*)g + lane + 64 * j);
        o8[64 * j] = (unsigned long long)pk2(v[j].x * rstd * gg.x, v[j].y * rstd * gg.y) | ((unsigned long long)pk2(v[j].z * rstd * gg.z, v[j].w * rstd * gg.w) << 32); }
}

struct Args { const float* in[13]; float* out; unsigned char* ws; int ph_lo, ph_hi; };
__global__ void __launch_bounds__(NWAVES * 64, 2) mega_fwd(Args args) {
    extern __shared__ __attribute__((aligned(16))) unsigned char lds[];
    Frame F;
    F.lds = (LAS unsigned char*)lds;
    F.MISC = (volatile LAS unsigned*)(F.lds + MISC_OFF);
    F.tid = threadIdx.x; F.lane = F.tid & 63; F.wave = __builtin_amdgcn_readfirstlane(F.tid >> 6);
    F.G = gridDim.x; { const int bx = blockIdx.x; F.vcu = (F.G % 8 == 0) ? (bx % 8) * (F.G / 8) + bx / 8 : bx; }
    unsigned char* ws = args.ws;
    F.ctl = (gu32*)(ws + WS_CTL);
    const float* x = args.in[0]; const float* norm1_g = args.in[1]; const float* w_in = args.in[2]; const float* moba_g = args.in[3]; const float* diff_g = args.in[4];
    const float* diff_lambda = args.in[5]; const float* subln_g = args.in[6]; const float* w_out = args.in[7]; const float* norm2_g = args.in[8]; const float* w_query = args.in[9];
    const float* sub_keys = args.in[10]; const float* peer_u = args.in[11]; const float* peer_v = args.in[12];
    float* out = args.out;
    bf16* WIN = (bf16*)(ws + WS_WIN); bf16* WOUT = (bf16*)(ws + WS_WOUT); bf16* WQ = (bf16*)(ws + WS_WQ); bf16* SK = (bf16*)(ws + WS_SK);
    float* KPART = (float*)(ws + WS_KPART); float* SSQ = (float*)(ws + WS_SSQ); float* MISCG = (float*)(ws + WS_MISC);
    unsigned char* U8 = ws + WS_U8; unsigned char* V8 = ws + WS_V8; float* SU = (float*)(ws + WS_SU); float* SV = (float*)(ws + WS_SV); unsigned char* XQ = ws + WS_XQ; float* HS = (float*)(ws + WS_HS); bf16* XN = (bf16*)(ws + WS_XN); bf16* MIX = (bf16*)(ws + WS_MIX); bf16* DOB = (bf16*)(ws + WS_DO);
    bf16* PROJ = (bf16*)(ws + WS_PROJ); bf16* QP = (bf16*)(ws + WS_QP); int* LE = (int*)(ws + WS_LE); float* LG = (float*)(ws + WS_LG); unsigned* PACK = (unsigned*)(ws + WS_PACK); float* RSTD = (float*)(ws + WS_RSTD);
    for (int u = F.tid; u < (LDS_BYTES - LDSCTL_OFF) / 4; u += NWAVES * 64) ((LAS unsigned*)(F.lds + LDSCTL_OFF))[u] = 0u;
    __syncthreads();
    XcdBarrier bar = xcd_barrier_post((unsigned*)(F.ctl + CW_BAR), F.MISC + 8);
    const int gw = F.vcu * NWAVES + F.wave, NGW = F.G * NWAVES;
    const int lo = args.ph_lo, hi = args.ph_hi;
#define IN(k) (lo <= (k) && (k) < hi)
#ifndef PROBE_DUP
#define PROBE_DUP -1
#endif
#define REP(k) for (int rep_ = 0; rep_ < ((PROBE_DUP == (k)) ? 2 : 1); ++rep_)
#define GRID_BAR() xcd_barrier(bar)

    if (IN(0)) {
        LAS float* scr = (LAS float*)(F.lds + RING_OFF + F.wave * 16384);
        constexpr int I_IN = (D / 64) * (NPROJ / 32), I_OUT = (D / 64) * (D / 32), I_Q = (D / 64) * (NQP / 32);
        for (int it = gw; it < I_IN + I_OUT + I_Q; it += NGW) {
            int r = it;
            if (r < I_IN) { p0_transpose_item<true>(w_in, D, NPROJ, WIN, nullptr, scr, r, F.lane); continue; } r -= I_IN;
            if (r < I_OUT) { p0_transpose_item<false>(w_out, D, D, WOUT, nullptr, scr, r, F.lane); continue; } r -= I_OUT;
            p0_transpose_item<false>(w_query, D, NQP, WQ, norm2_g, scr, r, F.lane);
        }
        constexpr size_t C_SK = (size_t)16 * 128 * 128 / 8;
        for (size_t c = (size_t)gw * 64 + F.lane; c < C_SK; c += (size_t)NGW * 64) cvt8(sub_keys, SK, c * 8, nullptr);
        for (int r = gw; r < 2 * NEXP; r += NGW) {
            const bool isu = r < NEXP; const int e = isu ? r : r - NEXP; const float* srow = (isu ? peer_u : peer_v) + (size_t)e * 1024 + F.lane * 16;
            float v[16];
#pragma unroll
            for (int q = 0; q < 4; ++q) { f32x4 a = *(const GAS f32x4*)(srow + 4 * q); if (isu) a = a * *(const f32x4*)(norm2_g + F.lane * 16 + 4 * q); v[4 * q] = a[0]; v[4 * q + 1] = a[1]; v[4 * q + 2] = a[2]; v[4 * q + 3] = a[3]; }
            const float sc = peer::quant_row16(v, (isu ? U8 : V8) + (size_t)e * 1024, F.lane, isu ? 0 : 128);
            if (F.lane == 0) (isu ? SU : SV)[e] = sc;
        }
        for (int m = gw; m < M; m += NGW) rms_row_to_bf16(x + (size_t)m * D, norm1_g, XN + (size_t)m * D, F.lane);
        if (gw == 0) { const float a = wave_sum(diff_lambda[F.lane] * diff_lambda[64 + F.lane]), b = wave_sum(diff_lambda[128 + F.lane] * diff_lambda[192 + F.lane]);
            if (F.lane == 0) MISCG[0] = expf(a) - expf(b) + 0.2f; }
        GRID_BAR();
    }
    if (IN(1)) {
        pg8::Gemm g{XN, WIN, M, NPROJ, D}; pg8::StaticOrder S; S.init(M, NPROJ, F.G, (int)blockIdx.x);
        pg8::EpiProj E{PROJ, moba_g, moba_g + 64, diff_g, diff_g + 64, KPART, C2};
        pg8::gemm_phase<pg8::EpiProj, pg8::StaticOrder, true, true>(F.lds + RING_OFF, g, S, E);
        GRID_BAR();
    }
    if (IN(2)) {
        REP(2) for (int p = F.vcu; p < 1536; p += F.G) {
            const int bvh = p >> 2, s = p & 3, b = bvh / 24, vh = bvh % 24;
            att::UnitDesc U; const bf16* pb = PROJ + (size_t)b * SEQ * NPROJ;
            if (vh < 8) { U.Q = (const att::bf16*)(pb + vh * 64); U.K = (const att::bf16*)(pb + 512 + vh * 64); U.V = (const att::bf16*)(pb + 1024 + vh * 64);
                U.O = (att::bf16*)(MIX + (size_t)b * SEQ * 1024 + vh * 64); U.slope2 = LOG2E * exp2f(-(float)(vh + 1)); U.moba = 1; U.kpart = KPART + (size_t)(b * 8) * 1024 + vh * 64; }
            else { const int dvh = vh - 8, dh = dvh >> 2, j = (dvh >> 1) & 1, c = dvh & 1;
                U.Q = (const att::bf16*)(pb + 1536 + dh * 128 + j * 64); U.K = (const att::bf16*)(pb + 2048 + dh * 128 + j * 64); U.V = (const att::bf16*)(pb + 2560 + dh * 128 + c * 64);
                U.O = (att::bf16*)(DOB + (size_t)b * SEQ * 1024 + (dh * 2 + j) * 128 + c * 64); U.slope2 = LOG2E * exp2f(-2.0f * (float)(dh + 1)); U.moba = 0; U.kpart = KPART; }
            U.nb = 7 - s; att::attn_unit(U, (char*)lds + RING_OFF);
            U.nb = s; att::attn_unit(U, (char*)lds + RING_OFF);
        }
        GRID_BAR();
    }
    if (IN(3)) {
        const float lam = MISCG[0];
        const int hh = F.lane >> 4, cc = (F.lane & 15) * 8;
        float gs[8];
#pragma unroll
        for (int i = 0; i < 8; ++i) gs[i] = subln_g[cc + i] * 0.8f;
        for (int t = gw; t < M; t += NGW) {
            const v4u a = *(const GAS v4u*)(DOB + (size_t)t * 1024 + hh * 256 + cc), b = *(const GAS v4u*)(DOB + (size_t)t * 1024 + hh * 256 + 128 + cc);
            float d[8]; float ss = 0.f;
#pragma unroll
            for (int i = 0; i < 4; ++i) { d[2 * i] = __uint_as_float(a[i] << 16) - lam * __uint_as_float(b[i] << 16); d[2 * i + 1] = __uint_as_float(a[i] & 0xffff0000u) - lam * __uint_as_float(b[i] & 0xffff0000u);
                ss += d[2 * i] * d[2 * i] + d[2 * i + 1] * d[2 * i + 1]; }
#pragma unroll
            for (int o = 1; o < 16; o <<= 1) ss += __shfl_xor(ss, o);
            const float r = 1.0f / sqrtf(ss * (1.0f / 128.0f) + RMS_EPS);
            v4u w; w.x = pk2(d[0] * r * gs[0], d[1] * r * gs[1]); w.y = pk2(d[2] * r * gs[2], d[3] * r * gs[3]); w.z = pk2(d[4] * r * gs[4], d[5] * r * gs[5]); w.w = pk2(d[6] * r * gs[6], d[7] * r * gs[7]);
            *(GAS v4u*)(MIX + (size_t)t * 1024 + 512 + hh * 128 + cc) = w;
        }
        GRID_BAR();
    }
    if (IN(4)) {
        pg8::Gemm g{MIX, WOUT, M, D, D}; pg8::StaticOrder S; S.init(M, D, F.G, (int)blockIdx.x);
        pg8::EpiOut E{x, out, XN, SSQ};
        pg8::gemm_phase<pg8::EpiOut, pg8::StaticOrder, true, true>(F.lds + RING_OFF, g, S, E);
        GRID_BAR();
    }
    if (IN(5)) {
        pg8::Gemm g{XN, WQ, M, NQP, D}; pg8::StaticOrder S; S.init(M, NQP, F.G, (int)blockIdx.x);
        pg8::EpiBf16 E{QP, NQP};
        pg8::gemm_phase<pg8::EpiBf16, pg8::StaticOrder, true, true>(F.lds + RING_OFF, g, S, E);
        GRID_BAR();
    }
    if (IN(6)) {
        REP(6) for (int task = gw; task < (M / 32) * 8; task += NGW) peer::topk_task((const peer::bf16*)QP, (const peer::bf16*)SK, SSQ, RSTD, LE, LG, task >> 3, task & 7, F.lane);
        for (int t = gw; t < M; t += NGW) peer::quant_token((const peer::bf16*)XN, SSQ, XQ, HS, t, F.lane);
        GRID_BAR();
    }
    if (IN(7)) {
        const int xl = (int)blockIdx.x & 7, nwx = (F.G >> 3) * NWAVES, wx = ((int)blockIdx.x >> 3) * NWAVES + F.wave;
        REP(70) peer::expert_u_pass(XQ, U8, HS, SU, SV, LE, LG, PACK, xl, wx, nwx, F.lane, (char*)lds + RING_OFF + F.wave * 8192);
        GRID_BAR();
        if (PROBE_DUP == 71) peer::expert_v_pass(V8, PACK, (float*)QP, xl, wx, nwx, F.lane);
        peer::expert_v_pass(V8, PACK, out, xl, wx, nwx, F.lane);
    }
#undef IN
#undef GRID_BAR
}

extern "C" void kernel_launch(void* const* d_in, const int* in_sizes, int n_in, void* d_out, int out_size, void* d_ws, size_t ws_size, hipStream_t stream) {
    static int grid = 0;
    if (grid == 0) {
        if (n_in != 13 || in_sizes[0] != M * D || out_size != M * D || ws_size < WS_END) { fprintf(stderr, "kernel_launch: unexpected shapes (n_in %d, in0 %d, out %d, ws %zu); nothing launched\n", n_in, n_in > 0 ? in_sizes[0] : -1, out_size, ws_size); grid = -1; return; }
        int dev = 0, cus = 0, per_cu = 0;
        if (hipGetDevice(&dev) != hipSuccess || hipDeviceGetAttribute(&cus, hipDeviceAttributeMultiprocessorCount, dev) != hipSuccess) { grid = -1; return; }
        if (hipFuncSetAttribute((const void*)mega_fwd, hipFuncAttributeMaxDynamicSharedMemorySize, LDS_BYTES) != hipSuccess) { fprintf(stderr, "kernel_launch: hipFuncSetAttribute failed\n"); grid = -1; return; }
        if (hipOccupancyMaxActiveBlocksPerMultiprocessor(&per_cu, (const void*)mega_fwd, NWAVES * 64, LDS_BYTES) != hipSuccess || per_cu < 1) { fprintf(stderr, "kernel_launch: occupancy query reports %d workgroups per CU\n", per_cu); }
        (void)hipGetLastError();
        grid = cus;
    }
    if (grid < 0) return;
    if (hipMemsetAsync((char*)d_ws + WS_CTL, 0, CTL_ZERO_BYTES, stream) != hipSuccess) return;
    Args a{};
    for (int i = 0; i < 13; ++i) a.in[i] = (const float*)d_in[i];
    a.out = (float*)d_out; a.ws = (unsigned char*)d_ws; a.ph_lo = 0; a.ph_hi = 8;
    hipLaunchKernelGGL(mega_fwd, dim3(grid), dim3(NWAVES * 64), LDS_BYTES, stream, a);
}
```

```cpp
#include <hip/hip_runtime.h>
#include <hip/hip_bf16.h>
#include <cstdio>
#include <cstdint>
#include <cmath>
namespace pg8 {
#define PG8_LAS __attribute__((address_space(3)))
typedef unsigned short bf16_t;
typedef short bf16x8 __attribute__((ext_vector_type(8)));
typedef float f32x4 __attribute__((ext_vector_type(4)));
typedef unsigned u32x4 __attribute__((ext_vector_type(4)));
constexpr int BM = 256, BK = 64, HALF = 128, HTB = HALF * BK * 2  , STAGE_BYTES = 8 * HTB, NXCD = 8, WGM = 8;

__host__ __device__ __forceinline__ int lds_byte(int r, int c) { const int st = (r >> 4) * 2 + (c >> 5), rr = r & 15, cc = c & 31, ob = rr * 64 + cc * 2; return st * 1024 + (ob ^ (((ob >> 9) & 1) << 5)); }
__host__ __device__ __forceinline__ void stage_rc(int b, int& R, int& C) { const int st = b / 1024, sb = b % 1024, swz = sb ^ (((sb >> 9) & 1) << 5); R = (st >> 1) * 16 + swz / 64; C = (st & 1) * 32 + (swz % 64) / 2; }
__host__ __device__ __forceinline__ int perm32(int rho) { const int n = rho >> 4, i = rho & 15; return 8 * (i >> 2) + 4 * n + (i & 3); }

struct Unit { int pm, pn; };
struct Gemm { const bf16_t* A; const bf16_t* Bt; int M, N, K; };

struct StaticOrder {
    int nM, nN, nwg, G, c;
    __host__ __device__ void init(int M, int N, int G_, int c_) { nM = M / BM; nN = N / BM; nwg = nM * nN; G = G_; c = c_; }
    __host__ __device__ bool next(int i, Unit& u) const {
        const long L = (long)i * G + c; if (L >= nwg) return false;
        int wgid = (int)L; { const int q = nwg / NXCD, r = nwg % NXCD, xcd = wgid % NXCD, off = wgid / NXCD; wgid = (xcd < r ? xcd * (q + 1) : r * (q + 1) + (xcd - r) * q) + off; }
        const int nig = WGM * nN, gid = wgid / nig, fm = gid * WGM, gsz = (nM - fm) < WGM ? (nM - fm) : WGM;
        u.pm = fm + ((wgid % nig) % gsz); u.pn = (wgid % nig) / gsz; return true;
    }
    __device__ __forceinline__ void a_ready(const Unit&) const {}
    __device__ __forceinline__ void done(const Unit&) const {}
};

__device__ __forceinline__ unsigned cvt_pk_bf16(float lo, float hi) { unsigned r; asm volatile("v_cvt_pk_bf16_f32 %0, %1, %2" : "=v"(r) : "v"(lo), "v"(hi)); return r; }
typedef unsigned u32x2 __attribute__((ext_vector_type(2)));

struct EpiBf16 {
    static constexpr bool PERM = true, AFTER_DRAIN = false;
    bf16_t* O; int ldc;
    __device__ __forceinline__ void operator()(const f32x4 (&acc)[2][2][4][2], const Unit& u, int wr, int wc, int fr, int fq) const {
        const int row0 = u.pm * BM + wr * 64 + fr; const int col0 = u.pn * BM + wc * 32 + 8 * fq;
#pragma unroll
        for (int ai = 0; ai < 2; ++ai)
#pragma unroll
            for (int m = 0; m < 4; ++m) { bf16_t* rowp = O + (size_t)(row0 + ai * HALF + m * 16) * ldc + col0;
#pragma unroll
                for (int bj = 0; bj < 2; ++bj) { const f32x4 v0 = acc[ai][bj][m][0], v1 = acc[ai][bj][m][1];
                    u32x4 w; w.x = cvt_pk_bf16(v0[0], v0[1]); w.y = cvt_pk_bf16(v0[2], v0[3]); w.z = cvt_pk_bf16(v1[0], v1[1]); w.w = cvt_pk_bf16(v1[2], v1[3]);
                    *(u32x4*)(rowp + bj * HALF) = w; } }
    }
};

struct EpiProj {
    static constexpr bool PERM = true, AFTER_DRAIN = false;
    bf16_t* P; const float *gmq, *gmk, *gdq, *gdk; float* kpart; float c2;
    __device__ __forceinline__ void operator()(const f32x4 (&acc)[2][2][4][2], const Unit& u, int wr, int wc, int fr, int fq) const {
        const int type = u.pn >> 1;
        const float* g = type == 0 ? gmq : type == 1 ? gmk : type == 3 ? gdq : type == 4 ? gdk : nullptr;
        const float sc0 = (type == 0 || type == 3) ? c2 : 1.f;
        f32x4 gv[2][2];
#pragma unroll
        for (int bj = 0; bj < 2; ++bj)
#pragma unroll
            for (int n = 0; n < 2; ++n) gv[bj][n] = g ? (*(const f32x4*)(g + 32 * bj + 8 * fq + 4 * n)) * sc0 : (f32x4){1.f, 1.f, 1.f, 1.f};
        f32x4 cs[2][2];
#pragma unroll
        for (int bj = 0; bj < 2; ++bj)
#pragma unroll
            for (int n = 0; n < 2; ++n) cs[bj][n] = (f32x4){0.f, 0.f, 0.f, 0.f};
        const int row0 = u.pm * BM + wr * 64 + fr; const int col0 = u.pn * BM + wc * 64 + 8 * fq;
#pragma unroll
        for (int ai = 0; ai < 2; ++ai)
#pragma unroll
            for (int m = 0; m < 4; ++m) {
                f32x4 v[2][2];
#pragma unroll
                for (int bj = 0; bj < 2; ++bj)
#pragma unroll
                    for (int n = 0; n < 2; ++n) v[bj][n] = acc[ai][bj][m][n];
                if (g) {
                    float ss = 0.f;
#pragma unroll
                    for (int bj = 0; bj < 2; ++bj)
#pragma unroll
                        for (int n = 0; n < 2; ++n) { const f32x4 x = v[bj][n]; ss += (x[0] * x[0] + x[1] * x[1]) + (x[2] * x[2] + x[3] * x[3]); }
                    ss += __shfl_xor(ss, 16); ss += __shfl_xor(ss, 32);
                    const float r = 1.0f / sqrtf(ss * (1.0f / 64.0f) + 1e-6f);
#pragma unroll
                    for (int bj = 0; bj < 2; ++bj)
#pragma unroll
                        for (int n = 0; n < 2; ++n) { v[bj][n] = v[bj][n] * r * gv[bj][n]; cs[bj][n] += v[bj][n]; }
                }
                bf16_t* rowp = P + (size_t)(row0 + ai * HALF + m * 16) * 3072 + col0;
#pragma unroll
                for (int bj = 0; bj < 2; ++bj) { const f32x4 v0 = v[bj][0], v1 = v[bj][1];
                    u32x4 w; w.x = cvt_pk_bf16(v0[0], v0[1]); w.y = cvt_pk_bf16(v0[2], v0[3]); w.z = cvt_pk_bf16(v1[0], v1[1]); w.w = cvt_pk_bf16(v1[2], v1[3]);
                    *(u32x4*)(rowp + bj * 32) = w; }
            }
        if (type == 1) {
#pragma unroll
            for (int bj = 0; bj < 2; ++bj)
#pragma unroll
                for (int n = 0; n < 2; ++n) { f32x4 c = cs[bj][n];
#pragma unroll
                    for (int o = 1; o < 16; o <<= 1) { c[0] += __shfl_xor(c[0], o); c[1] += __shfl_xor(c[1], o); c[2] += __shfl_xor(c[2], o); c[3] += __shfl_xor(c[3], o); }
                    if (fr == 0) *(f32x4*)(kpart + (size_t)(u.pm * 2 + wr) * 512 + (u.pn - 2) * 256 + wc * 64 + bj * 32 + fq * 8 + n * 4) = c; }
        }
    }
};

struct EpiOut {
    static constexpr bool PERM = false, AFTER_DRAIN = false;
    const float* x; float* out; bf16_t* xmb; float* ssq;
    __device__ __forceinline__ void operator()(const f32x4 (&acc)[2][2][4][2], const Unit& u, int wr, int wc, int fr, int fq) const {
        const int row0 = u.pm * BM + wr * 64 + fr; const int col0 = u.pn * BM + wc * 32 + 4 * fq;
#pragma unroll
        for (int ai = 0; ai < 2; ++ai)
#pragma unroll
            for (int m = 0; m < 4; ++m) { const int row = row0 + ai * HALF + m * 16; const size_t off = (size_t)row * 1024 + col0; float s = 0.f;
#pragma unroll
                for (int bj = 0; bj < 2; ++bj)
#pragma unroll
                    for (int n = 0; n < 2; ++n) { const f32x4 xv = *(const f32x4*)(x + off + bj * HALF + n * 16); const f32x4 y = xv + acc[ai][bj][m][n];
                        *(f32x4*)(out + off + bj * HALF + n * 16) = y; u32x2 w; w.x = cvt_pk_bf16(y[0], y[1]); w.y = cvt_pk_bf16(y[2], y[3]); *(u32x2*)(xmb + off + bj * HALF + n * 16) = w;
                        s += (y[0] * y[0] + y[1] * y[1]) + (y[2] * y[2] + y[3] * y[3]); }
                s += __shfl_xor(s, 16); s += __shfl_xor(s, 32);
                if (fq == 0) ssq[(size_t)row * 16 + u.pn * 4 + wc] = s;
                if (m & 1) asm volatile("" ::: "memory"); }
    }
};
template <class Epi, class Sched, bool ALIGN_EPI = false, bool SP2 = false>
__device__ __forceinline__ void gemm_phase(PG8_LAS unsigned char* lds, const Gemm g, const Sched& S, const Epi& E) {
    const int tid = threadIdx.x, wid = __builtin_amdgcn_readfirstlane(tid >> 6), lane = tid & 63, wr = wid >> 2, wc = wid & 3, fr = lane & 15, fq = lane >> 4;
    const int K = g.K, nt = K / BK;
    unsigned voffA[2], voffB[2];
#pragma unroll
    for (int i = 0; i < 2; ++i) { int R, C; stage_rc(tid * 16 + i * 8192, R, C); const int Rb = Epi::PERM ? ((R & ~31) + perm32(R & 31)) : R;
        voffA[i] = (unsigned)(R * K + C) * 2u; voffB[i] = (unsigned)(Rb * K + C) * 2u; }
    const size_t kstep = (size_t)(BK * 2);
    const size_t hstep = (size_t)HALF * K * 2;
    const size_t tstep = 2 * hstep;
    const unsigned ldsw = (unsigned)wid * 1024u;
    const int aoff = lds_byte(wr * 64 + fr, fq * 8), boff = lds_byte(wc * 32 + fr, fq * 8);
#define PG8_SA(b, h) (((b) * 2 + (h)) * HTB)
#define PG8_SB(b, h) ((4 + (b) * 2 + (h)) * HTB)
#define PG8_STAGE(bufoff, gbase, voff) do { _Pragma("unroll") for (int _i = 0; _i < 2; ++_i) \
        __builtin_amdgcn_global_load_lds((const unsigned*)((const char*)(gbase) + (voff)[_i]), (PG8_LAS unsigned*)(lds + (bufoff) + ldsw + _i * 8192), 16, 0, 0); } while (0)
#define PG8_LDA(dst, b, h) do { _Pragma("unroll") for (int m = 0; m < 4; ++m) _Pragma("unroll") for (int k = 0; k < 2; ++k) dst[m][k] = *(const PG8_LAS bf16x8*)(lds + PG8_SA(b, h) + aoff + m * 2048 + k * 1024); } while (0)
#define PG8_LDB(dst, b, h) do { _Pragma("unroll") for (int n = 0; n < 2; ++n) _Pragma("unroll") for (int k = 0; k < 2; ++k) dst[n][k] = *(const PG8_LAS bf16x8*)(lds + PG8_SB(b, h) + boff + n * 2048 + k * 1024); } while (0)
#define PG8_MMA(ai, bj, At, Bt) do { __builtin_amdgcn_s_setprio(1); _Pragma("unroll") for (int m = 0; m < 4; ++m) _Pragma("unroll") for (int n = 0; n < 2; ++n) _Pragma("unroll") for (int k = 0; k < 2; ++k) \
        acc[ai][bj][m][n] = __builtin_amdgcn_mfma_f32_16x16x32_bf16(Bt[n][k], At[m][k], acc[ai][bj][m][n], 0, 0, 0); __builtin_amdgcn_s_setprio(0); } while (0)
#define PG8_WAIT_V(n) asm volatile("s_waitcnt vmcnt(" #n ")" ::: "memory")
#define PG8_WAIT_L(n) asm volatile("s_waitcnt lgkmcnt(" #n ")" ::: "memory")
#define PG8_BAR __builtin_amdgcn_s_barrier()
#define PG8_SCHED __builtin_amdgcn_sched_barrier(0)
    Unit cur, nxt; int ui = 0;
    if (!S.next(0, cur)) return;
    f32x4 acc[2][2][4][2];
#pragma unroll
    for (int a = 0; a < 2; ++a)
#pragma unroll
        for (int b = 0; b < 2; ++b)
#pragma unroll
            for (int m = 0; m < 4; ++m)
#pragma unroll
                for (int n = 0; n < 2; ++n) acc[a][b][m][n] = (f32x4){0.f, 0.f, 0.f, 0.f};
    bf16x8 At[4][2], B0[2][2], B1[2][2];
    const char* cA = (const char*)g.A + (size_t)cur.pm * tstep; const char* cB = (const char*)g.Bt + (size_t)cur.pn * tstep;
    S.a_ready(cur);
    if constexpr (SP2) {
        PG8_STAGE(PG8_SB(0, 0), cB, voffB); PG8_STAGE(PG8_SB(0, 1), cB + hstep, voffB); PG8_STAGE(PG8_SA(0, 0), cA, voffA); PG8_STAGE(PG8_SA(0, 1), cA + hstep, voffA);
        if (wr == 1) PG8_BAR;
        PG8_WAIT_V(2); PG8_BAR;
        PG8_STAGE(PG8_SB(1, 0), cB + kstep, voffB); PG8_STAGE(PG8_SA(1, 0), cA + kstep, voffA); PG8_STAGE(PG8_SB(1, 1), cB + hstep + kstep, voffB);
        PG8_WAIT_V(6); PG8_BAR;
    } else {
        PG8_STAGE(PG8_SB(0, 0), cB, voffB); PG8_STAGE(PG8_SA(0, 0), cA, voffA); PG8_STAGE(PG8_SB(0, 1), cB + hstep, voffB); PG8_STAGE(PG8_SA(0, 1), cA + hstep, voffA);
        if (wr == 1) PG8_BAR;
        PG8_WAIT_V(4); PG8_BAR;
        PG8_STAGE(PG8_SB(1, 0), cB + kstep, voffB); PG8_STAGE(PG8_SA(1, 0), cA + kstep, voffA); PG8_STAGE(PG8_SB(1, 1), cB + hstep + kstep, voffB);
        PG8_WAIT_V(6); PG8_BAR;
    }
    for (;;) {
        const bool has_next = S.next(ui + 1, nxt);
        const char* nA = has_next ? (const char*)g.A + (size_t)nxt.pm * tstep : cA; const char* nB = has_next ? (const char*)g.Bt + (size_t)nxt.pn * tstep : cB;
        for (int t = 0; t < nt; t += 2) {
            const bool last = (t == nt - 2);
            const char* a1 = cA + (size_t)(t + 1) * kstep;
            const char* a2 = last ? nA : cA + (size_t)(t + 2) * kstep; const char* b2 = last ? nB : cB + (size_t)(t + 2) * kstep;
            const char* a3 = a2 + kstep; const char* b3 = b2 + kstep;
            if (last && has_next) S.a_ready(nxt);
            if constexpr (SP2) {
            PG8_LDB(B0, 0, 0); PG8_LDB(B1, 0, 1); PG8_SCHED; PG8_LDA(At, 0, 0); PG8_STAGE(PG8_SA(1, 1), a1 + hstep, voffA);
            PG8_WAIT_V(8); PG8_WAIT_L(0); PG8_BAR; PG8_MMA(0, 0, At, B0); PG8_MMA(0, 1, At, B1); PG8_BAR; PG8_SCHED;
            PG8_LDA(At, 0, 1); PG8_STAGE(PG8_SB(0, 0), b2, voffB); PG8_STAGE(PG8_SB(0, 1), b2 + hstep, voffB); PG8_STAGE(PG8_SA(0, 0), a2, voffA);
            PG8_WAIT_V(8); PG8_WAIT_L(0); PG8_BAR; PG8_MMA(1, 0, At, B0); PG8_MMA(1, 1, At, B1); PG8_BAR; PG8_SCHED;
            PG8_LDB(B0, 1, 0); PG8_LDB(B1, 1, 1); PG8_SCHED; PG8_LDA(At, 1, 0); PG8_STAGE(PG8_SA(0, 1), a2 + hstep, voffA);
            PG8_WAIT_V(8); PG8_WAIT_L(0); PG8_BAR; PG8_MMA(0, 0, At, B0); PG8_MMA(0, 1, At, B1); PG8_BAR; PG8_SCHED;
            PG8_LDA(At, 1, 1); PG8_STAGE(PG8_SB(1, 0), b3, voffB); PG8_STAGE(PG8_SB(1, 1), b3 + hstep, voffB); PG8_STAGE(PG8_SA(1, 0), a3, voffA);
            PG8_WAIT_V(8); PG8_WAIT_L(0); PG8_BAR; PG8_MMA(1, 0, At, B0); PG8_MMA(1, 1, At, B1); PG8_BAR; PG8_SCHED;
            } else {
            PG8_LDB(B0, 0, 0); PG8_SCHED; PG8_LDA(At, 0, 0); PG8_STAGE(PG8_SA(1, 1), a1 + hstep, voffA);
            PG8_WAIT_L(8); PG8_BAR; PG8_WAIT_L(0); PG8_MMA(0, 0, At, B0); PG8_BAR; PG8_SCHED;
            PG8_LDB(B1, 0, 1); PG8_STAGE(PG8_SB(0, 0), b2, voffB);
            PG8_BAR; PG8_WAIT_L(0); PG8_MMA(0, 1, At, B1); PG8_BAR;
            PG8_LDA(At, 0, 1); PG8_STAGE(PG8_SA(0, 0), a2, voffA);
            PG8_BAR; PG8_WAIT_L(0); PG8_MMA(1, 0, At, B0); PG8_BAR; PG8_SCHED;
            PG8_STAGE(PG8_SB(0, 1), b2 + hstep, voffB);
            PG8_WAIT_V(6); PG8_BAR; PG8_MMA(1, 1, At, B1); PG8_BAR;
            PG8_LDB(B0, 1, 0); PG8_SCHED; PG8_LDA(At, 1, 0); PG8_STAGE(PG8_SA(0, 1), a2 + hstep, voffA);
            PG8_WAIT_L(8); PG8_BAR; PG8_WAIT_L(0); PG8_MMA(0, 0, At, B0); PG8_BAR; PG8_SCHED;
            PG8_LDB(B1, 1, 1); PG8_STAGE(PG8_SB(1, 0), b3, voffB);
            PG8_BAR; PG8_WAIT_L(0); PG8_MMA(0, 1, At, B1); PG8_BAR;
            PG8_LDA(At, 1, 1); PG8_STAGE(PG8_SA(1, 0), a3, voffA);
            PG8_BAR; PG8_WAIT_L(0); PG8_MMA(1, 0, At, B0); PG8_BAR; PG8_SCHED;
            PG8_STAGE(PG8_SB(1, 1), b3 + hstep, voffB);
            PG8_WAIT_V(6); PG8_BAR; PG8_MMA(1, 1, At, B1); PG8_BAR;
            }
        }
        if constexpr (ALIGN_EPI) { if (wr == 0) PG8_BAR; }
        if constexpr (!Epi::AFTER_DRAIN) { E(acc, cur, wr, wc, fr, fq); S.done(cur); }
        if (!has_next) break;
#pragma unroll
        for (int a = 0; a < 2; ++a)
#pragma unroll
            for (int b = 0; b < 2; ++b)
#pragma unroll
                for (int m = 0; m < 4; ++m)
#pragma unroll
                    for (int n = 0; n < 2; ++n) acc[a][b][m][n] = (f32x4){0.f, 0.f, 0.f, 0.f};
        cur = nxt; cA = nA; cB = nB; ++ui;
        if constexpr (ALIGN_EPI) { if (wr == 1) PG8_BAR; }
    }
    PG8_WAIT_V(0);
    if constexpr (!ALIGN_EPI) { if (wr == 0) PG8_BAR; }
    PG8_BAR;
    if constexpr (Epi::AFTER_DRAIN) { E.fused(acc, cur, wr, wc, fr, fq, lds, wid, lane); S.done(cur); }
#undef PG8_SA
#undef PG8_SB
#undef PG8_STAGE
#undef PG8_LDA
#undef PG8_LDB
#undef PG8_MMA
#undef PG8_WAIT_V
#undef PG8_WAIT_L
#undef PG8_BAR
#undef PG8_SCHED
}
}
namespace att {
using bf16 = __hip_bfloat16;
using bf16x8 = __attribute__((ext_vector_type(8))) short;
using s16x4 = __attribute__((ext_vector_type(4))) short;
using f32x16 = __attribute__((ext_vector_type(16))) float;
using u32x4 = __attribute__((ext_vector_type(4))) unsigned;
constexpr int PITCH = 3072, QB = 256, KVBLK = 64, NW = 8;
constexpr int SLOTB = 8192, VSLOTB = 16384, LDS_K = 0, LDS_V = 2 * SLOTB, LDS_WS = LDS_V + 2 * VSLOTB, LDS_OST = LDS_WS + NW * 64 * 4, LDS_BYTES = LDS_OST + NW * 8192;
__device__ __forceinline__ int crow(int r, int hi) { return (r & 3) + 8 * (r >> 2) + 4 * hi; }
typedef float f32x2_t __attribute__((ext_vector_type(2))); typedef __bf16 bf16x2_t __attribute__((ext_vector_type(2)));
__device__ __forceinline__ unsigned cvtpk_s(float lo, float hi) { f32x2_t v = {lo, hi}; bf16x2_t b = __builtin_convertvector(v, bf16x2_t); return __builtin_bit_cast(unsigned, b); }

__device__ __forceinline__ void qkt(f32x16& p0, f32x16& p1, const char* Kslot, const bf16x8* qr, const f32x16& c0, const f32x16& c1, int r32, int hi) {
  const char* kb = Kslot + hi * 1024 + r32 * 16;
#pragma unroll
  for (int d0 = 0; d0 < 4; ++d0) {
    const bf16x8 b0 = *reinterpret_cast<const bf16x8*>(kb + d0 * 2048);
    const bf16x8 b1 = *reinterpret_cast<const bf16x8*>(kb + d0 * 2048 + 512);
    if (d0 == 0) { p0 = __builtin_amdgcn_mfma_f32_32x32x16_bf16(b0, qr[0], c0, 0, 0, 0); p1 = __builtin_amdgcn_mfma_f32_32x32x16_bf16(b1, qr[0], c1, 0, 0, 0); }
    else { p0 = __builtin_amdgcn_mfma_f32_32x32x16_bf16(b0, qr[d0], p0, 0, 0, 0); p1 = __builtin_amdgcn_mfma_f32_32x32x16_bf16(b1, qr[d0], p1, 0, 0, 0); } }
}
template <int NDB> __device__ __forceinline__ void pv(f32x16* o, int vb, bf16x8 pa0, bf16x8 pa1, bf16x8 pa2, bf16x8 pa3) {
#pragma unroll
  for (int d0 = 0; d0 < NDB; ++d0) { s16x4 lo[4], hi[4];
#pragma unroll
    for (int ks = 0; ks < 4; ++ks) {
      asm volatile("ds_read_b64_tr_b16 %0,%1 offset:%c2" : "=&v"(lo[ks]) : "v"(vb), "i"(d0 * 4096 + ks * 1024) : "memory");
      asm volatile("ds_read_b64_tr_b16 %0,%1 offset:%c2" : "=&v"(hi[ks]) : "v"(vb), "i"(d0 * 4096 + ks * 1024 + 512) : "memory"); }
    asm volatile("s_waitcnt lgkmcnt(0)" ::: "memory"); __builtin_amdgcn_sched_barrier(0);
#define PK(k) (bf16x8){lo[k][0], lo[k][1], lo[k][2], lo[k][3], hi[k][0], hi[k][1], hi[k][2], hi[k][3]}
    o[d0] = __builtin_amdgcn_mfma_f32_32x32x16_bf16(pa0, PK(0), o[d0], 0, 0, 0);
    o[d0] = __builtin_amdgcn_mfma_f32_32x32x16_bf16(pa1, PK(1), o[d0], 0, 0, 0);
    o[d0] = __builtin_amdgcn_mfma_f32_32x32x16_bf16(pa2, PK(2), o[d0], 0, 0, 0);
    o[d0] = __builtin_amdgcn_mfma_f32_32x32x16_bf16(pa3, PK(3), o[d0], 0, 0, 0);
#undef PK
  }
}
struct UnitDesc { const bf16* Q; const bf16* K; const bf16* V; bf16* O; float slope2; int nb; int moba; const float* kpart; float dmin; float bnd; };
template <int DV> __device__ __forceinline__ void attn_unit(const UnitDesc& U, char* shm) {
  constexpr int NDB = DV / 32;
  const int tid = threadIdx.x, lane = tid & 63, r32 = lane & 31, hi = lane >> 5; const int wid = __builtin_amdgcn_readfirstlane(tid >> 6);
  const int nb = U.nb, q0 = nb * QB;
  const bf16* Qw = U.Q + (long)(q0 + wid * 32) * PITCH;
  const unsigned lds0 = (unsigned)(uintptr_t)shm;
  float* wsf = (float*)(shm + LDS_WS) + wid * 64;
  bf16x8 qr[4];
#pragma unroll
  for (int d0 = 0; d0 < 4; ++d0) qr[d0] = *reinterpret_cast<const bf16x8*>(&Qw[(long)r32 * PITCH + d0 * 16 + hi * 8]);
  unsigned sel = 0xffu;
  if (U.moba) {
    float g[4] = {0.f, 0.f, 0.f, 0.f};
    const bf16* qrow = Qw + (long)r32 * PITCH;
    for (int c = 0; c < 8; ++c) {
      const u32x4 qv = *reinterpret_cast<const u32x4*>(qrow + c * 8);
      float qf[8];
#pragma unroll
      for (int i = 0; i < 4; ++i) { qf[2 * i] = __uint_as_float(qv[i] << 16); qf[2 * i + 1] = __uint_as_float(qv[i] & 0xffff0000u); }
#pragma unroll
      for (int j = 0; j < 4; ++j) { const int n = 4 * hi + j;
        if (n < nb) { const float* k0 = U.kpart + (size_t)(n * 2) * 512 + c * 8; const float* k1 = k0 + 512;
#pragma unroll
          for (int i = 0; i < 8; ++i) g[j] += qf[i] * (k0[i] + k1[i]); } }
    }
    float ga[8];
#pragma unroll
    for (int j = 0; j < 4; ++j) { const float o = __shfl_xor(g[j], 32); ga[j] = hi ? o : g[j]; ga[4 + j] = hi ? g[j] : o; }
    sel = 0u;
#pragma unroll
    for (int n = 0; n < 8; ++n) { int rank = 0;
#pragma unroll
      for (int m = 0; m < 8; ++m) if (m != n) rank += (m < nb && (ga[m] > ga[n] || (ga[m] == ga[n] && m < n))) ? 1 : 0;
      if (n < nb && rank < 3) sel |= (1u << n); }
  }
  const int NT = 4 * (nb + 1);
  int ts = (int)floorf(((float)q0 - 63.f - U.dmin) * (1.0f / 64.0f)) + 1; ts = ts < 0 ? 0 : (ts > NT - 4 ? NT - 4 : ts);
  float mref = -U.bnd, lrun = 0.f; f32x16 o[NDB];
#pragma unroll
  for (int d = 0; d < NDB; ++d) o[d] = f32x16{};
  const int qrel = wid * 32 + r32;
  const bf16* ksrc = U.K + (long)lane * PITCH + wid * 8;
  const bf16* vsrc = U.V + (long)(16 * (wid & 3) + (lane >> 2)) * PITCH + (wid >> 2) * 32 + (lane & 3) * 8;
  char* kdst = shm + LDS_K + wid * 1024 + lane * 16; char* vdst = shm + LDS_V + wid * 1024 + lane * 16;
  const int vb0 = (int)(lds0 + LDS_V) + ((lane >> 4) & 1) * 32 + (lane & 3) * 8 + (4 * hi + ((lane & 15) >> 2)) * 64;
  u32x4 kreg = *reinterpret_cast<const u32x4*>(ksrc + (long)ts * KVBLK * PITCH), vreg = *reinterpret_cast<const u32x4*>(vsrc + (long)ts * KVBLK * PITCH), vreg2 = vreg;
  if (DV == 128) vreg2 = *reinterpret_cast<const u32x4*>(vsrc + (long)ts * KVBLK * PITCH + 64);
  const float s2 = U.slope2, s2x64 = 64.f * s2;
  f32x16 cb0, cb1;
#define ATT_REBUILD(T_) do { const float base_ = s2 * (float)(64 * (T_) - q0 + 4 * hi) - mref; const bool on_ = ((T_) >= NT - 4) || (((sel >> ((T_) >> 2)) & 1u) != 0u); \
    _Pragma("unroll") for (int r = 0; r < 16; ++r) { const float v_ = base_ + s2 * (float)((r & 3) + 8 * (r >> 2)); cb0[r] = on_ ? v_ : -INFINITY; cb1[r] = on_ ? v_ + 32.f * s2 : -INFINITY; } } while (0)
  ATT_REBUILD(ts);
  for (int t = ts; t < NT; ++t) {
    const int slot = (t & 1) * SLOTB, vslot = (t & 1) * VSLOTB;
    *reinterpret_cast<u32x4*>(kdst + slot) = kreg; *reinterpret_cast<u32x4*>(vdst + vslot) = vreg; if (DV == 128) *reinterpret_cast<u32x4*>(vdst + vslot + 8192) = vreg2;
    __syncthreads();
    if (t + 1 < NT) { kreg = *reinterpret_cast<const u32x4*>(ksrc + (long)(t + 1) * KVBLK * PITCH); vreg = *reinterpret_cast<const u32x4*>(vsrc + (long)(t + 1) * KVBLK * PITCH);
      if (DV == 128) vreg2 = *reinterpret_cast<const u32x4*>(vsrc + (long)(t + 1) * KVBLK * PITCH + 64); }
    f32x16 p0, p1; qkt(p0, p1, shm + LDS_K + slot, qr, cb0, cb1, r32, hi);
    const int jb = t - (NT - 4);
    if (jb >= 0) { const int kb = 64 * jb + 4 * hi;
#pragma unroll
      for (int r = 0; r < 16; ++r) { const int kv = kb + (r & 3) + 8 * (r >> 2); if (kv > qrel) p0[r] = -INFINITY; if (kv + 32 > qrel) p1[r] = -INFINITY; } }
    float rm = fmaxf(p0[0], p1[0]);
#pragma unroll
    for (int r = 1; r < 16; ++r) rm = fmaxf(rm, fmaxf(p0[r], p1[r]));
    rm = fmaxf(rm, __shfl_xor(rm, 32));
    bool resc = false;
    if (__any(rm > 8.0f)) { const float dl = fmaxf(rm, 0.f); mref += dl;
#pragma unroll
      for (int r = 0; r < 16; ++r) { p0[r] -= dl; p1[r] -= dl; cb0[r] -= dl; cb1[r] -= dl; }
      const float f = __builtin_amdgcn_exp2f(-dl); lrun *= f; if (hi == 0) wsf[r32] = f; resc = true; }
    float ps = 0.f;
#pragma unroll
    for (int r = 0; r < 16; ++r) { p0[r] = __builtin_amdgcn_exp2f(p0[r]); p1[r] = __builtin_amdgcn_exp2f(p1[r]); ps += p0[r] + p1[r]; }
    lrun += ps;
    u32x4 pw0, pw1, pw2, pw3;
#pragma unroll
    for (int i = 0; i < 4; ++i) { pw0[i] = cvtpk_s(p0[2 * i], p0[2 * i + 1]); pw1[i] = cvtpk_s(p0[8 + 2 * i], p0[9 + 2 * i]); pw2[i] = cvtpk_s(p1[2 * i], p1[2 * i + 1]); pw3[i] = cvtpk_s(p1[8 + 2 * i], p1[9 + 2 * i]); }
    if (resc) { asm volatile("s_waitcnt lgkmcnt(0)" ::: "memory");
#pragma unroll
      for (int r = 0; r < 16; ++r) { const float fr_ = wsf[crow(r, hi)];
#pragma unroll
        for (int d = 0; d < NDB; ++d) o[d][r] *= fr_; } }
    pv<NDB>(o, vb0 + vslot, __builtin_bit_cast(bf16x8, pw0), __builtin_bit_cast(bf16x8, pw1), __builtin_bit_cast(bf16x8, pw2), __builtin_bit_cast(bf16x8, pw3));
    if (((t + 1) & 3) == 0) { if (t + 1 < NT) ATT_REBUILD(t + 1); }
    else {
#pragma unroll
      for (int r = 0; r < 16; ++r) { cb0[r] += s2x64; cb1[r] += s2x64; } }
  }
#undef ATT_REBUILD
  lrun += __shfl_xor(lrun, 32);
  if (hi == 0) wsf[32 + r32] = lrun;
  asm volatile("s_waitcnt lgkmcnt(0)" ::: "memory");
  float rli[16];
#pragma unroll
  for (int r = 0; r < 16; ++r) rli[r] = 1.0f / wsf[32 + crow(r, hi)];
  bf16* Ow = U.O + (long)(q0 + wid * 32) * 1024;
  { bf16* stg = (bf16*)(shm + LDS_OST) + wid * 4096;
#pragma unroll
    for (int r = 0; r < 16; ++r) { const int orow = crow(r, hi);
#pragma unroll
      for (int d0 = 0; d0 < NDB; ++d0) stg[orow * DV + d0 * 32 + r32] = __float2bfloat16(o[d0][r] * rli[r]); }
    asm volatile("s_waitcnt lgkmcnt(0)" ::: "memory");
    constexpr int CPR = DV / 8, RPI = 64 / CPR;
#pragma unroll
    for (int i = 0; i < 32 / RPI; ++i) { const int row = i * RPI + lane / CPR, ch = lane % CPR; const u32x4 v = *(const u32x4*)(stg + row * DV + ch * 8); *(u32x4*)(Ow + (long)row * 1024 + ch * 8) = v; } }
  asm volatile("s_waitcnt lgkmcnt(0)" ::: "memory");
  __syncthreads();
}
}
namespace peer {
using bf16 = __hip_bfloat16;
using bf16x8 = __attribute__((ext_vector_type(8))) short;
using f32x16 = __attribute__((ext_vector_type(16))) float;
using u32x4 = __attribute__((ext_vector_type(4))) unsigned;
__device__ __forceinline__ int crow(int r, int hi) { return (r & 3) + 8 * (r >> 2) + 4 * hi; }
__device__ __forceinline__ int f2key(float f) { const int b = __float_as_int(f); return b ^ ((b >> 31) & 0x7fffffff); }
__device__ __forceinline__ float key2f(int k) { return __int_as_float(k ^ ((k >> 31) & 0x7fffffff)); }
__device__ __forceinline__ void ins16(int (&L)[16], int v) {
#pragma unroll
  for (int i = 0; i < 16; ++i) { const int a = L[i]; L[i] = a > v ? a : v; v = a > v ? v : a; }
}
#define PEER_CE(A_, B_) do { const int a_ = (A_), b_ = (B_); (A_) = a_ > b_ ? a_ : b_; (B_) = a_ > b_ ? b_ : a_; } while (0)
#define PEER_SORT16(V) do { PEER_CE(V[0], V[1]); PEER_CE(V[3], V[2]); PEER_CE(V[4], V[5]); PEER_CE(V[7], V[6]); PEER_CE(V[8], V[9]); PEER_CE(V[11], V[10]); PEER_CE(V[12], V[13]); PEER_CE(V[15], V[14]); PEER_CE(V[0], V[2]); PEER_CE(V[1], V[3]); PEER_CE(V[6], V[4]); PEER_CE(V[7], V[5]); PEER_CE(V[8], V[10]); PEER_CE(V[9], V[11]); PEER_CE(V[14], V[12]); PEER_CE(V[15], V[13]); PEER_CE(V[0], V[1]); PEER_CE(V[2], V[3]); PEER_CE(V[5], V[4]); PEER_CE(V[7], V[6]); PEER_CE(V[8], V[9]); PEER_CE(V[10], V[11]); PEER_CE(V[13], V[12]); PEER_CE(V[15], V[14]); PEER_CE(V[0], V[4]); PEER_CE(V[1], V[5]); PEER_CE(V[2], V[6]); PEER_CE(V[3], V[7]); PEER_CE(V[12], V[8]); PEER_CE(V[13], V[9]); PEER_CE(V[14], V[10]); PEER_CE(V[15], V[11]); PEER_CE(V[0], V[2]); PEER_CE(V[1], V[3]); PEER_CE(V[4], V[6]); PEER_CE(V[5], V[7]); PEER_CE(V[10], V[8]); PEER_CE(V[11], V[9]); PEER_CE(V[14], V[12]); PEER_CE(V[15], V[13]); PEER_CE(V[0], V[1]); PEER_CE(V[2], V[3]); PEER_CE(V[4], V[5]); PEER_CE(V[6], V[7]); PEER_CE(V[9], V[8]); PEER_CE(V[11], V[10]); PEER_CE(V[13], V[12]); PEER_CE(V[15], V[14]); PEER_CE(V[0], V[8]); PEER_CE(V[1], V[9]); PEER_CE(V[2], V[10]); PEER_CE(V[3], V[11]); PEER_CE(V[4], V[12]); PEER_CE(V[5], V[13]); PEER_CE(V[6], V[14]); PEER_CE(V[7], V[15]); PEER_CE(V[0], V[4]); PEER_CE(V[1], V[5]); PEER_CE(V[2], V[6]); PEER_CE(V[3], V[7]); PEER_CE(V[8], V[12]); PEER_CE(V[9], V[13]); PEER_CE(V[10], V[14]); PEER_CE(V[11], V[15]); PEER_CE(V[0], V[2]); PEER_CE(V[1], V[3]); PEER_CE(V[4], V[6]); PEER_CE(V[5], V[7]); PEER_CE(V[8], V[10]); PEER_CE(V[9], V[11]); PEER_CE(V[12], V[14]); PEER_CE(V[13], V[15]); PEER_CE(V[0], V[1]); PEER_CE(V[2], V[3]); PEER_CE(V[4], V[5]); PEER_CE(V[6], V[7]); PEER_CE(V[8], V[9]); PEER_CE(V[10], V[11]); PEER_CE(V[12], V[13]); PEER_CE(V[14], V[15]); } while (0)
__device__ __forceinline__ void mergetop16(int (&L)[16], const int (&S)[16]) {
  int M[16];
#pragma unroll
  for (int i = 0; i < 16; ++i) M[i] = L[i] > S[15 - i] ? L[i] : S[15 - i];
#pragma unroll
  for (int s = 8; s >= 1; s >>= 1)
#pragma unroll
    for (int i = 0; i < 16; ++i) if ((i & s) == 0) PEER_CE(M[i], M[i + s]);
#pragma unroll
  for (int i = 0; i < 16; ++i) L[i] = M[i];
}
__device__ __forceinline__ void merge16(int (&L)[16]) {
  int S[16];
#pragma unroll
  for (int i = 0; i < 16; ++i) S[i] = __shfl_xor(L[i], 32);
  mergetop16(L, S);
}
#define PEER_CAND_LIST(X) \
  X(0,0,0, 2,1) X(1,0,1, 2,2) X(2,0,2, 2,3) X(3,0,3, 2,4) X(4,0,4, 3,0) X(5,0,5, 3,1) X(6,0,6, 3,2) X(7,0,7, 3,3) X(8,0,8, 4,0) X(9,0,9, 4,1) X(10,0,10, 4,2) X(11,0,11, 5,0) X(12,0,12, 5,1) X(13,0,13, 6,0) X(14,0,14, 6,1) X(15,0,15, 7,0) X(16,1,0, 7,1) X(17,1,1, 8,0) X(18,1,2, 9,0) X(19,1,3, 10,0) X(20,1,4, 11,0) X(21,1,5, 12,0) X(22,1,6, 13,0) X(23,1,7, 14,0) X(24,2,0, 15,0)

#define PEER_KROW 272
__device__ __forceinline__ void topk_task(const bf16* QP, const char* ksl, const float* ssq, float* RSTD, int* LE, float* LG, int tg, int h, int lane, bf16x8 (&q0f)[8], int tg_next) {
  const int r32 = lane & 31, hi = lane >> 5; const int t = tg * 32 + r32;
  int A[16], B[16];
  bf16x8 q1f[8];
#pragma unroll
  for (int ks = 0; ks < 8; ++ks) q1f[ks] = *reinterpret_cast<const bf16x8*>(QP + (size_t)t * 2048 + h * 256 + 128 + ks * 16 + hi * 8);
#pragma unroll
  for (int p = 0; p < 2; ++p) {
    int L[16];
#pragma unroll
    for (int i = 0; i < 16; ++i) L[i] = (int)0x80000000;
    const char* kb = ksl + p * (128 * PEER_KROW) + r32 * PEER_KROW + hi * 16;
#pragma unroll 1
    for (int i = 0; i < 4; ++i) {
      f32x16 acc = {};
#pragma unroll
      for (int ks = 0; ks < 8; ++ks) { const bf16x8 a = *reinterpret_cast<const bf16x8*>(kb + i * (32 * PEER_KROW) + ks * 32); acc = __builtin_amdgcn_mfma_f32_32x32x16_bf16(a, p == 0 ? q0f[ks] : q1f[ks], acc, 0, 0, 0); }
      int S[16];
#pragma unroll
      for (int r = 0; r < 16; ++r) S[r] = (f2key(acc[r]) & ~127) | (i * 32 + crow(r, hi));
      PEER_SORT16(S);
      mergetop16(L, S);
    }
    merge16(L);
#pragma unroll
    for (int i = 0; i < 16; ++i) { if (p == 0) A[i] = L[i]; else B[i] = L[i]; }
    if (p == 0 && tg_next >= 0) {
#pragma unroll
      for (int ks = 0; ks < 8; ++ks) q0f[ks] = *reinterpret_cast<const bf16x8*>(QP + (size_t)(tg_next * 32 + r32) * 2048 + h * 256 + ks * 16 + hi * 8); }
  }
  float Af[16], Bf[16];
#pragma unroll
  for (int i = 0; i < 16; ++i) { Af[i] = key2f(A[i] & ~127); Bf[i] = key2f(B[i] & ~127); }
  float C[25];
#define X(c, i0, j0, i1, j1) C[c] = hi ? (Af[i1] + Bf[j1]) : (Af[i0] + Bf[j0]);
  PEER_CAND_LIST(X)
#undef X
  int L[16];
#pragma unroll
  for (int i = 0; i < 16; ++i) L[i] = (int)0x80000000;
#pragma unroll
  for (int c = 0; c < 25; ++c) ins16(L, f2key(C[c]));
  merge16(L);
  const int tau = L[15]; const float cmax = Af[0] + Bf[0];
  float s = 0.f;
#pragma unroll
  for (int i = 0; i < 16; ++i) s += ssq[(size_t)t * 16 + i];
  const float rstd = 1.0f / sqrtf(s * (1.0f / 1024.0f) + 1e-6f);
  const float k2 = rstd * 1.4426950408889634f;
  if (h == 0 && hi == 0) RSTD[t] = rstd;
  float E[25]; float den = 0.f; int cnt = 0; unsigned selm = 0u;
#pragma unroll
  for (int c = 0; c < 25; ++c) { const bool sl = f2key(C[c]) >= tau; E[c] = sl ? __builtin_amdgcn_exp2f((C[c] - cmax) * k2) : 0.f; den += E[c]; cnt += sl ? 1 : 0; selm |= sl ? (1u << c) : 0u; }
  den += __shfl_xor(den, 32);
  const int ocnt = __shfl_xor(cnt, 32);
  int pos = hi ? ocnt : 0;
  const float rden = 1.0f / den;
  int* le = LE + (size_t)t * 128 + h * 16; float* lg = LG + (size_t)t * 128 + h * 16;
#define X(c, i0, j0, i1, j1) { if (((selm >> c) & 1u) && pos < 16) { const int ka = (hi ? A[i1] : A[i0]) & 127, kb2 = (hi ? B[j1] : B[j0]) & 127; le[pos] = ka * 128 + kb2; lg[pos] = E[c] * rden; ++pos; } }
  PEER_CAND_LIST(X)
#undef X
}

__device__ __forceinline__ float gelu_erf(float v) { return 0.5f * v * (1.0f + erff(v * 0.70710678118654752f)); }
__device__ __forceinline__ void unpack8(const u32x4 w, float (&f)[8]) {
#pragma unroll
  for (int i = 0; i < 4; ++i) { f[2 * i] = __uint_as_float(w[i] << 16); f[2 * i + 1] = __uint_as_float(w[i] & 0xffff0000u); }
}
#define PEER_DPP(v, ctrl, rmask) __int_as_float(__builtin_amdgcn_update_dpp(0, __float_as_int(v), ctrl, rmask, 0xf, false))
__device__ __forceinline__ float wave_total(float v) {
  v += PEER_DPP(v, 0xB1, 0xf);
  v += PEER_DPP(v, 0x4E, 0xf);
  v += PEER_DPP(v, 0x141, 0xf);
  v += PEER_DPP(v, 0x140, 0xf);
  v += PEER_DPP(v, 0x142, 0xa);
  v += PEER_DPP(v, 0x143, 0xc);
  return __int_as_float(__builtin_amdgcn_readlane(__float_as_int(v), 63));
}
typedef float f32x4_t __attribute__((ext_vector_type(4)));
typedef float f32x2_t __attribute__((ext_vector_type(2)));
__device__ __forceinline__ float ub0(unsigned w) { return (float)(w & 255u); }
__device__ __forceinline__ float ub1(unsigned w) { return (float)((w >> 8) & 255u); }
__device__ __forceinline__ float ub2(unsigned w) { return (float)((w >> 16) & 255u); }
__device__ __forceinline__ float ub3(unsigned w) { return (float)(w >> 24); }
#define PEER_DPPI(v, ctrl, rmask) __builtin_amdgcn_update_dpp(0, v, ctrl, rmask, 0xf, false)
__device__ __forceinline__ int wave_total_i(int v) {
  v += PEER_DPPI(v, 0xB1, 0xf); v += PEER_DPPI(v, 0x4E, 0xf); v += PEER_DPPI(v, 0x141, 0xf); v += PEER_DPPI(v, 0x140, 0xf); v += PEER_DPPI(v, 0x142, 0xa); v += PEER_DPPI(v, 0x143, 0xc);
  return __builtin_amdgcn_readlane(v, 63);
}
__device__ __forceinline__ float quant_row16(const float (&v)[16], unsigned char* dst_row, int lane, int bias) {
  float m = 0.f;
#pragma unroll
  for (int i = 0; i < 16; ++i) m = fmaxf(m, fabsf(v[i]));
#pragma unroll
  for (int o = 1; o < 64; o <<= 1) m = fmaxf(m, __shfl_xor(m, o));
  const float inv = m > 0.f ? 127.0f / m : 0.f;
  u32x4 w;
#pragma unroll
  for (int q = 0; q < 4; ++q) { unsigned x = 0u;
#pragma unroll
    for (int i = 0; i < 4; ++i) { const int qi = (int)rintf(v[4 * q + i] * inv) + bias; x |= ((unsigned)qi & 255u) << (8 * i); }
    w[q] = x; }
  *reinterpret_cast<u32x4*>(dst_row + lane * 16) = w;
  return m * (1.0f / 127.0f);
}
#define PEER_UFETCH(G_) do { const size_t tb_ = (size_t)(G_) * 4; _Pragma("unroll") for (int j = 0; j < 4; ++j) { \
    e0[j] = LE[(tb_ + j) * 128 + lane] & 16383; e1[j] = LE[(tb_ + j) * 128 + 64 + lane] & 16383; g0[j] = LG[(tb_ + j) * 128 + lane]; g1[j] = LG[(tb_ + j) * 128 + 64 + lane]; \
    xa[j] = *reinterpret_cast<const u32x4*>(XQ + (tb_ + j) * 1024 + lane * 16); } \
    rs4 = *reinterpret_cast<const f32x4_t*>(HS + tb_); } while (0)
__device__ __forceinline__ void expert_u_pass(const unsigned char* XQ, const unsigned char* U8, const float* HS, const float* SU, const float* SV, const int* LE, const float* LG, unsigned* PACK, int slice, int wx, int nwx, int lane, char* wl) {
  unsigned* list = (unsigned*)(wl + 4096);
  int e0[4], e1[4]; float g0[4], g1[4]; u32x4 xa[4]; f32x4_t rs4;
  int gi = wx;
  if (gi < 8192) PEER_UFETCH(gi);
  for (; gi < 8192; gi += nwx) {
    int n = 0;
    const f32x4_t rs = rs4;
#pragma unroll
    for (int j = 0; j < 4; ++j) {
      *reinterpret_cast<u32x4*>(wl + j * 1024 + lane * 16) = xa[j];
      { const bool in = (e0[j] >> 11) == slice; const unsigned long long m = __ballot(in);
        if (in) { const int pos = n + (int)__builtin_amdgcn_mbcnt_hi((unsigned)(m >> 32), __builtin_amdgcn_mbcnt_lo((unsigned)m, 0u)); list[2 * pos] = (unsigned)e0[j] | ((unsigned)lane << 14) | ((unsigned)j << 21); list[2 * pos + 1] = __float_as_uint(g0[j]); }
        n += __builtin_popcountll(m); }
      { const bool in = (e1[j] >> 11) == slice; const unsigned long long m = __ballot(in);
        if (in) { const int pos = n + (int)__builtin_amdgcn_mbcnt_hi((unsigned)(m >> 32), __builtin_amdgcn_mbcnt_lo((unsigned)m, 0u)); list[2 * pos] = (unsigned)e1[j] | ((unsigned)(64 + lane) << 14) | ((unsigned)j << 21); list[2 * pos + 1] = __float_as_uint(g1[j]); }
        n += __builtin_popcountll(m); }
    }
    n = __builtin_amdgcn_readfirstlane(n);
    const int gnext = gi + nwx;
    if (gnext < 8192) PEER_UFETCH(gnext);
#define PEER_UISSUE(UA_, JJ_, WL_, SU_, SV_, B_) do { _Pragma("unroll") for (int s = 0; s < 16; ++s) { const int i = ((B_) + s < n) ? ((B_) + s) : (n - 1); const unsigned w = (unsigned)__builtin_amdgcn_readfirstlane((int)list[2 * i]); \
        JJ_[s] = (w >> 21) & 3u; UA_[s] = *reinterpret_cast<const u32x4*>(U8 + (size_t)(w & 16383u) * 1024 + lane * 16); } \
      { const int i = ((B_) + (lane >> 2) < n) ? ((B_) + (lane >> 2)) : (n - 1); WL_ = list[2 * i]; SU_ = SU[WL_ & 16383u]; SV_ = SV[WL_ & 16383u]; } } while (0)
#define PEER_UCOMP(UA_, JJ_, WL_, SU_, SV_, B_) do { int q[16]; \
      _Pragma("unroll") for (int s = 0; s < 16; ++s) { const u32x4 xl = *reinterpret_cast<const u32x4*>(wl + JJ_[s] * 1024 + lane * 16); int q_ = 0; \
        _Pragma("unroll") for (int i = 0; i < 4; ++i) q_ = __builtin_amdgcn_sdot4((int)UA_[s][i], (int)xl[i], q_, false); q[s] = q_; } \
        \
      int r8[8], r4[4], r2[2], r1; \
      { const bool bb = (lane & 32) != 0; _Pragma("unroll") for (int i = 0; i < 8; ++i) { const int keep = bb ? q[8 + i] : q[i], send = bb ? q[i] : q[8 + i]; r8[i] = keep + __shfl_xor(send, 32); } } \
      { const bool bb = (lane & 16) != 0; _Pragma("unroll") for (int i = 0; i < 4; ++i) { const int keep = bb ? r8[4 + i] : r8[i], send = bb ? r8[i] : r8[4 + i]; r4[i] = keep + __shfl_xor(send, 16); } } \
      { const bool bb = (lane & 8) != 0; _Pragma("unroll") for (int i = 0; i < 2; ++i) { const int keep = bb ? r4[2 + i] : r4[i], send = bb ? r4[i] : r4[2 + i]; r2[i] = keep + __shfl_xor(send, 8); } } \
      { const bool bb = (lane & 4) != 0; const int keep = bb ? r2[1] : r2[0], send = bb ? r2[0] : r2[1]; r1 = keep + __shfl_xor(send, 4); } \
      r1 += PEER_DPPI(r1, 0xB1, 0xf); r1 += PEER_DPPI(r1, 0x4E, 0xf); \
      if ((lane & 3) == 0 && (B_) + (lane >> 2) < n) { const unsigned w = WL_; const float gk = __uint_as_float(list[2 * ((B_) + (lane >> 2)) + 1]); const unsigned j = (w >> 21) & 3u; const unsigned e = w & 16383u; \
        const float r = j == 0 ? rs[0] : j == 1 ? rs[1] : j == 2 ? rs[2] : rs[3]; \
        const float a = gelu_erf((float)r1 * r * SU_) * gk * SV_; const unsigned ab = __float_as_uint(a); const unsigned rb = (ab + 0x7fffu + ((ab >> 16) & 1u)) & 0xffff0000u; \
        PACK[((size_t)gi * 4 + j) * 128 + ((w >> 14) & 127u)] = rb | e; } } while (0)
    if (n > 0) {
      u32x4 uA[16], uB[16]; unsigned jA[16], jB[16]; unsigned wA, wB; float suA, svA, suB, svB;
      PEER_UISSUE(uA, jA, wA, suA, svA, 0);
      for (int b = 0; b < n; b += 32) {
        if (b + 16 < n) PEER_UISSUE(uB, jB, wB, suB, svB, b + 16);
        PEER_UCOMP(uA, jA, wA, suA, svA, b);
        if (b + 16 >= n) break;
        if (b + 32 < n) PEER_UISSUE(uA, jA, wA, suA, svA, b + 32);
        PEER_UCOMP(uB, jB, wB, suB, svB, b + 16);
      }
    }
  }
}
#define PEER_VISSUE(S_, A_, P0_, P1_) do { _Pragma("unroll") for (int i = 0; i < 16; ++i) { const unsigned pk = (unsigned)__builtin_amdgcn_ds_bpermute(((8 * i + g) & 63) << 2, (int)(i < 8 ? P0_ : P1_)); \
    A_[i] = __uint_as_float(pk & 0xffff0000u); S_[i] = *reinterpret_cast<const u32x4*>(V8 + (size_t)(pk & 16383u) * 1024 + slice * 128 + c * 16); } } while (0)
#define PEER_VFINISH(S_, A_, T_, O_) do { float acc[16]; float asum = 0.f; _Pragma("unroll") for (int i = 0; i < 16; ++i) acc[i] = 0.f; \
    _Pragma("unroll") for (int i = 0; i < 16; ++i) { const float a_ = A_[i]; asum += a_; _Pragma("unroll") for (int q = 0; q < 4; ++q) { const unsigned w_ = S_[i][q]; \
        acc[4 * q] += a_ * ub0(w_); acc[4 * q + 1] += a_ * ub1(w_); acc[4 * q + 2] += a_ * ub2(w_); acc[4 * q + 3] += a_ * ub3(w_); } } \
    _Pragma("unroll") for (int i = 0; i < 16; ++i) acc[i] -= 128.f * asum; \
    float m8[8], m4[4], m2[2]; \
    { const bool bb = (g & 4) != 0; _Pragma("unroll") for (int i = 0; i < 8; ++i) { const float keep = bb ? acc[8 + i] : acc[i], send = bb ? acc[i] : acc[8 + i]; m8[i] = keep + __shfl_xor(send, 32); } } \
    { const bool bb = (g & 2) != 0; _Pragma("unroll") for (int i = 0; i < 4; ++i) { const float keep = bb ? m8[4 + i] : m8[i], send = bb ? m8[i] : m8[4 + i]; m4[i] = keep + __shfl_xor(send, 16); } } \
    { const bool bb = (g & 1) != 0; _Pragma("unroll") for (int i = 0; i < 2; ++i) { const float keep = bb ? m4[2 + i] : m4[i], send = bb ? m4[i] : m4[2 + i]; m2[i] = keep + __shfl_xor(send, 8); } } \
    f32x2_t r_ = (O_); r_[0] += m2[0]; r_[1] += m2[1]; *reinterpret_cast<f32x2_t*>(out + (size_t)(T_) * 1024 + slice * 128 + 16 * c + 2 * g) = r_; } while (0)
__device__ __forceinline__ void expert_v_pass(const unsigned char* V8, const unsigned* PACK, float* out, int slice, int wx, int nwx, int lane) {
  const int g = lane >> 3, c = lane & 7;
  const int MT = 32768;
  u32x4 sA[16], sB[16]; float aA[16], aB[16];
  int t = wx;
  unsigned p0 = 0, p1 = 0; f32x2_t oc = {0.f, 0.f}, on = {0.f, 0.f};
#define PEER_OLD(T_) (*reinterpret_cast<const f32x2_t*>(out + (size_t)(T_) * 1024 + slice * 128 + 16 * c + 2 * g))
  if (t < MT) { p0 = PACK[(size_t)t * 128 + lane]; p1 = PACK[(size_t)t * 128 + 64 + lane]; oc = PEER_OLD(t); }
  if (t < MT) PEER_VISSUE(sA, aA, p0, p1);
  if (t + nwx < MT) { const int t1 = t + nwx; p0 = PACK[(size_t)t1 * 128 + lane]; p1 = PACK[(size_t)t1 * 128 + 64 + lane]; on = PEER_OLD(t1); }
  for (; t < MT; t += 2 * nwx) {
    const int t1 = t + nwx, t2 = t + 2 * nwx, t3 = t + 3 * nwx;
    if (t1 < MT) PEER_VISSUE(sB, aB, p0, p1);
    f32x2_t o2 = {0.f, 0.f};
    if (t2 < MT) { p0 = PACK[(size_t)t2 * 128 + lane]; p1 = PACK[(size_t)t2 * 128 + 64 + lane]; o2 = PEER_OLD(t2); }
    PEER_VFINISH(sA, aA, t, oc);
    if (t1 >= MT) break;
    if (t2 < MT) PEER_VISSUE(sA, aA, p0, p1);
    f32x2_t o3 = {0.f, 0.f};
    if (t3 < MT) { p0 = PACK[(size_t)t3 * 128 + lane]; p1 = PACK[(size_t)t3 * 128 + 64 + lane]; o3 = PEER_OLD(t3); }
    PEER_VFINISH(sB, aB, t1, on);
    oc = o2; on = o3;
  }
#undef PEER_OLD
}
__device__ __forceinline__ void quant_token(const bf16* XMB, const float* ssq, unsigned char* XQ, float* HS, int t, int lane) {
  const u32x4 a = *reinterpret_cast<const u32x4*>(XMB + (size_t)t * 1024 + lane * 16), b = *reinterpret_cast<const u32x4*>(XMB + (size_t)t * 1024 + lane * 16 + 8);
  float fa[8], fb[8], v[16]; unpack8(a, fa); unpack8(b, fb);
#pragma unroll
  for (int i = 0; i < 8; ++i) { v[i] = fa[i]; v[8 + i] = fb[i]; }
  const float sx = quant_row16(v, XQ + (size_t)t * 1024, lane, 0);
  float s = 0.f;
#pragma unroll
  for (int i = 0; i < 16; ++i) s += ssq[(size_t)t * 16 + i];
  if (lane == 0) HS[t] = sx / sqrtf(s * (1.0f / 1024.0f) + 1e-6f);
}
}
constexpr int NWAVES = 8;
constexpr int BATCH = 16, SEQ = 2048, D = 1024, M = BATCH * SEQ, NPROJ = 3072, NQP = 2048, NEXP = 16384;
constexpr float RMS_EPS = 1e-6f;
constexpr float C2 = 0.125f * 1.4426950408889634f;
constexpr float LOG2E = 1.4426950408889634f;
constexpr size_t MiB = 1u << 20;
constexpr size_t WS_CTL = 0, CTL_ZERO_BYTES = 1 * MiB;
constexpr size_t WS_WIN = 1 * MiB;
constexpr size_t WS_WOUT = 7 * MiB;
constexpr size_t WS_WQ = 9 * MiB;
constexpr size_t WS_SK = 13 * MiB;
constexpr size_t WS_KPART = 13 * MiB + 512 * 1024;
constexpr size_t WS_SSQ = 14 * MiB;
constexpr size_t WS_MISC = 16 * MiB;
constexpr size_t WS_SU = WS_MISC + 65536, WS_SV = WS_MISC + 131072, WS_HS = WS_MISC + 262144;
constexpr size_t WS_U8 = 17 * MiB;
constexpr size_t WS_V8 = 33 * MiB;
constexpr size_t WS_XQ = 49 * MiB;
constexpr size_t WS_XN = 81 * MiB;
constexpr size_t WS_MIX = 145 * MiB;
constexpr size_t WS_DO = 209 * MiB;
constexpr size_t WS_PROJ = 273 * MiB;
constexpr size_t WS_QP = WS_PROJ;
constexpr size_t WS_LE = WS_PROJ + 128 * MiB;
constexpr size_t WS_LG = WS_PROJ + 144 * MiB;
constexpr size_t WS_PACK = WS_PROJ + 160 * MiB;
constexpr size_t WS_RSTD = WS_PROJ + 176 * MiB;
constexpr size_t WS_END = 465 * MiB;
constexpr int CW_BAR = 4096;
constexpr int RING_OFF = 0, RING_BYTES = 131072;
constexpr int LDSCTL_OFF = RING_BYTES, MISC_OFF = LDSCTL_OFF + 320;
constexpr int LDS_BYTES = 147456;
static_assert(att::LDS_BYTES <= RING_BYTES, "attention scratch fits the ring region");

#define GAS __attribute__((address_space(1)))
#define LAS __attribute__((address_space(3)))
typedef unsigned short bf16;
typedef unsigned v4u __attribute__((ext_vector_type(4)));
typedef unsigned v2u __attribute__((ext_vector_type(2)));
typedef float f32x4 __attribute__((ext_vector_type(4)));
typedef GAS unsigned gu32;
#define RLX_AGENT __ATOMIC_RELAXED, __HIP_MEMORY_SCOPE_AGENT
#define LDS_WAIT() asm volatile("s_waitcnt lgkmcnt(0)" ::: "memory")
#define VM_WAIT() asm volatile("s_waitcnt vmcnt(0)" ::: "memory")
__device__ __forceinline__ unsigned f2bf(float f) { unsigned u = __builtin_bit_cast(unsigned, f); return (u + 0x7fffu + ((u >> 16) & 1u)) >> 16; }
__device__ __forceinline__ unsigned pk2(float lo, float hi) { return f2bf(lo) | (f2bf(hi) << 16); }
#define XB_TMO      128
#define XB_XCNT(j)  (256  + 64 * (j))
#define XB_XSUB(j)  (1280 + 64 * (j))
#define XB_XGEN(j)  (2304 + 64 * (j))
#define XB_TOP      3328
#define XB_TOPGEN   3392
#define XCD_BAR_WORDS 3456
#define XB_SPIN_CAP (1u << 23)

__device__ __forceinline__ unsigned xb_ld(unsigned* p)              { return __hip_atomic_load(p, __ATOMIC_RELAXED, __HIP_MEMORY_SCOPE_AGENT); }
__device__ __forceinline__ unsigned xb_add(unsigned* p, unsigned v) { return __hip_atomic_fetch_add(p, v, __ATOMIC_RELAXED, __HIP_MEMORY_SCOPE_AGENT); }
__device__ __forceinline__ unsigned xb_xcc_id() { return (unsigned)__builtin_amdgcn_s_getreg((3 << 11) | 20) & 0xFu; }
#define XB_SPIN(cond, bar) do { unsigned _sp = 0; while (cond) { __builtin_amdgcn_s_sleep(1); \
    if ((++_sp & 255u) == 0u) { if (xb_ld(&(bar)[XB_TMO])) break; if (_sp > XB_SPIN_CAP) { atomicAdd(&(bar)[XB_TMO], 1u); break; } } } } while (0)

struct XcdBarrier {
    unsigned* bar; unsigned x;
    volatile LAS unsigned* st;
};

__device__ __forceinline__ XcdBarrier xcd_barrier_post(unsigned* bar, volatile LAS unsigned* st) {
    XcdBarrier b; b.bar = bar; b.x = xb_xcc_id(); b.st = st;
    if (threadIdx.x == 0) (void)xb_add(&bar[XB_XCNT(b.x)], 1u);
    return b;
}
__device__ __forceinline__ void xcd_barrier_complete(unsigned* bar, unsigned x, unsigned& nloc, unsigned& nx) {
    const unsigned G = gridDim.x * gridDim.y * gridDim.z;
    unsigned sum, cnt, mine, sp = 0u;
    for (;;) {
        sum = 0u; cnt = 0u; mine = 0u;
#pragma unroll
        for (unsigned j = 0; j < 16; ++j) { const unsigned c = xb_ld(&bar[XB_XCNT(j)]); sum += c; cnt += (c > 0u) ? 1u : 0u; mine = (j == x) ? c : mine; }
        if (sum == G) break;
        __builtin_amdgcn_s_sleep(1);
        if ((++sp & 255u) == 0u) { if (xb_ld(&bar[XB_TMO])) break; if (sp > XB_SPIN_CAP) { atomicAdd(&bar[XB_TMO], 1u); break; } }
    }
    nloc = mine > 0u ? mine : 1u; nx = cnt > 0u ? cnt : 1u;
}

__device__ __forceinline__ void xcd_barrier(const XcdBarrier& b) {
    asm volatile("s_waitcnt vmcnt(0)" ::: "memory");
    __syncthreads();
    if (threadIdx.x == 0) {
        unsigned* bar = b.bar;
        __builtin_amdgcn_s_waitcnt(0);
        unsigned nloc = b.st[0], nx = b.st[1];
        if (nloc == 0u) { xcd_barrier_complete(bar, b.x, nloc, nx); b.st[0] = nloc; b.st[1] = nx; }
        const unsigned old = xb_add(&bar[XB_XSUB(b.x)], 1u);
        const unsigned gen = old / nloc;
        if (old + 1u == (gen + 1u) * nloc) {
            __builtin_amdgcn_fence(__ATOMIC_RELEASE, "agent");
            asm volatile("s_waitcnt vmcnt(0)" ::: "memory");
            const unsigned og = xb_add(&bar[XB_TOP], 1u);
            const unsigned tg = og / nx;
            if (og + 1u == (tg + 1u) * nx) xb_add(&bar[XB_TOPGEN], 1u);
            else XB_SPIN(xb_ld(&bar[XB_TOPGEN]) == tg, bar);
            __builtin_amdgcn_fence(__ATOMIC_ACQUIRE, "agent");
            xb_add(&bar[XB_XGEN(b.x)], 1u);
            asm volatile("s_waitcnt vmcnt(0)" ::: "memory");
        } else {
            XB_SPIN(xb_ld(&bar[XB_XGEN(b.x)]) == gen, bar);
            __builtin_amdgcn_fence(__ATOMIC_ACQUIRE, "agent");
            asm volatile("s_waitcnt vmcnt(0)" ::: "memory");
        }
    }
    __syncthreads();
}
struct Frame {
    LAS unsigned char* lds;
    volatile LAS unsigned* MISC;
    gu32* ctl;
    int tid, lane, wave;
    int vcu, G;
};
__device__ __forceinline__ float wave_sum(float v) {
#pragma unroll
    for (int o = 1; o < 64; o <<= 1) v += __shfl_xor(v, o);
    return v;
}
template <bool PERMROWS>
__device__ __forceinline__ void p0_transpose_item(const float* W, int K, int N, bf16* WT, const float* kscale, LAS float* scr, int item, int lane) {
    const int nblk = N / 32, kb = item / nblk, nb = item % nblk, k0 = 64 * kb, n0 = 32 * nb;
#pragma unroll 8
    for (int i = 0; i < 32; ++i) { const int kk = 2 * i + (lane >> 5); float w = W[(size_t)(k0 + kk) * N + n0 + (lane & 31)]; if (kscale) w *= kscale[k0 + kk]; scr[kk * 33 + (lane & 31)] = w; }
    LDS_WAIT(); asm volatile("" ::: "memory");
    int r0 = n0;
    if (PERMROWS) { const int tl = n0 >> 8, np = n0 & 255; r0 = tl * 256 + ((np >> 5) & 1) * 128 + (np >> 6) * 32; }
    const int c = lane & 7;
#pragma unroll
    for (int j = 0; j < 4; ++j) { const int n = (lane >> 3) + 8 * j; const LAS float* s = scr + (8 * c) * 33 + n;
        v4u o; o.x = pk2(s[0 * 33], s[1 * 33]); o.y = pk2(s[2 * 33], s[3 * 33]); o.z = pk2(s[4 * 33], s[5 * 33]); o.w = pk2(s[6 * 33], s[7 * 33]);
        *(GAS v4u*)(WT + (size_t)(r0 + n) * K + k0 + 8 * c) = o; }
    LDS_WAIT(); asm volatile("" ::: "memory");
}
__device__ __forceinline__ void cvt8(const float* src, bf16* dst, size_t e, const float* cscale) {
    f32x4 a = *(const GAS f32x4*)(src + e), b = *(const GAS f32x4*)(src + e + 4);
    if (cscale) { const int c = (int)(e & 1023); const f32x4 ga = *(const f32x4*)(cscale + c), gb = *(const f32x4*)(cscale + c + 4); a = a * ga; b = b * gb; }
    v4u o; o.x = pk2(a[0], a[1]); o.y = pk2(a[2], a[3]); o.z = pk2(b[0], b[1]); o.w = pk2(b[2], b[3]);
    *(GAS v4u*)(dst + e) = o;
}
__device__ __forceinline__ void rms_row_to_bf16(const float* xrow, const float* g, bf16* orow, int lane) {
    const GAS f32x4* xr = (const GAS f32x4*)xrow + lane;
    f32x4 v[4]; float s = 0.f;
#pragma unroll
    for (int j = 0; j < 4; ++j) { v[j] = xr[64 * j]; s += (v[j].x * v[j].x + v[j].y * v[j].y) + (v[j].z * v[j].z + v[j].w * v[j].w); }
    const float rstd = 1.f / sqrtf(wave_sum(s) * (1.f / 1024.f) + RMS_EPS);
    GAS unsigned long long* o8 = (GAS unsigned long long*)orow + lane;
#pragma unroll
    for (int j = 0; j < 4; ++j) { const f32x4 gg = *((const f32x4*)g + lane + 64 * j);
        o8[64 * j] = (unsigned long long)pk2(v[j].x * rstd * gg.x, v[j].y * rstd * gg.y) | ((unsigned long long)pk2(v[j].z * rstd * gg.z, v[j].w * rstd * gg.w) << 32); }
}

struct Args { const float* in[13]; float* out; unsigned char* ws; int ph_lo, ph_hi; };
__global__ void __launch_bounds__(NWAVES * 64, 2) mega_fwd(Args args) {
    extern __shared__ __attribute__((aligned(16))) unsigned char lds[];
    Frame F;
    F.lds = (LAS unsigned char*)lds;
    F.MISC = (volatile LAS unsigned*)(F.lds + MISC_OFF);
    F.tid = threadIdx.x; F.lane = F.tid & 63; F.wave = __builtin_amdgcn_readfirstlane(F.tid >> 6);
    F.G = gridDim.x; { const int bx = blockIdx.x; F.vcu = (F.G % 8 == 0) ? (bx % 8) * (F.G / 8) + bx / 8 : bx; }
    unsigned char* ws = args.ws;
    F.ctl = (gu32*)(ws + WS_CTL);
    const float* x = args.in[0]; const float* norm1_g = args.in[1]; const float* w_in = args.in[2]; const float* moba_g = args.in[3]; const float* diff_g = args.in[4];
    const float* diff_lambda = args.in[5]; const float* subln_g = args.in[6]; const float* w_out = args.in[7]; const float* norm2_g = args.in[8]; const float* w_query = args.in[9];
    const float* sub_keys = args.in[10]; const float* peer_u = args.in[11]; const float* peer_v = args.in[12];
    float* out = args.out;
    bf16* WIN = (bf16*)(ws + WS_WIN); bf16* WOUT = (bf16*)(ws + WS_WOUT); bf16* WQ = (bf16*)(ws + WS_WQ); bf16* SK = (bf16*)(ws + WS_SK);
    float* KPART = (float*)(ws + WS_KPART); float* SSQ = (float*)(ws + WS_SSQ); float* MISCG = (float*)(ws + WS_MISC);
    unsigned char* U8 = ws + WS_U8; unsigned char* V8 = ws + WS_V8; float* SU = (float*)(ws + WS_SU); float* SV = (float*)(ws + WS_SV); unsigned char* XQ = ws + WS_XQ; float* HS = (float*)(ws + WS_HS); bf16* XN = (bf16*)(ws + WS_XN); bf16* MIX = (bf16*)(ws + WS_MIX); bf16* DOB = (bf16*)(ws + WS_DO);
    bf16* PROJ = (bf16*)(ws + WS_PROJ); bf16* QP = (bf16*)(ws + WS_QP); int* LE = (int*)(ws + WS_LE); float* LG = (float*)(ws + WS_LG); unsigned* PACK = (unsigned*)(ws + WS_PACK); float* RSTD = (float*)(ws + WS_RSTD);
    for (int u = F.tid; u < (LDS_BYTES - LDSCTL_OFF) / 4; u += NWAVES * 64) ((LAS unsigned*)(F.lds + LDSCTL_OFF))[u] = 0u;
    __syncthreads();
    XcdBarrier bar = xcd_barrier_post((unsigned*)(F.ctl + CW_BAR), F.MISC + 8);
    const int gw = F.vcu * NWAVES + F.wave, NGW = F.G * NWAVES;
    const int lo = args.ph_lo, hi = args.ph_hi;
#define IN(k) (lo <= (k) && (k) < hi)
#ifndef PROBE_DUP
#define PROBE_DUP -1
#endif
#define REP(k) for (int rep_ = 0; rep_ < ((PROBE_DUP == (k)) ? 2 : 1); ++rep_)
#define GRID_BAR() xcd_barrier(bar)

    if (IN(0)) {
        REP(0) {
        LAS float* scr = (LAS float*)(F.lds + RING_OFF + F.wave * 16384);
        constexpr int I_IN = (D / 64) * (NPROJ / 32), I_OUT = (D / 64) * (D / 32), I_Q = (D / 64) * (NQP / 32);
        for (int it = gw; it < I_IN + I_OUT + I_Q; it += NGW) {
            int r = it;
            if (r < I_IN) { p0_transpose_item<true>(w_in, D, NPROJ, WIN, nullptr, scr, r, F.lane); continue; } r -= I_IN;
            if (r < I_OUT) { p0_transpose_item<false>(w_out, D, D, WOUT, nullptr, scr, r, F.lane); continue; } r -= I_OUT;
            p0_transpose_item<false>(w_query, D, NQP, WQ, norm2_g, scr, r, F.lane);
        }
        constexpr size_t C_SK = (size_t)16 * 128 * 128 / 8;
        for (size_t c = (size_t)gw * 64 + F.lane; c < C_SK; c += (size_t)NGW * 64) cvt8(sub_keys, SK, c * 8, nullptr);
        for (int r = gw; r < 2 * NEXP; r += NGW) {
            const bool isu = r < NEXP; const int e = isu ? r : r - NEXP; const float* srow = (isu ? peer_u : peer_v) + (size_t)e * 1024 + F.lane * 16;
            float v[16];
#pragma unroll
            for (int q = 0; q < 4; ++q) { f32x4 a = *(const GAS f32x4*)(srow + 4 * q); if (isu) a = a * *(const f32x4*)(norm2_g + F.lane * 16 + 4 * q); v[4 * q] = a[0]; v[4 * q + 1] = a[1]; v[4 * q + 2] = a[2]; v[4 * q + 3] = a[3]; }
            const float sc = peer::quant_row16(v, (isu ? U8 : V8) + (size_t)e * 1024, F.lane, isu ? 0 : 128);
            if (F.lane == 0) (isu ? SU : SV)[e] = sc;
        }
        for (int m = gw; m < M; m += NGW) rms_row_to_bf16(x + (size_t)m * D, norm1_g, XN + (size_t)m * D, F.lane);
        if (gw == 0) { const float a = wave_sum(diff_lambda[F.lane] * diff_lambda[64 + F.lane]), b = wave_sum(diff_lambda[128 + F.lane] * diff_lambda[192 + F.lane]);
            if (F.lane == 0) MISCG[0] = expf(a) - expf(b) + 0.2f;
            float mq = fabsf(moba_g[F.lane]), mk = fabsf(moba_g[64 + F.lane]), dq = fabsf(diff_g[F.lane]), dk = fabsf(diff_g[64 + F.lane]);
#pragma unroll
            for (int o = 1; o < 64; o <<= 1) { mq = fmaxf(mq, __shfl_xor(mq, o)); mk = fmaxf(mk, __shfl_xor(mk, o)); dq = fmaxf(dq, __shfl_xor(dq, o)); dk = fmaxf(dk, __shfl_xor(dk, o)); }
            if (F.lane == 0) { MISCG[1] = 64.f * C2 * mq * mk * 1.02f; MISCG[2] = 64.f * C2 * dq * dk * 1.02f; } }
        }
        GRID_BAR();
    }
    if (IN(1)) {
        REP(1) {
        pg8::Gemm g{XN, WIN, M, NPROJ, D}; pg8::StaticOrder S; S.init(M, NPROJ, F.G, (int)blockIdx.x);
        pg8::EpiProj E{PROJ, moba_g, moba_g + 64, diff_g, diff_g + 64, KPART, C2};
        pg8::gemm_phase<pg8::EpiProj, pg8::StaticOrder, true, true>(F.lds + RING_OFF, g, S, E);
        }
        GRID_BAR();
    }
    if (IN(2)) {
        const float bnd_m = MISCG[1], bnd_d = MISCG[2];
        volatile LAS int* uq = (volatile LAS int*)(F.lds + MISC_OFF + 64);
        REP(2) {
#define ATT_QUEUE(QI_, ...) { gu32* ctr = F.ctl + 2048 + 128 * rep_ + 64 * (QI_); \
        if (F.tid == 0) uq[0] = (int)__hip_atomic_fetch_add(ctr, 1u, RLX_AGENT); \
        __syncthreads(); \
        for (;;) { const int u = uq[0]; __syncthreads(); if (u >= 1024) break; \
            if (F.tid == 0) uq[0] = (int)__hip_atomic_fetch_add(ctr, 1u, RLX_AGENT);       \
            const int nbq = 7 - (u >> 7), r = u & 127, b = r >> 3; const bf16* pb = PROJ + (size_t)b * SEQ * NPROJ; att::UnitDesc U; U.nb = nbq; __VA_ARGS__ } \
        __syncthreads(); }
        ATT_QUEUE(0, { const int dvh = r & 7, dh = dvh >> 1, j = dvh & 1;
                U.Q = (const att::bf16*)(pb + 1536 + dh * 128 + j * 64); U.K = (const att::bf16*)(pb + 2048 + dh * 128 + j * 64); U.V = (const att::bf16*)(pb + 2560 + dh * 128);
                U.O = (att::bf16*)(DOB + (size_t)b * SEQ * 1024 + (dh * 2 + j) * 128); U.slope2 = LOG2E * exp2f(-2.0f * (float)(dh + 1)); U.moba = 0; U.kpart = KPART; U.dmin = (2.f * bnd_d + 40.f) / U.slope2; U.bnd = bnd_d;
                att::attn_unit<128>(U, (char*)lds + RING_OFF); })
        ATT_QUEUE(1, { const int vh = r & 7;
                U.Q = (const att::bf16*)(pb + vh * 64); U.K = (const att::bf16*)(pb + 512 + vh * 64); U.V = (const att::bf16*)(pb + 1024 + vh * 64);
                U.O = (att::bf16*)(MIX + (size_t)b * SEQ * 1024 + vh * 64); U.slope2 = LOG2E * exp2f(-(float)(vh + 1)); U.moba = 1; U.kpart = KPART + (size_t)(b * 8) * 1024 + vh * 64; U.dmin = (2.f * bnd_m + 40.f) / U.slope2; U.bnd = bnd_m;
                att::attn_unit<64>(U, (char*)lds + RING_OFF); })
#undef ATT_QUEUE
        }
        GRID_BAR();
    }
    if (IN(3)) {
        const float lam = MISCG[0];
        const int hh = F.lane >> 4, cc = (F.lane & 15) * 8;
        float gs[8];
#pragma unroll
        for (int i = 0; i < 8; ++i) gs[i] = subln_g[cc + i] * 0.8f;
        for (int t = gw; t < M; t += NGW) {
            const v4u a = *(const GAS v4u*)(DOB + (size_t)t * 1024 + hh * 256 + cc), b = *(const GAS v4u*)(DOB + (size_t)t * 1024 + hh * 256 + 128 + cc);
            float d[8]; float ss = 0.f;
#pragma unroll
            for (int i = 0; i < 4; ++i) { d[2 * i] = __uint_as_float(a[i] << 16) - lam * __uint_as_float(b[i] << 16); d[2 * i + 1] = __uint_as_float(a[i] & 0xffff0000u) - lam * __uint_as_float(b[i] & 0xffff0000u);
                ss += d[2 * i] * d[2 * i] + d[2 * i + 1] * d[2 * i + 1]; }
#pragma unroll
            for (int o = 1; o < 16; o <<= 1) ss += __shfl_xor(ss, o);
            const float r = 1.0f / sqrtf(ss * (1.0f / 128.0f) + RMS_EPS);
            v4u w; w.x = pk2(d[0] * r * gs[0], d[1] * r * gs[1]); w.y = pk2(d[2] * r * gs[2], d[3] * r * gs[3]); w.z = pk2(d[4] * r * gs[4], d[5] * r * gs[5]); w.w = pk2(d[6] * r * gs[6], d[7] * r * gs[7]);
            *(GAS v4u*)(MIX + (size_t)t * 1024 + 512 + hh * 128 + cc) = w;
        }
        GRID_BAR();
    }
    if (IN(4)) {
        pg8::Gemm g{MIX, WOUT, M, D, D}; pg8::StaticOrder S; S.init(M, D, F.G, (int)blockIdx.x);
        pg8::EpiOut E{x, out, XN, SSQ};
        pg8::gemm_phase<pg8::EpiOut, pg8::StaticOrder, true, true>(F.lds + RING_OFF, g, S, E);
        GRID_BAR();
    }
    if (IN(5)) {
        REP(5) {
        pg8::Gemm g{XN, WQ, M, NQP, D}; pg8::StaticOrder S; S.init(M, NQP, F.G, (int)blockIdx.x);
        pg8::EpiBf16 E{QP, NQP};
        pg8::gemm_phase<pg8::EpiBf16, pg8::StaticOrder, true, true>(F.lds + RING_OFF, g, S, E);
        }
        GRID_BAR();
    }
    if (IN(6)) {
        for (int item = (int)blockIdx.x; item < 256; item += F.G) {
            const int h = item & 7, ch = item >> 3;
            __syncthreads();
            { const bf16* ksrc = SK + (size_t)h * 2 * 128 * 128;
              for (int c = F.tid; c < 4096; c += NWAVES * 64) { const int row = c >> 4, cc = c & 15; *(LAS v4u*)(F.lds + RING_OFF + row * PEER_KROW + cc * 16) = *(const GAS v4u*)(ksrc + (size_t)row * 128 + cc * 8); } }
            __syncthreads();
            const int tg0 = ch * 32 + F.wave * 4;
            peer::bf16x8 q0f[8];
            { const int r32 = F.lane & 31, hi5 = F.lane >> 5;
#pragma unroll
              for (int ks = 0; ks < 8; ++ks) q0f[ks] = *reinterpret_cast<const peer::bf16x8*>(QP + (size_t)(tg0 * 32 + r32) * 2048 + h * 256 + ks * 16 + hi5 * 8); }
            for (int i = 0; i < 4; ++i) peer::topk_task((const peer::bf16*)QP, (const char*)lds + RING_OFF, SSQ, RSTD, LE, LG, tg0 + i, h, F.lane, q0f, i < 3 ? tg0 + i + 1 : -1);
        }
        for (int t = gw; t < M; t += NGW) peer::quant_token((const peer::bf16*)XN, SSQ, XQ, HS, t, F.lane);
        GRID_BAR();
    }
    if (IN(7)) {
        const int xl = (int)blockIdx.x & 7, nwx = (F.G >> 3) * NWAVES, wx = ((int)blockIdx.x >> 3) * NWAVES + F.wave;
        REP(70) peer::expert_u_pass(XQ, U8, HS, SU, SV, LE, LG, PACK, xl, wx, nwx, F.lane, (char*)lds + RING_OFF + F.wave * 8192);
        GRID_BAR();
        if (PROBE_DUP == 71) peer::expert_v_pass(V8, PACK, (float*)QP, xl, wx, nwx, F.lane);
        peer::expert_v_pass(V8, PACK, out, xl, wx, nwx, F.lane);
    }
#undef IN
#undef GRID_BAR
}

extern "C" void kernel_launch(void* const* d_in, const int* in_sizes, int n_in, void* d_out, int out_size, void* d_ws, size_t ws_size, hipStream_t stream) {
    static int grid = 0;
    if (grid == 0) {
        if (n_in != 13 || in_sizes[0] != M * D || out_size != M * D || ws_size < WS_END) { fprintf(stderr, "kernel_launch: unexpected shapes (n_in %d, in0 %d, out %d, ws %zu); nothing launched\n", n_in, n_in > 0 ? in_sizes[0] : -1, out_size, ws_size); grid = -1; return; }
        int dev = 0, cus = 0, per_cu = 0;
        if (hipGetDevice(&dev) != hipSuccess || hipDeviceGetAttribute(&cus, hipDeviceAttributeMultiprocessorCount, dev) != hipSuccess) { grid = -1; return; }
        if (hipFuncSetAttribute((const void*)mega_fwd, hipFuncAttributeMaxDynamicSharedMemorySize, LDS_BYTES) != hipSuccess) { fprintf(stderr, "kernel_launch: hipFuncSetAttribute failed\n"); grid = -1; return; }
        if (hipOccupancyMaxActiveBlocksPerMultiprocessor(&per_cu, (const void*)mega_fwd, NWAVES * 64, LDS_BYTES) != hipSuccess || per_cu < 1) { fprintf(stderr, "kernel_launch: occupancy query reports %d workgroups per CU\n", per_cu); }
        (void)hipGetLastError();
        grid = cus;
    }
    if (grid < 0) return;
    if (hipMemsetAsync((char*)d_ws + WS_CTL, 0, CTL_ZERO_BYTES, stream) != hipSuccess) return;
    Args a{};
    for (int i = 0; i < 13; ++i) a.in[i] = (const float*)d_in[i];
    a.out = (float*)d_out; a.ws = (unsigned char*)d_ws; a.ph_lo = 0; a.ph_hi = 8;
    hipLaunchKernelGGL(mega_fwd, dim3(grid), dim3(NWAVES * 64), LDS_BYTES, stream, a);
}
```

```cpp
#include <hip/hip_runtime.h>
#include <hip/hip_bf16.h>
#include <cstdio>
#include <cstdint>
#include <cmath>
#ifndef PROFSEG
#define PROFSEG -1
#endif
#ifndef PROFBLK
#define PROFBLK 0
#endif
#if PROFSEG >= 0
#define PROF_ARGS , unsigned long long& prof_acc, unsigned long long& prof_t
#define PROF_PASS , prof_acc, prof_t
#define PROF_MARK(seg) do { const unsigned long long n_ = __builtin_amdgcn_s_memrealtime(); if ((seg) == PROFSEG) prof_acc += n_ - prof_t; prof_t = n_; } while (0)
#define PROF_PHASE(k) do { const unsigned long long n_ = __builtin_amdgcn_s_memrealtime(); if (100 + (k) == PROFSEG) prof_acc += n_ - prof_pt; prof_pt = n_; } while (0)
#else
#define PROF_PHASE(k) do { } while (0)
#define PROF_ARGS
#define PROF_PASS
#define PROF_MARK(seg) do { } while (0)
#endif
namespace pg8 {
#define PG8_LAS __attribute__((address_space(3)))
typedef unsigned short bf16_t;
typedef short bf16x8 __attribute__((ext_vector_type(8)));
typedef float f32x4 __attribute__((ext_vector_type(4)));
typedef unsigned u32x4 __attribute__((ext_vector_type(4)));
constexpr int BM = 256, BK = 64, HALF = 128, HTB = HALF * BK * 2  , STAGE_BYTES = 8 * HTB, NXCD = 8, WGM = 8;

__host__ __device__ __forceinline__ int lds_byte(int r, int c) { const int st = (r >> 4) * 2 + (c >> 5), rr = r & 15, cc = c & 31, ob = rr * 64 + cc * 2; return st * 1024 + (ob ^ (((ob >> 9) & 1) << 5)); }
__host__ __device__ __forceinline__ void stage_rc(int b, int& R, int& C) { const int st = b / 1024, sb = b % 1024, swz = sb ^ (((sb >> 9) & 1) << 5); R = (st >> 1) * 16 + swz / 64; C = (st & 1) * 32 + (swz % 64) / 2; }
__host__ __device__ __forceinline__ int perm32(int rho) { const int n = rho >> 4, i = rho & 15; return 8 * (i >> 2) + 4 * n + (i & 3); }

struct Unit { int pm, pn; };
struct Gemm { const bf16_t* A; const bf16_t* Bt; int M, N, K; };

struct StaticOrder {
    int nM, nN, nwg, G, c;
    __host__ __device__ void init(int M, int N, int G_, int c_) { nM = M / BM; nN = N / BM; nwg = nM * nN; G = G_; c = c_; }
    __host__ __device__ bool next(int i, Unit& u) const {
        const long L = (long)i * G + c; if (L >= nwg) return false;
        int wgid = (int)L; { const int q = nwg / NXCD, r = nwg % NXCD, xcd = wgid % NXCD, off = wgid / NXCD; wgid = (xcd < r ? xcd * (q + 1) : r * (q + 1) + (xcd - r) * q) + off; }
        const int nig = WGM * nN, gid = wgid / nig, fm = gid * WGM, gsz = (nM - fm) < WGM ? (nM - fm) : WGM;
        u.pm = fm + ((wgid % nig) % gsz); u.pn = (wgid % nig) / gsz; return true;
    }
    __device__ __forceinline__ void a_ready(const Unit&) const {}
    __device__ __forceinline__ void done(const Unit&) const {}
};

__device__ __forceinline__ unsigned cvt_pk_bf16(float lo, float hi) { unsigned r; asm volatile("v_cvt_pk_bf16_f32 %0, %1, %2" : "=v"(r) : "v"(lo), "v"(hi)); return r; }
typedef unsigned u32x2 __attribute__((ext_vector_type(2)));

struct EpiBf16 {
    static constexpr bool PERM = true, AFTER_DRAIN = false;
    bf16_t* O; int ldc;
    __device__ __forceinline__ void operator()(const f32x4 (&acc)[2][2][4][2], const Unit& u, int wr, int wc, int fr, int fq) const {
        const int row0 = u.pm * BM + wr * 64 + fr; const int col0 = u.pn * BM + wc * 32 + 8 * fq;
#pragma unroll
        for (int ai = 0; ai < 2; ++ai)
#pragma unroll
            for (int m = 0; m < 4; ++m) { bf16_t* rowp = O + (size_t)(row0 + ai * HALF + m * 16) * ldc + col0;
#pragma unroll
                for (int bj = 0; bj < 2; ++bj) { const f32x4 v0 = acc[ai][bj][m][0], v1 = acc[ai][bj][m][1];
                    u32x4 w; w.x = cvt_pk_bf16(v0[0], v0[1]); w.y = cvt_pk_bf16(v0[2], v0[3]); w.z = cvt_pk_bf16(v1[0], v1[1]); w.w = cvt_pk_bf16(v1[2], v1[3]);
                    *(u32x4*)(rowp + bj * HALF) = w; } }
    }
};

struct EpiProj {
    static constexpr bool PERM = true, AFTER_DRAIN = false;
    bf16_t* P; const float *gmq, *gmk, *gdq, *gdk; float* kpart; float c2;
    __device__ __forceinline__ void operator()(const f32x4 (&acc)[2][2][4][2], const Unit& u, int wr, int wc, int fr, int fq) const {
        const int type = u.pn >> 1;
        const float* g = type == 0 ? gmq : type == 1 ? gmk : type == 3 ? gdq : type == 4 ? gdk : nullptr;
        const float sc0 = (type == 0 || type == 3) ? c2 : 1.f;
        f32x4 gv[2][2];
#pragma unroll
        for (int bj = 0; bj < 2; ++bj)
#pragma unroll
            for (int n = 0; n < 2; ++n) gv[bj][n] = g ? (*(const f32x4*)(g + 32 * bj + 8 * fq + 4 * n)) * sc0 : (f32x4){1.f, 1.f, 1.f, 1.f};
        f32x4 cs[2][2];
#pragma unroll
        for (int bj = 0; bj < 2; ++bj)
#pragma unroll
            for (int n = 0; n < 2; ++n) cs[bj][n] = (f32x4){0.f, 0.f, 0.f, 0.f};
        const int row0 = u.pm * BM + wr * 64 + fr; const int col0 = u.pn * BM + wc * 64 + 8 * fq;
#pragma unroll
        for (int ai = 0; ai < 2; ++ai)
#pragma unroll
            for (int m = 0; m < 4; ++m) {
                f32x4 v[2][2];
#pragma unroll
                for (int bj = 0; bj < 2; ++bj)
#pragma unroll
                    for (int n = 0; n < 2; ++n) v[bj][n] = acc[ai][bj][m][n];
                if (g) {
                    float ss = 0.f;
#pragma unroll
                    for (int bj = 0; bj < 2; ++bj)
#pragma unroll
                        for (int n = 0; n < 2; ++n) { const f32x4 x = v[bj][n]; ss += (x[0] * x[0] + x[1] * x[1]) + (x[2] * x[2] + x[3] * x[3]); }
                    ss += __shfl_xor(ss, 16); ss += __shfl_xor(ss, 32);
                    const float r = 1.0f / sqrtf(ss * (1.0f / 64.0f) + 1e-6f);
#pragma unroll
                    for (int bj = 0; bj < 2; ++bj)
#pragma unroll
                        for (int n = 0; n < 2; ++n) { v[bj][n] = v[bj][n] * r * gv[bj][n]; cs[bj][n] += v[bj][n]; }
                }
                bf16_t* rowp = P + (size_t)(row0 + ai * HALF + m * 16) * 3072 + col0;
#pragma unroll
                for (int bj = 0; bj < 2; ++bj) { const f32x4 v0 = v[bj][0], v1 = v[bj][1];
                    u32x4 w; w.x = cvt_pk_bf16(v0[0], v0[1]); w.y = cvt_pk_bf16(v0[2], v0[3]); w.z = cvt_pk_bf16(v1[0], v1[1]); w.w = cvt_pk_bf16(v1[2], v1[3]);
                    *(u32x4*)(rowp + bj * 32) = w; }
            }
        if (type == 1) {
#pragma unroll
            for (int bj = 0; bj < 2; ++bj)
#pragma unroll
                for (int n = 0; n < 2; ++n) { f32x4 c = cs[bj][n];
#pragma unroll
                    for (int o = 1; o < 16; o <<= 1) { c[0] += __shfl_xor(c[0], o); c[1] += __shfl_xor(c[1], o); c[2] += __shfl_xor(c[2], o); c[3] += __shfl_xor(c[3], o); }
                    if (fr == 0) *(f32x4*)(kpart + (size_t)(u.pm * 2 + wr) * 512 + (u.pn - 2) * 256 + wc * 64 + bj * 32 + fq * 8 + n * 4) = c; }
        }
    }
};

struct EpiOut {
    static constexpr bool PERM = false, AFTER_DRAIN = false;
    const float* x; float* out; bf16_t* xmb; float* ssq;
    __device__ __forceinline__ void operator()(const f32x4 (&acc)[2][2][4][2], const Unit& u, int wr, int wc, int fr, int fq) const {
        const int row0 = u.pm * BM + wr * 64 + fr; const int col0 = u.pn * BM + wc * 32 + 4 * fq;
#pragma unroll
        for (int ai = 0; ai < 2; ++ai)
#pragma unroll
            for (int m = 0; m < 4; ++m) { const int row = row0 + ai * HALF + m * 16; const size_t off = (size_t)row * 1024 + col0; float s = 0.f;
#pragma unroll
                for (int bj = 0; bj < 2; ++bj)
#pragma unroll
                    for (int n = 0; n < 2; ++n) { const f32x4 xv = *(const f32x4*)(x + off + bj * HALF + n * 16); const f32x4 y = xv + acc[ai][bj][m][n];
                        *(f32x4*)(out + off + bj * HALF + n * 16) = y; u32x2 w; w.x = cvt_pk_bf16(y[0], y[1]); w.y = cvt_pk_bf16(y[2], y[3]); *(u32x2*)(xmb + off + bj * HALF + n * 16) = w;
                        s += (y[0] * y[0] + y[1] * y[1]) + (y[2] * y[2] + y[3] * y[3]); }
                s += __shfl_xor(s, 16); s += __shfl_xor(s, 32);
                if (fq == 0) ssq[(size_t)row * 16 + u.pn * 4 + wc] = s;
                if (m & 1) asm volatile("" ::: "memory"); }
    }
};
template <class Epi, class Sched, bool ALIGN_EPI = false, bool SP2 = false>
__device__ __forceinline__ void gemm_phase(PG8_LAS unsigned char* lds, const Gemm g, const Sched& S, const Epi& E) {
    const int tid = threadIdx.x, wid = __builtin_amdgcn_readfirstlane(tid >> 6), lane = tid & 63, wr = wid >> 2, wc = wid & 3, fr = lane & 15, fq = lane >> 4;
    const int K = g.K, nt = K / BK;
    unsigned voffA[2], voffB[2];
#pragma unroll
    for (int i = 0; i < 2; ++i) { int R, C; stage_rc(tid * 16 + i * 8192, R, C); const int Rb = Epi::PERM ? ((R & ~31) + perm32(R & 31)) : R;
        voffA[i] = (unsigned)(R * K + C) * 2u; voffB[i] = (unsigned)(Rb * K + C) * 2u; }
    const size_t kstep = (size_t)(BK * 2);
    const size_t hstep = (size_t)HALF * K * 2;
    const size_t tstep = 2 * hstep;
    const unsigned ldsw = (unsigned)wid * 1024u;
    const int aoff = lds_byte(wr * 64 + fr, fq * 8), boff = lds_byte(wc * 32 + fr, fq * 8);
#define PG8_SA(b, h) (((b) * 2 + (h)) * HTB)
#define PG8_SB(b, h) ((4 + (b) * 2 + (h)) * HTB)
#define PG8_STAGE(bufoff, gbase, voff) do { _Pragma("unroll") for (int _i = 0; _i < 2; ++_i) \
        __builtin_amdgcn_global_load_lds((const unsigned*)((const char*)(gbase) + (voff)[_i]), (PG8_LAS unsigned*)(lds + (bufoff) + ldsw + _i * 8192), 16, 0, 0); } while (0)
#define PG8_LDA(dst, b, h) do { _Pragma("unroll") for (int m = 0; m < 4; ++m) _Pragma("unroll") for (int k = 0; k < 2; ++k) dst[m][k] = *(const PG8_LAS bf16x8*)(lds + PG8_SA(b, h) + aoff + m * 2048 + k * 1024); } while (0)
#define PG8_LDB(dst, b, h) do { _Pragma("unroll") for (int n = 0; n < 2; ++n) _Pragma("unroll") for (int k = 0; k < 2; ++k) dst[n][k] = *(const PG8_LAS bf16x8*)(lds + PG8_SB(b, h) + boff + n * 2048 + k * 1024); } while (0)
#define PG8_MMA(ai, bj, At, Bt) do { __builtin_amdgcn_s_setprio(1); _Pragma("unroll") for (int m = 0; m < 4; ++m) _Pragma("unroll") for (int n = 0; n < 2; ++n) _Pragma("unroll") for (int k = 0; k < 2; ++k) \
        acc[ai][bj][m][n] = __builtin_amdgcn_mfma_f32_16x16x32_bf16(Bt[n][k], At[m][k], acc[ai][bj][m][n], 0, 0, 0); __builtin_amdgcn_s_setprio(0); } while (0)
#define PG8_WAIT_V(n) asm volatile("s_waitcnt vmcnt(" #n ")" ::: "memory")
#define PG8_WAIT_L(n) asm volatile("s_waitcnt lgkmcnt(" #n ")" ::: "memory")
#define PG8_BAR __builtin_amdgcn_s_barrier()
#define PG8_SCHED __builtin_amdgcn_sched_barrier(0)
    Unit cur, nxt; int ui = 0;
    if (!S.next(0, cur)) return;
    f32x4 acc[2][2][4][2];
#pragma unroll
    for (int a = 0; a < 2; ++a)
#pragma unroll
        for (int b = 0; b < 2; ++b)
#pragma unroll
            for (int m = 0; m < 4; ++m)
#pragma unroll
                for (int n = 0; n < 2; ++n) acc[a][b][m][n] = (f32x4){0.f, 0.f, 0.f, 0.f};
    bf16x8 At[4][2], B0[2][2], B1[2][2];
    const char* cA = (const char*)g.A + (size_t)cur.pm * tstep; const char* cB = (const char*)g.Bt + (size_t)cur.pn * tstep;
    S.a_ready(cur);
    if constexpr (SP2) {
        PG8_STAGE(PG8_SB(0, 0), cB, voffB); PG8_STAGE(PG8_SB(0, 1), cB + hstep, voffB); PG8_STAGE(PG8_SA(0, 0), cA, voffA); PG8_STAGE(PG8_SA(0, 1), cA + hstep, voffA);
        if (wr == 1) PG8_BAR;
        PG8_WAIT_V(2); PG8_BAR;
        PG8_STAGE(PG8_SB(1, 0), cB + kstep, voffB); PG8_STAGE(PG8_SA(1, 0), cA + kstep, voffA); PG8_STAGE(PG8_SB(1, 1), cB + hstep + kstep, voffB);
        PG8_WAIT_V(6); PG8_BAR;
    } else {
        PG8_STAGE(PG8_SB(0, 0), cB, voffB); PG8_STAGE(PG8_SA(0, 0), cA, voffA); PG8_STAGE(PG8_SB(0, 1), cB + hstep, voffB); PG8_STAGE(PG8_SA(0, 1), cA + hstep, voffA);
        if (wr == 1) PG8_BAR;
        PG8_WAIT_V(4); PG8_BAR;
        PG8_STAGE(PG8_SB(1, 0), cB + kstep, voffB); PG8_STAGE(PG8_SA(1, 0), cA + kstep, voffA); PG8_STAGE(PG8_SB(1, 1), cB + hstep + kstep, voffB);
        PG8_WAIT_V(6); PG8_BAR;
    }
    for (;;) {
        const bool has_next = S.next(ui + 1, nxt);
        const char* nA = has_next ? (const char*)g.A + (size_t)nxt.pm * tstep : cA; const char* nB = has_next ? (const char*)g.Bt + (size_t)nxt.pn * tstep : cB;
        for (int t = 0; t < nt; t += 2) {
            const bool last = (t == nt - 2);
            const char* a1 = cA + (size_t)(t + 1) * kstep;
            const char* a2 = last ? nA : cA + (size_t)(t + 2) * kstep; const char* b2 = last ? nB : cB + (size_t)(t + 2) * kstep;
            const char* a3 = a2 + kstep; const char* b3 = b2 + kstep;
            if (last && has_next) S.a_ready(nxt);
            if constexpr (SP2) {
            PG8_LDB(B0, 0, 0); PG8_LDB(B1, 0, 1); PG8_SCHED; PG8_LDA(At, 0, 0); PG8_STAGE(PG8_SA(1, 1), a1 + hstep, voffA);
            PG8_WAIT_V(8); PG8_WAIT_L(0); PG8_BAR; PG8_MMA(0, 0, At, B0); PG8_MMA(0, 1, At, B1); PG8_BAR; PG8_SCHED;
            PG8_LDA(At, 0, 1); PG8_STAGE(PG8_SB(0, 0), b2, voffB); PG8_STAGE(PG8_SB(0, 1), b2 + hstep, voffB); PG8_STAGE(PG8_SA(0, 0), a2, voffA);
            PG8_WAIT_V(8); PG8_WAIT_L(0); PG8_BAR; PG8_MMA(1, 0, At, B0); PG8_MMA(1, 1, At, B1); PG8_BAR; PG8_SCHED;
            PG8_LDB(B0, 1, 0); PG8_LDB(B1, 1, 1); PG8_SCHED; PG8_LDA(At, 1, 0); PG8_STAGE(PG8_SA(0, 1), a2 + hstep, voffA);
            PG8_WAIT_V(8); PG8_WAIT_L(0); PG8_BAR; PG8_MMA(0, 0, At, B0); PG8_MMA(0, 1, At, B1); PG8_BAR; PG8_SCHED;
            PG8_LDA(At, 1, 1); PG8_STAGE(PG8_SB(1, 0), b3, voffB); PG8_STAGE(PG8_SB(1, 1), b3 + hstep, voffB); PG8_STAGE(PG8_SA(1, 0), a3, voffA);
            PG8_WAIT_V(8); PG8_WAIT_L(0); PG8_BAR; PG8_MMA(1, 0, At, B0); PG8_MMA(1, 1, At, B1); PG8_BAR; PG8_SCHED;
            } else {
            PG8_LDB(B0, 0, 0); PG8_SCHED; PG8_LDA(At, 0, 0); PG8_STAGE(PG8_SA(1, 1), a1 + hstep, voffA);
            PG8_WAIT_L(8); PG8_BAR; PG8_WAIT_L(0); PG8_MMA(0, 0, At, B0); PG8_BAR; PG8_SCHED;
            PG8_LDB(B1, 0, 1); PG8_STAGE(PG8_SB(0, 0), b2, voffB);
            PG8_BAR; PG8_WAIT_L(0); PG8_MMA(0, 1, At, B1); PG8_BAR;
            PG8_LDA(At, 0, 1); PG8_STAGE(PG8_SA(0, 0), a2, voffA);
            PG8_BAR; PG8_WAIT_L(0); PG8_MMA(1, 0, At, B0); PG8_BAR; PG8_SCHED;
            PG8_STAGE(PG8_SB(0, 1), b2 + hstep, voffB);
            PG8_WAIT_V(6); PG8_BAR; PG8_MMA(1, 1, At, B1); PG8_BAR;
            PG8_LDB(B0, 1, 0); PG8_SCHED; PG8_LDA(At, 1, 0); PG8_STAGE(PG8_SA(0, 1), a2 + hstep, voffA);
            PG8_WAIT_L(8); PG8_BAR; PG8_WAIT_L(0); PG8_MMA(0, 0, At, B0); PG8_BAR; PG8_SCHED;
            PG8_LDB(B1, 1, 1); PG8_STAGE(PG8_SB(1, 0), b3, voffB);
            PG8_BAR; PG8_WAIT_L(0); PG8_MMA(0, 1, At, B1); PG8_BAR;
            PG8_LDA(At, 1, 1); PG8_STAGE(PG8_SA(1, 0), a3, voffA);
            PG8_BAR; PG8_WAIT_L(0); PG8_MMA(1, 0, At, B0); PG8_BAR; PG8_SCHED;
            PG8_STAGE(PG8_SB(1, 1), b3 + hstep, voffB);
            PG8_WAIT_V(6); PG8_BAR; PG8_MMA(1, 1, At, B1); PG8_BAR;
            }
        }
        if constexpr (ALIGN_EPI) { if (wr == 0) PG8_BAR; }
        if constexpr (!Epi::AFTER_DRAIN) { E(acc, cur, wr, wc, fr, fq); S.done(cur); }
        if (!has_next) break;
#pragma unroll
        for (int a = 0; a < 2; ++a)
#pragma unroll
            for (int b = 0; b < 2; ++b)
#pragma unroll
                for (int m = 0; m < 4; ++m)
#pragma unroll
                    for (int n = 0; n < 2; ++n) acc[a][b][m][n] = (f32x4){0.f, 0.f, 0.f, 0.f};
        cur = nxt; cA = nA; cB = nB; ++ui;
        if constexpr (ALIGN_EPI) { if (wr == 1) PG8_BAR; }
    }
    PG8_WAIT_V(0);
    if constexpr (!ALIGN_EPI) { if (wr == 0) PG8_BAR; }
    PG8_BAR;
    if constexpr (Epi::AFTER_DRAIN) { E.fused(acc, cur, wr, wc, fr, fq, lds, wid, lane); S.done(cur); }
#undef PG8_SA
#undef PG8_SB
#undef PG8_STAGE
#undef PG8_LDA
#undef PG8_LDB
#undef PG8_MMA
#undef PG8_WAIT_V
#undef PG8_WAIT_L
#undef PG8_BAR
#undef PG8_SCHED
}
}
namespace att {
using bf16 = __hip_bfloat16;
using bf16x8 = __attribute__((ext_vector_type(8))) short;
using s16x4 = __attribute__((ext_vector_type(4))) short;
using f32x16 = __attribute__((ext_vector_type(16))) float;
using u32x4 = __attribute__((ext_vector_type(4))) unsigned;
constexpr int PITCH = 3072, QB = 256, KVBLK = 64, NW = 8;
constexpr int SLOTB = 8192, VSLOTB = 16384, LDS_K = 0, LDS_V = 2 * SLOTB, LDS_WS = LDS_V + 2 * VSLOTB, LDS_OST = LDS_WS + NW * 64 * 4, LDS_BYTES = LDS_OST + NW * 8192;
__device__ __forceinline__ int crow(int r, int hi) { return (r & 3) + 8 * (r >> 2) + 4 * hi; }
typedef float f32x2_t __attribute__((ext_vector_type(2))); typedef __bf16 bf16x2_t __attribute__((ext_vector_type(2)));
__device__ __forceinline__ unsigned cvtpk_s(float lo, float hi) { f32x2_t v = {lo, hi}; bf16x2_t b = __builtin_convertvector(v, bf16x2_t); return __builtin_bit_cast(unsigned, b); }

__device__ __forceinline__ void qkt(f32x16& p0, f32x16& p1, const char* Kslot, const bf16x8* qr, const f32x16& c0, const f32x16& c1, int r32, int hi) {
  const char* kb = Kslot + hi * 1024 + r32 * 16;
#pragma unroll
  for (int d0 = 0; d0 < 4; ++d0) {
    const bf16x8 b0 = *reinterpret_cast<const bf16x8*>(kb + d0 * 2048);
    const bf16x8 b1 = *reinterpret_cast<const bf16x8*>(kb + d0 * 2048 + 512);
    if (d0 == 0) { p0 = __builtin_amdgcn_mfma_f32_32x32x16_bf16(b0, qr[0], c0, 0, 0, 0); p1 = __builtin_amdgcn_mfma_f32_32x32x16_bf16(b1, qr[0], c1, 0, 0, 0); }
    else { p0 = __builtin_amdgcn_mfma_f32_32x32x16_bf16(b0, qr[d0], p0, 0, 0, 0); p1 = __builtin_amdgcn_mfma_f32_32x32x16_bf16(b1, qr[d0], p1, 0, 0, 0); } }
}
template <int NDB> __device__ __forceinline__ void pv(f32x16* o, int vb, bf16x8 pa0, bf16x8 pa1, bf16x8 pa2, bf16x8 pa3) {
#pragma unroll
  for (int d0 = 0; d0 < NDB; ++d0) { s16x4 lo[4], hi[4];
#pragma unroll
    for (int ks = 0; ks < 4; ++ks) {
      asm volatile("ds_read_b64_tr_b16 %0,%1 offset:%c2" : "=&v"(lo[ks]) : "v"(vb), "i"(d0 * 4096 + ks * 1024) : "memory");
      asm volatile("ds_read_b64_tr_b16 %0,%1 offset:%c2" : "=&v"(hi[ks]) : "v"(vb), "i"(d0 * 4096 + ks * 1024 + 512) : "memory"); }
    asm volatile("s_waitcnt lgkmcnt(0)" ::: "memory"); __builtin_amdgcn_sched_barrier(0);
#define PK(k) (bf16x8){lo[k][0], lo[k][1], lo[k][2], lo[k][3], hi[k][0], hi[k][1], hi[k][2], hi[k][3]}
    o[d0] = __builtin_amdgcn_mfma_f32_32x32x16_bf16(pa0, PK(0), o[d0], 0, 0, 0);
    o[d0] = __builtin_amdgcn_mfma_f32_32x32x16_bf16(pa1, PK(1), o[d0], 0, 0, 0);
    o[d0] = __builtin_amdgcn_mfma_f32_32x32x16_bf16(pa2, PK(2), o[d0], 0, 0, 0);
    o[d0] = __builtin_amdgcn_mfma_f32_32x32x16_bf16(pa3, PK(3), o[d0], 0, 0, 0);
#undef PK
  }
}
struct UnitDesc { const bf16* Q; const bf16* K; const bf16* V; bf16* O; float slope2; int nb; int moba; const float* kpart; float dmin; float bnd; };
template <int DV> __device__ __forceinline__ void attn_unit(const UnitDesc& U, char* shm PROF_ARGS) {
  PROF_MARK(19);
  constexpr int NDB = DV / 32;
  const int tid = threadIdx.x, lane = tid & 63, r32 = lane & 31, hi = lane >> 5; const int wid = __builtin_amdgcn_readfirstlane(tid >> 6);
  const int nb = U.nb, q0 = nb * QB;
  const bf16* Qw = U.Q + (long)(q0 + wid * 32) * PITCH;
  const unsigned lds0 = (unsigned)(uintptr_t)shm;
  float* wsf = (float*)(shm + LDS_WS) + wid * 64;
  bf16x8 qr[4];
#pragma unroll
  for (int d0 = 0; d0 < 4; ++d0) qr[d0] = *reinterpret_cast<const bf16x8*>(&Qw[(long)r32 * PITCH + d0 * 16 + hi * 8]);
  unsigned sel = 0xffu;
  if (U.moba) {
    float g[4] = {0.f, 0.f, 0.f, 0.f};
    const bf16* qrow = Qw + (long)r32 * PITCH;
    for (int c = 0; c < 8; ++c) {
      const u32x4 qv = *reinterpret_cast<const u32x4*>(qrow + c * 8);
      float qf[8];
#pragma unroll
      for (int i = 0; i < 4; ++i) { qf[2 * i] = __uint_as_float(qv[i] << 16); qf[2 * i + 1] = __uint_as_float(qv[i] & 0xffff0000u); }
#pragma unroll
      for (int j = 0; j < 4; ++j) { const int n = 4 * hi + j;
        if (n < nb) { const float* k0 = U.kpart + (size_t)(n * 2) * 512 + c * 8; const float* k1 = k0 + 512;
#pragma unroll
          for (int i = 0; i < 8; ++i) g[j] += qf[i] * (k0[i] + k1[i]); } }
    }
    float ga[8];
#pragma unroll
    for (int j = 0; j < 4; ++j) { const float o = __shfl_xor(g[j], 32); ga[j] = hi ? o : g[j]; ga[4 + j] = hi ? g[j] : o; }
    sel = 0u;
#pragma unroll
    for (int n = 0; n < 8; ++n) { int rank = 0;
#pragma unroll
      for (int m = 0; m < 8; ++m) if (m != n) rank += (m < nb && (ga[m] > ga[n] || (ga[m] == ga[n] && m < n))) ? 1 : 0;
      if (n < nb && rank < 3) sel |= (1u << n); }
  }
  PROF_MARK(10);
  const int NT = 4 * (nb + 1);
  int ts = (int)floorf(((float)q0 - 63.f - U.dmin) * (1.0f / 64.0f)) + 1; ts = ts < 0 ? 0 : (ts > NT - 4 ? NT - 4 : ts);
  float mref = -U.bnd, lrun = 0.f; f32x16 o[NDB];
#pragma unroll
  for (int d = 0; d < NDB; ++d) o[d] = f32x16{};
  const int qrel = wid * 32 + r32;
  const bf16* ksrc = U.K + (long)lane * PITCH + wid * 8;
  const bf16* vsrc = U.V + (long)(16 * (wid & 3) + (lane >> 2)) * PITCH + (wid >> 2) * 32 + (lane & 3) * 8;
  char* kdst = shm + LDS_K + wid * 1024 + lane * 16; char* vdst = shm + LDS_V + wid * 1024 + lane * 16;
  const int vb0 = (int)(lds0 + LDS_V) + ((lane >> 4) & 1) * 32 + (lane & 3) * 8 + (4 * hi + ((lane & 15) >> 2)) * 64;
  u32x4 kreg = *reinterpret_cast<const u32x4*>(ksrc + (long)ts * KVBLK * PITCH), vreg = *reinterpret_cast<const u32x4*>(vsrc + (long)ts * KVBLK * PITCH), vreg2 = vreg;
  if (DV == 128) vreg2 = *reinterpret_cast<const u32x4*>(vsrc + (long)ts * KVBLK * PITCH + 64);
  const float s2 = U.slope2, s2x64 = 64.f * s2;
  f32x16 cb0, cb1;
#define ATT_REBUILD(T_) do { const float base_ = s2 * (float)(64 * (T_) - q0 + 4 * hi) - mref; const bool on_ = ((T_) >= NT - 4) || (((sel >> ((T_) >> 2)) & 1u) != 0u); \
    _Pragma("unroll") for (int r = 0; r < 16; ++r) { const float v_ = base_ + s2 * (float)((r & 3) + 8 * (r >> 2)); cb0[r] = on_ ? v_ : -INFINITY; cb1[r] = on_ ? v_ + 32.f * s2 : -INFINITY; } } while (0)
  ATT_REBUILD(ts);
  for (int t = ts; t < NT; ++t) {
    const int slot = (t & 1) * SLOTB, vslot = (t & 1) * VSLOTB;
    *reinterpret_cast<u32x4*>(kdst + slot) = kreg; *reinterpret_cast<u32x4*>(vdst + vslot) = vreg; if (DV == 128) *reinterpret_cast<u32x4*>(vdst + vslot + 8192) = vreg2;
    PROF_MARK(11);
    __syncthreads();
    PROF_MARK(12);
    if (t + 1 < NT) { kreg = *reinterpret_cast<const u32x4*>(ksrc + (long)(t + 1) * KVBLK * PITCH); vreg = *reinterpret_cast<const u32x4*>(vsrc + (long)(t + 1) * KVBLK * PITCH);
      if (DV == 128) vreg2 = *reinterpret_cast<const u32x4*>(vsrc + (long)(t + 1) * KVBLK * PITCH + 64); }
    f32x16 p0, p1; qkt(p0, p1, shm + LDS_K + slot, qr, cb0, cb1, r32, hi);
    PROF_MARK(13);
    const int jb = t - (NT - 4);
    if (jb >= 0) { const int kb = 64 * jb + 4 * hi;
#pragma unroll
      for (int r = 0; r < 16; ++r) { const int kv = kb + (r & 3) + 8 * (r >> 2); if (kv > qrel) p0[r] = -INFINITY; if (kv + 32 > qrel) p1[r] = -INFINITY; } }
    float rm = fmaxf(p0[0], p1[0]);
#pragma unroll
    for (int r = 1; r < 16; ++r) rm = fmaxf(rm, fmaxf(p0[r], p1[r]));
    rm = fmaxf(rm, __shfl_xor(rm, 32));
    bool resc = false;
    if (__any(rm > 8.0f)) { const float dl = fmaxf(rm, 0.f); mref += dl;
#pragma unroll
      for (int r = 0; r < 16; ++r) { p0[r] -= dl; p1[r] -= dl; cb0[r] -= dl; cb1[r] -= dl; }
      const float f = __builtin_amdgcn_exp2f(-dl); lrun *= f; if (hi == 0) wsf[r32] = f; resc = true; }
    float ps = 0.f;
#pragma unroll
    for (int r = 0; r < 16; ++r) { p0[r] = __builtin_amdgcn_exp2f(p0[r]); p1[r] = __builtin_amdgcn_exp2f(p1[r]); ps += p0[r] + p1[r]; }
    lrun += ps;
    u32x4 pw0, pw1, pw2, pw3;
#pragma unroll
    for (int i = 0; i < 4; ++i) { pw0[i] = cvtpk_s(p0[2 * i], p0[2 * i + 1]); pw1[i] = cvtpk_s(p0[8 + 2 * i], p0[9 + 2 * i]); pw2[i] = cvtpk_s(p1[2 * i], p1[2 * i + 1]); pw3[i] = cvtpk_s(p1[8 + 2 * i], p1[9 + 2 * i]); }
    PROF_MARK(14);
    if (resc) { asm volatile("s_waitcnt lgkmcnt(0)" ::: "memory");
#pragma unroll
      for (int r = 0; r < 16; ++r) { const float fr_ = wsf[crow(r, hi)];
#pragma unroll
        for (int d = 0; d < NDB; ++d) o[d][r] *= fr_; } }
    pv<NDB>(o, vb0 + vslot, __builtin_bit_cast(bf16x8, pw0), __builtin_bit_cast(bf16x8, pw1), __builtin_bit_cast(bf16x8, pw2), __builtin_bit_cast(bf16x8, pw3));
    PROF_MARK(15);
    if (((t + 1) & 3) == 0) { if (t + 1 < NT) ATT_REBUILD(t + 1); }
    else {
#pragma unroll
      for (int r = 0; r < 16; ++r) { cb0[r] += s2x64; cb1[r] += s2x64; } }
  }
#undef ATT_REBUILD
  PROF_MARK(16);
  lrun += __shfl_xor(lrun, 32);
  if (hi == 0) wsf[32 + r32] = lrun;
  asm volatile("s_waitcnt lgkmcnt(0)" ::: "memory");
  float rli[16];
#pragma unroll
  for (int r = 0; r < 16; ++r) rli[r] = 1.0f / wsf[32 + crow(r, hi)];
  bf16* Ow = U.O + (long)(q0 + wid * 32) * 1024;
  { bf16* stg = (bf16*)(shm + LDS_OST) + wid * 4096;
#pragma unroll
    for (int r = 0; r < 16; ++r) { const int orow = crow(r, hi);
#pragma unroll
      for (int d0 = 0; d0 < NDB; ++d0) stg[orow * DV + d0 * 32 + r32] = __float2bfloat16(o[d0][r] * rli[r]); }
    asm volatile("s_waitcnt lgkmcnt(0)" ::: "memory");
    constexpr int CPR = DV / 8, RPI = 64 / CPR;
#pragma unroll
    for (int i = 0; i < 32 / RPI; ++i) { const int row = i * RPI + lane / CPR, ch = lane % CPR; const u32x4 v = *(const u32x4*)(stg + row * DV + ch * 8); *(u32x4*)(Ow + (long)row * 1024 + ch * 8) = v; } }
  asm volatile("s_waitcnt lgkmcnt(0)" ::: "memory");
  __syncthreads();
  PROF_MARK(17);
}
}
namespace peer {
using bf16 = __hip_bfloat16;
using bf16x8 = __attribute__((ext_vector_type(8))) short;
using f32x16 = __attribute__((ext_vector_type(16))) float;
using u32x4 = __attribute__((ext_vector_type(4))) unsigned;
__device__ __forceinline__ int crow(int r, int hi) { return (r & 3) + 8 * (r >> 2) + 4 * hi; }
__device__ __forceinline__ int f2key(float f) { const int b = __float_as_int(f); return b ^ ((b >> 31) & 0x7fffffff); }
__device__ __forceinline__ float key2f(int k) { return __int_as_float(k ^ ((k >> 31) & 0x7fffffff)); }
__device__ __forceinline__ void ins16(int (&L)[16], int v) {
#pragma unroll
  for (int i = 0; i < 16; ++i) { const int a = L[i]; L[i] = a > v ? a : v; v = a > v ? v : a; }
}
#define PEER_CE(A_, B_) do { const int a_ = (A_), b_ = (B_); (A_) = a_ > b_ ? a_ : b_; (B_) = a_ > b_ ? b_ : a_; } while (0)
#define PEER_SORT16(V) do { PEER_CE(V[0], V[1]); PEER_CE(V[3], V[2]); PEER_CE(V[4], V[5]); PEER_CE(V[7], V[6]); PEER_CE(V[8], V[9]); PEER_CE(V[11], V[10]); PEER_CE(V[12], V[13]); PEER_CE(V[15], V[14]); PEER_CE(V[0], V[2]); PEER_CE(V[1], V[3]); PEER_CE(V[6], V[4]); PEER_CE(V[7], V[5]); PEER_CE(V[8], V[10]); PEER_CE(V[9], V[11]); PEER_CE(V[14], V[12]); PEER_CE(V[15], V[13]); PEER_CE(V[0], V[1]); PEER_CE(V[2], V[3]); PEER_CE(V[5], V[4]); PEER_CE(V[7], V[6]); PEER_CE(V[8], V[9]); PEER_CE(V[10], V[11]); PEER_CE(V[13], V[12]); PEER_CE(V[15], V[14]); PEER_CE(V[0], V[4]); PEER_CE(V[1], V[5]); PEER_CE(V[2], V[6]); PEER_CE(V[3], V[7]); PEER_CE(V[12], V[8]); PEER_CE(V[13], V[9]); PEER_CE(V[14], V[10]); PEER_CE(V[15], V[11]); PEER_CE(V[0], V[2]); PEER_CE(V[1], V[3]); PEER_CE(V[4], V[6]); PEER_CE(V[5], V[7]); PEER_CE(V[10], V[8]); PEER_CE(V[11], V[9]); PEER_CE(V[14], V[12]); PEER_CE(V[15], V[13]); PEER_CE(V[0], V[1]); PEER_CE(V[2], V[3]); PEER_CE(V[4], V[5]); PEER_CE(V[6], V[7]); PEER_CE(V[9], V[8]); PEER_CE(V[11], V[10]); PEER_CE(V[13], V[12]); PEER_CE(V[15], V[14]); PEER_CE(V[0], V[8]); PEER_CE(V[1], V[9]); PEER_CE(V[2], V[10]); PEER_CE(V[3], V[11]); PEER_CE(V[4], V[12]); PEER_CE(V[5], V[13]); PEER_CE(V[6], V[14]); PEER_CE(V[7], V[15]); PEER_CE(V[0], V[4]); PEER_CE(V[1], V[5]); PEER_CE(V[2], V[6]); PEER_CE(V[3], V[7]); PEER_CE(V[8], V[12]); PEER_CE(V[9], V[13]); PEER_CE(V[10], V[14]); PEER_CE(V[11], V[15]); PEER_CE(V[0], V[2]); PEER_CE(V[1], V[3]); PEER_CE(V[4], V[6]); PEER_CE(V[5], V[7]); PEER_CE(V[8], V[10]); PEER_CE(V[9], V[11]); PEER_CE(V[12], V[14]); PEER_CE(V[13], V[15]); PEER_CE(V[0], V[1]); PEER_CE(V[2], V[3]); PEER_CE(V[4], V[5]); PEER_CE(V[6], V[7]); PEER_CE(V[8], V[9]); PEER_CE(V[10], V[11]); PEER_CE(V[12], V[13]); PEER_CE(V[14], V[15]); } while (0)
__device__ __forceinline__ void mergetop16(int (&L)[16], const int (&S)[16]) {
  int M[16];
#pragma unroll
  for (int i = 0; i < 16; ++i) M[i] = L[i] > S[15 - i] ? L[i] : S[15 - i];
#pragma unroll
  for (int s = 8; s >= 1; s >>= 1)
#pragma unroll
    for (int i = 0; i < 16; ++i) if ((i & s) == 0) PEER_CE(M[i], M[i + s]);
#pragma unroll
  for (int i = 0; i < 16; ++i) L[i] = M[i];
}
__device__ __forceinline__ void merge16(int (&L)[16]) {
  int S[16];
#pragma unroll
  for (int i = 0; i < 16; ++i) S[i] = __shfl_xor(L[i], 32);
  mergetop16(L, S);
}
#define PEER_CAND_LIST(X) \
  X(0,0,0, 2,1) X(1,0,1, 2,2) X(2,0,2, 2,3) X(3,0,3, 2,4) X(4,0,4, 3,0) X(5,0,5, 3,1) X(6,0,6, 3,2) X(7,0,7, 3,3) X(8,0,8, 4,0) X(9,0,9, 4,1) X(10,0,10, 4,2) X(11,0,11, 5,0) X(12,0,12, 5,1) X(13,0,13, 6,0) X(14,0,14, 6,1) X(15,0,15, 7,0) X(16,1,0, 7,1) X(17,1,1, 8,0) X(18,1,2, 9,0) X(19,1,3, 10,0) X(20,1,4, 11,0) X(21,1,5, 12,0) X(22,1,6, 13,0) X(23,1,7, 14,0) X(24,2,0, 15,0)

#define PEER_KROW 272
__device__ __forceinline__ void topk_task(const bf16* QP, const char* ksl, const float* ssq, float* RSTD, int* LE, float* LG, int tg, int h, int lane, bf16x8 (&q0f)[8], int tg_next) {
  const int r32 = lane & 31, hi = lane >> 5; const int t = tg * 32 + r32;
  int A[16], B[16];
  bf16x8 q1f[8];
#pragma unroll
  for (int ks = 0; ks < 8; ++ks) q1f[ks] = *reinterpret_cast<const bf16x8*>(QP + (size_t)t * 2048 + h * 256 + 128 + ks * 16 + hi * 8);
#pragma unroll
  for (int p = 0; p < 2; ++p) {
    int L[16];
#pragma unroll
    for (int i = 0; i < 16; ++i) L[i] = (int)0x80000000;
    const char* kb = ksl + p * (128 * PEER_KROW) + r32 * PEER_KROW + hi * 16;
#pragma unroll 1
    for (int i = 0; i < 4; ++i) {
      f32x16 acc = {};
#pragma unroll
      for (int ks = 0; ks < 8; ++ks) { const bf16x8 a = *reinterpret_cast<const bf16x8*>(kb + i * (32 * PEER_KROW) + ks * 32); acc = __builtin_amdgcn_mfma_f32_32x32x16_bf16(a, p == 0 ? q0f[ks] : q1f[ks], acc, 0, 0, 0); }
      int S[16];
#pragma unroll
      for (int r = 0; r < 16; ++r) S[r] = (f2key(acc[r]) & ~127) | (i * 32 + crow(r, hi));
      PEER_SORT16(S);
      mergetop16(L, S);
    }
    merge16(L);
#pragma unroll
    for (int i = 0; i < 16; ++i) { if (p == 0) A[i] = L[i]; else B[i] = L[i]; }
    if (p == 0 && tg_next >= 0) {
#pragma unroll
      for (int ks = 0; ks < 8; ++ks) q0f[ks] = *reinterpret_cast<const bf16x8*>(QP + (size_t)(tg_next * 32 + r32) * 2048 + h * 256 + ks * 16 + hi * 8); }
  }
  float Af[16], Bf[16];
#pragma unroll
  for (int i = 0; i < 16; ++i) { Af[i] = key2f(A[i] & ~127); Bf[i] = key2f(B[i] & ~127); }
  float C[25];
#define X(c, i0, j0, i1, j1) C[c] = hi ? (Af[i1] + Bf[j1]) : (Af[i0] + Bf[j0]);
  PEER_CAND_LIST(X)
#undef X
  int L[16];
#pragma unroll
  for (int i = 0; i < 16; ++i) L[i] = (int)0x80000000;
#pragma unroll
  for (int c = 0; c < 25; ++c) ins16(L, f2key(C[c]));
  merge16(L);
  const int tau = L[15]; const float cmax = Af[0] + Bf[0];
  float s = 0.f;
#pragma unroll
  for (int i = 0; i < 16; ++i) s += ssq[(size_t)t * 16 + i];
  const float rstd = 1.0f / sqrtf(s * (1.0f / 1024.0f) + 1e-6f);
  const float k2 = rstd * 1.4426950408889634f;
  if (h == 0 && hi == 0) RSTD[t] = rstd;
  float E[25]; float den = 0.f; int cnt = 0; unsigned selm = 0u;
#pragma unroll
  for (int c = 0; c < 25; ++c) { const bool sl = f2key(C[c]) >= tau; E[c] = sl ? __builtin_amdgcn_exp2f((C[c] - cmax) * k2) : 0.f; den += E[c]; cnt += sl ? 1 : 0; selm |= sl ? (1u << c) : 0u; }
  den += __shfl_xor(den, 32);
  const int ocnt = __shfl_xor(cnt, 32);
  int pos = hi ? ocnt : 0;
  const float rden = 1.0f / den;
  int* le = LE + (size_t)t * 128 + h * 16; float* lg = LG + (size_t)t * 128 + h * 16;
#define X(c, i0, j0, i1, j1) { if (((selm >> c) & 1u) && pos < 16) { const int ka = (hi ? A[i1] : A[i0]) & 127, kb2 = (hi ? B[j1] : B[j0]) & 127; le[pos] = ka * 128 + kb2; lg[pos] = E[c] * rden; ++pos; } }
  PEER_CAND_LIST(X)
#undef X
}

__device__ __forceinline__ float gelu_erf(float v) { return 0.5f * v * (1.0f + erff(v * 0.70710678118654752f)); }
__device__ __forceinline__ void unpack8(const u32x4 w, float (&f)[8]) {
#pragma unroll
  for (int i = 0; i < 4; ++i) { f[2 * i] = __uint_as_float(w[i] << 16); f[2 * i + 1] = __uint_as_float(w[i] & 0xffff0000u); }
}
#define PEER_DPP(v, ctrl, rmask) __int_as_float(__builtin_amdgcn_update_dpp(0, __float_as_int(v), ctrl, rmask, 0xf, false))
__device__ __forceinline__ float wave_total(float v) {
  v += PEER_DPP(v, 0xB1, 0xf);
  v += PEER_DPP(v, 0x4E, 0xf);
  v += PEER_DPP(v, 0x141, 0xf);
  v += PEER_DPP(v, 0x140, 0xf);
  v += PEER_DPP(v, 0x142, 0xa);
  v += PEER_DPP(v, 0x143, 0xc);
  return __int_as_float(__builtin_amdgcn_readlane(__float_as_int(v), 63));
}
typedef float f32x4_t __attribute__((ext_vector_type(4)));
typedef float f32x2_t __attribute__((ext_vector_type(2)));
__device__ __forceinline__ float ub0(unsigned w) { return (float)(w & 255u); }
__device__ __forceinline__ float ub1(unsigned w) { return (float)((w >> 8) & 255u); }
__device__ __forceinline__ float ub2(unsigned w) { return (float)((w >> 16) & 255u); }
__device__ __forceinline__ float ub3(unsigned w) { return (float)(w >> 24); }
#define PEER_DPPI(v, ctrl, rmask) __builtin_amdgcn_update_dpp(0, v, ctrl, rmask, 0xf, false)
__device__ __forceinline__ int wave_total_i(int v) {
  v += PEER_DPPI(v, 0xB1, 0xf); v += PEER_DPPI(v, 0x4E, 0xf); v += PEER_DPPI(v, 0x141, 0xf); v += PEER_DPPI(v, 0x140, 0xf); v += PEER_DPPI(v, 0x142, 0xa); v += PEER_DPPI(v, 0x143, 0xc);
  return __builtin_amdgcn_readlane(v, 63);
}
__device__ __forceinline__ float quant_row16(const float (&v)[16], unsigned char* dst16  , int bias) {
  float m = 0.f;
#pragma unroll
  for (int i = 0; i < 16; ++i) m = fmaxf(m, fabsf(v[i]));
#pragma unroll
  for (int o = 1; o < 64; o <<= 1) m = fmaxf(m, __shfl_xor(m, o));
  const float inv = m > 0.f ? 127.0f / m : 0.f;
  u32x4 w;
#pragma unroll
  for (int q = 0; q < 4; ++q) { unsigned x = 0u;
#pragma unroll
    for (int i = 0; i < 4; ++i) { const int qi = (int)rintf(v[4 * q + i] * inv) + bias; x |= ((unsigned)qi & 255u) << (8 * i); }
    w[q] = x; }
  *reinterpret_cast<u32x4*>(dst16) = w;
  return m * (1.0f / 127.0f);
}
#define PEER_UFETCH(G_) do { const size_t tb_ = (size_t)(G_) * 4; _Pragma("unroll") for (int j = 0; j < 4; ++j) { \
    e0[j] = LE[(tb_ + j) * 128 + lane] & 16383; e1[j] = LE[(tb_ + j) * 128 + 64 + lane] & 16383; g0[j] = LG[(tb_ + j) * 128 + lane]; g1[j] = LG[(tb_ + j) * 128 + 64 + lane]; \
    xa[j] = *reinterpret_cast<const u32x4*>(XQ + (tb_ + j) * 1024 + lane * 16); } \
    rs4 = *reinterpret_cast<const f32x4_t*>(HS + tb_); } while (0)
__device__ __forceinline__ void expert_u_pass(const unsigned char* XQ, const unsigned char* U8, const float* HS, const float* SU, const float* SV, const int* LE, const float* LG, unsigned* PACK, int slice, int wx, int nwx, int lane, char* wl) {
  unsigned* list = (unsigned*)(wl + 4096);
  int e0[4], e1[4]; float g0[4], g1[4]; u32x4 xa[4]; f32x4_t rs4;
  int gi = wx;
  if (gi < 8192) PEER_UFETCH(gi);
  for (; gi < 8192; gi += nwx) {
    int n = 0;
    const f32x4_t rs = rs4;
#pragma unroll
    for (int j = 0; j < 4; ++j) {
      *reinterpret_cast<u32x4*>(wl + j * 1024 + lane * 16) = xa[j];
      { const bool in = (e0[j] >> 11) == slice; const unsigned long long m = __ballot(in);
        if (in) { const int pos = n + (int)__builtin_amdgcn_mbcnt_hi((unsigned)(m >> 32), __builtin_amdgcn_mbcnt_lo((unsigned)m, 0u)); list[2 * pos] = (unsigned)e0[j] | ((unsigned)lane << 14) | ((unsigned)j << 21); list[2 * pos + 1] = __float_as_uint(g0[j]); }
        n += __builtin_popcountll(m); }
      { const bool in = (e1[j] >> 11) == slice; const unsigned long long m = __ballot(in);
        if (in) { const int pos = n + (int)__builtin_amdgcn_mbcnt_hi((unsigned)(m >> 32), __builtin_amdgcn_mbcnt_lo((unsigned)m, 0u)); list[2 * pos] = (unsigned)e1[j] | ((unsigned)(64 + lane) << 14) | ((unsigned)j << 21); list[2 * pos + 1] = __float_as_uint(g1[j]); }
        n += __builtin_popcountll(m); }
    }
    n = __builtin_amdgcn_readfirstlane(n);
    const int gnext = gi + nwx;
#define PEER_UISSUE(UA_, WL_, GK_, SU_, SV_, B_) do { { const int i = ((B_) + (lane >> 2) < n) ? ((B_) + (lane >> 2)) : (n - 1); WL_ = list[2 * i]; GK_ = __uint_as_float(list[2 * i + 1]); } \
      _Pragma("unroll") for (int s = 0; s < 16; ++s) { const unsigned w = (unsigned)__builtin_amdgcn_readlane((int)WL_, 4 * s); \
        UA_[s] = *reinterpret_cast<const u32x4*>(U8 + (size_t)(w & 16383u) * 1024 + lane * 16); } \
      SU_ = SU[WL_ & 16383u]; SV_ = SV[WL_ & 16383u]; } while (0)
#define PEER_UCOMP(UA_, WL_, GK_, SU_, SV_, B_) do { int q[16]; \
      _Pragma("unroll") for (int s = 0; s < 16; ++s) { const unsigned js_ = ((unsigned)__builtin_amdgcn_readlane((int)WL_, 4 * s) >> 21) & 3u; const u32x4 xl = *reinterpret_cast<const u32x4*>(wl + js_ * 1024 + lane * 16); int q_ = 0; \
        _Pragma("unroll") for (int i = 0; i < 4; ++i) q_ = __builtin_amdgcn_sdot4((int)UA_[s][i], (int)xl[i], q_, false); q[s] = q_; if ((s & 3) == 3) __builtin_amdgcn_sched_barrier(0); } \
        \
      int r8[8], r4[4], r2[2], r1; \
      { const bool bb = (lane & 32) != 0; _Pragma("unroll") for (int i = 0; i < 8; ++i) { const int keep = bb ? q[8 + i] : q[i], send = bb ? q[i] : q[8 + i]; r8[i] = keep + __shfl_xor(send, 32); } } \
      { const bool bb = (lane & 16) != 0; _Pragma("unroll") for (int i = 0; i < 4; ++i) { const int keep = bb ? r8[4 + i] : r8[i], send = bb ? r8[i] : r8[4 + i]; r4[i] = keep + __shfl_xor(send, 16); } } \
      { const bool bb = (lane & 8) != 0; _Pragma("unroll") for (int i = 0; i < 2; ++i) { const int keep = bb ? r4[2 + i] : r4[i], send = bb ? r4[i] : r4[2 + i]; r2[i] = keep + __shfl_xor(send, 8); } } \
      { const bool bb = (lane & 4) != 0; const int keep = bb ? r2[1] : r2[0], send = bb ? r2[0] : r2[1]; r1 = keep + __shfl_xor(send, 4); } \
      r1 += PEER_DPPI(r1, 0xB1, 0xf); r1 += PEER_DPPI(r1, 0x4E, 0xf); \
      if ((lane & 3) == 0 && (B_) + (lane >> 2) < n) { const unsigned w = WL_; const float gk = GK_; const unsigned j = (w >> 21) & 3u; const unsigned e = w & 16383u; \
        const float r = j == 0 ? rs[0] : j == 1 ? rs[1] : j == 2 ? rs[2] : rs[3]; \
        const float a = gelu_erf((float)r1 * r * SU_) * gk * SV_; const unsigned ab = __float_as_uint(a); const unsigned rb = (ab + 0x7fffu + ((ab >> 16) & 1u)) & 0xffff0000u; \
        PACK[((size_t)gi * 4 + j) * 128 + ((w >> 14) & 127u)] = rb | e; } } while (0)
    if (gnext < 8192) PEER_UFETCH(gnext);
    if (n > 0) {
      u32x4 uA[16], uB[16]; unsigned wA, wB; float gA, gB, suA, svA, suB, svB;
      PEER_UISSUE(uA, wA, gA, suA, svA, 0);
      for (int b = 0; b < n; b += 32) {
        if (b + 16 < n) PEER_UISSUE(uB, wB, gB, suB, svB, b + 16);
        PEER_UCOMP(uA, wA, gA, suA, svA, b);
        if (b + 16 >= n) break;
        if (b + 32 < n) PEER_UISSUE(uA, wA, gA, suA, svA, b + 32);
        PEER_UCOMP(uB, wB, gB, suB, svB, b + 16);
      }
    }
  }
}
#define PEER_VISSUE(S_, A_, P0_, P1_) do { _Pragma("unroll") for (int i = 0; i < 16; ++i) { const unsigned pk = (unsigned)__builtin_amdgcn_ds_bpermute(((8 * i + g) & 63) << 2, (int)(i < 8 ? P0_ : P1_)); \
    A_[i] = __uint_as_float(pk & 0xffff0000u); S_[i] = *reinterpret_cast<const u32x4*>(V8 + (size_t)slice * (16384 * 128) + (size_t)(pk & 16383u) * 128 + c * 16); } } while (0)
#define PEER_VFINISH(S_, A_, T_, O_) do { float acc[16]; float asum = 0.f; _Pragma("unroll") for (int i = 0; i < 16; ++i) acc[i] = 0.f; \
    _Pragma("unroll") for (int i = 0; i < 16; ++i) { const float a_ = A_[i]; asum += a_; _Pragma("unroll") for (int q = 0; q < 4; ++q) { const unsigned w_ = S_[i][q]; \
        acc[4 * q] += a_ * ub0(w_); acc[4 * q + 1] += a_ * ub1(w_); acc[4 * q + 2] += a_ * ub2(w_); acc[4 * q + 3] += a_ * ub3(w_); } } \
    _Pragma("unroll") for (int i = 0; i < 16; ++i) acc[i] -= 128.f * asum; \
    float m8[8], m4[4], m2[2]; \
    { const bool bb = (g & 4) != 0; _Pragma("unroll") for (int i = 0; i < 8; ++i) { const float keep = bb ? acc[8 + i] : acc[i], send = bb ? acc[i] : acc[8 + i]; m8[i] = keep + __shfl_xor(send, 32); } } \
    { const bool bb = (g & 2) != 0; _Pragma("unroll") for (int i = 0; i < 4; ++i) { const float keep = bb ? m8[4 + i] : m8[i], send = bb ? m8[i] : m8[4 + i]; m4[i] = keep + __shfl_xor(send, 16); } } \
    { const bool bb = (g & 1) != 0; _Pragma("unroll") for (int i = 0; i < 2; ++i) { const float keep = bb ? m4[2 + i] : m4[i], send = bb ? m4[i] : m4[2 + i]; m2[i] = keep + __shfl_xor(send, 8); } } \
    f32x2_t r_ = (O_); r_[0] += m2[0]; r_[1] += m2[1]; *reinterpret_cast<f32x2_t*>(out + (size_t)(T_) * 1024 + slice * 128 + 16 * c + 2 * g) = r_; } while (0)
__device__ __forceinline__ void expert_v_pass(const unsigned char* V8, const unsigned* PACK, float* out, int slice, int wx, int nwx, int lane) {
  const int g = lane >> 3, c = lane & 7;
  const int MT = 32768;
  u32x4 sA[16], sB[16]; float aA[16], aB[16];
  unsigned pA0 = 0, pA1 = 0, pB0 = 0, pB1 = 0, pC0 = 0, pC1 = 0, pD0 = 0, pD1 = 0; f32x2_t oA = {0.f, 0.f}, oB = oA, oC = oA, oD = oA;
#define PEER_OLD(T_) (*reinterpret_cast<const f32x2_t*>(out + (size_t)(T_) * 1024 + slice * 128 + 16 * c + 2 * g))
#define PEER_VMETA(P0_, P1_, O_, T_) do { if ((T_) < MT) { P0_ = PACK[(size_t)(T_) * 128 + lane]; P1_ = PACK[(size_t)(T_) * 128 + 64 + lane]; O_ = PEER_OLD(T_); } } while (0)
  int t = wx;
  PEER_VMETA(pA0, pA1, oA, t); PEER_VMETA(pB0, pB1, oB, t + nwx); PEER_VMETA(pC0, pC1, oC, t + 2 * nwx); PEER_VMETA(pD0, pD1, oD, t + 3 * nwx);
  if (t < MT) PEER_VISSUE(sA, aA, pA0, pA1);
  for (; t < MT; t += 2 * nwx) {
    const int t1 = t + nwx, t2 = t + 2 * nwx;
    if (t1 < MT) PEER_VISSUE(sB, aB, pB0, pB1);
    unsigned pE0 = 0, pE1 = 0, pF0 = 0, pF1 = 0; f32x2_t oE = {0.f, 0.f}, oF = oE;
    PEER_VMETA(pE0, pE1, oE, t + 4 * nwx);
    PEER_VFINISH(sA, aA, t, oA);
    if (t1 >= MT) break;
    if (t2 < MT) PEER_VISSUE(sA, aA, pC0, pC1);
    PEER_VMETA(pF0, pF1, oF, t + 5 * nwx);
    PEER_VFINISH(sB, aB, t1, oB);
    pA0 = pC0; pA1 = pC1; oA = oC; pB0 = pD0; pB1 = pD1; oB = oD; pC0 = pE0; pC1 = pE1; oC = oE; pD0 = pF0; pD1 = pF1; oD = oF;
  }
#undef PEER_OLD
#undef PEER_VMETA
}
__device__ __forceinline__ void quant_token(const bf16* XMB, const float* ssq, unsigned char* XQ, float* HS, int t, int lane) {
  const u32x4 a = *reinterpret_cast<const u32x4*>(XMB + (size_t)t * 1024 + lane * 16), b = *reinterpret_cast<const u32x4*>(XMB + (size_t)t * 1024 + lane * 16 + 8);
  float fa[8], fb[8], v[16]; unpack8(a, fa); unpack8(b, fb);
#pragma unroll
  for (int i = 0; i < 8; ++i) { v[i] = fa[i]; v[8 + i] = fb[i]; }
  const float sx = quant_row16(v, XQ + (size_t)t * 1024 + lane * 16, 0);
  float s = 0.f;
#pragma unroll
  for (int i = 0; i < 16; ++i) s += ssq[(size_t)t * 16 + i];
  if (lane == 0) HS[t] = sx / sqrtf(s * (1.0f / 1024.0f) + 1e-6f);
}
}
constexpr int NWAVES = 8;
constexpr int BATCH = 16, SEQ = 2048, D = 1024, M = BATCH * SEQ, NPROJ = 3072, NQP = 2048, NEXP = 16384;
constexpr float RMS_EPS = 1e-6f;
constexpr float C2 = 0.125f * 1.4426950408889634f;
constexpr float LOG2E = 1.4426950408889634f;
constexpr size_t MiB = 1u << 20;
constexpr size_t WS_CTL = 0, CTL_ZERO_BYTES = 1 * MiB;
constexpr size_t WS_WIN = 1 * MiB;
constexpr size_t WS_WOUT = 7 * MiB;
constexpr size_t WS_WQ = 9 * MiB;
constexpr size_t WS_SK = 13 * MiB;
constexpr size_t WS_KPART = 13 * MiB + 512 * 1024;
constexpr size_t WS_SSQ = 14 * MiB;
constexpr size_t WS_MISC = 16 * MiB;
constexpr size_t WS_SU = WS_MISC + 65536, WS_SV = WS_MISC + 131072, WS_HS = WS_MISC + 262144;
constexpr size_t WS_U8 = 17 * MiB;
constexpr size_t WS_V8 = 33 * MiB;
constexpr size_t WS_XQ = 49 * MiB;
constexpr size_t WS_XN = 81 * MiB;
constexpr size_t WS_MIX = 145 * MiB;
constexpr size_t WS_DO = 209 * MiB;
constexpr size_t WS_PROJ = 273 * MiB;
constexpr size_t WS_QP = WS_PROJ;
constexpr size_t WS_LE = WS_PROJ + 128 * MiB;
constexpr size_t WS_LG = WS_PROJ + 144 * MiB;
constexpr size_t WS_PACK = WS_PROJ + 160 * MiB;
constexpr size_t WS_RSTD = WS_PROJ + 176 * MiB;
constexpr size_t WS_END = 465 * MiB;
constexpr int CW_BAR = 4096;
constexpr int RING_OFF = 0, RING_BYTES = 131072;
constexpr int LDSCTL_OFF = RING_BYTES, MISC_OFF = LDSCTL_OFF + 320;
constexpr int LDS_BYTES = 147456;
static_assert(att::LDS_BYTES <= RING_BYTES, "attention scratch fits the ring region");

#define GAS __attribute__((address_space(1)))
#define LAS __attribute__((address_space(3)))
typedef unsigned short bf16;
typedef unsigned v4u __attribute__((ext_vector_type(4)));
typedef unsigned v2u __attribute__((ext_vector_type(2)));
typedef float f32x4 __attribute__((ext_vector_type(4)));
typedef GAS unsigned gu32;
#define RLX_AGENT __ATOMIC_RELAXED, __HIP_MEMORY_SCOPE_AGENT
#define LDS_WAIT() asm volatile("s_waitcnt lgkmcnt(0)" ::: "memory")
#define VM_WAIT() asm volatile("s_waitcnt vmcnt(0)" ::: "memory")
__device__ __forceinline__ unsigned f2bf(float f) { unsigned u = __builtin_bit_cast(unsigned, f); return (u + 0x7fffu + ((u >> 16) & 1u)) >> 16; }
__device__ __forceinline__ unsigned pk2(float lo, float hi) { return f2bf(lo) | (f2bf(hi) << 16); }
#define XB_TMO      128
#define XB_XCNT(j)  (256  + 64 * (j))
#define XB_XSUB(j)  (1280 + 64 * (j))
#define XB_XGEN(j)  (2304 + 64 * (j))
#define XB_TOP      3328
#define XB_TOPGEN   3392
#define XCD_BAR_WORDS 3456
#define XB_SPIN_CAP (1u << 23)

__device__ __forceinline__ unsigned xb_ld(unsigned* p)              { return __hip_atomic_load(p, __ATOMIC_RELAXED, __HIP_MEMORY_SCOPE_AGENT); }
__device__ __forceinline__ unsigned xb_add(unsigned* p, unsigned v) { return __hip_atomic_fetch_add(p, v, __ATOMIC_RELAXED, __HIP_MEMORY_SCOPE_AGENT); }
__device__ __forceinline__ unsigned xb_xcc_id() { return (unsigned)__builtin_amdgcn_s_getreg((3 << 11) | 20) & 0xFu; }
#define XB_SPIN(cond, bar) do { unsigned _sp = 0; while (cond) { __builtin_amdgcn_s_sleep(1); \
    if ((++_sp & 255u) == 0u) { if (xb_ld(&(bar)[XB_TMO])) break; if (_sp > XB_SPIN_CAP) { atomicAdd(&(bar)[XB_TMO], 1u); break; } } } } while (0)

struct XcdBarrier {
    unsigned* bar; unsigned x;
    volatile LAS unsigned* st;
};

__device__ __forceinline__ XcdBarrier xcd_barrier_post(unsigned* bar, volatile LAS unsigned* st) {
    XcdBarrier b; b.bar = bar; b.x = xb_xcc_id(); b.st = st;
    if (threadIdx.x == 0) (void)xb_add(&bar[XB_XCNT(b.x)], 1u);
    return b;
}
__device__ __forceinline__ void xcd_barrier_complete(unsigned* bar, unsigned x, unsigned& nloc, unsigned& nx) {
    const unsigned G = gridDim.x * gridDim.y * gridDim.z;
    unsigned sum, cnt, mine, sp = 0u;
    for (;;) {
        sum = 0u; cnt = 0u; mine = 0u;
#pragma unroll
        for (unsigned j = 0; j < 16; ++j) { const unsigned c = xb_ld(&bar[XB_XCNT(j)]); sum += c; cnt += (c > 0u) ? 1u : 0u; mine = (j == x) ? c : mine; }
        if (sum == G) break;
        __builtin_amdgcn_s_sleep(1);
        if ((++sp & 255u) == 0u) { if (xb_ld(&bar[XB_TMO])) break; if (sp > XB_SPIN_CAP) { atomicAdd(&bar[XB_TMO], 1u); break; } }
    }
    nloc = mine > 0u ? mine : 1u; nx = cnt > 0u ? cnt : 1u;
}

__device__ __forceinline__ void xcd_barrier(const XcdBarrier& b) {
    asm volatile("s_waitcnt vmcnt(0)" ::: "memory");
    __syncthreads();
    if (threadIdx.x == 0) {
        unsigned* bar = b.bar;
        __builtin_amdgcn_s_waitcnt(0);
        unsigned nloc = b.st[0], nx = b.st[1];
        if (nloc == 0u) { xcd_barrier_complete(bar, b.x, nloc, nx); b.st[0] = nloc; b.st[1] = nx; }
        const unsigned old = xb_add(&bar[XB_XSUB(b.x)], 1u);
        const unsigned gen = old / nloc;
        if (old + 1u == (gen + 1u) * nloc) {
            __builtin_amdgcn_fence(__ATOMIC_RELEASE, "agent");
            asm volatile("s_waitcnt vmcnt(0)" ::: "memory");
            const unsigned og = xb_add(&bar[XB_TOP], 1u);
            const unsigned tg = og / nx;
            if (og + 1u == (tg + 1u) * nx) xb_add(&bar[XB_TOPGEN], 1u);
            else XB_SPIN(xb_ld(&bar[XB_TOPGEN]) == tg, bar);
            __builtin_amdgcn_fence(__ATOMIC_ACQUIRE, "agent");
            xb_add(&bar[XB_XGEN(b.x)], 1u);
            asm volatile("s_waitcnt vmcnt(0)" ::: "memory");
        } else {
            XB_SPIN(xb_ld(&bar[XB_XGEN(b.x)]) == gen, bar);
            __builtin_amdgcn_fence(__ATOMIC_ACQUIRE, "agent");
            asm volatile("s_waitcnt vmcnt(0)" ::: "memory");
        }
    }
    __syncthreads();
}
struct Frame {
    LAS unsigned char* lds;
    volatile LAS unsigned* MISC;
    gu32* ctl;
    int tid, lane, wave;
    int vcu, G;
};
__device__ __forceinline__ float wave_sum(float v) {
#pragma unroll
    for (int o = 1; o < 64; o <<= 1) v += __shfl_xor(v, o);
    return v;
}
template <bool PERMROWS>
__device__ __forceinline__ void p0_transpose_item(const float* W, int K, int N, bf16* WT, const float* kscale, LAS float* scr, int item, int lane) {
    const int nblk = N / 32, kb = item / nblk, nb = item % nblk, k0 = 64 * kb, n0 = 32 * nb;
#pragma unroll 8
    for (int i = 0; i < 32; ++i) { const int kk = 2 * i + (lane >> 5); float w = W[(size_t)(k0 + kk) * N + n0 + (lane & 31)]; if (kscale) w *= kscale[k0 + kk]; scr[kk * 33 + (lane & 31)] = w; }
    LDS_WAIT(); asm volatile("" ::: "memory");
    int r0 = n0;
    if (PERMROWS) { const int tl = n0 >> 8, np = n0 & 255; r0 = tl * 256 + ((np >> 5) & 1) * 128 + (np >> 6) * 32; }
    const int c = lane & 7;
#pragma unroll
    for (int j = 0; j < 4; ++j) { const int n = (lane >> 3) + 8 * j; const LAS float* s = scr + (8 * c) * 33 + n;
        v4u o; o.x = pk2(s[0 * 33], s[1 * 33]); o.y = pk2(s[2 * 33], s[3 * 33]); o.z = pk2(s[4 * 33], s[5 * 33]); o.w = pk2(s[6 * 33], s[7 * 33]);
        *(GAS v4u*)(WT + (size_t)(r0 + n) * K + k0 + 8 * c) = o; }
    LDS_WAIT(); asm volatile("" ::: "memory");
}
__device__ __forceinline__ void cvt8(const float* src, bf16* dst, size_t e, const float* cscale) {
    f32x4 a = *(const GAS f32x4*)(src + e), b = *(const GAS f32x4*)(src + e + 4);
    if (cscale) { const int c = (int)(e & 1023); const f32x4 ga = *(const f32x4*)(cscale + c), gb = *(const f32x4*)(cscale + c + 4); a = a * ga; b = b * gb; }
    v4u o; o.x = pk2(a[0], a[1]); o.y = pk2(a[2], a[3]); o.z = pk2(b[0], b[1]); o.w = pk2(b[2], b[3]);
    *(GAS v4u*)(dst + e) = o;
}
__device__ __forceinline__ void rms_row_to_bf16(const float* xrow, const float* g, bf16* orow, int lane) {
    const GAS f32x4* xr = (const GAS f32x4*)xrow + lane;
    f32x4 v[4]; float s = 0.f;
#pragma unroll
    for (int j = 0; j < 4; ++j) { v[j] = xr[64 * j]; s += (v[j].x * v[j].x + v[j].y * v[j].y) + (v[j].z * v[j].z + v[j].w * v[j].w); }
    const float rstd = 1.f / sqrtf(wave_sum(s) * (1.f / 1024.f) + RMS_EPS);
    GAS unsigned long long* o8 = (GAS unsigned long long*)orow + lane;
#pragma unroll
    for (int j = 0; j < 4; ++j) { const f32x4 gg = *((const f32x4*)g + lane + 64 * j);
        o8[64 * j] = (unsigned long long)pk2(v[j].x * rstd * gg.x, v[j].y * rstd * gg.y) | ((unsigned long long)pk2(v[j].z * rstd * gg.z, v[j].w * rstd * gg.w) << 32); }
}

struct Args { const float* in[13]; float* out; unsigned char* ws; int ph_lo, ph_hi; };
__global__ void __launch_bounds__(NWAVES * 64, 2) mega_fwd(Args args) {
    extern __shared__ __attribute__((aligned(16))) unsigned char lds[];
    Frame F;
    F.lds = (LAS unsigned char*)lds;
    F.MISC = (volatile LAS unsigned*)(F.lds + MISC_OFF);
    F.tid = threadIdx.x; F.lane = F.tid & 63; F.wave = __builtin_amdgcn_readfirstlane(F.tid >> 6);
    F.G = gridDim.x; { const int bx = blockIdx.x; F.vcu = (F.G % 8 == 0) ? (bx % 8) * (F.G / 8) + bx / 8 : bx; }
    unsigned char* ws = args.ws;
    F.ctl = (gu32*)(ws + WS_CTL);
    const float* x = args.in[0]; const float* norm1_g = args.in[1]; const float* w_in = args.in[2]; const float* moba_g = args.in[3]; const float* diff_g = args.in[4];
    const float* diff_lambda = args.in[5]; const float* subln_g = args.in[6]; const float* w_out = args.in[7]; const float* norm2_g = args.in[8]; const float* w_query = args.in[9];
    const float* sub_keys = args.in[10]; const float* peer_u = args.in[11]; const float* peer_v = args.in[12];
    float* out = args.out;
    bf16* WIN = (bf16*)(ws + WS_WIN); bf16* WOUT = (bf16*)(ws + WS_WOUT); bf16* WQ = (bf16*)(ws + WS_WQ); bf16* SK = (bf16*)(ws + WS_SK);
    float* KPART = (float*)(ws + WS_KPART); float* SSQ = (float*)(ws + WS_SSQ); float* MISCG = (float*)(ws + WS_MISC);
    unsigned char* U8 = ws + WS_U8; unsigned char* V8 = ws + WS_V8; float* SU = (float*)(ws + WS_SU); float* SV = (float*)(ws + WS_SV); unsigned char* XQ = ws + WS_XQ; float* HS = (float*)(ws + WS_HS); bf16* XN = (bf16*)(ws + WS_XN); bf16* MIX = (bf16*)(ws + WS_MIX); bf16* DOB = (bf16*)(ws + WS_DO);
    bf16* PROJ = (bf16*)(ws + WS_PROJ); bf16* QP = (bf16*)(ws + WS_QP); int* LE = (int*)(ws + WS_LE); float* LG = (float*)(ws + WS_LG); unsigned* PACK = (unsigned*)(ws + WS_PACK); float* RSTD = (float*)(ws + WS_RSTD);
    for (int u = F.tid; u < (LDS_BYTES - LDSCTL_OFF) / 4; u += NWAVES * 64) ((LAS unsigned*)(F.lds + LDSCTL_OFF))[u] = 0u;
    __syncthreads();
    XcdBarrier bar = xcd_barrier_post((unsigned*)(F.ctl + CW_BAR), F.MISC + 8);
    const int gw = F.vcu * NWAVES + F.wave, NGW = F.G * NWAVES;
    const int lo = args.ph_lo, hi = args.ph_hi;
#define IN(k) (lo <= (k) && (k) < hi)
#ifndef PROBE_DUP
#define PROBE_DUP -1
#endif
#define REP(k) for (int rep_ = 0; rep_ < ((PROBE_DUP == (k)) ? 2 : 1); ++rep_)
#define GRID_BAR() xcd_barrier(bar)
#if PROFSEG >= 0
    unsigned long long prof_acc = 0ull, prof_t = __builtin_amdgcn_s_memrealtime(), prof_pt = prof_t; const unsigned long long prof_t0 = prof_t;
#endif

    if (IN(0)) {
        REP(0) {
        LAS float* scr = (LAS float*)(F.lds + RING_OFF + F.wave * 16384);
        constexpr int I_IN = (D / 64) * (NPROJ / 32), I_OUT = (D / 64) * (D / 32), I_Q = (D / 64) * (NQP / 32);
        for (int it = gw; it < I_IN + I_OUT + I_Q; it += NGW) {
            int r = it;
            if (r < I_IN) { p0_transpose_item<true>(w_in, D, NPROJ, WIN, nullptr, scr, r, F.lane); continue; } r -= I_IN;
            if (r < I_OUT) { p0_transpose_item<false>(w_out, D, D, WOUT, nullptr, scr, r, F.lane); continue; } r -= I_OUT;
            p0_transpose_item<false>(w_query, D, NQP, WQ, norm2_g, scr, r, F.lane);
        }
        constexpr size_t C_SK = (size_t)16 * 128 * 128 / 8;
        for (size_t c = (size_t)gw * 64 + F.lane; c < C_SK; c += (size_t)NGW * 64) cvt8(sub_keys, SK, c * 8, nullptr);
        {
            f32x4 nx[4];
#define P0_TLOAD(R_) do { const bool isu_ = (R_) < NEXP; const float* s_ = (isu_ ? peer_u : peer_v) + (size_t)(isu_ ? (R_) : (R_) - NEXP) * 1024 + F.lane * 16; \
                _Pragma("unroll") for (int q = 0; q < 4; ++q) nx[q] = *(const GAS f32x4*)(s_ + 4 * q); } while (0)
            int r = gw;
            if (r < 2 * NEXP) P0_TLOAD(r);
            f32x4 gq[4];
#pragma unroll
            for (int q = 0; q < 4; ++q) gq[q] = *(const f32x4*)(norm2_g + F.lane * 16 + 4 * q);
            for (; r < 2 * NEXP; r += NGW) {
                const bool isu = r < NEXP; const int e = isu ? r : r - NEXP;
                float v[16];
#pragma unroll
                for (int q = 0; q < 4; ++q) { const f32x4 a = isu ? nx[q] * gq[q] : nx[q]; v[4 * q] = a[0]; v[4 * q + 1] = a[1]; v[4 * q + 2] = a[2]; v[4 * q + 3] = a[3]; }
                if (r + NGW < 2 * NEXP) P0_TLOAD(r + NGW);
                const float sc = peer::quant_row16(v, isu ? U8 + (size_t)e * 1024 + F.lane * 16 : V8 + (size_t)(F.lane >> 3) * (16384 * 128) + (size_t)e * 128 + (F.lane & 7) * 16, isu ? 0 : 128);
                if (F.lane == 0) (isu ? SU : SV)[e] = sc;
            }
#undef P0_TLOAD
        }
        {
            f32x4 cur[4], nxt[4]; f32x4 gg[4];
#pragma unroll
            for (int j = 0; j < 4; ++j) gg[j] = *((const f32x4*)norm1_g + F.lane + 64 * j);
            int m = gw;
            if (m < M) {
#pragma unroll
                for (int j = 0; j < 4; ++j) nxt[j] = *((const GAS f32x4*)(x + (size_t)m * D) + F.lane + 64 * j); }
            for (; m < M; m += NGW) {
#pragma unroll
                for (int j = 0; j < 4; ++j) cur[j] = nxt[j];
                if (m + NGW < M) {
#pragma unroll
                    for (int j = 0; j < 4; ++j) nxt[j] = *((const GAS f32x4*)(x + (size_t)(m + NGW) * D) + F.lane + 64 * j); }
                float s = 0.f;
#pragma unroll
                for (int j = 0; j < 4; ++j) s += (cur[j].x * cur[j].x + cur[j].y * cur[j].y) + (cur[j].z * cur[j].z + cur[j].w * cur[j].w);
                const float rstd = 1.f / sqrtf(wave_sum(s) * (1.f / 1024.f) + RMS_EPS);
                GAS unsigned long long* o8 = (GAS unsigned long long*)(XN + (size_t)m * D) + F.lane;
#pragma unroll
                for (int j = 0; j < 4; ++j) o8[64 * j] = (unsigned long long)pk2(cur[j].x * rstd * gg[j].x, cur[j].y * rstd * gg[j].y) | ((unsigned long long)pk2(cur[j].z * rstd * gg[j].z, cur[j].w * rstd * gg[j].w) << 32);
            }
        }
        if (gw == 0) { const float a = wave_sum(diff_lambda[F.lane] * diff_lambda[64 + F.lane]), b = wave_sum(diff_lambda[128 + F.lane] * diff_lambda[192 + F.lane]);
            if (F.lane == 0) MISCG[0] = expf(a) - expf(b) + 0.2f;
            float mq = fabsf(moba_g[F.lane]), mk = fabsf(moba_g[64 + F.lane]), dq = fabsf(diff_g[F.lane]), dk = fabsf(diff_g[64 + F.lane]);
#pragma unroll
            for (int o = 1; o < 64; o <<= 1) { mq = fmaxf(mq, __shfl_xor(mq, o)); mk = fmaxf(mk, __shfl_xor(mk, o)); dq = fmaxf(dq, __shfl_xor(dq, o)); dk = fmaxf(dk, __shfl_xor(dk, o)); }
            if (F.lane == 0) { MISCG[1] = 64.f * C2 * mq * mk * 1.02f; MISCG[2] = 64.f * C2 * dq * dk * 1.02f; } }
        }
        GRID_BAR(); PROF_PHASE(0);
    }
    if (IN(1)) {
        REP(1) {
        pg8::Gemm g{XN, WIN, M, NPROJ, D}; pg8::StaticOrder S; S.init(M, NPROJ, F.G, (int)blockIdx.x);
        pg8::EpiProj E{PROJ, moba_g, moba_g + 64, diff_g, diff_g + 64, KPART, C2};
        pg8::gemm_phase<pg8::EpiProj, pg8::StaticOrder, true, true>(F.lds + RING_OFF, g, S, E);
        }
        GRID_BAR(); PROF_PHASE(1);
    }
    if (IN(2)) {
        const float bnd_m = MISCG[1], bnd_d = MISCG[2];
        volatile LAS int* uq = (volatile LAS int*)(F.lds + MISC_OFF + 64);
        REP(2) {
#define ATT_QUEUE(QI_, ...) { gu32* ctr = F.ctl + 2048 + 128 * rep_ + 64 * (QI_); \
        if (F.tid == 0) uq[0] = (int)__hip_atomic_fetch_add(ctr, 1u, RLX_AGENT); \
        __syncthreads(); \
        for (;;) { const int u = uq[0]; __syncthreads(); if (u >= 1024) break; \
            if (F.tid == 0) uq[0] = (int)__hip_atomic_fetch_add(ctr, 1u, RLX_AGENT);       \
            const int nbq = 7 - (u >> 7), r = u & 127, b = r >> 3; const bf16* pb = PROJ + (size_t)b * SEQ * NPROJ; att::UnitDesc U; U.nb = nbq; __VA_ARGS__ } \
        __syncthreads(); }
        ATT_QUEUE(0, { const int dvh = r & 7, dh = dvh >> 1, j = dvh & 1;
                U.Q = (const att::bf16*)(pb + 1536 + dh * 128 + j * 64); U.K = (const att::bf16*)(pb + 2048 + dh * 128 + j * 64); U.V = (const att::bf16*)(pb + 2560 + dh * 128);
                U.O = (att::bf16*)(DOB + (size_t)b * SEQ * 1024 + (dh * 2 + j) * 128); U.slope2 = LOG2E * exp2f(-2.0f * (float)(dh + 1)); U.moba = 0; U.kpart = KPART; U.dmin = (2.f * bnd_d + 40.f) / U.slope2; U.bnd = bnd_d;
                att::attn_unit<128>(U, (char*)lds + RING_OFF PROF_PASS); })
        ATT_QUEUE(1, { const int vh = r & 7;
                U.Q = (const att::bf16*)(pb + vh * 64); U.K = (const att::bf16*)(pb + 512 + vh * 64); U.V = (const att::bf16*)(pb + 1024 + vh * 64);
                U.O = (att::bf16*)(MIX + (size_t)b * SEQ * 1024 + vh * 64); U.slope2 = LOG2E * exp2f(-(float)(vh + 1)); U.moba = 1; U.kpart = KPART + (size_t)(b * 8) * 1024 + vh * 64; U.dmin = (2.f * bnd_m + 40.f) / U.slope2; U.bnd = bnd_m;
                att::attn_unit<64>(U, (char*)lds + RING_OFF PROF_PASS); })
#undef ATT_QUEUE
        }
        GRID_BAR(); PROF_PHASE(2);
    }
    if (IN(3)) {
        const float lam = MISCG[0];
        const int hh = F.lane >> 4, cc = (F.lane & 15) * 8;
        float gs[8];
#pragma unroll
        for (int i = 0; i < 8; ++i) gs[i] = subln_g[cc + i] * 0.8f;
        v4u na = {}, nb2 = {};
        int t = gw;
        if (t < M) { na = *(const GAS v4u*)(DOB + (size_t)t * 1024 + hh * 256 + cc); nb2 = *(const GAS v4u*)(DOB + (size_t)t * 1024 + hh * 256 + 128 + cc); }
        for (; t < M; t += NGW) {
            const v4u a = na, b = nb2;
            if (t + NGW < M) { na = *(const GAS v4u*)(DOB + (size_t)(t + NGW) * 1024 + hh * 256 + cc); nb2 = *(const GAS v4u*)(DOB + (size_t)(t + NGW) * 1024 + hh * 256 + 128 + cc); }
            float d[8]; float ss = 0.f;
#pragma unroll
            for (int i = 0; i < 4; ++i) { d[2 * i] = __uint_as_float(a[i] << 16) - lam * __uint_as_float(b[i] << 16); d[2 * i + 1] = __uint_as_float(a[i] & 0xffff0000u) - lam * __uint_as_float(b[i] & 0xffff0000u);
                ss += d[2 * i] * d[2 * i] + d[2 * i + 1] * d[2 * i + 1]; }
#pragma unroll
            for (int o = 1; o < 16; o <<= 1) ss += __shfl_xor(ss, o);
            const float r = 1.0f / sqrtf(ss * (1.0f / 128.0f) + RMS_EPS);
            v4u w; w.x = pk2(d[0] * r * gs[0], d[1] * r * gs[1]); w.y = pk2(d[2] * r * gs[2], d[3] * r * gs[3]); w.z = pk2(d[4] * r * gs[4], d[5] * r * gs[5]); w.w = pk2(d[6] * r * gs[6], d[7] * r * gs[7]);
            *(GAS v4u*)(MIX + (size_t)t * 1024 + 512 + hh * 128 + cc) = w;
        }
        GRID_BAR(); PROF_PHASE(3);
    }
    if (IN(4)) {
        pg8::Gemm g{MIX, WOUT, M, D, D}; pg8::StaticOrder S; S.init(M, D, F.G, (int)blockIdx.x);
        pg8::EpiOut E{x, out, XN, SSQ};
        pg8::gemm_phase<pg8::EpiOut, pg8::StaticOrder, true, true>(F.lds + RING_OFF, g, S, E);
        GRID_BAR(); PROF_PHASE(4);
    }
    if (IN(5)) {
        REP(5) {
        pg8::Gemm g{XN, WQ, M, NQP, D}; pg8::StaticOrder S; S.init(M, NQP, F.G, (int)blockIdx.x);
        pg8::EpiBf16 E{QP, NQP};
        pg8::gemm_phase<pg8::EpiBf16, pg8::StaticOrder, true, true>(F.lds + RING_OFF, g, S, E);
        }
        GRID_BAR(); PROF_PHASE(5);
    }
    if (IN(6)) {
        for (int item = (int)blockIdx.x; item < 256; item += F.G) {
            const int h = item & 7, ch = item >> 3;
            __syncthreads();
            { const bf16* ksrc = SK + (size_t)h * 2 * 128 * 128;
              for (int c = F.tid; c < 4096; c += NWAVES * 64) { const int row = c >> 4, cc = c & 15; *(LAS v4u*)(F.lds + RING_OFF + row * PEER_KROW + cc * 16) = *(const GAS v4u*)(ksrc + (size_t)row * 128 + cc * 8); } }
            __syncthreads();
            const int tg0 = ch * 32 + F.wave * 4;
            peer::bf16x8 q0f[8];
            { const int r32 = F.lane & 31, hi5 = F.lane >> 5;
#pragma unroll
              for (int ks = 0; ks < 8; ++ks) q0f[ks] = *reinterpret_cast<const peer::bf16x8*>(QP + (size_t)(tg0 * 32 + r32) * 2048 + h * 256 + ks * 16 + hi5 * 8); }
            for (int i = 0; i < 4; ++i) peer::topk_task((const peer::bf16*)QP, (const char*)lds + RING_OFF, SSQ, RSTD, LE, LG, tg0 + i, h, F.lane, q0f, i < 3 ? tg0 + i + 1 : -1);
        }
        {
            v4u ca, cb_, na = {}, nb_ = {}; f32x4 cs[4], ns[4] = {};
#define P6_QLOAD(T_) do { na = *(const GAS v4u*)(XN + (size_t)(T_) * 1024 + F.lane * 16); nb_ = *(const GAS v4u*)(XN + (size_t)(T_) * 1024 + F.lane * 16 + 8); \
                _Pragma("unroll") for (int q = 0; q < 4; ++q) ns[q] = *(const GAS f32x4*)(SSQ + (size_t)(T_) * 16 + 4 * q); } while (0)
            int t = gw;
            if (t < M) P6_QLOAD(t);
            for (; t < M; t += NGW) {
                ca = na; cb_ = nb_;
#pragma unroll
                for (int q = 0; q < 4; ++q) cs[q] = ns[q];
                if (t + NGW < M) P6_QLOAD(t + NGW);
                float v[16];
#pragma unroll
                for (int i = 0; i < 4; ++i) { v[2 * i] = __uint_as_float(ca[i] << 16); v[2 * i + 1] = __uint_as_float(ca[i] & 0xffff0000u); v[8 + 2 * i] = __uint_as_float(cb_[i] << 16); v[9 + 2 * i] = __uint_as_float(cb_[i] & 0xffff0000u); }
                const float sx = peer::quant_row16(v, XQ + (size_t)t * 1024 + F.lane * 16, 0);
                float s = 0.f;
#pragma unroll
                for (int q = 0; q < 4; ++q) s += (cs[q][0] + cs[q][1]) + (cs[q][2] + cs[q][3]);
                if (F.lane == 0) HS[t] = sx / sqrtf(s * (1.0f / 1024.0f) + 1e-6f);
            }
#undef P6_QLOAD
        }
        GRID_BAR(); PROF_PHASE(6);
    }
    if (IN(7)) {
        const int xl = (int)blockIdx.x & 7, nwx = (F.G >> 3) * NWAVES, wx = ((int)blockIdx.x >> 3) * NWAVES + F.wave;
        REP(70) peer::expert_u_pass(XQ, U8, HS, SU, SV, LE, LG, PACK, xl, wx, nwx, F.lane, (char*)lds + RING_OFF + F.wave * 8192);
        GRID_BAR(); PROF_PHASE(7);
        if (PROBE_DUP == 71) peer::expert_v_pass(V8, PACK, (float*)QP, xl, wx, nwx, F.lane);
        peer::expert_v_pass(V8, PACK, out, xl, wx, nwx, F.lane);
        PROF_PHASE(8);
    }
#if PROFSEG >= 0
    if (PROFSEG == 200) prof_acc = __builtin_amdgcn_s_memrealtime() - prof_t0;
    if (blockIdx.x == PROFBLK && F.wave == 0) { const unsigned long long t0_ = __builtin_amdgcn_s_memrealtime(); while (__builtin_amdgcn_s_memrealtime() - t0_ < 8ull * prof_acc) __builtin_amdgcn_s_sleep(8); }
#endif
#undef IN
#undef GRID_BAR
}

extern "C" void kernel_launch(void* const* d_in, const int* in_sizes, int n_in, void* d_out, int out_size, void* d_ws, size_t ws_size, hipStream_t stream) {
    static int grid = 0;
    if (grid == 0) {
        if (n_in != 13 || in_sizes[0] != M * D || out_size != M * D || ws_size < WS_END) { fprintf(stderr, "kernel_launch: unexpected shapes (n_in %d, in0 %d, out %d, ws %zu); nothing launched\n", n_in, n_in > 0 ? in_sizes[0] : -1, out_size, ws_size); grid = -1; return; }
        int dev = 0, cus = 0, per_cu = 0;
        if (hipGetDevice(&dev) != hipSuccess || hipDeviceGetAttribute(&cus, hipDeviceAttributeMultiprocessorCount, dev) != hipSuccess) { grid = -1; return; }
        if (hipFuncSetAttribute((const void*)mega_fwd, hipFuncAttributeMaxDynamicSharedMemorySize, LDS_BYTES) != hipSuccess) { fprintf(stderr, "kernel_launch: hipFuncSetAttribute failed\n"); grid = -1; return; }
        if (hipOccupancyMaxActiveBlocksPerMultiprocessor(&per_cu, (const void*)mega_fwd, NWAVES * 64, LDS_BYTES) != hipSuccess || per_cu < 1) { fprintf(stderr, "kernel_launch: occupancy query reports %d workgroups per CU\n", per_cu); }
        (void)hipGetLastError();
        grid = cus;
    }
    if (grid < 0) return;
    if (hipMemsetAsync((char*)d_ws + WS_CTL, 0, CTL_ZERO_BYTES, stream) != hipSuccess) return;
    Args a{};
    for (int i = 0; i < 13; ++i) a.in[i] = (const float*)d_in[i];
    a.out = (float*)d_out; a.ws = (unsigned char*)d_ws; a.ph_lo = 0; a.ph_hi = 8;
    hipLaunchKernelGGL(mega_fwd, dim3(grid), dim3(NWAVES * 64), LDS_BYTES, stream, a);
}
```

```cpp
#include <hip/hip_runtime.h>
#include <hip/hip_bf16.h>
#include <cstdio>
#include <cstdint>
#include <cmath>
#ifndef PROFSEG
#define PROFSEG -1
#endif
#ifndef PROFBLK
#define PROFBLK 0
#endif
#if PROFSEG >= 0
#define PROF_ARGS , unsigned long long& prof_acc, unsigned long long& prof_t
#define PROF_PASS , prof_acc, prof_t
#define PROF_MARK(seg) do { if (PROFSEG != 25 && PROFSEG != 35 && PROFSEG != 45 && PROFSEG != 46) { const unsigned long long n_ = __builtin_amdgcn_s_memrealtime(); if ((seg) == PROFSEG) prof_acc += n_ - prof_t; prof_t = n_; } } while (0)
#define PROF_SPAN0(seg) do { if ((seg) == PROFSEG) prof_t = __builtin_amdgcn_s_memrealtime(); } while (0)
#define PROF_SPAN1(seg) do { if ((seg) == PROFSEG) prof_acc += __builtin_amdgcn_s_memrealtime() - prof_t; } while (0)
#define PROF_PHASE(k) do { const unsigned long long n_ = __builtin_amdgcn_s_memrealtime(); if (100 + (k) == PROFSEG) prof_acc += n_ - prof_pt; prof_pt = n_; } while (0)
#else
#define PROF_PHASE(k) do { } while (0)
#define PROF_SPAN0(seg) do { } while (0)
#define PROF_SPAN1(seg) do { } while (0)
#define PROF_ARGS
#define PROF_PASS
#define PROF_MARK(seg) do { } while (0)
#endif
namespace pg8 {
#define PG8_LAS __attribute__((address_space(3)))
typedef unsigned short bf16_t;
typedef short bf16x8 __attribute__((ext_vector_type(8)));
typedef float f32x4 __attribute__((ext_vector_type(4)));
typedef unsigned u32x4 __attribute__((ext_vector_type(4)));
constexpr int BM = 256, BK = 64, HALF = 128, HTB = HALF * BK * 2  , STAGE_BYTES = 8 * HTB, NXCD = 8, WGM = 8;

__host__ __device__ __forceinline__ int lds_byte(int r, int c) { const int st = (r >> 4) * 2 + (c >> 5), rr = r & 15, cc = c & 31, ob = rr * 64 + cc * 2; return st * 1024 + (ob ^ (((ob >> 9) & 1) << 5)); }
__host__ __device__ __forceinline__ void stage_rc(int b, int& R, int& C) { const int st = b / 1024, sb = b % 1024, swz = sb ^ (((sb >> 9) & 1) << 5); R = (st >> 1) * 16 + swz / 64; C = (st & 1) * 32 + (swz % 64) / 2; }
__host__ __device__ __forceinline__ int perm32(int rho) { const int n = rho >> 4, i = rho & 15; return 8 * (i >> 2) + 4 * n + (i & 3); }

struct Unit { int pm, pn; };
struct Gemm { const bf16_t* A; const bf16_t* Bt; int M, N, K; };

struct StaticOrder {
    int nM, nN, nwg, G, c;
    __host__ __device__ void init(int M, int N, int G_, int c_) { nM = M / BM; nN = N / BM; nwg = nM * nN; G = G_; c = c_; }
    __host__ __device__ bool next(int i, Unit& u) const {
        const long L = (long)i * G + c; if (L >= nwg) return false;
        int wgid = (int)L; { const int q = nwg / NXCD, r = nwg % NXCD, xcd = wgid % NXCD, off = wgid / NXCD; wgid = (xcd < r ? xcd * (q + 1) : r * (q + 1) + (xcd - r) * q) + off; }
        const int nig = WGM * nN, gid = wgid / nig, fm = gid * WGM, gsz = (nM - fm) < WGM ? (nM - fm) : WGM;
        u.pm = fm + ((wgid % nig) % gsz); u.pn = (wgid % nig) / gsz; return true;
    }
    __device__ __forceinline__ void a_ready(const Unit&) const {}
    __device__ __forceinline__ void done(const Unit&) const {}
};

__device__ __forceinline__ unsigned cvt_pk_bf16(float lo, float hi) { unsigned r; asm volatile("v_cvt_pk_bf16_f32 %0, %1, %2" : "=v"(r) : "v"(lo), "v"(hi)); return r; }
typedef unsigned u32x2 __attribute__((ext_vector_type(2)));

struct EpiBf16 {
    static constexpr bool PERM = true, AFTER_DRAIN = false;
    bf16_t* O; int ldc;
    __device__ __forceinline__ void operator()(const f32x4 (&acc)[2][2][4][2], const Unit& u, int wr, int wc, int fr, int fq) const {
        const int row0 = u.pm * BM + wr * 64 + fr; const int col0 = u.pn * BM + wc * 32 + 8 * fq;
#pragma unroll
        for (int ai = 0; ai < 2; ++ai)
#pragma unroll
            for (int m = 0; m < 4; ++m) { bf16_t* rowp = O + (size_t)(row0 + ai * HALF + m * 16) * ldc + col0;
#pragma unroll
                for (int bj = 0; bj < 2; ++bj) { const f32x4 v0 = acc[ai][bj][m][0], v1 = acc[ai][bj][m][1];
                    u32x4 w; w.x = cvt_pk_bf16(v0[0], v0[1]); w.y = cvt_pk_bf16(v0[2], v0[3]); w.z = cvt_pk_bf16(v1[0], v1[1]); w.w = cvt_pk_bf16(v1[2], v1[3]);
                    *(u32x4*)(rowp + bj * HALF) = w; } }
    }
};

struct EpiProj {
    static constexpr bool PERM = true, AFTER_DRAIN = false;
    bf16_t* P; const float *gmq, *gmk, *gdq, *gdk; float* kpart; float c2;
    __device__ __forceinline__ void operator()(const f32x4 (&acc)[2][2][4][2], const Unit& u, int wr, int wc, int fr, int fq) const {
        const int type = u.pn >> 1;
        const float* g = type == 0 ? gmq : type == 1 ? gmk : type == 3 ? gdq : type == 4 ? gdk : nullptr;
        const float sc0 = (type == 0 || type == 3) ? c2 : 1.f;
        f32x4 gv[2][2];
#pragma unroll
        for (int bj = 0; bj < 2; ++bj)
#pragma unroll
            for (int n = 0; n < 2; ++n) gv[bj][n] = g ? (*(const f32x4*)(g + 32 * bj + 8 * fq + 4 * n)) * sc0 : (f32x4){1.f, 1.f, 1.f, 1.f};
        f32x4 cs[2][2];
#pragma unroll
        for (int bj = 0; bj < 2; ++bj)
#pragma unroll
            for (int n = 0; n < 2; ++n) cs[bj][n] = (f32x4){0.f, 0.f, 0.f, 0.f};
        const int row0 = u.pm * BM + wr * 64 + fr; const int col0 = u.pn * BM + wc * 64 + 8 * fq;
#pragma unroll
        for (int ai = 0; ai < 2; ++ai)
#pragma unroll
            for (int m = 0; m < 4; ++m) {
                f32x4 v[2][2];
#pragma unroll
                for (int bj = 0; bj < 2; ++bj)
#pragma unroll
                    for (int n = 0; n < 2; ++n) v[bj][n] = acc[ai][bj][m][n];
                if (g) {
                    float ss = 0.f;
#pragma unroll
                    for (int bj = 0; bj < 2; ++bj)
#pragma unroll
                        for (int n = 0; n < 2; ++n) { const f32x4 x = v[bj][n]; ss += (x[0] * x[0] + x[1] * x[1]) + (x[2] * x[2] + x[3] * x[3]); }
                    ss += __shfl_xor(ss, 16); ss += __shfl_xor(ss, 32);
                    const float r = 1.0f / sqrtf(ss * (1.0f / 64.0f) + 1e-6f);
#pragma unroll
                    for (int bj = 0; bj < 2; ++bj)
#pragma unroll
                        for (int n = 0; n < 2; ++n) { v[bj][n] = v[bj][n] * r * gv[bj][n]; cs[bj][n] += v[bj][n]; }
                }
                bf16_t* rowp = P + (size_t)(row0 + ai * HALF + m * 16) * 3072 + col0;
#pragma unroll
                for (int bj = 0; bj < 2; ++bj) { const f32x4 v0 = v[bj][0], v1 = v[bj][1];
                    u32x4 w; w.x = cvt_pk_bf16(v0[0], v0[1]); w.y = cvt_pk_bf16(v0[2], v0[3]); w.z = cvt_pk_bf16(v1[0], v1[1]); w.w = cvt_pk_bf16(v1[2], v1[3]);
                    *(u32x4*)(rowp + bj * 32) = w; }
            }
        if (type == 1) {
#pragma unroll
            for (int bj = 0; bj < 2; ++bj)
#pragma unroll
                for (int n = 0; n < 2; ++n) { f32x4 c = cs[bj][n];
#pragma unroll
                    for (int o = 1; o < 16; o <<= 1) { c[0] += __shfl_xor(c[0], o); c[1] += __shfl_xor(c[1], o); c[2] += __shfl_xor(c[2], o); c[3] += __shfl_xor(c[3], o); }
                    if (fr == 0) *(f32x4*)(kpart + (size_t)(u.pm * 2 + wr) * 512 + (u.pn - 2) * 256 + wc * 64 + bj * 32 + fq * 8 + n * 4) = c; }
        }
    }
};

struct EpiOut {
    static constexpr bool PERM = false, AFTER_DRAIN = false;
    const float* x; float* out; bf16_t* xmb; float* ssq;
    __device__ __forceinline__ void operator()(const f32x4 (&acc)[2][2][4][2], const Unit& u, int wr, int wc, int fr, int fq) const {
        const int row0 = u.pm * BM + wr * 64 + fr; const int col0 = u.pn * BM + wc * 32 + 4 * fq;
#pragma unroll
        for (int ai = 0; ai < 2; ++ai)
#pragma unroll
            for (int m = 0; m < 4; ++m) { const int row = row0 + ai * HALF + m * 16; const size_t off = (size_t)row * 1024 + col0; float s = 0.f;
#pragma unroll
                for (int bj = 0; bj < 2; ++bj)
#pragma unroll
                    for (int n = 0; n < 2; ++n) { const f32x4 xv = *(const f32x4*)(x + off + bj * HALF + n * 16); const f32x4 y = xv + acc[ai][bj][m][n];
                        *(f32x4*)(out + off + bj * HALF + n * 16) = y; u32x2 w; w.x = cvt_pk_bf16(y[0], y[1]); w.y = cvt_pk_bf16(y[2], y[3]); *(u32x2*)(xmb + off + bj * HALF + n * 16) = w;
                        s += (y[0] * y[0] + y[1] * y[1]) + (y[2] * y[2] + y[3] * y[3]); }
                s += __shfl_xor(s, 16); s += __shfl_xor(s, 32);
                if (fq == 0) ssq[(size_t)row * 16 + u.pn * 4 + wc] = s;
                if (m & 1) asm volatile("" ::: "memory"); }
    }
};
template <class Epi, class Sched, bool ALIGN_EPI = false, bool SP2 = false>
__device__ __forceinline__ void gemm_phase(PG8_LAS unsigned char* lds, const Gemm g, const Sched& S, const Epi& E) {
    const int tid = threadIdx.x, wid = __builtin_amdgcn_readfirstlane(tid >> 6), lane = tid & 63, wr = wid >> 2, wc = wid & 3, fr = lane & 15, fq = lane >> 4;
    const int K = g.K, nt = K / BK;
    unsigned voffA[2], voffB[2];
#pragma unroll
    for (int i = 0; i < 2; ++i) { int R, C; stage_rc(tid * 16 + i * 8192, R, C); const int Rb = Epi::PERM ? ((R & ~31) + perm32(R & 31)) : R;
        voffA[i] = (unsigned)(R * K + C) * 2u; voffB[i] = (unsigned)(Rb * K + C) * 2u; }
    const size_t kstep = (size_t)(BK * 2);
    const size_t hstep = (size_t)HALF * K * 2;
    const size_t tstep = 2 * hstep;
    const unsigned ldsw = (unsigned)wid * 1024u;
    const int aoff = lds_byte(wr * 64 + fr, fq * 8), boff = lds_byte(wc * 32 + fr, fq * 8);
#define PG8_SA(b, h) (((b) * 2 + (h)) * HTB)
#define PG8_SB(b, h) ((4 + (b) * 2 + (h)) * HTB)
#define PG8_STAGE(bufoff, gbase, voff) do { _Pragma("unroll") for (int _i = 0; _i < 2; ++_i) \
        __builtin_amdgcn_global_load_lds((const unsigned*)((const char*)(gbase) + (voff)[_i]), (PG8_LAS unsigned*)(lds + (bufoff) + ldsw + _i * 8192), 16, 0, 0); } while (0)
#define PG8_LDA(dst, b, h) do { _Pragma("unroll") for (int m = 0; m < 4; ++m) _Pragma("unroll") for (int k = 0; k < 2; ++k) dst[m][k] = *(const PG8_LAS bf16x8*)(lds + PG8_SA(b, h) + aoff + m * 2048 + k * 1024); } while (0)
#define PG8_LDB(dst, b, h) do { _Pragma("unroll") for (int n = 0; n < 2; ++n) _Pragma("unroll") for (int k = 0; k < 2; ++k) dst[n][k] = *(const PG8_LAS bf16x8*)(lds + PG8_SB(b, h) + boff + n * 2048 + k * 1024); } while (0)
#define PG8_MMA(ai, bj, At, Bt) do { __builtin_amdgcn_s_setprio(1); _Pragma("unroll") for (int m = 0; m < 4; ++m) _Pragma("unroll") for (int n = 0; n < 2; ++n) _Pragma("unroll") for (int k = 0; k < 2; ++k) \
        acc[ai][bj][m][n] = __builtin_amdgcn_mfma_f32_16x16x32_bf16(Bt[n][k], At[m][k], acc[ai][bj][m][n], 0, 0, 0); __builtin_amdgcn_s_setprio(0); } while (0)
#define PG8_WAIT_V(n) asm volatile("s_waitcnt vmcnt(" #n ")" ::: "memory")
#define PG8_WAIT_L(n) asm volatile("s_waitcnt lgkmcnt(" #n ")" ::: "memory")
#define PG8_BAR __builtin_amdgcn_s_barrier()
#define PG8_SCHED __builtin_amdgcn_sched_barrier(0)
    Unit cur, nxt; int ui = 0;
    if (!S.next(0, cur)) return;
    f32x4 acc[2][2][4][2];
#pragma unroll
    for (int a = 0; a < 2; ++a)
#pragma unroll
        for (int b = 0; b < 2; ++b)
#pragma unroll
            for (int m = 0; m < 4; ++m)
#pragma unroll
                for (int n = 0; n < 2; ++n) acc[a][b][m][n] = (f32x4){0.f, 0.f, 0.f, 0.f};
    bf16x8 At[4][2], B0[2][2], B1[2][2];
    const char* cA = (const char*)g.A + (size_t)cur.pm * tstep; const char* cB = (const char*)g.Bt + (size_t)cur.pn * tstep;
    S.a_ready(cur);
    if constexpr (SP2) {
        PG8_STAGE(PG8_SB(0, 0), cB, voffB); PG8_STAGE(PG8_SB(0, 1), cB + hstep, voffB); PG8_STAGE(PG8_SA(0, 0), cA, voffA); PG8_STAGE(PG8_SA(0, 1), cA + hstep, voffA);
        if (wr == 1) PG8_BAR;
        PG8_WAIT_V(2); PG8_BAR;
        PG8_STAGE(PG8_SB(1, 0), cB + kstep, voffB); PG8_STAGE(PG8_SA(1, 0), cA + kstep, voffA); PG8_STAGE(PG8_SB(1, 1), cB + hstep + kstep, voffB);
        PG8_WAIT_V(6); PG8_BAR;
    } else {
        PG8_STAGE(PG8_SB(0, 0), cB, voffB); PG8_STAGE(PG8_SA(0, 0), cA, voffA); PG8_STAGE(PG8_SB(0, 1), cB + hstep, voffB); PG8_STAGE(PG8_SA(0, 1), cA + hstep, voffA);
        if (wr == 1) PG8_BAR;
        PG8_WAIT_V(4); PG8_BAR;
        PG8_STAGE(PG8_SB(1, 0), cB + kstep, voffB); PG8_STAGE(PG8_SA(1, 0), cA + kstep, voffA); PG8_STAGE(PG8_SB(1, 1), cB + hstep + kstep, voffB);
        PG8_WAIT_V(6); PG8_BAR;
    }
    for (;;) {
        const bool has_next = S.next(ui + 1, nxt);
        const char* nA = has_next ? (const char*)g.A + (size_t)nxt.pm * tstep : cA; const char* nB = has_next ? (const char*)g.Bt + (size_t)nxt.pn * tstep : cB;
        for (int t = 0; t < nt; t += 2) {
            const bool last = (t == nt - 2);
            const char* a1 = cA + (size_t)(t + 1) * kstep;
            const char* a2 = last ? nA : cA + (size_t)(t + 2) * kstep; const char* b2 = last ? nB : cB + (size_t)(t + 2) * kstep;
            const char* a3 = a2 + kstep; const char* b3 = b2 + kstep;
            if (last && has_next) S.a_ready(nxt);
            if constexpr (SP2) {
            PG8_LDB(B0, 0, 0); PG8_LDB(B1, 0, 1); PG8_SCHED; PG8_LDA(At, 0, 0); PG8_STAGE(PG8_SA(1, 1), a1 + hstep, voffA);
            PG8_WAIT_V(8); PG8_WAIT_L(0); PG8_BAR; PG8_MMA(0, 0, At, B0); PG8_MMA(0, 1, At, B1); PG8_BAR; PG8_SCHED;
            PG8_LDA(At, 0, 1); PG8_STAGE(PG8_SB(0, 0), b2, voffB); PG8_STAGE(PG8_SB(0, 1), b2 + hstep, voffB); PG8_STAGE(PG8_SA(0, 0), a2, voffA);
            PG8_WAIT_V(8); PG8_WAIT_L(0); PG8_BAR; PG8_MMA(1, 0, At, B0); PG8_MMA(1, 1, At, B1); PG8_BAR; PG8_SCHED;
            PG8_LDB(B0, 1, 0); PG8_LDB(B1, 1, 1); PG8_SCHED; PG8_LDA(At, 1, 0); PG8_STAGE(PG8_SA(0, 1), a2 + hstep, voffA);
            PG8_WAIT_V(8); PG8_WAIT_L(0); PG8_BAR; PG8_MMA(0, 0, At, B0); PG8_MMA(0, 1, At, B1); PG8_BAR; PG8_SCHED;
            PG8_LDA(At, 1, 1); PG8_STAGE(PG8_SB(1, 0), b3, voffB); PG8_STAGE(PG8_SB(1, 1), b3 + hstep, voffB); PG8_STAGE(PG8_SA(1, 0), a3, voffA);
            PG8_WAIT_V(8); PG8_WAIT_L(0); PG8_BAR; PG8_MMA(1, 0, At, B0); PG8_MMA(1, 1, At, B1); PG8_BAR; PG8_SCHED;
            } else {
            PG8_LDB(B0, 0, 0); PG8_SCHED; PG8_LDA(At, 0, 0); PG8_STAGE(PG8_SA(1, 1), a1 + hstep, voffA);
            PG8_WAIT_L(8); PG8_BAR; PG8_WAIT_L(0); PG8_MMA(0, 0, At, B0); PG8_BAR; PG8_SCHED;
            PG8_LDB(B1, 0, 1); PG8_STAGE(PG8_SB(0, 0), b2, voffB);
            PG8_BAR; PG8_WAIT_L(0); PG8_MMA(0, 1, At, B1); PG8_BAR;
            PG8_LDA(At, 0, 1); PG8_STAGE(PG8_SA(0, 0), a2, voffA);
            PG8_BAR; PG8_WAIT_L(0); PG8_MMA(1, 0, At, B0); PG8_BAR; PG8_SCHED;
            PG8_STAGE(PG8_SB(0, 1), b2 + hstep, voffB);
            PG8_WAIT_V(6); PG8_BAR; PG8_MMA(1, 1, At, B1); PG8_BAR;
            PG8_LDB(B0, 1, 0); PG8_SCHED; PG8_LDA(At, 1, 0); PG8_STAGE(PG8_SA(0, 1), a2 + hstep, voffA);
            PG8_WAIT_L(8); PG8_BAR; PG8_WAIT_L(0); PG8_MMA(0, 0, At, B0); PG8_BAR; PG8_SCHED;
            PG8_LDB(B1, 1, 1); PG8_STAGE(PG8_SB(1, 0), b3, voffB);
            PG8_BAR; PG8_WAIT_L(0); PG8_MMA(0, 1, At, B1); PG8_BAR;
            PG8_LDA(At, 1, 1); PG8_STAGE(PG8_SA(1, 0), a3, voffA);
            PG8_BAR; PG8_WAIT_L(0); PG8_MMA(1, 0, At, B0); PG8_BAR; PG8_SCHED;
            PG8_STAGE(PG8_SB(1, 1), b3 + hstep, voffB);
            PG8_WAIT_V(6); PG8_BAR; PG8_MMA(1, 1, At, B1); PG8_BAR;
            }
        }
        if constexpr (ALIGN_EPI) { if (wr == 0) PG8_BAR; }
        if constexpr (!Epi::AFTER_DRAIN) { E(acc, cur, wr, wc, fr, fq); S.done(cur); }
        if (!has_next) break;
#pragma unroll
        for (int a = 0; a < 2; ++a)
#pragma unroll
            for (int b = 0; b < 2; ++b)
#pragma unroll
                for (int m = 0; m < 4; ++m)
#pragma unroll
                    for (int n = 0; n < 2; ++n) acc[a][b][m][n] = (f32x4){0.f, 0.f, 0.f, 0.f};
        cur = nxt; cA = nA; cB = nB; ++ui;
        if constexpr (ALIGN_EPI) { if (wr == 1) PG8_BAR; }
    }
    PG8_WAIT_V(0);
    if constexpr (!ALIGN_EPI) { if (wr == 0) PG8_BAR; }
    PG8_BAR;
    if constexpr (Epi::AFTER_DRAIN) { E.fused(acc, cur, wr, wc, fr, fq, lds, wid, lane); S.done(cur); }
#undef PG8_SA
#undef PG8_SB
#undef PG8_STAGE
#undef PG8_LDA
#undef PG8_LDB
#undef PG8_MMA
#undef PG8_WAIT_V
#undef PG8_WAIT_L
#undef PG8_BAR
#undef PG8_SCHED
}
}
namespace att {
using bf16 = __hip_bfloat16;
using bf16x8 = __attribute__((ext_vector_type(8))) short;
using s16x4 = __attribute__((ext_vector_type(4))) short;
using f32x16 = __attribute__((ext_vector_type(16))) float;
using u32x4 = __attribute__((ext_vector_type(4))) unsigned;
constexpr int PITCH = 3072, QB = 256, KVBLK = 64, NW = 8;
constexpr int SLOTB = 8192, VSLOTB = 16384, LDS_K = 0, LDS_V = 2 * SLOTB, LDS_WS = LDS_V + 2 * VSLOTB, LDS_OST = LDS_WS + NW * 64 * 4, LDS_BYTES = LDS_OST + NW * 8192;
__device__ __forceinline__ int crow(int r, int hi) { return (r & 3) + 8 * (r >> 2) + 4 * hi; }
typedef float f32x2_t __attribute__((ext_vector_type(2))); typedef __bf16 bf16x2_t __attribute__((ext_vector_type(2)));
__device__ __forceinline__ unsigned cvtpk_s(float lo, float hi) { f32x2_t v = {lo, hi}; bf16x2_t b = __builtin_convertvector(v, bf16x2_t); return __builtin_bit_cast(unsigned, b); }

__device__ __forceinline__ void qkt(f32x16& p0, f32x16& p1, const char* Kslot, const bf16x8* qr, const f32x16& c0, const f32x16& c1, int r32, int hi) {
  const char* kb = Kslot + hi * 1024 + r32 * 16;
#pragma unroll
  for (int d0 = 0; d0 < 4; ++d0) {
    const bf16x8 b0 = *reinterpret_cast<const bf16x8*>(kb + d0 * 2048);
    const bf16x8 b1 = *reinterpret_cast<const bf16x8*>(kb + d0 * 2048 + 512);
    if (d0 == 0) { p0 = __builtin_amdgcn_mfma_f32_32x32x16_bf16(b0, qr[0], c0, 0, 0, 0); p1 = __builtin_amdgcn_mfma_f32_32x32x16_bf16(b1, qr[0], c1, 0, 0, 0); }
    else { p0 = __builtin_amdgcn_mfma_f32_32x32x16_bf16(b0, qr[d0], p0, 0, 0, 0); p1 = __builtin_amdgcn_mfma_f32_32x32x16_bf16(b1, qr[d0], p1, 0, 0, 0); } }
}
template <int NDB> __device__ __forceinline__ void pv(f32x16* o, int vb, bf16x8 pa0, bf16x8 pa1, bf16x8 pa2, bf16x8 pa3) {
#pragma unroll
  for (int d0 = 0; d0 < NDB; ++d0) { s16x4 lo[4], hi[4];
#pragma unroll
    for (int ks = 0; ks < 4; ++ks) {
      asm volatile("ds_read_b64_tr_b16 %0,%1 offset:%c2" : "=&v"(lo[ks]) : "v"(vb), "i"(d0 * 4096 + ks * 1024) : "memory");
      asm volatile("ds_read_b64_tr_b16 %0,%1 offset:%c2" : "=&v"(hi[ks]) : "v"(vb), "i"(d0 * 4096 + ks * 1024 + 512) : "memory"); }
    asm volatile("s_waitcnt lgkmcnt(0)" ::: "memory"); __builtin_amdgcn_sched_barrier(0);
#define PK(k) (bf16x8){lo[k][0], lo[k][1], lo[k][2], lo[k][3], hi[k][0], hi[k][1], hi[k][2], hi[k][3]}
    o[d0] = __builtin_amdgcn_mfma_f32_32x32x16_bf16(pa0, PK(0), o[d0], 0, 0, 0);
    o[d0] = __builtin_amdgcn_mfma_f32_32x32x16_bf16(pa1, PK(1), o[d0], 0, 0, 0);
    o[d0] = __builtin_amdgcn_mfma_f32_32x32x16_bf16(pa2, PK(2), o[d0], 0, 0, 0);
    o[d0] = __builtin_amdgcn_mfma_f32_32x32x16_bf16(pa3, PK(3), o[d0], 0, 0, 0);
#undef PK
  }
}
struct UnitDesc { const bf16* Q; const bf16* K; const bf16* V; bf16* O; float slope2; int nb; int moba; const float* kpart; float dmin; float bnd; };
template <int DV> __device__ __forceinline__ void attn_unit(const UnitDesc& U, char* shm PROF_ARGS) {
  PROF_MARK(19);
  constexpr int NDB = DV / 32;
  const int tid = threadIdx.x, lane = tid & 63, r32 = lane & 31, hi = lane >> 5; const int wid = __builtin_amdgcn_readfirstlane(tid >> 6);
  const int nb = U.nb, q0 = nb * QB;
  const bf16* Qw = U.Q + (long)(q0 + wid * 32) * PITCH;
  const unsigned lds0 = (unsigned)(uintptr_t)shm;
  float* wsf = (float*)(shm + LDS_WS) + wid * 64;
  bf16x8 qr[4];
#pragma unroll
  for (int d0 = 0; d0 < 4; ++d0) qr[d0] = *reinterpret_cast<const bf16x8*>(&Qw[(long)r32 * PITCH + d0 * 16 + hi * 8]);
  unsigned sel = 0xffu;
  if (U.moba) {
    { const int n = tid >> 6, d = tid & 63; const float* k0 = U.kpart + (size_t)(n * 2) * 512 + d; const float km = k0[0] + k0[512];
      const __hip_bfloat16 h = __float2bfloat16(km); const __hip_bfloat16 l = __float2bfloat16(km - __bfloat162float(h));
      *reinterpret_cast<__hip_bfloat16*>(shm + LDS_K + (d >> 3) * 1024 + n * 16 + (d & 7) * 2) = h; *reinterpret_cast<__hip_bfloat16*>(shm + LDS_K + SLOTB + (d >> 3) * 1024 + n * 16 + (d & 7) * 2) = l; }
    __syncthreads();
    f32x16 gh = {};
    { const char* kb = shm + LDS_K + hi * 1024 + r32 * 16;
#pragma unroll
      for (int d0 = 0; d0 < 4; ++d0) { const bf16x8 bh = *reinterpret_cast<const bf16x8*>(kb + d0 * 2048), bl = *reinterpret_cast<const bf16x8*>(kb + SLOTB + d0 * 2048);
        gh = __builtin_amdgcn_mfma_f32_32x32x16_bf16(bh, qr[d0], gh, 0, 0, 0); gh = __builtin_amdgcn_mfma_f32_32x32x16_bf16(bl, qr[d0], gh, 0, 0, 0); } }
    float g[4] = {gh[0], gh[1], gh[2], gh[3]};
    __syncthreads();
    float ga[8];
#pragma unroll
    for (int j = 0; j < 4; ++j) { const float o = __shfl_xor(g[j], 32); ga[j] = hi ? o : g[j]; ga[4 + j] = hi ? g[j] : o; }
    sel = 0u;
#pragma unroll
    for (int n = 0; n < 8; ++n) { int rank = 0;
#pragma unroll
      for (int m = 0; m < 8; ++m) if (m != n) rank += (m < nb && (ga[m] > ga[n] || (ga[m] == ga[n] && m < n))) ? 1 : 0;
      if (n < nb && rank < 3) sel |= (1u << n); }
  }
  PROF_MARK(10);
  const int NT = 4 * (nb + 1);
  int ts = (int)floorf(((float)q0 - 63.f - U.dmin) * (1.0f / 64.0f)) + 1; ts = ts < 0 ? 0 : (ts > NT - 4 ? NT - 4 : ts);
  float mref = -U.bnd, lrun = 0.f; f32x16 o[NDB];
#pragma unroll
  for (int d = 0; d < NDB; ++d) o[d] = f32x16{};
  const int qrel = wid * 32 + r32;
  const bf16* ksrc = U.K + (long)lane * PITCH + wid * 8;
  const bf16* vsrc = U.V + (long)(16 * (wid & 3) + (lane >> 2)) * PITCH + (wid >> 2) * 32 + (lane & 3) * 8;
  char* kdst = shm + LDS_K + wid * 1024 + lane * 16; char* vdst = shm + LDS_V + wid * 1024 + lane * 16;
  const int vb0 = (int)(lds0 + LDS_V) + ((lane >> 4) & 1) * 32 + (lane & 3) * 8 + (4 * hi + ((lane & 15) >> 2)) * 64;
  u32x4 kreg = *reinterpret_cast<const u32x4*>(ksrc + (long)ts * KVBLK * PITCH), vreg = *reinterpret_cast<const u32x4*>(vsrc + (long)ts * KVBLK * PITCH), vreg2 = vreg;
  if (DV == 128) vreg2 = *reinterpret_cast<const u32x4*>(vsrc + (long)ts * KVBLK * PITCH + 64);
  const float s2 = U.slope2, s2x64 = 64.f * s2;
  f32x16 cb0, cb1;
#define ATT_REBUILD(T_) do { const float base_ = s2 * (float)(64 * (T_) - q0 + 4 * hi) - mref; const bool on_ = ((T_) >= NT - 4) || (((sel >> ((T_) >> 2)) & 1u) != 0u); \
    _Pragma("unroll") for (int r = 0; r < 16; ++r) { const float v_ = base_ + s2 * (float)((r & 3) + 8 * (r >> 2)); cb0[r] = on_ ? v_ : -INFINITY; cb1[r] = on_ ? v_ + 32.f * s2 : -INFINITY; } } while (0)
  ATT_REBUILD(ts);
  for (int t = ts; t < NT; ++t) {
    const int slot = (t & 1) * SLOTB, vslot = (t & 1) * VSLOTB;
    *reinterpret_cast<u32x4*>(kdst + slot) = kreg; *reinterpret_cast<u32x4*>(vdst + vslot) = vreg; if (DV == 128) *reinterpret_cast<u32x4*>(vdst + vslot + 8192) = vreg2;
    PROF_MARK(11);
    __syncthreads();
    PROF_MARK(12);
    if (t + 1 < NT) { kreg = *reinterpret_cast<const u32x4*>(ksrc + (long)(t + 1) * KVBLK * PITCH); vreg = *reinterpret_cast<const u32x4*>(vsrc + (long)(t + 1) * KVBLK * PITCH);
      if (DV == 128) vreg2 = *reinterpret_cast<const u32x4*>(vsrc + (long)(t + 1) * KVBLK * PITCH + 64); }
    f32x16 p0, p1; qkt(p0, p1, shm + LDS_K + slot, qr, cb0, cb1, r32, hi);
    PROF_MARK(13);
    const int jb = t - (NT - 4);
    if (jb >= 0) { const int kb = 64 * jb + 4 * hi;
#pragma unroll
      for (int r = 0; r < 16; ++r) { const int kv = kb + (r & 3) + 8 * (r >> 2); if (kv > qrel) p0[r] = -INFINITY; if (kv + 32 > qrel) p1[r] = -INFINITY; } }
    float rm = fmaxf(p0[0], p1[0]);
#pragma unroll
    for (int r = 1; r < 16; ++r) rm = fmaxf(rm, fmaxf(p0[r], p1[r]));
    rm = fmaxf(rm, __shfl_xor(rm, 32));
    bool resc = false;
    if (__any(rm > 8.0f)) { const float dl = fmaxf(rm, 0.f); mref += dl;
#pragma unroll
      for (int r = 0; r < 16; ++r) { p0[r] -= dl; p1[r] -= dl; cb0[r] -= dl; cb1[r] -= dl; }
      const float f = __builtin_amdgcn_exp2f(-dl); lrun *= f; if (hi == 0) wsf[r32] = f; resc = true; }
    float ps = 0.f;
#pragma unroll
    for (int r = 0; r < 16; ++r) { p0[r] = __builtin_amdgcn_exp2f(p0[r]); p1[r] = __builtin_amdgcn_exp2f(p1[r]); ps += p0[r] + p1[r]; }
    lrun += ps;
    u32x4 pw0, pw1, pw2, pw3;
#pragma unroll
    for (int i = 0; i < 4; ++i) { pw0[i] = cvtpk_s(p0[2 * i], p0[2 * i + 1]); pw1[i] = cvtpk_s(p0[8 + 2 * i], p0[9 + 2 * i]); pw2[i] = cvtpk_s(p1[2 * i], p1[2 * i + 1]); pw3[i] = cvtpk_s(p1[8 + 2 * i], p1[9 + 2 * i]); }
    PROF_MARK(14);
    if (resc) { asm volatile("s_waitcnt lgkmcnt(0)" ::: "memory");
#pragma unroll
      for (int r = 0; r < 16; ++r) { const float fr_ = wsf[crow(r, hi)];
#pragma unroll
        for (int d = 0; d < NDB; ++d) o[d][r] *= fr_; } }
    pv<NDB>(o, vb0 + vslot, __builtin_bit_cast(bf16x8, pw0), __builtin_bit_cast(bf16x8, pw1), __builtin_bit_cast(bf16x8, pw2), __builtin_bit_cast(bf16x8, pw3));
    PROF_MARK(15);
    if (((t + 1) & 3) == 0) { if (t + 1 < NT) ATT_REBUILD(t + 1); }
    else {
#pragma unroll
      for (int r = 0; r < 16; ++r) { cb0[r] += s2x64; cb1[r] += s2x64; } }
  }
#undef ATT_REBUILD
  PROF_MARK(16);
  lrun += __shfl_xor(lrun, 32);
  if (hi == 0) wsf[32 + r32] = lrun;
  asm volatile("s_waitcnt lgkmcnt(0)" ::: "memory");
  float rli[16];
#pragma unroll
  for (int r = 0; r < 16; ++r) rli[r] = 1.0f / wsf[32 + crow(r, hi)];
  bf16* Ow = U.O + (long)(q0 + wid * 32) * 1024;
  { bf16* stg = (bf16*)(shm + LDS_OST) + wid * 4096;
#pragma unroll
    for (int r = 0; r < 16; ++r) { const int orow = crow(r, hi);
#pragma unroll
      for (int d0 = 0; d0 < NDB; ++d0) stg[orow * DV + d0 * 32 + r32] = __float2bfloat16(o[d0][r] * rli[r]); }
    asm volatile("s_waitcnt lgkmcnt(0)" ::: "memory");
    constexpr int CPR = DV / 8, RPI = 64 / CPR;
#pragma unroll
    for (int i = 0; i < 32 / RPI; ++i) { const int row = i * RPI + lane / CPR, ch = lane % CPR; const u32x4 v = *(const u32x4*)(stg + row * DV + ch * 8); *(u32x4*)(Ow + (long)row * 1024 + ch * 8) = v; } }
  asm volatile("s_waitcnt lgkmcnt(0)" ::: "memory");
  __syncthreads();
  PROF_MARK(17);
}
}
namespace peer {
using bf16 = __hip_bfloat16;
using bf16x8 = __attribute__((ext_vector_type(8))) short;
using f32x16 = __attribute__((ext_vector_type(16))) float;
using u32x4 = __attribute__((ext_vector_type(4))) unsigned;
__device__ __forceinline__ int crow(int r, int hi) { return (r & 3) + 8 * (r >> 2) + 4 * hi; }
__device__ __forceinline__ int f2key(float f) { const int b = __float_as_int(f); return b ^ ((b >> 31) & 0x7fffffff); }
__device__ __forceinline__ float key2f(int k) { return __int_as_float(k ^ ((k >> 31) & 0x7fffffff)); }
__device__ __forceinline__ void ins16(int (&L)[16], int v) {
#pragma unroll
  for (int i = 0; i < 16; ++i) { const int a = L[i]; L[i] = a > v ? a : v; v = a > v ? v : a; }
}
#define PEER_CE(A_, B_) do { const int a_ = (A_), b_ = (B_); (A_) = a_ > b_ ? a_ : b_; (B_) = a_ > b_ ? b_ : a_; } while (0)
#define PEER_SORT16(V) do { PEER_CE(V[0], V[1]); PEER_CE(V[3], V[2]); PEER_CE(V[4], V[5]); PEER_CE(V[7], V[6]); PEER_CE(V[8], V[9]); PEER_CE(V[11], V[10]); PEER_CE(V[12], V[13]); PEER_CE(V[15], V[14]); PEER_CE(V[0], V[2]); PEER_CE(V[1], V[3]); PEER_CE(V[6], V[4]); PEER_CE(V[7], V[5]); PEER_CE(V[8], V[10]); PEER_CE(V[9], V[11]); PEER_CE(V[14], V[12]); PEER_CE(V[15], V[13]); PEER_CE(V[0], V[1]); PEER_CE(V[2], V[3]); PEER_CE(V[5], V[4]); PEER_CE(V[7], V[6]); PEER_CE(V[8], V[9]); PEER_CE(V[10], V[11]); PEER_CE(V[13], V[12]); PEER_CE(V[15], V[14]); PEER_CE(V[0], V[4]); PEER_CE(V[1], V[5]); PEER_CE(V[2], V[6]); PEER_CE(V[3], V[7]); PEER_CE(V[12], V[8]); PEER_CE(V[13], V[9]); PEER_CE(V[14], V[10]); PEER_CE(V[15], V[11]); PEER_CE(V[0], V[2]); PEER_CE(V[1], V[3]); PEER_CE(V[4], V[6]); PEER_CE(V[5], V[7]); PEER_CE(V[10], V[8]); PEER_CE(V[11], V[9]); PEER_CE(V[14], V[12]); PEER_CE(V[15], V[13]); PEER_CE(V[0], V[1]); PEER_CE(V[2], V[3]); PEER_CE(V[4], V[5]); PEER_CE(V[6], V[7]); PEER_CE(V[9], V[8]); PEER_CE(V[11], V[10]); PEER_CE(V[13], V[12]); PEER_CE(V[15], V[14]); PEER_CE(V[0], V[8]); PEER_CE(V[1], V[9]); PEER_CE(V[2], V[10]); PEER_CE(V[3], V[11]); PEER_CE(V[4], V[12]); PEER_CE(V[5], V[13]); PEER_CE(V[6], V[14]); PEER_CE(V[7], V[15]); PEER_CE(V[0], V[4]); PEER_CE(V[1], V[5]); PEER_CE(V[2], V[6]); PEER_CE(V[3], V[7]); PEER_CE(V[8], V[12]); PEER_CE(V[9], V[13]); PEER_CE(V[10], V[14]); PEER_CE(V[11], V[15]); PEER_CE(V[0], V[2]); PEER_CE(V[1], V[3]); PEER_CE(V[4], V[6]); PEER_CE(V[5], V[7]); PEER_CE(V[8], V[10]); PEER_CE(V[9], V[11]); PEER_CE(V[12], V[14]); PEER_CE(V[13], V[15]); PEER_CE(V[0], V[1]); PEER_CE(V[2], V[3]); PEER_CE(V[4], V[5]); PEER_CE(V[6], V[7]); PEER_CE(V[8], V[9]); PEER_CE(V[10], V[11]); PEER_CE(V[12], V[13]); PEER_CE(V[14], V[15]); } while (0)
__device__ __forceinline__ void mergetop16(int (&L)[16], const int (&S)[16]) {
  int M[16];
#pragma unroll
  for (int i = 0; i < 16; ++i) M[i] = L[i] > S[15 - i] ? L[i] : S[15 - i];
#pragma unroll
  for (int s = 8; s >= 1; s >>= 1)
#pragma unroll
    for (int i = 0; i < 16; ++i) if ((i & s) == 0) PEER_CE(M[i], M[i + s]);
#pragma unroll
  for (int i = 0; i < 16; ++i) L[i] = M[i];
}
__device__ __forceinline__ void merge16(int (&L)[16]) {
  int S[16];
#pragma unroll
  for (int i = 0; i < 16; ++i) S[i] = __shfl_xor(L[i], 32);
  mergetop16(L, S);
}
#define PEER_CAND_LIST(X) \
  X(0,0,0, 2,1) X(1,0,1, 2,2) X(2,0,2, 2,3) X(3,0,3, 2,4) X(4,0,4, 3,0) X(5,0,5, 3,1) X(6,0,6, 3,2) X(7,0,7, 3,3) X(8,0,8, 4,0) X(9,0,9, 4,1) X(10,0,10, 4,2) X(11,0,11, 5,0) X(12,0,12, 5,1) X(13,0,13, 6,0) X(14,0,14, 6,1) X(15,0,15, 7,0) X(16,1,0, 7,1) X(17,1,1, 8,0) X(18,1,2, 9,0) X(19,1,3, 10,0) X(20,1,4, 11,0) X(21,1,5, 12,0) X(22,1,6, 13,0) X(23,1,7, 14,0) X(24,2,0, 15,0)

#define PEER_KROW 272
__device__ __forceinline__ void topk_task(const bf16* QP, const char* ksl, const float* ssq, float* RSTD, int* LE, float* LG, int tg, int h, int lane, bf16x8 (&q0f)[8], int tg_next) {
  const int r32 = lane & 31, hi = lane >> 5; const int t = tg * 32 + r32;
  int A[16], B[16];
  bf16x8 q1f[8];
#pragma unroll
  for (int ks = 0; ks < 8; ++ks) q1f[ks] = *reinterpret_cast<const bf16x8*>(QP + (size_t)t * 2048 + h * 256 + 128 + ks * 16 + hi * 8);
#pragma unroll
  for (int p = 0; p < 2; ++p) {
    int L[16];
#pragma unroll
    for (int i = 0; i < 16; ++i) L[i] = (int)0x80000000;
    const char* kb = ksl + p * (128 * PEER_KROW) + r32 * PEER_KROW + hi * 16;
#pragma unroll 1
    for (int i = 0; i < 4; ++i) {
      f32x16 acc = {};
#pragma unroll
      for (int ks = 0; ks < 8; ++ks) { const bf16x8 a = *reinterpret_cast<const bf16x8*>(kb + i * (32 * PEER_KROW) + ks * 32); acc = __builtin_amdgcn_mfma_f32_32x32x16_bf16(a, p == 0 ? q0f[ks] : q1f[ks], acc, 0, 0, 0); }
      int S[16];
#pragma unroll
      for (int r = 0; r < 16; ++r) S[r] = (f2key(acc[r]) & ~127) | (i * 32 + crow(r, hi));
      PEER_SORT16(S);
      mergetop16(L, S);
    }
    merge16(L);
#pragma unroll
    for (int i = 0; i < 16; ++i) { if (p == 0) A[i] = L[i]; else B[i] = L[i]; }
    if (p == 0 && tg_next >= 0) {
#pragma unroll
      for (int ks = 0; ks < 8; ++ks) q0f[ks] = *reinterpret_cast<const bf16x8*>(QP + (size_t)(tg_next * 32 + r32) * 2048 + h * 256 + ks * 16 + hi * 8); }
  }
  float Af[16], Bf[16];
#pragma unroll
  for (int i = 0; i < 16; ++i) { Af[i] = key2f(A[i] & ~127); Bf[i] = key2f(B[i] & ~127); }
  float C[25];
#define X(c, i0, j0, i1, j1) C[c] = hi ? (Af[i1] + Bf[j1]) : (Af[i0] + Bf[j0]);
  PEER_CAND_LIST(X)
#undef X
  int L[16];
#pragma unroll
  for (int i = 0; i < 16; ++i) L[i] = (int)0x80000000;
#pragma unroll
  for (int c = 0; c < 25; ++c) ins16(L, f2key(C[c]));
  merge16(L);
  const int tau = L[15]; const float cmax = Af[0] + Bf[0];
  float s = 0.f;
#pragma unroll
  for (int i = 0; i < 16; ++i) s += ssq[(size_t)t * 16 + i];
  const float rstd = 1.0f / sqrtf(s * (1.0f / 1024.0f) + 1e-6f);
  const float k2 = rstd * 1.4426950408889634f;
  if (h == 0 && hi == 0) RSTD[t] = rstd;
  float E[25]; float den = 0.f; int cnt = 0; unsigned selm = 0u;
#pragma unroll
  for (int c = 0; c < 25; ++c) { const bool sl = f2key(C[c]) >= tau; E[c] = sl ? __builtin_amdgcn_exp2f((C[c] - cmax) * k2) : 0.f; den += E[c]; cnt += sl ? 1 : 0; selm |= sl ? (1u << c) : 0u; }
  den += __shfl_xor(den, 32);
  const int ocnt = __shfl_xor(cnt, 32);
  int pos = hi ? ocnt : 0;
  const float rden = 1.0f / den;
  int* le = LE + (size_t)t * 128 + h * 16; float* lg = LG + (size_t)t * 128 + h * 16;
#define X(c, i0, j0, i1, j1) { if (((selm >> c) & 1u) && pos < 16) { const int ka = (hi ? A[i1] : A[i0]) & 127, kb2 = (hi ? B[j1] : B[j0]) & 127; le[pos] = ka * 128 + kb2; lg[pos] = E[c] * rden; ++pos; } }
  PEER_CAND_LIST(X)
#undef X
}

__device__ __forceinline__ float gelu_erf(float v) { return 0.5f * v * (1.0f + erff(v * 0.70710678118654752f)); }
__device__ __forceinline__ void unpack8(const u32x4 w, float (&f)[8]) {
#pragma unroll
  for (int i = 0; i < 4; ++i) { f[2 * i] = __uint_as_float(w[i] << 16); f[2 * i + 1] = __uint_as_float(w[i] & 0xffff0000u); }
}
#define PEER_DPP(v, ctrl, rmask) __int_as_float(__builtin_amdgcn_update_dpp(0, __float_as_int(v), ctrl, rmask, 0xf, false))
__device__ __forceinline__ float wave_total(float v) {
  v += PEER_DPP(v, 0xB1, 0xf);
  v += PEER_DPP(v, 0x4E, 0xf);
  v += PEER_DPP(v, 0x141, 0xf);
  v += PEER_DPP(v, 0x140, 0xf);
  v += PEER_DPP(v, 0x142, 0xa);
  v += PEER_DPP(v, 0x143, 0xc);
  return __int_as_float(__builtin_amdgcn_readlane(__float_as_int(v), 63));
}
typedef float f32x4_t __attribute__((ext_vector_type(4)));
typedef float f32x2_t __attribute__((ext_vector_type(2)));
__device__ __forceinline__ float ub0(unsigned w) { return (float)(w & 255u); }
__device__ __forceinline__ float ub1(unsigned w) { return (float)((w >> 8) & 255u); }
__device__ __forceinline__ float ub2(unsigned w) { return (float)((w >> 16) & 255u); }
__device__ __forceinline__ float ub3(unsigned w) { return (float)(w >> 24); }
#define PEER_DPPI(v, ctrl, rmask) __builtin_amdgcn_update_dpp(0, v, ctrl, rmask, 0xf, false)
__device__ __forceinline__ int wave_total_i(int v) {
  v += PEER_DPPI(v, 0xB1, 0xf); v += PEER_DPPI(v, 0x4E, 0xf); v += PEER_DPPI(v, 0x141, 0xf); v += PEER_DPPI(v, 0x140, 0xf); v += PEER_DPPI(v, 0x142, 0xa); v += PEER_DPPI(v, 0x143, 0xc);
  return __builtin_amdgcn_readlane(v, 63);
}
__device__ __forceinline__ float quant_row16(const float (&v)[16], unsigned char* dst16  , int bias) {
  float m = 0.f;
#pragma unroll
  for (int i = 0; i < 16; ++i) m = fmaxf(m, fabsf(v[i]));
#pragma unroll
  for (int o = 1; o < 64; o <<= 1) m = fmaxf(m, __shfl_xor(m, o));
  const float inv = m > 0.f ? 127.0f / m : 0.f;
  u32x4 w;
#pragma unroll
  for (int q = 0; q < 4; ++q) { unsigned x = 0u;
#pragma unroll
    for (int i = 0; i < 4; ++i) { const int qi = (int)rintf(v[4 * q + i] * inv) + bias; x |= ((unsigned)qi & 255u) << (8 * i); }
    w[q] = x; }
  *reinterpret_cast<u32x4*>(dst16) = w;
  return m * (1.0f / 127.0f);
}
#define PEER_UFETCH(G_) do { const size_t tb_ = (size_t)(G_) * 4; _Pragma("unroll") for (int j = 0; j < 4; ++j) { \
    e0[j] = LE[(tb_ + j) * 128 + lane] & 16383; e1[j] = LE[(tb_ + j) * 128 + 64 + lane] & 16383; g0[j] = LG[(tb_ + j) * 128 + lane]; g1[j] = LG[(tb_ + j) * 128 + 64 + lane]; \
    xa[j] = *reinterpret_cast<const u32x4*>(XQ + (tb_ + j) * 1024 + lane * 16); } \
    rs4 = *reinterpret_cast<const f32x4_t*>(HS + tb_); } while (0)
__device__ __forceinline__ void expert_u_pass(const unsigned char* XQ, const unsigned char* U8, const float* HS, const float* SU, const float* SV, const int* LE, const float* LG, unsigned* PACK, int slice, int wx, int nwx, int lane, char* wl PROF_ARGS) {
  unsigned* list = (unsigned*)(wl + 4096);
  int e0[4], e1[4]; float g0[4], g1[4]; u32x4 xa[4]; f32x4_t rs4;
  int gi = wx;
  if (gi < 8192) PEER_UFETCH(gi);
  for (; gi < 8192; gi += nwx) {
    PROF_MARK(24);
    int n = 0;
    const f32x4_t rs = rs4;
#pragma unroll
    for (int j = 0; j < 4; ++j) {
      *reinterpret_cast<u32x4*>(wl + j * 1024 + lane * 16) = xa[j];
      { const bool in = (e0[j] >> 11) == slice; const unsigned long long m = __ballot(in);
        if (in) { const int pos = n + (int)__builtin_amdgcn_mbcnt_hi((unsigned)(m >> 32), __builtin_amdgcn_mbcnt_lo((unsigned)m, 0u)); list[2 * pos] = (unsigned)e0[j] | ((unsigned)lane << 14) | ((unsigned)j << 21); list[2 * pos + 1] = __float_as_uint(g0[j]); }
        n += __builtin_popcountll(m); }
      { const bool in = (e1[j] >> 11) == slice; const unsigned long long m = __ballot(in);
        if (in) { const int pos = n + (int)__builtin_amdgcn_mbcnt_hi((unsigned)(m >> 32), __builtin_amdgcn_mbcnt_lo((unsigned)m, 0u)); list[2 * pos] = (unsigned)e1[j] | ((unsigned)(64 + lane) << 14) | ((unsigned)j << 21); list[2 * pos + 1] = __float_as_uint(g1[j]); }
        n += __builtin_popcountll(m); }
    }
    n = __builtin_amdgcn_readfirstlane(n);
    PROF_MARK(20);
    const int gnext = gi + nwx;
#define PEER_UISSUE(UA_, WL_, GK_, SU_, SV_, B_) do { { const int i = ((B_) + (lane >> 2) < n) ? ((B_) + (lane >> 2)) : (n - 1); WL_ = list[2 * i]; GK_ = __uint_as_float(list[2 * i + 1]); } \
      _Pragma("unroll") for (int s = 0; s < 16; ++s) { const unsigned w = (unsigned)__builtin_amdgcn_readlane((int)WL_, 4 * s); \
        UA_[s] = *reinterpret_cast<const u32x4*>(U8 + (size_t)(w & 16383u) * 1024 + lane * 16); } \
      SU_ = SU[WL_ & 16383u]; SV_ = SV[WL_ & 16383u]; } while (0)
#define PEER_UCOMP(UA_, WL_, GK_, SU_, SV_, B_) do { int q[16]; \
      _Pragma("unroll") for (int s = 0; s < 16; ++s) { const unsigned js_ = ((unsigned)__builtin_amdgcn_readlane((int)WL_, 4 * s) >> 21) & 3u; const u32x4 xl = *reinterpret_cast<const u32x4*>(wl + js_ * 1024 + lane * 16); int q_ = 0; \
        _Pragma("unroll") for (int i = 0; i < 4; ++i) q_ = __builtin_amdgcn_sdot4((int)UA_[s][i], (int)xl[i], q_, false); q[s] = q_; if ((s & 3) == 3) __builtin_amdgcn_sched_barrier(0); } \
        \
      int r8[8], r4[4], r2[2], r1; \
      { const bool bb = (lane & 32) != 0; _Pragma("unroll") for (int i = 0; i < 8; ++i) { const int keep = bb ? q[8 + i] : q[i], send = bb ? q[i] : q[8 + i]; r8[i] = keep + __shfl_xor(send, 32); } } \
      { const bool bb = (lane & 16) != 0; _Pragma("unroll") for (int i = 0; i < 4; ++i) { const int keep = bb ? r8[4 + i] : r8[i], send = bb ? r8[i] : r8[4 + i]; r4[i] = keep + __shfl_xor(send, 16); } } \
      { const bool bb = (lane & 8) != 0; _Pragma("unroll") for (int i = 0; i < 2; ++i) { const int keep = bb ? r4[2 + i] : r4[i], send = bb ? r4[i] : r4[2 + i]; r2[i] = keep + __shfl_xor(send, 8); } } \
      { const bool bb = (lane & 4) != 0; const int keep = bb ? r2[1] : r2[0], send = bb ? r2[0] : r2[1]; r1 = keep + __shfl_xor(send, 4); } \
      r1 += PEER_DPPI(r1, 0xB1, 0xf); r1 += PEER_DPPI(r1, 0x4E, 0xf); \
      if ((lane & 3) == 0 && (B_) + (lane >> 2) < n) { const unsigned w = WL_; const float gk = GK_; const unsigned j = (w >> 21) & 3u; const unsigned e = w & 16383u; \
        const float r = j == 0 ? rs[0] : j == 1 ? rs[1] : j == 2 ? rs[2] : rs[3]; \
        const float a = gelu_erf((float)r1 * r * SU_) * gk * SV_; const unsigned ab = __float_as_uint(a); const unsigned rb = (ab + 0x7fffu + ((ab >> 16) & 1u)) & 0xffff0000u; \
        PACK[((size_t)gi * 4 + j) * 128 + ((w >> 14) & 127u)] = rb | e; } } while (0)
    if (gnext < 8192) PEER_UFETCH(gnext);
    PROF_MARK(23);
    if (n > 0) {
      u32x4 uA[16], uB[16]; unsigned wA, wB; float gA, gB, suA, svA, suB, svB;
      PEER_UISSUE(uA, wA, gA, suA, svA, 0);
      PROF_MARK(21);
      for (int b = 0; b < n; b += 32) {
        if (b + 16 < n) PEER_UISSUE(uB, wB, gB, suB, svB, b + 16);
        PROF_MARK(21);
        PEER_UCOMP(uA, wA, gA, suA, svA, b);
        PROF_MARK(22);
        if (b + 16 >= n) break;
        if (b + 32 < n) PEER_UISSUE(uA, wA, gA, suA, svA, b + 32);
        PROF_MARK(21);
        PEER_UCOMP(uB, wB, gB, suB, svB, b + 16);
        PROF_MARK(22);
      }
    }
  }
}
#define PEER_VISSUE(S_, A_, P0_, P1_) do { _Pragma("unroll") for (int i = 0; i < 16; ++i) { const unsigned pk = (unsigned)__builtin_amdgcn_ds_bpermute(((8 * i + g) & 63) << 2, (int)(i < 8 ? P0_ : P1_)); \
    A_[i] = __uint_as_float(pk & 0xffff0000u); S_[i] = *reinterpret_cast<const u32x4*>(V8 + (size_t)slice * (16384 * 128) + (size_t)(pk & 16383u) * 128 + c * 16); } } while (0)
#define PEER_VFINISH(S_, A_, T_, O_) do { float acc[16]; float asum = 0.f; _Pragma("unroll") for (int i = 0; i < 16; ++i) acc[i] = 0.f; \
    _Pragma("unroll") for (int i = 0; i < 16; ++i) { const float a_ = A_[i]; asum += a_; _Pragma("unroll") for (int q = 0; q < 4; ++q) { const unsigned w_ = S_[i][q]; \
        acc[4 * q] += a_ * ub0(w_); acc[4 * q + 1] += a_ * ub1(w_); acc[4 * q + 2] += a_ * ub2(w_); acc[4 * q + 3] += a_ * ub3(w_); } } \
    _Pragma("unroll") for (int i = 0; i < 16; ++i) acc[i] -= 128.f * asum; \
    float m8[8], m4[4], m2[2]; \
    { const bool bb = (g & 4) != 0; _Pragma("unroll") for (int i = 0; i < 8; ++i) { const float keep = bb ? acc[8 + i] : acc[i], send = bb ? acc[i] : acc[8 + i]; m8[i] = keep + __shfl_xor(send, 32); } } \
    { const bool bb = (g & 2) != 0; _Pragma("unroll") for (int i = 0; i < 4; ++i) { const float keep = bb ? m8[4 + i] : m8[i], send = bb ? m8[i] : m8[4 + i]; m4[i] = keep + __shfl_xor(send, 16); } } \
    { const bool bb = (g & 1) != 0; _Pragma("unroll") for (int i = 0; i < 2; ++i) { const float keep = bb ? m4[2 + i] : m4[i], send = bb ? m4[i] : m4[2 + i]; m2[i] = keep + __shfl_xor(send, 8); } } \
    f32x2_t r_ = (O_); r_[0] += m2[0]; r_[1] += m2[1]; *reinterpret_cast<f32x2_t*>(out + (size_t)(T_) * 1024 + slice * 128 + 16 * c + 2 * g) = r_; } while (0)
__device__ __forceinline__ void expert_v_pass(const unsigned char* V8, const unsigned* PACK, float* out, int slice, int wx, int nwx, int lane PROF_ARGS) {
  const int g = lane >> 3, c = lane & 7;
  const int MT = 32768;
  u32x4 sA[16], sB[16]; float aA[16], aB[16];
  unsigned pA0 = 0, pA1 = 0, pB0 = 0, pB1 = 0, pC0 = 0, pC1 = 0, pD0 = 0, pD1 = 0; f32x2_t oA = {0.f, 0.f}, oB = oA, oC = oA, oD = oA;
#define PEER_OLD(T_) (*reinterpret_cast<const f32x2_t*>(out + (size_t)(T_) * 1024 + slice * 128 + 16 * c + 2 * g))
#define PEER_VMETA(P0_, P1_, O_, T_) do { if ((T_) < MT) { P0_ = PACK[(size_t)(T_) * 128 + lane]; P1_ = PACK[(size_t)(T_) * 128 + 64 + lane]; O_ = PEER_OLD(T_); } } while (0)
  int t = wx;
  PEER_VMETA(pA0, pA1, oA, t); PEER_VMETA(pB0, pB1, oB, t + nwx); PEER_VMETA(pC0, pC1, oC, t + 2 * nwx); PEER_VMETA(pD0, pD1, oD, t + 3 * nwx);
  if (t < MT) PEER_VISSUE(sA, aA, pA0, pA1);
  for (; t < MT; t += 2 * nwx) {
    const int t1 = t + nwx, t2 = t + 2 * nwx;
    PROF_MARK(34);
    if (t1 < MT) PEER_VISSUE(sB, aB, pB0, pB1);
    PROF_MARK(30);
    unsigned pE0 = 0, pE1 = 0, pF0 = 0, pF1 = 0; f32x2_t oE = {0.f, 0.f}, oF = oE;
    PEER_VMETA(pE0, pE1, oE, t + 4 * nwx);
    PROF_MARK(31);
    PEER_VFINISH(sA, aA, t, oA);
    PROF_MARK(32);
    if (t1 >= MT) break;
    if (t2 < MT) PEER_VISSUE(sA, aA, pC0, pC1);
    PROF_MARK(30);
    PEER_VMETA(pF0, pF1, oF, t + 5 * nwx);
    PROF_MARK(31);
    PEER_VFINISH(sB, aB, t1, oB);
    PROF_MARK(32);
    pA0 = pC0; pA1 = pC1; oA = oC; pB0 = pD0; pB1 = pD1; oB = oD; pC0 = pE0; pC1 = pE1; oC = oE; pD0 = pF0; pD1 = pF1; oD = oF;
  }
#undef PEER_OLD
#undef PEER_VMETA
}
__device__ __forceinline__ void quant_token(const bf16* XMB, const float* ssq, unsigned char* XQ, float* HS, int t, int lane) {
  const u32x4 a = *reinterpret_cast<const u32x4*>(XMB + (size_t)t * 1024 + lane * 16), b = *reinterpret_cast<const u32x4*>(XMB + (size_t)t * 1024 + lane * 16 + 8);
  float fa[8], fb[8], v[16]; unpack8(a, fa); unpack8(b, fb);
#pragma unroll
  for (int i = 0; i < 8; ++i) { v[i] = fa[i]; v[8 + i] = fb[i]; }
  const float sx = quant_row16(v, XQ + (size_t)t * 1024 + lane * 16, 0);
  float s = 0.f;
#pragma unroll
  for (int i = 0; i < 16; ++i) s += ssq[(size_t)t * 16 + i];
  if (lane == 0) HS[t] = sx / sqrtf(s * (1.0f / 1024.0f) + 1e-6f);
}
}
constexpr int NWAVES = 8;
constexpr int BATCH = 16, SEQ = 2048, D = 1024, M = BATCH * SEQ, NPROJ = 3072, NQP = 2048, NEXP = 16384;
constexpr float RMS_EPS = 1e-6f;
constexpr float C2 = 0.125f * 1.4426950408889634f;
constexpr float LOG2E = 1.4426950408889634f;
constexpr size_t MiB = 1u << 20;
constexpr size_t WS_CTL = 0, CTL_ZERO_BYTES = 1 * MiB;
constexpr size_t WS_WIN = 1 * MiB;
constexpr size_t WS_WOUT = 7 * MiB;
constexpr size_t WS_WQ = 9 * MiB;
constexpr size_t WS_SK = 13 * MiB;
constexpr size_t WS_KPART = 13 * MiB + 512 * 1024;
constexpr size_t WS_SSQ = 14 * MiB;
constexpr size_t WS_MISC = 16 * MiB;
constexpr size_t WS_SU = WS_MISC + 65536, WS_SV = WS_MISC + 131072, WS_HS = WS_MISC + 262144;
constexpr size_t WS_U8 = 17 * MiB;
constexpr size_t WS_V8 = 33 * MiB;
constexpr size_t WS_XQ = 49 * MiB;
constexpr size_t WS_XN = 81 * MiB;
constexpr size_t WS_MIX = 145 * MiB;
constexpr size_t WS_DO = 209 * MiB;
constexpr size_t WS_PROJ = 273 * MiB;
constexpr size_t WS_QP = WS_PROJ;
constexpr size_t WS_LE = WS_PROJ + 128 * MiB;
constexpr size_t WS_LG = WS_PROJ + 144 * MiB;
constexpr size_t WS_PACK = WS_PROJ + 160 * MiB;
constexpr size_t WS_RSTD = WS_PROJ + 176 * MiB;
constexpr size_t WS_END = 465 * MiB;
constexpr int CW_BAR = 4096;
constexpr int RING_OFF = 0, RING_BYTES = 131072;
constexpr int LDSCTL_OFF = RING_BYTES, MISC_OFF = LDSCTL_OFF + 320;
constexpr int LDS_BYTES = 147456;
static_assert(att::LDS_BYTES <= RING_BYTES, "attention scratch fits the ring region");

#define GAS __attribute__((address_space(1)))
#define LAS __attribute__((address_space(3)))
typedef unsigned short bf16;
typedef unsigned v4u __attribute__((ext_vector_type(4)));
typedef unsigned v2u __attribute__((ext_vector_type(2)));
typedef float f32x4 __attribute__((ext_vector_type(4)));
typedef GAS unsigned gu32;
#define RLX_AGENT __ATOMIC_RELAXED, __HIP_MEMORY_SCOPE_AGENT
#define LDS_WAIT() asm volatile("s_waitcnt lgkmcnt(0)" ::: "memory")
#define VM_WAIT() asm volatile("s_waitcnt vmcnt(0)" ::: "memory")
__device__ __forceinline__ unsigned f2bf(float f) { unsigned u = __builtin_bit_cast(unsigned, f); return (u + 0x7fffu + ((u >> 16) & 1u)) >> 16; }
__device__ __forceinline__ unsigned pk2(float lo, float hi) { return f2bf(lo) | (f2bf(hi) << 16); }
#define XB_TMO      128
#define XB_XCNT(j)  (256  + 64 * (j))
#define XB_XSUB(j)  (1280 + 64 * (j))
#define XB_XGEN(j)  (2304 + 64 * (j))
#define XB_TOP      3328
#define XB_TOPGEN   3392
#define XCD_BAR_WORDS 3456
#define XB_SPIN_CAP (1u << 23)

__device__ __forceinline__ unsigned xb_ld(unsigned* p)              { return __hip_atomic_load(p, __ATOMIC_RELAXED, __HIP_MEMORY_SCOPE_AGENT); }
__device__ __forceinline__ unsigned xb_add(unsigned* p, unsigned v) { return __hip_atomic_fetch_add(p, v, __ATOMIC_RELAXED, __HIP_MEMORY_SCOPE_AGENT); }
__device__ __forceinline__ unsigned xb_xcc_id() { return (unsigned)__builtin_amdgcn_s_getreg((3 << 11) | 20) & 0xFu; }
#define XB_SPIN(cond, bar) do { unsigned _sp = 0; while (cond) { __builtin_amdgcn_s_sleep(1); \
    if ((++_sp & 255u) == 0u) { if (xb_ld(&(bar)[XB_TMO])) break; if (_sp > XB_SPIN_CAP) { atomicAdd(&(bar)[XB_TMO], 1u); break; } } } } while (0)

struct XcdBarrier {
    unsigned* bar; unsigned x;
    volatile LAS unsigned* st;
};

__device__ __forceinline__ XcdBarrier xcd_barrier_post(unsigned* bar, volatile LAS unsigned* st) {
    XcdBarrier b; b.bar = bar; b.x = xb_xcc_id(); b.st = st;
    if (threadIdx.x == 0) (void)xb_add(&bar[XB_XCNT(b.x)], 1u);
    return b;
}
__device__ __forceinline__ void xcd_barrier_complete(unsigned* bar, unsigned x, unsigned& nloc, unsigned& nx) {
    const unsigned G = gridDim.x * gridDim.y * gridDim.z;
    unsigned sum, cnt, mine, sp = 0u;
    for (;;) {
        sum = 0u; cnt = 0u; mine = 0u;
#pragma unroll
        for (unsigned j = 0; j < 16; ++j) { const unsigned c = xb_ld(&bar[XB_XCNT(j)]); sum += c; cnt += (c > 0u) ? 1u : 0u; mine = (j == x) ? c : mine; }
        if (sum == G) break;
        __builtin_amdgcn_s_sleep(1);
        if ((++sp & 255u) == 0u) { if (xb_ld(&bar[XB_TMO])) break; if (sp > XB_SPIN_CAP) { atomicAdd(&bar[XB_TMO], 1u); break; } }
    }
    nloc = mine > 0u ? mine : 1u; nx = cnt > 0u ? cnt : 1u;
}

__device__ __forceinline__ void xcd_barrier(const XcdBarrier& b) {
    asm volatile("s_waitcnt vmcnt(0)" ::: "memory");
    __syncthreads();
    if (threadIdx.x == 0) {
        unsigned* bar = b.bar;
        __builtin_amdgcn_s_waitcnt(0);
        unsigned nloc = b.st[0], nx = b.st[1];
        if (nloc == 0u) { xcd_barrier_complete(bar, b.x, nloc, nx); b.st[0] = nloc; b.st[1] = nx; }
        const unsigned old = xb_add(&bar[XB_XSUB(b.x)], 1u);
        const unsigned gen = old / nloc;
        if (old + 1u == (gen + 1u) * nloc) {
            __builtin_amdgcn_fence(__ATOMIC_RELEASE, "agent");
            asm volatile("s_waitcnt vmcnt(0)" ::: "memory");
            const unsigned og = xb_add(&bar[XB_TOP], 1u);
            const unsigned tg = og / nx;
            if (og + 1u == (tg + 1u) * nx) xb_add(&bar[XB_TOPGEN], 1u);
            else XB_SPIN(xb_ld(&bar[XB_TOPGEN]) == tg, bar);
            __builtin_amdgcn_fence(__ATOMIC_ACQUIRE, "agent");
            xb_add(&bar[XB_XGEN(b.x)], 1u);
            asm volatile("s_waitcnt vmcnt(0)" ::: "memory");
        } else {
            XB_SPIN(xb_ld(&bar[XB_XGEN(b.x)]) == gen, bar);
            __builtin_amdgcn_fence(__ATOMIC_ACQUIRE, "agent");
            asm volatile("s_waitcnt vmcnt(0)" ::: "memory");
        }
    }
    __syncthreads();
}
struct Frame {
    LAS unsigned char* lds;
    volatile LAS unsigned* MISC;
    gu32* ctl;
    int tid, lane, wave;
    int vcu, G;
};
__device__ __forceinline__ float wave_sum(float v) {
#pragma unroll
    for (int o = 1; o < 64; o <<= 1) v += __shfl_xor(v, o);
    return v;
}
template <bool PERMROWS>
__device__ __forceinline__ void p0_transpose_item(const float* W, int K, int N, bf16* WT, const float* kscale, LAS float* scr, int item, int lane) {
    const int nblk = N / 32, kb = item / nblk, nb = item % nblk, k0 = 64 * kb, n0 = 32 * nb;
#pragma unroll 8
    for (int i = 0; i < 32; ++i) { const int kk = 2 * i + (lane >> 5); float w = W[(size_t)(k0 + kk) * N + n0 + (lane & 31)]; if (kscale) w *= kscale[k0 + kk]; scr[kk * 33 + (lane & 31)] = w; }
    LDS_WAIT(); asm volatile("" ::: "memory");
    int r0 = n0;
    if (PERMROWS) { const int tl = n0 >> 8, np = n0 & 255; r0 = tl * 256 + ((np >> 5) & 1) * 128 + (np >> 6) * 32; }
    const int c = lane & 7;
#pragma unroll
    for (int j = 0; j < 4; ++j) { const int n = (lane >> 3) + 8 * j; const LAS float* s = scr + (8 * c) * 33 + n;
        v4u o; o.x = pk2(s[0 * 33], s[1 * 33]); o.y = pk2(s[2 * 33], s[3 * 33]); o.z = pk2(s[4 * 33], s[5 * 33]); o.w = pk2(s[6 * 33], s[7 * 33]);
        *(GAS v4u*)(WT + (size_t)(r0 + n) * K + k0 + 8 * c) = o; }
    LDS_WAIT(); asm volatile("" ::: "memory");
}
__device__ __forceinline__ void cvt8(const float* src, bf16* dst, size_t e, const float* cscale) {
    f32x4 a = *(const GAS f32x4*)(src + e), b = *(const GAS f32x4*)(src + e + 4);
    if (cscale) { const int c = (int)(e & 1023); const f32x4 ga = *(const f32x4*)(cscale + c), gb = *(const f32x4*)(cscale + c + 4); a = a * ga; b = b * gb; }
    v4u o; o.x = pk2(a[0], a[1]); o.y = pk2(a[2], a[3]); o.z = pk2(b[0], b[1]); o.w = pk2(b[2], b[3]);
    *(GAS v4u*)(dst + e) = o;
}
__device__ __forceinline__ void rms_row_to_bf16(const float* xrow, const float* g, bf16* orow, int lane) {
    const GAS f32x4* xr = (const GAS f32x4*)xrow + lane;
    f32x4 v[4]; float s = 0.f;
#pragma unroll
    for (int j = 0; j < 4; ++j) { v[j] = xr[64 * j]; s += (v[j].x * v[j].x + v[j].y * v[j].y) + (v[j].z * v[j].z + v[j].w * v[j].w); }
    const float rstd = 1.f / sqrtf(wave_sum(s) * (1.f / 1024.f) + RMS_EPS);
    GAS unsigned long long* o8 = (GAS unsigned long long*)orow + lane;
#pragma unroll
    for (int j = 0; j < 4; ++j) { const f32x4 gg = *((const f32x4*)g + lane + 64 * j);
        o8[64 * j] = (unsigned long long)pk2(v[j].x * rstd * gg.x, v[j].y * rstd * gg.y) | ((unsigned long long)pk2(v[j].z * rstd * gg.z, v[j].w * rstd * gg.w) << 32); }
}

#define P0_TLOAD(R_) do { const bool isu_ = (R_) < NEXP; const float* s_ = (isu_ ? peer_u : peer_v) + (size_t)(isu_ ? (R_) : (R_) - NEXP) * 1024 + F.lane * 16; \
                _Pragma("unroll") for (int q = 0; q < 4; ++q) nx[q] = *(const GAS f32x4*)(s_ + 4 * q); } while (0)
#define DEFERRED_WEIGHTS_BLOCK { LAS float* scr_ = (LAS float*)(F.lds + RING_OFF + F.wave * 16384); constexpr int IO_ = (D / 64) * (D / 32), IQ_ = (D / 64) * (NQP / 32); \
    for (int it = gw; it < IO_ + IQ_; it += NGW) { if (it < IO_) p0_transpose_item<false>(w_out, D, D, WOUT, nullptr, scr_, it, F.lane); else p0_transpose_item<false>(w_query, D, NQP, WQ, norm2_g, scr_, it - IO_, F.lane); } \
    for (size_t c = (size_t)gw * 64 + F.lane; c < (size_t)16 * 128 * 128 / 8; c += (size_t)NGW * 64) cvt8(sub_keys, SK, c * 8, nullptr); __syncthreads(); }
#define TABLE_QUANT_BLOCK { f32x4 nx[4]; int r = gw; if (r < 2 * NEXP) P0_TLOAD(r); f32x4 gq[4]; _Pragma("unroll") for (int q = 0; q < 4; ++q) gq[q] = *(const f32x4*)(norm2_g + F.lane * 16 + 4 * q); for (; r < 2 * NEXP; r += NGW) { const bool isu = r < NEXP; const int e = isu ? r : r - NEXP; float v[16]; _Pragma("unroll") for (int q = 0; q < 4; ++q) { const f32x4 a = isu ? nx[q] * gq[q] : nx[q]; v[4 * q] = a[0]; v[4 * q + 1] = a[1]; v[4 * q + 2] = a[2]; v[4 * q + 3] = a[3]; } if (r + NGW < 2 * NEXP) P0_TLOAD(r + NGW); const float sc = peer::quant_row16(v, isu ? U8 + (size_t)e * 1024 + F.lane * 16 : V8 + (size_t)(F.lane >> 3) * (16384 * 128) + (size_t)e * 128 + (F.lane & 7) * 16, isu ? 0 : 128); if (F.lane == 0) (isu ? SU : SV)[e] = sc; } }
struct Args { const float* in[13]; float* out; unsigned char* ws; int ph_lo, ph_hi; };
__global__ void __launch_bounds__(NWAVES * 64, 2) mega_fwd(Args args) {
    extern __shared__ __attribute__((aligned(16))) unsigned char lds[];
    Frame F;
    F.lds = (LAS unsigned char*)lds;
    F.MISC = (volatile LAS unsigned*)(F.lds + MISC_OFF);
    F.tid = threadIdx.x; F.lane = F.tid & 63; F.wave = __builtin_amdgcn_readfirstlane(F.tid >> 6);
    F.G = gridDim.x; { const int bx = blockIdx.x; F.vcu = (F.G % 8 == 0) ? (bx % 8) * (F.G / 8) + bx / 8 : bx; }
    unsigned char* ws = args.ws;
    F.ctl = (gu32*)(ws + WS_CTL);
    const float* x = args.in[0]; const float* norm1_g = args.in[1]; const float* w_in = args.in[2]; const float* moba_g = args.in[3]; const float* diff_g = args.in[4];
    const float* diff_lambda = args.in[5]; const float* subln_g = args.in[6]; const float* w_out = args.in[7]; const float* norm2_g = args.in[8]; const float* w_query = args.in[9];
    const float* sub_keys = args.in[10]; const float* peer_u = args.in[11]; const float* peer_v = args.in[12];
    float* out = args.out;
    bf16* WIN = (bf16*)(ws + WS_WIN); bf16* WOUT = (bf16*)(ws + WS_WOUT); bf16* WQ = (bf16*)(ws + WS_WQ); bf16* SK = (bf16*)(ws + WS_SK);
    float* KPART = (float*)(ws + WS_KPART); float* SSQ = (float*)(ws + WS_SSQ); float* MISCG = (float*)(ws + WS_MISC);
    unsigned char* U8 = ws + WS_U8; unsigned char* V8 = ws + WS_V8; float* SU = (float*)(ws + WS_SU); float* SV = (float*)(ws + WS_SV); unsigned char* XQ = ws + WS_XQ; float* HS = (float*)(ws + WS_HS); bf16* XN = (bf16*)(ws + WS_XN); bf16* MIX = (bf16*)(ws + WS_MIX); bf16* DOB = (bf16*)(ws + WS_DO);
    bf16* PROJ = (bf16*)(ws + WS_PROJ); bf16* QP = (bf16*)(ws + WS_QP); int* LE = (int*)(ws + WS_LE); float* LG = (float*)(ws + WS_LG); unsigned* PACK = (unsigned*)(ws + WS_PACK); float* RSTD = (float*)(ws + WS_RSTD);
    for (int u = F.tid; u < (LDS_BYTES - LDSCTL_OFF) / 4; u += NWAVES * 64) ((LAS unsigned*)(F.lds + LDSCTL_OFF))[u] = 0u;
    __syncthreads();
    XcdBarrier bar = xcd_barrier_post((unsigned*)(F.ctl + CW_BAR), F.MISC + 8);
    const int gw = F.vcu * NWAVES + F.wave, NGW = F.G * NWAVES;
    const int lo = args.ph_lo, hi = args.ph_hi;
#define IN(k) (lo <= (k) && (k) < hi)
#ifndef PROBE_DUP
#define PROBE_DUP -1
#endif
#define REP(k) for (int rep_ = 0; rep_ < ((PROBE_DUP == (k)) ? 2 : 1); ++rep_)
#define GRID_BAR() xcd_barrier(bar)
#if PROFSEG >= 0
    unsigned long long prof_acc = 0ull, prof_t = __builtin_amdgcn_s_memrealtime(), prof_pt = prof_t; const unsigned long long prof_t0 = prof_t;
#endif

    if (IN(0)) {
        REP(0) {
        LAS float* scr = (LAS float*)(F.lds + RING_OFF + F.wave * 16384);
        constexpr int I_IN = (D / 64) * (NPROJ / 32), I_OUT = (D / 64) * (D / 32), I_Q = (D / 64) * (NQP / 32);
        for (int it = gw; it < I_IN; it += NGW) p0_transpose_item<true>(w_in, D, NPROJ, WIN, nullptr, scr, it, F.lane);
        {
            f32x4 cur[4], nxt[4]; f32x4 gg[4];
#pragma unroll
            for (int j = 0; j < 4; ++j) gg[j] = *((const f32x4*)norm1_g + F.lane + 64 * j);
            int m = gw;
            if (m < M) {
#pragma unroll
                for (int j = 0; j < 4; ++j) nxt[j] = *((const GAS f32x4*)(x + (size_t)m * D) + F.lane + 64 * j); }
            for (; m < M; m += NGW) {
#pragma unroll
                for (int j = 0; j < 4; ++j) cur[j] = nxt[j];
                if (m + NGW < M) {
#pragma unroll
                    for (int j = 0; j < 4; ++j) nxt[j] = *((const GAS f32x4*)(x + (size_t)(m + NGW) * D) + F.lane + 64 * j); }
                float s = 0.f;
#pragma unroll
                for (int j = 0; j < 4; ++j) s += (cur[j].x * cur[j].x + cur[j].y * cur[j].y) + (cur[j].z * cur[j].z + cur[j].w * cur[j].w);
                const float rstd = 1.f / sqrtf(wave_sum(s) * (1.f / 1024.f) + RMS_EPS);
                GAS unsigned long long* o8 = (GAS unsigned long long*)(XN + (size_t)m * D) + F.lane;
#pragma unroll
                for (int j = 0; j < 4; ++j) o8[64 * j] = (unsigned long long)pk2(cur[j].x * rstd * gg[j].x, cur[j].y * rstd * gg[j].y) | ((unsigned long long)pk2(cur[j].z * rstd * gg[j].z, cur[j].w * rstd * gg[j].w) << 32);
            }
        }
        if (gw == 0) { const float a = wave_sum(diff_lambda[F.lane] * diff_lambda[64 + F.lane]), b = wave_sum(diff_lambda[128 + F.lane] * diff_lambda[192 + F.lane]);
            if (F.lane == 0) MISCG[0] = expf(a) - expf(b) + 0.2f;
            float mq = fabsf(moba_g[F.lane]), mk = fabsf(moba_g[64 + F.lane]), dq = fabsf(diff_g[F.lane]), dk = fabsf(diff_g[64 + F.lane]);
#pragma unroll
            for (int o = 1; o < 64; o <<= 1) { mq = fmaxf(mq, __shfl_xor(mq, o)); mk = fmaxf(mk, __shfl_xor(mk, o)); dq = fmaxf(dq, __shfl_xor(dq, o)); dk = fmaxf(dk, __shfl_xor(dk, o)); }
            if (F.lane == 0) { MISCG[1] = 64.f * C2 * mq * mk * 1.02f; MISCG[2] = 64.f * C2 * dq * dk * 1.02f; } }
        }
        GRID_BAR(); PROF_PHASE(0);
    }
    if (IN(1)) {
        REP(1) {
        pg8::Gemm g{XN, WIN, M, NPROJ, D}; pg8::StaticOrder S; S.init(M, NPROJ, F.G, (int)blockIdx.x);
        pg8::EpiProj E{PROJ, moba_g, moba_g + 64, diff_g, diff_g + 64, KPART, C2};
        pg8::gemm_phase<pg8::EpiProj, pg8::StaticOrder, true, true>(F.lds + RING_OFF, g, S, E);
        }
        GRID_BAR(); PROF_PHASE(1);
    }
    if (IN(2)) {
        PROF_SPAN0(45); PROF_SPAN0(46);
        const float bnd_m = MISCG[1], bnd_d = MISCG[2];
        volatile LAS int* uq = (volatile LAS int*)(F.lds + MISC_OFF + 64);
        bool tq_done = false; int tq_cnt = 0;
        REP(2) {
#define ATT_QUEUE(QI_, ...) { gu32* ctr = F.ctl + 2048 + 128 * rep_ + 64 * (QI_); \
        if (F.tid == 0) uq[0] = (int)__hip_atomic_fetch_add(ctr, 1u, RLX_AGENT); \
        __syncthreads(); \
        for (;;) { const int u = uq[0]; __syncthreads(); if (u >= 1024) break; \
            if (F.tid == 0) uq[0] = (int)__hip_atomic_fetch_add(ctr, 1u, RLX_AGENT);       \
            const int nbq = 7 - (u >> 7), r = u & 127, b = r >> 3; const bf16* pb = PROJ + (size_t)b * SEQ * NPROJ; att::UnitDesc U; U.nb = nbq; __VA_ARGS__ \
            if ((QI_) == 1 && !tq_done && tq_cnt++ == ((int)blockIdx.x & 3)) { tq_done = true; TABLE_QUANT_BLOCK } } \
        __syncthreads(); }
        ATT_QUEUE(0, { const int dvh = r & 7, dh = dvh >> 1, j = dvh & 1;
                U.Q = (const att::bf16*)(pb + 1536 + dh * 128 + j * 64); U.K = (const att::bf16*)(pb + 2048 + dh * 128 + j * 64); U.V = (const att::bf16*)(pb + 2560 + dh * 128);
                U.O = (att::bf16*)(DOB + (size_t)b * SEQ * 1024 + (dh * 2 + j) * 128); U.slope2 = LOG2E * exp2f(-2.0f * (float)(dh + 1)); U.moba = 0; U.kpart = KPART; U.dmin = (2.f * bnd_d + 40.f) / U.slope2; U.bnd = bnd_d;
                att::attn_unit<128>(U, (char*)lds + RING_OFF PROF_PASS); })
        PROF_SPAN1(46);
        ATT_QUEUE(1, { const int vh = r & 7;
                U.Q = (const att::bf16*)(pb + vh * 64); U.K = (const att::bf16*)(pb + 512 + vh * 64); U.V = (const att::bf16*)(pb + 1024 + vh * 64);
                U.O = (att::bf16*)(MIX + (size_t)b * SEQ * 1024 + vh * 64); U.slope2 = LOG2E * exp2f(-(float)(vh + 1)); U.moba = 1; U.kpart = KPART + (size_t)(b * 8) * 1024 + vh * 64; U.dmin = (2.f * bnd_m + 40.f) / U.slope2; U.bnd = bnd_m;
                att::attn_unit<64>(U, (char*)lds + RING_OFF PROF_PASS); })
#undef ATT_QUEUE
        }
        if (!tq_done) { tq_done = true; TABLE_QUANT_BLOCK }
        DEFERRED_WEIGHTS_BLOCK
        PROF_SPAN1(45);
        GRID_BAR(); PROF_PHASE(2);
    }
    if (IN(3)) {
        const float lam = MISCG[0];
        const int hh = F.lane >> 4, cc = (F.lane & 15) * 8;
        float gs[8];
#pragma unroll
        for (int i = 0; i < 8; ++i) gs[i] = subln_g[cc + i] * 0.8f;
        v4u na = {}, nb2 = {};
        int t = gw;
        if (t < M) { na = *(const GAS v4u*)(DOB + (size_t)t * 1024 + hh * 256 + cc); nb2 = *(const GAS v4u*)(DOB + (size_t)t * 1024 + hh * 256 + 128 + cc); }
        for (; t < M; t += NGW) {
            const v4u a = na, b = nb2;
            if (t + NGW < M) { na = *(const GAS v4u*)(DOB + (size_t)(t + NGW) * 1024 + hh * 256 + cc); nb2 = *(const GAS v4u*)(DOB + (size_t)(t + NGW) * 1024 + hh * 256 + 128 + cc); }
            float d[8]; float ss = 0.f;
#pragma unroll
            for (int i = 0; i < 4; ++i) { d[2 * i] = __uint_as_float(a[i] << 16) - lam * __uint_as_float(b[i] << 16); d[2 * i + 1] = __uint_as_float(a[i] & 0xffff0000u) - lam * __uint_as_float(b[i] & 0xffff0000u);
                ss += d[2 * i] * d[2 * i] + d[2 * i + 1] * d[2 * i + 1]; }
#pragma unroll
            for (int o = 1; o < 16; o <<= 1) ss += __shfl_xor(ss, o);
            const float r = 1.0f / sqrtf(ss * (1.0f / 128.0f) + RMS_EPS);
            v4u w; w.x = pk2(d[0] * r * gs[0], d[1] * r * gs[1]); w.y = pk2(d[2] * r * gs[2], d[3] * r * gs[3]); w.z = pk2(d[4] * r * gs[4], d[5] * r * gs[5]); w.w = pk2(d[6] * r * gs[6], d[7] * r * gs[7]);
            *(GAS v4u*)(MIX + (size_t)t * 1024 + 512 + hh * 128 + cc) = w;
        }
        GRID_BAR(); PROF_PHASE(3);
    }
    if (IN(4)) {
        pg8::Gemm g{MIX, WOUT, M, D, D}; pg8::StaticOrder S; S.init(M, D, F.G, (int)blockIdx.x);
        pg8::EpiOut E{x, out, XN, SSQ};
        pg8::gemm_phase<pg8::EpiOut, pg8::StaticOrder, true, true>(F.lds + RING_OFF, g, S, E);
        GRID_BAR(); PROF_PHASE(4);
    }
    if (IN(5)) {
        REP(5) {
        pg8::Gemm g{XN, WQ, M, NQP, D}; pg8::StaticOrder S; S.init(M, NQP, F.G, (int)blockIdx.x);
        pg8::EpiBf16 E{QP, NQP};
        pg8::gemm_phase<pg8::EpiBf16, pg8::StaticOrder, true, true>(F.lds + RING_OFF, g, S, E);
        }
        GRID_BAR(); PROF_PHASE(5);
    }
    if (IN(6)) {
        for (int item = (int)blockIdx.x; item < 256; item += F.G) {
            const int h = item & 7, ch = item >> 3;
            __syncthreads();
            { const bf16* ksrc = SK + (size_t)h * 2 * 128 * 128;
              for (int c = F.tid; c < 4096; c += NWAVES * 64) { const int row = c >> 4, cc = c & 15; *(LAS v4u*)(F.lds + RING_OFF + row * PEER_KROW + cc * 16) = *(const GAS v4u*)(ksrc + (size_t)row * 128 + cc * 8); } }
            __syncthreads();
            const int tg0 = ch * 32 + F.wave * 4;
            peer::bf16x8 q0f[8];
            { const int r32 = F.lane & 31, hi5 = F.lane >> 5;
#pragma unroll
              for (int ks = 0; ks < 8; ++ks) q0f[ks] = *reinterpret_cast<const peer::bf16x8*>(QP + (size_t)(tg0 * 32 + r32) * 2048 + h * 256 + ks * 16 + hi5 * 8); }
            for (int i = 0; i < 4; ++i) peer::topk_task((const peer::bf16*)QP, (const char*)lds + RING_OFF, SSQ, RSTD, LE, LG, tg0 + i, h, F.lane, q0f, i < 3 ? tg0 + i + 1 : -1);
        }
        {
            v4u ca, cb_, na = {}, nb_ = {}; f32x4 cs[4], ns[4] = {};
#define P6_QLOAD(T_) do { na = *(const GAS v4u*)(XN + (size_t)(T_) * 1024 + F.lane * 16); nb_ = *(const GAS v4u*)(XN + (size_t)(T_) * 1024 + F.lane * 16 + 8); \
                _Pragma("unroll") for (int q = 0; q < 4; ++q) ns[q] = *(const GAS f32x4*)(SSQ + (size_t)(T_) * 16 + 4 * q); } while (0)
            int t = gw;
            if (t < M) P6_QLOAD(t);
            for (; t < M; t += NGW) {
                ca = na; cb_ = nb_;
#pragma unroll
                for (int q = 0; q < 4; ++q) cs[q] = ns[q];
                if (t + NGW < M) P6_QLOAD(t + NGW);
                float v[16];
#pragma unroll
                for (int i = 0; i < 4; ++i) { v[2 * i] = __uint_as_float(ca[i] << 16); v[2 * i + 1] = __uint_as_float(ca[i] & 0xffff0000u); v[8 + 2 * i] = __uint_as_float(cb_[i] << 16); v[9 + 2 * i] = __uint_as_float(cb_[i] & 0xffff0000u); }
                const float sx = peer::quant_row16(v, XQ + (size_t)t * 1024 + F.lane * 16, 0);
                float s = 0.f;
#pragma unroll
                for (int q = 0; q < 4; ++q) s += (cs[q][0] + cs[q][1]) + (cs[q][2] + cs[q][3]);
                if (F.lane == 0) HS[t] = sx / sqrtf(s * (1.0f / 1024.0f) + 1e-6f);
            }
#undef P6_QLOAD
        }
        GRID_BAR(); PROF_PHASE(6);
    }
    if (IN(7)) {
        const int xl = (int)blockIdx.x & 7, nwx = (F.G >> 3) * NWAVES, wx = ((int)blockIdx.x >> 3) * NWAVES + F.wave;
        PROF_SPAN0(25);
        REP(70) peer::expert_u_pass(XQ, U8, HS, SU, SV, LE, LG, PACK, xl, wx, nwx, F.lane, (char*)lds + RING_OFF + F.wave * 8192 PROF_PASS);
        PROF_SPAN1(25);
        GRID_BAR(); PROF_PHASE(7);
        PROF_SPAN0(35);
        if (PROBE_DUP == 71) peer::expert_v_pass(V8, PACK, (float*)QP, xl, wx, nwx, F.lane PROF_PASS);
        peer::expert_v_pass(V8, PACK, out, xl, wx, nwx, F.lane PROF_PASS);
        PROF_SPAN1(35);
        PROF_PHASE(8);
    }
#if PROFSEG >= 0
    if (PROFSEG == 200) prof_acc = __builtin_amdgcn_s_memrealtime() - prof_t0;
    if (blockIdx.x == PROFBLK && F.wave == 0) { const unsigned long long t0_ = __builtin_amdgcn_s_memrealtime(); while (__builtin_amdgcn_s_memrealtime() - t0_ < 8ull * prof_acc) __builtin_amdgcn_s_sleep(8); }
#endif
#undef IN
#undef GRID_BAR
}

extern "C" void kernel_launch(void* const* d_in, const int* in_sizes, int n_in, void* d_out, int out_size, void* d_ws, size_t ws_size, hipStream_t stream) {
    static int grid = 0;
    if (grid == 0) {
        if (n_in != 13 || in_sizes[0] != M * D || out_size != M * D || ws_size < WS_END) { fprintf(stderr, "kernel_launch: unexpected shapes (n_in %d, in0 %d, out %d, ws %zu); nothing launched\n", n_in, n_in > 0 ? in_sizes[0] : -1, out_size, ws_size); grid = -1; return; }
        int dev = 0, cus = 0, per_cu = 0;
        if (hipGetDevice(&dev) != hipSuccess || hipDeviceGetAttribute(&cus, hipDeviceAttributeMultiprocessorCount, dev) != hipSuccess) { grid = -1; return; }
        if (hipFuncSetAttribute((const void*)mega_fwd, hipFuncAttributeMaxDynamicSharedMemorySize, LDS_BYTES) != hipSuccess) { fprintf(stderr, "kernel_launch: hipFuncSetAttribute failed\n"); grid = -1; return; }
        if (hipOccupancyMaxActiveBlocksPerMultiprocessor(&per_cu, (const void*)mega_fwd, NWAVES * 64, LDS_BYTES) != hipSuccess || per_cu < 1) { fprintf(stderr, "kernel_launch: occupancy query reports %d workgroups per CU\n", per_cu); }
        (void)hipGetLastError();
        grid = cus;
    }
    if (grid < 0) return;
    if (hipMemsetAsync((char*)d_ws + WS_CTL, 0, CTL_ZERO_BYTES, stream) != hipSuccess) return;
    Args a{};
    for (int i = 0; i < 13; ++i) a.in[i] = (const float*)d_in[i];
    a.out = (float*)d_out; a.ws = (unsigned char*)d_ws; a.ph_lo = 0; a.ph_hi = 8;
    hipLaunchKernelGGL(mega_fwd, dim3(grid), dim3(NWAVES * 64), LDS_BYTES, stream, a);
}
```

```cpp
#include <hip/hip_runtime.h>
#include <hip/hip_bf16.h>
#include <cstdio>
#include <cstdint>
#include <cmath>
#ifndef PROFSEG
#define PROFSEG -1
#endif
#ifndef PROFBLK
#define PROFBLK 0
#endif
#ifndef PROFWAVE
#define PROFWAVE 0
#endif
#if PROFSEG >= 0
#define PROF_ARGS , unsigned long long& prof_acc, unsigned long long& prof_t
#define PROF_PASS , prof_acc, prof_t
#define PROF_MARK(seg) do { if (PROFSEG != 25 && PROFSEG != 35 && PROFSEG != 45 && PROFSEG != 46 && !(PROFSEG >= 60 && PROFSEG <= 79)) { const unsigned long long n_ = __builtin_amdgcn_s_memrealtime(); if ((seg) == PROFSEG) prof_acc += n_ - prof_t; prof_t = n_; } } while (0)
#define PROF_SPAN0(seg) do { if ((seg) == PROFSEG) prof_t = __builtin_amdgcn_s_memrealtime(); } while (0)
#define PROF_SPAN1(seg) do { if ((seg) == PROFSEG) prof_acc += __builtin_amdgcn_s_memrealtime() - prof_t; } while (0)
#define PROF_PHASE(k) do { const unsigned long long n_ = __builtin_amdgcn_s_memrealtime(); if (100 + (k) == PROFSEG) prof_acc += n_ - prof_pt; prof_pt = n_; } while (0)
#else
#define PROF_PHASE(k) do { } while (0)
#define PROF_SPAN0(seg) do { } while (0)
#define PROF_SPAN1(seg) do { } while (0)
#define PROF_ARGS
#define PROF_PASS
#define PROF_MARK(seg) do { } while (0)
#endif
namespace pg8 {
#define PG8_LAS __attribute__((address_space(3)))
typedef unsigned short bf16_t;
typedef short bf16x8 __attribute__((ext_vector_type(8)));
typedef float f32x4 __attribute__((ext_vector_type(4)));
typedef unsigned u32x4 __attribute__((ext_vector_type(4)));
constexpr int BM = 256, BK = 64, HALF = 128, HTB = HALF * BK * 2  , STAGE_BYTES = 8 * HTB, NXCD = 8, WGM = 8;

__host__ __device__ __forceinline__ int lds_byte(int r, int c) { const int st = (r >> 4) * 2 + (c >> 5), rr = r & 15, cc = c & 31, ob = rr * 64 + cc * 2; return st * 1024 + (ob ^ (((ob >> 9) & 1) << 5)); }
__host__ __device__ __forceinline__ void stage_rc(int b, int& R, int& C) { const int st = b / 1024, sb = b % 1024, swz = sb ^ (((sb >> 9) & 1) << 5); R = (st >> 1) * 16 + swz / 64; C = (st & 1) * 32 + (swz % 64) / 2; }
__host__ __device__ __forceinline__ int perm32(int rho) { const int n = rho >> 4, i = rho & 15; return 8 * (i >> 2) + 4 * n + (i & 3); }

struct Unit { int pm, pn; };
struct Gemm { const bf16_t* A; const bf16_t* Bt; int M, N, K; };

struct StaticOrder {
    int nM, nN, nwg, G, c;
    __host__ __device__ void init(int M, int N, int G_, int c_) { nM = M / BM; nN = N / BM; nwg = nM * nN; G = G_; c = c_; }
    __host__ __device__ bool next(int i, Unit& u) const {
        const long L = (long)i * G + c; if (L >= nwg) return false;
        int wgid = (int)L; { const int q = nwg / NXCD, r = nwg % NXCD, xcd = wgid % NXCD, off = wgid / NXCD; wgid = (xcd < r ? xcd * (q + 1) : r * (q + 1) + (xcd - r) * q) + off; }
        const int nig = WGM * nN, gid = wgid / nig, fm = gid * WGM, gsz = (nM - fm) < WGM ? (nM - fm) : WGM;
        u.pm = fm + ((wgid % nig) % gsz); u.pn = (wgid % nig) / gsz; return true;
    }
    __device__ __forceinline__ void a_ready(const Unit&) const {}
    __device__ __forceinline__ void done(const Unit&) const {}
};

__device__ __forceinline__ unsigned cvt_pk_bf16(float lo, float hi) { unsigned r; asm volatile("v_cvt_pk_bf16_f32 %0, %1, %2" : "=v"(r) : "v"(lo), "v"(hi)); return r; }
typedef unsigned u32x2 __attribute__((ext_vector_type(2)));

struct EpiBf16 {
    static constexpr bool PERM = true, AFTER_DRAIN = false;
    bf16_t* O; int ldc;
    __device__ __forceinline__ void operator()(const f32x4 (&acc)[2][2][4][2], const Unit& u, int wr, int wc, int fr, int fq) const {
        const int row0 = u.pm * BM + wr * 64 + fr; const int col0 = u.pn * BM + wc * 32 + 8 * fq;
#pragma unroll
        for (int ai = 0; ai < 2; ++ai)
#pragma unroll
            for (int m = 0; m < 4; ++m) { bf16_t* rowp = O + (size_t)(row0 + ai * HALF + m * 16) * ldc + col0;
#pragma unroll
                for (int bj = 0; bj < 2; ++bj) { const f32x4 v0 = acc[ai][bj][m][0], v1 = acc[ai][bj][m][1];
                    u32x4 w; w.x = cvt_pk_bf16(v0[0], v0[1]); w.y = cvt_pk_bf16(v0[2], v0[3]); w.z = cvt_pk_bf16(v1[0], v1[1]); w.w = cvt_pk_bf16(v1[2], v1[3]);
                    *(u32x4*)(rowp + bj * HALF) = w; } }
    }
};

struct EpiProj {
    static constexpr bool PERM = true, AFTER_DRAIN = false;
    bf16_t* P; const float *gmq, *gmk, *gdq, *gdk; float* kpart; float c2;
    __device__ __forceinline__ void operator()(const f32x4 (&acc)[2][2][4][2], const Unit& u, int wr, int wc, int fr, int fq) const {
        const int type = u.pn >> 1;
        const float* g = type == 0 ? gmq : type == 1 ? gmk : type == 3 ? gdq : type == 4 ? gdk : nullptr;
        const float sc0 = (type == 0 || type == 3) ? c2 : 1.f;
        f32x4 gv[2][2];
#pragma unroll
        for (int bj = 0; bj < 2; ++bj)
#pragma unroll
            for (int n = 0; n < 2; ++n) gv[bj][n] = g ? (*(const f32x4*)(g + 32 * bj + 8 * fq + 4 * n)) * sc0 : (f32x4){1.f, 1.f, 1.f, 1.f};
        f32x4 cs[2][2];
#pragma unroll
        for (int bj = 0; bj < 2; ++bj)
#pragma unroll
            for (int n = 0; n < 2; ++n) cs[bj][n] = (f32x4){0.f, 0.f, 0.f, 0.f};
        const int row0 = u.pm * BM + wr * 64 + fr; const int col0 = u.pn * BM + wc * 64 + 8 * fq;
#pragma unroll
        for (int ai = 0; ai < 2; ++ai)
#pragma unroll
            for (int m = 0; m < 4; ++m) {
                f32x4 v[2][2];
#pragma unroll
                for (int bj = 0; bj < 2; ++bj)
#pragma unroll
                    for (int n = 0; n < 2; ++n) v[bj][n] = acc[ai][bj][m][n];
                if (g) {
                    float ss = 0.f;
#pragma unroll
                    for (int bj = 0; bj < 2; ++bj)
#pragma unroll
                        for (int n = 0; n < 2; ++n) { const f32x4 x = v[bj][n]; ss += (x[0] * x[0] + x[1] * x[1]) + (x[2] * x[2] + x[3] * x[3]); }
                    ss += __shfl_xor(ss, 16); ss += __shfl_xor(ss, 32);
                    const float r = 1.0f / sqrtf(ss * (1.0f / 64.0f) + 1e-6f);
#pragma unroll
                    for (int bj = 0; bj < 2; ++bj)
#pragma unroll
                        for (int n = 0; n < 2; ++n) { v[bj][n] = v[bj][n] * r * gv[bj][n]; cs[bj][n] += v[bj][n]; }
                }
                bf16_t* rowp = P + (size_t)(row0 + ai * HALF + m * 16) * 3072 + col0;
#pragma unroll
                for (int bj = 0; bj < 2; ++bj) { const f32x4 v0 = v[bj][0], v1 = v[bj][1];
                    u32x4 w; w.x = cvt_pk_bf16(v0[0], v0[1]); w.y = cvt_pk_bf16(v0[2], v0[3]); w.z = cvt_pk_bf16(v1[0], v1[1]); w.w = cvt_pk_bf16(v1[2], v1[3]);
                    *(u32x4*)(rowp + bj * 32) = w; }
            }
        if (type == 1) {
#pragma unroll
            for (int bj = 0; bj < 2; ++bj)
#pragma unroll
                for (int n = 0; n < 2; ++n) { f32x4 c = cs[bj][n];
#pragma unroll
                    for (int o = 1; o < 16; o <<= 1) { c[0] += __shfl_xor(c[0], o); c[1] += __shfl_xor(c[1], o); c[2] += __shfl_xor(c[2], o); c[3] += __shfl_xor(c[3], o); }
                    if (fr == 0) *(f32x4*)(kpart + (size_t)(u.pm * 2 + wr) * 512 + (u.pn - 2) * 256 + wc * 64 + bj * 32 + fq * 8 + n * 4) = c; }
        }
    }
};

struct EpiOut {
    static constexpr bool PERM = false, AFTER_DRAIN = false;
    const float* x; float* out; bf16_t* xmb; float* ssq;
    __device__ __forceinline__ void operator()(const f32x4 (&acc)[2][2][4][2], const Unit& u, int wr, int wc, int fr, int fq) const {
        const int row0 = u.pm * BM + wr * 64 + fr; const int col0 = u.pn * BM + wc * 32 + 4 * fq;
#pragma unroll
        for (int ai = 0; ai < 2; ++ai)
#pragma unroll
            for (int m = 0; m < 4; ++m) { const int row = row0 + ai * HALF + m * 16; const size_t off = (size_t)row * 1024 + col0; float s = 0.f;
#pragma unroll
                for (int bj = 0; bj < 2; ++bj)
#pragma unroll
                    for (int n = 0; n < 2; ++n) { const f32x4 xv = *(const f32x4*)(x + off + bj * HALF + n * 16); const f32x4 y = xv + acc[ai][bj][m][n];
                        *(f32x4*)(out + off + bj * HALF + n * 16) = y; u32x2 w; w.x = cvt_pk_bf16(y[0], y[1]); w.y = cvt_pk_bf16(y[2], y[3]); *(u32x2*)(xmb + off + bj * HALF + n * 16) = w;
                        s += (y[0] * y[0] + y[1] * y[1]) + (y[2] * y[2] + y[3] * y[3]); }
                s += __shfl_xor(s, 16); s += __shfl_xor(s, 32);
                if (fq == 0) ssq[(size_t)row * 16 + u.pn * 4 + wc] = s;
                if (m & 1) asm volatile("" ::: "memory"); }
    }
};
template <class Epi, class Sched, bool ALIGN_EPI = false, bool SP2 = false>
__device__ __forceinline__ void gemm_phase(PG8_LAS unsigned char* lds, const Gemm g, const Sched& S, const Epi& E) {
    const int tid = threadIdx.x, wid = __builtin_amdgcn_readfirstlane(tid >> 6), lane = tid & 63, wr = wid >> 2, wc = wid & 3, fr = lane & 15, fq = lane >> 4;
    const int K = g.K, nt = K / BK;
    unsigned voffA[2], voffB[2];
#pragma unroll
    for (int i = 0; i < 2; ++i) { int R, C; stage_rc(tid * 16 + i * 8192, R, C); const int Rb = Epi::PERM ? ((R & ~31) + perm32(R & 31)) : R;
        voffA[i] = (unsigned)(R * K + C) * 2u; voffB[i] = (unsigned)(Rb * K + C) * 2u; }
    const size_t kstep = (size_t)(BK * 2);
    const size_t hstep = (size_t)HALF * K * 2;
    const size_t tstep = 2 * hstep;
    const unsigned ldsw = (unsigned)wid * 1024u;
    const int aoff = lds_byte(wr * 64 + fr, fq * 8), boff = lds_byte(wc * 32 + fr, fq * 8);
#define PG8_SA(b, h) (((b) * 2 + (h)) * HTB)
#define PG8_SB(b, h) ((4 + (b) * 2 + (h)) * HTB)
#define PG8_STAGE(bufoff, gbase, voff) do { _Pragma("unroll") for (int _i = 0; _i < 2; ++_i) \
        __builtin_amdgcn_global_load_lds((const unsigned*)((const char*)(gbase) + (voff)[_i]), (PG8_LAS unsigned*)(lds + (bufoff) + ldsw + _i * 8192), 16, 0, 0); } while (0)
#define PG8_LDA(dst, b, h) do { _Pragma("unroll") for (int m = 0; m < 4; ++m) _Pragma("unroll") for (int k = 0; k < 2; ++k) dst[m][k] = *(const PG8_LAS bf16x8*)(lds + PG8_SA(b, h) + aoff + m * 2048 + k * 1024); } while (0)
#define PG8_LDB(dst, b, h) do { _Pragma("unroll") for (int n = 0; n < 2; ++n) _Pragma("unroll") for (int k = 0; k < 2; ++k) dst[n][k] = *(const PG8_LAS bf16x8*)(lds + PG8_SB(b, h) + boff + n * 2048 + k * 1024); } while (0)
#define PG8_MMA(ai, bj, At, Bt) do { __builtin_amdgcn_s_setprio(1); _Pragma("unroll") for (int m = 0; m < 4; ++m) _Pragma("unroll") for (int n = 0; n < 2; ++n) _Pragma("unroll") for (int k = 0; k < 2; ++k) \
        acc[ai][bj][m][n] = __builtin_amdgcn_mfma_f32_16x16x32_bf16(Bt[n][k], At[m][k], acc[ai][bj][m][n], 0, 0, 0); __builtin_amdgcn_s_setprio(0); } while (0)
#define PG8_WAIT_V(n) asm volatile("s_waitcnt vmcnt(" #n ")" ::: "memory")
#define PG8_WAIT_L(n) asm volatile("s_waitcnt lgkmcnt(" #n ")" ::: "memory")
#define PG8_BAR __builtin_amdgcn_s_barrier()
#define PG8_SCHED __builtin_amdgcn_sched_barrier(0)
    Unit cur, nxt; int ui = 0;
    if (!S.next(0, cur)) return;
    f32x4 acc[2][2][4][2];
#pragma unroll
    for (int a = 0; a < 2; ++a)
#pragma unroll
        for (int b = 0; b < 2; ++b)
#pragma unroll
            for (int m = 0; m < 4; ++m)
#pragma unroll
                for (int n = 0; n < 2; ++n) acc[a][b][m][n] = (f32x4){0.f, 0.f, 0.f, 0.f};
    bf16x8 At[4][2], B0[2][2], B1[2][2];
    const char* cA = (const char*)g.A + (size_t)cur.pm * tstep; const char* cB = (const char*)g.Bt + (size_t)cur.pn * tstep;
    S.a_ready(cur);
    if constexpr (SP2) {
        PG8_STAGE(PG8_SB(0, 0), cB, voffB); PG8_STAGE(PG8_SB(0, 1), cB + hstep, voffB); PG8_STAGE(PG8_SA(0, 0), cA, voffA); PG8_STAGE(PG8_SA(0, 1), cA + hstep, voffA);
        if (wr == 1) PG8_BAR;
        PG8_WAIT_V(2); PG8_BAR;
        PG8_STAGE(PG8_SB(1, 0), cB + kstep, voffB); PG8_STAGE(PG8_SA(1, 0), cA + kstep, voffA); PG8_STAGE(PG8_SB(1, 1), cB + hstep + kstep, voffB);
        PG8_WAIT_V(6); PG8_BAR;
    } else {
        PG8_STAGE(PG8_SB(0, 0), cB, voffB); PG8_STAGE(PG8_SA(0, 0), cA, voffA); PG8_STAGE(PG8_SB(0, 1), cB + hstep, voffB); PG8_STAGE(PG8_SA(0, 1), cA + hstep, voffA);
        if (wr == 1) PG8_BAR;
        PG8_WAIT_V(4); PG8_BAR;
        PG8_STAGE(PG8_SB(1, 0), cB + kstep, voffB); PG8_STAGE(PG8_SA(1, 0), cA + kstep, voffA); PG8_STAGE(PG8_SB(1, 1), cB + hstep + kstep, voffB);
        PG8_WAIT_V(6); PG8_BAR;
    }
    for (;;) {
        const bool has_next = S.next(ui + 1, nxt);
        const char* nA = has_next ? (const char*)g.A + (size_t)nxt.pm * tstep : cA; const char* nB = has_next ? (const char*)g.Bt + (size_t)nxt.pn * tstep : cB;
        for (int t = 0; t < nt; t += 2) {
            const bool last = (t == nt - 2);
            const char* a1 = cA + (size_t)(t + 1) * kstep;
            const char* a2 = last ? nA : cA + (size_t)(t + 2) * kstep; const char* b2 = last ? nB : cB + (size_t)(t + 2) * kstep;
            const char* a3 = a2 + kstep; const char* b3 = b2 + kstep;
            if (last && has_next) S.a_ready(nxt);
            if constexpr (SP2) {
            PG8_LDB(B0, 0, 0); PG8_LDB(B1, 0, 1); PG8_SCHED; PG8_LDA(At, 0, 0); PG8_STAGE(PG8_SA(1, 1), a1 + hstep, voffA);
            PG8_WAIT_V(8); PG8_WAIT_L(0); PG8_BAR; PG8_MMA(0, 0, At, B0); PG8_MMA(0, 1, At, B1); PG8_BAR; PG8_SCHED;
            PG8_LDA(At, 0, 1); PG8_STAGE(PG8_SB(0, 0), b2, voffB); PG8_STAGE(PG8_SB(0, 1), b2 + hstep, voffB); PG8_STAGE(PG8_SA(0, 0), a2, voffA);
            PG8_WAIT_V(8); PG8_WAIT_L(0); PG8_BAR; PG8_MMA(1, 0, At, B0); PG8_MMA(1, 1, At, B1); PG8_BAR; PG8_SCHED;
            PG8_LDB(B0, 1, 0); PG8_LDB(B1, 1, 1); PG8_SCHED; PG8_LDA(At, 1, 0); PG8_STAGE(PG8_SA(0, 1), a2 + hstep, voffA);
            PG8_WAIT_V(8); PG8_WAIT_L(0); PG8_BAR; PG8_MMA(0, 0, At, B0); PG8_MMA(0, 1, At, B1); PG8_BAR; PG8_SCHED;
            PG8_LDA(At, 1, 1); PG8_STAGE(PG8_SB(1, 0), b3, voffB); PG8_STAGE(PG8_SB(1, 1), b3 + hstep, voffB); PG8_STAGE(PG8_SA(1, 0), a3, voffA);
            PG8_WAIT_V(8); PG8_WAIT_L(0); PG8_BAR; PG8_MMA(1, 0, At, B0); PG8_MMA(1, 1, At, B1); PG8_BAR; PG8_SCHED;
            } else {
            PG8_LDB(B0, 0, 0); PG8_SCHED; PG8_LDA(At, 0, 0); PG8_STAGE(PG8_SA(1, 1), a1 + hstep, voffA);
            PG8_WAIT_L(8); PG8_BAR; PG8_WAIT_L(0); PG8_MMA(0, 0, At, B0); PG8_BAR; PG8_SCHED;
            PG8_LDB(B1, 0, 1); PG8_STAGE(PG8_SB(0, 0), b2, voffB);
            PG8_BAR; PG8_WAIT_L(0); PG8_MMA(0, 1, At, B1); PG8_BAR;
            PG8_LDA(At, 0, 1); PG8_STAGE(PG8_SA(0, 0), a2, voffA);
            PG8_BAR; PG8_WAIT_L(0); PG8_MMA(1, 0, At, B0); PG8_BAR; PG8_SCHED;
            PG8_STAGE(PG8_SB(0, 1), b2 + hstep, voffB);
            PG8_WAIT_V(6); PG8_BAR; PG8_MMA(1, 1, At, B1); PG8_BAR;
            PG8_LDB(B0, 1, 0); PG8_SCHED; PG8_LDA(At, 1, 0); PG8_STAGE(PG8_SA(0, 1), a2 + hstep, voffA);
            PG8_WAIT_L(8); PG8_BAR; PG8_WAIT_L(0); PG8_MMA(0, 0, At, B0); PG8_BAR; PG8_SCHED;
            PG8_LDB(B1, 1, 1); PG8_STAGE(PG8_SB(1, 0), b3, voffB);
            PG8_BAR; PG8_WAIT_L(0); PG8_MMA(0, 1, At, B1); PG8_BAR;
            PG8_LDA(At, 1, 1); PG8_STAGE(PG8_SA(1, 0), a3, voffA);
            PG8_BAR; PG8_WAIT_L(0); PG8_MMA(1, 0, At, B0); PG8_BAR; PG8_SCHED;
            PG8_STAGE(PG8_SB(1, 1), b3 + hstep, voffB);
            PG8_WAIT_V(6); PG8_BAR; PG8_MMA(1, 1, At, B1); PG8_BAR;
            }
        }
        if constexpr (ALIGN_EPI) { if (wr == 0) PG8_BAR; }
        if constexpr (!Epi::AFTER_DRAIN) { E(acc, cur, wr, wc, fr, fq); S.done(cur); }
        if (!has_next) break;
#pragma unroll
        for (int a = 0; a < 2; ++a)
#pragma unroll
            for (int b = 0; b < 2; ++b)
#pragma unroll
                for (int m = 0; m < 4; ++m)
#pragma unroll
                    for (int n = 0; n < 2; ++n) acc[a][b][m][n] = (f32x4){0.f, 0.f, 0.f, 0.f};
        cur = nxt; cA = nA; cB = nB; ++ui;
        if constexpr (ALIGN_EPI) { if (wr == 1) PG8_BAR; }
    }
    PG8_WAIT_V(0);
    if constexpr (!ALIGN_EPI) { if (wr == 0) PG8_BAR; }
    PG8_BAR;
    if constexpr (Epi::AFTER_DRAIN) { E.fused(acc, cur, wr, wc, fr, fq, lds, wid, lane); S.done(cur); }
#undef PG8_SA
#undef PG8_SB
#undef PG8_STAGE
#undef PG8_LDA
#undef PG8_LDB
#undef PG8_MMA
#undef PG8_WAIT_V
#undef PG8_WAIT_L
#undef PG8_BAR
#undef PG8_SCHED
}
}
namespace att {
using bf16 = __hip_bfloat16;
using bf16x8 = __attribute__((ext_vector_type(8))) short;
using s16x4 = __attribute__((ext_vector_type(4))) short;
using f32x16 = __attribute__((ext_vector_type(16))) float;
using u32x4 = __attribute__((ext_vector_type(4))) unsigned;
constexpr int PITCH = 3072, QB = 256, KVBLK = 64, NW = 8;
constexpr int SLOTB = 8192, VSLOTB = 16384, LDS_K = 0, LDS_V = 2 * SLOTB, LDS_WS = LDS_V + 2 * VSLOTB, LDS_OST = LDS_WS + NW * 64 * 4, LDS_BYTES = LDS_OST + NW * 8192;
__device__ __forceinline__ int crow(int r, int hi) { return (r & 3) + 8 * (r >> 2) + 4 * hi; }
typedef float f32x2_t __attribute__((ext_vector_type(2))); typedef __bf16 bf16x2_t __attribute__((ext_vector_type(2)));
__device__ __forceinline__ unsigned cvtpk_s(float lo, float hi) { f32x2_t v = {lo, hi}; bf16x2_t b = __builtin_convertvector(v, bf16x2_t); return __builtin_bit_cast(unsigned, b); }

__device__ __forceinline__ void qkt(f32x16& p0, f32x16& p1, const char* Kslot, const bf16x8* qr, const f32x16& c0, const f32x16& c1, int r32, int hi) {
  const char* kb = Kslot + hi * 1024 + r32 * 16;
#pragma unroll
  for (int d0 = 0; d0 < 4; ++d0) {
    const bf16x8 b0 = *reinterpret_cast<const bf16x8*>(kb + d0 * 2048);
    const bf16x8 b1 = *reinterpret_cast<const bf16x8*>(kb + d0 * 2048 + 512);
    if (d0 == 0) { p0 = __builtin_amdgcn_mfma_f32_32x32x16_bf16(b0, qr[0], c0, 0, 0, 0); p1 = __builtin_amdgcn_mfma_f32_32x32x16_bf16(b1, qr[0], c1, 0, 0, 0); }
    else { p0 = __builtin_amdgcn_mfma_f32_32x32x16_bf16(b0, qr[d0], p0, 0, 0, 0); p1 = __builtin_amdgcn_mfma_f32_32x32x16_bf16(b1, qr[d0], p1, 0, 0, 0); } }
}
template <int NDB> __device__ __forceinline__ void pv(f32x16* o, int vb, bf16x8 pa0, bf16x8 pa1, bf16x8 pa2, bf16x8 pa3) {
#pragma unroll
  for (int d0 = 0; d0 < NDB; ++d0) { s16x4 lo[4], hi[4];
#pragma unroll
    for (int ks = 0; ks < 4; ++ks) {
      asm volatile("ds_read_b64_tr_b16 %0,%1 offset:%c2" : "=&v"(lo[ks]) : "v"(vb), "i"(d0 * 4096 + ks * 1024) : "memory");
      asm volatile("ds_read_b64_tr_b16 %0,%1 offset:%c2" : "=&v"(hi[ks]) : "v"(vb), "i"(d0 * 4096 + ks * 1024 + 512) : "memory"); }
    asm volatile("s_waitcnt lgkmcnt(0)" ::: "memory"); __builtin_amdgcn_sched_barrier(0);
#define PK(k) (bf16x8){lo[k][0], lo[k][1], lo[k][2], lo[k][3], hi[k][0], hi[k][1], hi[k][2], hi[k][3]}
    o[d0] = __builtin_amdgcn_mfma_f32_32x32x16_bf16(pa0, PK(0), o[d0], 0, 0, 0);
    o[d0] = __builtin_amdgcn_mfma_f32_32x32x16_bf16(pa1, PK(1), o[d0], 0, 0, 0);
    o[d0] = __builtin_amdgcn_mfma_f32_32x32x16_bf16(pa2, PK(2), o[d0], 0, 0, 0);
    o[d0] = __builtin_amdgcn_mfma_f32_32x32x16_bf16(pa3, PK(3), o[d0], 0, 0, 0);
#undef PK
  }
}
struct UnitDesc { const bf16* Q; const bf16* K; const bf16* V; bf16* O; float slope2; int nb; int moba; const float* kpart; float dmin; float bnd; };
template <int DV> __device__ __forceinline__ void attn_unit(const UnitDesc& U, char* shm PROF_ARGS) {
  PROF_MARK(19);
  constexpr int NDB = DV / 32;
  const int tid = threadIdx.x, lane = tid & 63, r32 = lane & 31, hi = lane >> 5; const int wid = __builtin_amdgcn_readfirstlane(tid >> 6);
  const int nb = U.nb, q0 = nb * QB;
  const bf16* Qw = U.Q + (long)(q0 + wid * 32) * PITCH;
  const unsigned lds0 = (unsigned)(uintptr_t)shm;
  float* wsf = (float*)(shm + LDS_WS) + wid * 64;
  bf16x8 qr[4];
#pragma unroll
  for (int d0 = 0; d0 < 4; ++d0) qr[d0] = *reinterpret_cast<const bf16x8*>(&Qw[(long)r32 * PITCH + d0 * 16 + hi * 8]);
  unsigned sel = 0xffu;
  if (U.moba) {
    { const int n = tid >> 6, d = tid & 63; const float* k0 = U.kpart + (size_t)(n * 2) * 512 + d; const float km = k0[0] + k0[512];
      const __hip_bfloat16 h = __float2bfloat16(km); const __hip_bfloat16 l = __float2bfloat16(km - __bfloat162float(h));
      *reinterpret_cast<__hip_bfloat16*>(shm + LDS_K + (d >> 3) * 1024 + n * 16 + (d & 7) * 2) = h; *reinterpret_cast<__hip_bfloat16*>(shm + LDS_K + SLOTB + (d >> 3) * 1024 + n * 16 + (d & 7) * 2) = l; }
    __syncthreads();
    f32x16 gh = {};
    { const char* kb = shm + LDS_K + hi * 1024 + r32 * 16;
#pragma unroll
      for (int d0 = 0; d0 < 4; ++d0) { const bf16x8 bh = *reinterpret_cast<const bf16x8*>(kb + d0 * 2048), bl = *reinterpret_cast<const bf16x8*>(kb + SLOTB + d0 * 2048);
        gh = __builtin_amdgcn_mfma_f32_32x32x16_bf16(bh, qr[d0], gh, 0, 0, 0); gh = __builtin_amdgcn_mfma_f32_32x32x16_bf16(bl, qr[d0], gh, 0, 0, 0); } }
    float g[4] = {gh[0], gh[1], gh[2], gh[3]};
    __syncthreads();
    float ga[8];
#pragma unroll
    for (int j = 0; j < 4; ++j) { const float o = __shfl_xor(g[j], 32); ga[j] = hi ? o : g[j]; ga[4 + j] = hi ? g[j] : o; }
    sel = 0u;
#pragma unroll
    for (int n = 0; n < 8; ++n) { int rank = 0;
#pragma unroll
      for (int m = 0; m < 8; ++m) if (m != n) rank += (m < nb && (ga[m] > ga[n] || (ga[m] == ga[n] && m < n))) ? 1 : 0;
      if (n < nb && rank < 3) sel |= (1u << n); }
  }
  PROF_MARK(10);
  const int NT = 4 * (nb + 1);
  int ts = (int)floorf(((float)q0 - 63.f - U.dmin) * (1.0f / 64.0f)) + 1; ts = ts < 0 ? 0 : (ts > NT - 4 ? NT - 4 : ts);
  float mref = -U.bnd, lrun = 0.f; f32x16 o[NDB];
#pragma unroll
  for (int d = 0; d < NDB; ++d) o[d] = f32x16{};
  const int qrel = wid * 32 + r32;
  const bf16* ksrc = U.K + (long)lane * PITCH + wid * 8;
  const bf16* vsrc = U.V + (long)(16 * (wid & 3) + (lane >> 2)) * PITCH + (wid >> 2) * 32 + (lane & 3) * 8;
  char* kdst = shm + LDS_K + wid * 1024 + lane * 16; char* vdst = shm + LDS_V + wid * 1024 + lane * 16;
  const int vb0 = (int)(lds0 + LDS_V) + ((lane >> 4) & 1) * 32 + (lane & 3) * 8 + (4 * hi + ((lane & 15) >> 2)) * 64;
  u32x4 kreg = *reinterpret_cast<const u32x4*>(ksrc + (long)ts * KVBLK * PITCH), vreg = *reinterpret_cast<const u32x4*>(vsrc + (long)ts * KVBLK * PITCH), vreg2 = vreg;
  if (DV == 128) vreg2 = *reinterpret_cast<const u32x4*>(vsrc + (long)ts * KVBLK * PITCH + 64);
  const float s2 = U.slope2, s2x64 = 64.f * s2;
  f32x16 cb0, cb1;
#define ATT_REBUILD(T_) do { const float base_ = s2 * (float)(64 * (T_) - q0 + 4 * hi) - mref; const bool on_ = ((T_) >= NT - 4) || (((sel >> ((T_) >> 2)) & 1u) != 0u); \
    _Pragma("unroll") for (int r = 0; r < 16; ++r) { const float v_ = base_ + s2 * (float)((r & 3) + 8 * (r >> 2)); cb0[r] = on_ ? v_ : -INFINITY; cb1[r] = on_ ? v_ + 32.f * s2 : -INFINITY; } } while (0)
  ATT_REBUILD(ts);
  for (int t = ts; t < NT; ++t) {
    const int slot = (t & 1) * SLOTB, vslot = (t & 1) * VSLOTB;
    *reinterpret_cast<u32x4*>(kdst + slot) = kreg; *reinterpret_cast<u32x4*>(vdst + vslot) = vreg; if (DV == 128) *reinterpret_cast<u32x4*>(vdst + vslot + 8192) = vreg2;
    PROF_MARK(11);
    __syncthreads();
    PROF_MARK(12);
    if (t + 1 < NT) { kreg = *reinterpret_cast<const u32x4*>(ksrc + (long)(t + 1) * KVBLK * PITCH); vreg = *reinterpret_cast<const u32x4*>(vsrc + (long)(t + 1) * KVBLK * PITCH);
      if (DV == 128) vreg2 = *reinterpret_cast<const u32x4*>(vsrc + (long)(t + 1) * KVBLK * PITCH + 64); }
    f32x16 p0, p1; qkt(p0, p1, shm + LDS_K + slot, qr, cb0, cb1, r32, hi);
    PROF_MARK(13);
    const int jb = t - (NT - 4);
    if (jb >= 0) { const int kb = 64 * jb + 4 * hi;
#pragma unroll
      for (int r = 0; r < 16; ++r) { const int kv = kb + (r & 3) + 8 * (r >> 2); if (kv > qrel) p0[r] = -INFINITY; if (kv + 32 > qrel) p1[r] = -INFINITY; } }
    float rm = fmaxf(p0[0], p1[0]);
#pragma unroll
    for (int r = 1; r < 16; ++r) rm = fmaxf(rm, fmaxf(p0[r], p1[r]));
    rm = fmaxf(rm, __shfl_xor(rm, 32));
    bool resc = false;
    if (__any(rm > 8.0f)) { const float dl = fmaxf(rm, 0.f); mref += dl;
#pragma unroll
      for (int r = 0; r < 16; ++r) { p0[r] -= dl; p1[r] -= dl; cb0[r] -= dl; cb1[r] -= dl; }
      const float f = __builtin_amdgcn_exp2f(-dl); lrun *= f; if (hi == 0) wsf[r32] = f; resc = true; }
    float ps = 0.f;
#pragma unroll
    for (int r = 0; r < 16; ++r) { p0[r] = __builtin_amdgcn_exp2f(p0[r]); p1[r] = __builtin_amdgcn_exp2f(p1[r]); ps += p0[r] + p1[r]; }
    lrun += ps;
    u32x4 pw0, pw1, pw2, pw3;
#pragma unroll
    for (int i = 0; i < 4; ++i) { pw0[i] = cvtpk_s(p0[2 * i], p0[2 * i + 1]); pw1[i] = cvtpk_s(p0[8 + 2 * i], p0[9 + 2 * i]); pw2[i] = cvtpk_s(p1[2 * i], p1[2 * i + 1]); pw3[i] = cvtpk_s(p1[8 + 2 * i], p1[9 + 2 * i]); }
    PROF_MARK(14);
    if (resc) { asm volatile("s_waitcnt lgkmcnt(0)" ::: "memory");
#pragma unroll
      for (int r = 0; r < 16; ++r) { const float fr_ = wsf[crow(r, hi)];
#pragma unroll
        for (int d = 0; d < NDB; ++d) o[d][r] *= fr_; } }
    pv<NDB>(o, vb0 + vslot, __builtin_bit_cast(bf16x8, pw0), __builtin_bit_cast(bf16x8, pw1), __builtin_bit_cast(bf16x8, pw2), __builtin_bit_cast(bf16x8, pw3));
    PROF_MARK(15);
    if (((t + 1) & 3) == 0) { if (t + 1 < NT) ATT_REBUILD(t + 1); }
    else {
#pragma unroll
      for (int r = 0; r < 16; ++r) { cb0[r] += s2x64; cb1[r] += s2x64; } }
  }
#undef ATT_REBUILD
  PROF_MARK(16);
  lrun += __shfl_xor(lrun, 32);
  if (hi == 0) wsf[32 + r32] = lrun;
  asm volatile("s_waitcnt lgkmcnt(0)" ::: "memory");
  float rli[16];
#pragma unroll
  for (int r = 0; r < 16; ++r) rli[r] = 1.0f / wsf[32 + crow(r, hi)];
  bf16* Ow = U.O + (long)(q0 + wid * 32) * 1024;
  { bf16* stg = (bf16*)(shm + LDS_OST) + wid * 4096;
#pragma unroll
    for (int r = 0; r < 16; ++r) { const int orow = crow(r, hi);
#pragma unroll
      for (int d0 = 0; d0 < NDB; ++d0) stg[orow * DV + d0 * 32 + r32] = __float2bfloat16(o[d0][r] * rli[r]); }
    asm volatile("s_waitcnt lgkmcnt(0)" ::: "memory");
    constexpr int CPR = DV / 8, RPI = 64 / CPR;
#pragma unroll
    for (int i = 0; i < 32 / RPI; ++i) { const int row = i * RPI + lane / CPR, ch = lane % CPR; const u32x4 v = *(const u32x4*)(stg + row * DV + ch * 8); *(u32x4*)(Ow + (long)row * 1024 + ch * 8) = v; } }
  asm volatile("s_waitcnt lgkmcnt(0)" ::: "memory");
  __syncthreads();
  PROF_MARK(17);
}
}
namespace peer {
using bf16 = __hip_bfloat16;
using bf16x8 = __attribute__((ext_vector_type(8))) short;
using f32x16 = __attribute__((ext_vector_type(16))) float;
using u32x4 = __attribute__((ext_vector_type(4))) unsigned;
__device__ __forceinline__ int crow(int r, int hi) { return (r & 3) + 8 * (r >> 2) + 4 * hi; }
__device__ __forceinline__ int f2key(float f) { const int b = __float_as_int(f); return b ^ ((b >> 31) & 0x7fffffff); }
__device__ __forceinline__ float key2f(int k) { return __int_as_float(k ^ ((k >> 31) & 0x7fffffff)); }
__device__ __forceinline__ void ins16(int (&L)[16], int v) {
#pragma unroll
  for (int i = 0; i < 16; ++i) { const int a = L[i]; L[i] = a > v ? a : v; v = a > v ? v : a; }
}
#define PEER_CE(A_, B_) do { const int a_ = (A_), b_ = (B_); (A_) = a_ > b_ ? a_ : b_; (B_) = a_ > b_ ? b_ : a_; } while (0)
#define PEER_SORT16(V) do { PEER_CE(V[0], V[1]); PEER_CE(V[3], V[2]); PEER_CE(V[4], V[5]); PEER_CE(V[7], V[6]); PEER_CE(V[8], V[9]); PEER_CE(V[11], V[10]); PEER_CE(V[12], V[13]); PEER_CE(V[15], V[14]); PEER_CE(V[0], V[2]); PEER_CE(V[1], V[3]); PEER_CE(V[6], V[4]); PEER_CE(V[7], V[5]); PEER_CE(V[8], V[10]); PEER_CE(V[9], V[11]); PEER_CE(V[14], V[12]); PEER_CE(V[15], V[13]); PEER_CE(V[0], V[1]); PEER_CE(V[2], V[3]); PEER_CE(V[5], V[4]); PEER_CE(V[7], V[6]); PEER_CE(V[8], V[9]); PEER_CE(V[10], V[11]); PEER_CE(V[13], V[12]); PEER_CE(V[15], V[14]); PEER_CE(V[0], V[4]); PEER_CE(V[1], V[5]); PEER_CE(V[2], V[6]); PEER_CE(V[3], V[7]); PEER_CE(V[12], V[8]); PEER_CE(V[13], V[9]); PEER_CE(V[14], V[10]); PEER_CE(V[15], V[11]); PEER_CE(V[0], V[2]); PEER_CE(V[1], V[3]); PEER_CE(V[4], V[6]); PEER_CE(V[5], V[7]); PEER_CE(V[10], V[8]); PEER_CE(V[11], V[9]); PEER_CE(V[14], V[12]); PEER_CE(V[15], V[13]); PEER_CE(V[0], V[1]); PEER_CE(V[2], V[3]); PEER_CE(V[4], V[5]); PEER_CE(V[6], V[7]); PEER_CE(V[9], V[8]); PEER_CE(V[11], V[10]); PEER_CE(V[13], V[12]); PEER_CE(V[15], V[14]); PEER_CE(V[0], V[8]); PEER_CE(V[1], V[9]); PEER_CE(V[2], V[10]); PEER_CE(V[3], V[11]); PEER_CE(V[4], V[12]); PEER_CE(V[5], V[13]); PEER_CE(V[6], V[14]); PEER_CE(V[7], V[15]); PEER_CE(V[0], V[4]); PEER_CE(V[1], V[5]); PEER_CE(V[2], V[6]); PEER_CE(V[3], V[7]); PEER_CE(V[8], V[12]); PEER_CE(V[9], V[13]); PEER_CE(V[10], V[14]); PEER_CE(V[11], V[15]); PEER_CE(V[0], V[2]); PEER_CE(V[1], V[3]); PEER_CE(V[4], V[6]); PEER_CE(V[5], V[7]); PEER_CE(V[8], V[10]); PEER_CE(V[9], V[11]); PEER_CE(V[12], V[14]); PEER_CE(V[13], V[15]); PEER_CE(V[0], V[1]); PEER_CE(V[2], V[3]); PEER_CE(V[4], V[5]); PEER_CE(V[6], V[7]); PEER_CE(V[8], V[9]); PEER_CE(V[10], V[11]); PEER_CE(V[12], V[13]); PEER_CE(V[14], V[15]); } while (0)
__device__ __forceinline__ void mergetop16(int (&L)[16], const int (&S)[16]) {
  int M[16];
#pragma unroll
  for (int i = 0; i < 16; ++i) M[i] = L[i] > S[15 - i] ? L[i] : S[15 - i];
#pragma unroll
  for (int s = 8; s >= 1; s >>= 1)
#pragma unroll
    for (int i = 0; i < 16; ++i) if ((i & s) == 0) PEER_CE(M[i], M[i + s]);
#pragma unroll
  for (int i = 0; i < 16; ++i) L[i] = M[i];
}
__device__ __forceinline__ void merge16(int (&L)[16]) {
  int S[16];
#pragma unroll
  for (int i = 0; i < 16; ++i) S[i] = __shfl_xor(L[i], 32);
  mergetop16(L, S);
}
#define PEER_CAND_LIST(X) \
  X(0,0,0, 2,1) X(1,0,1, 2,2) X(2,0,2, 2,3) X(3,0,3, 2,4) X(4,0,4, 3,0) X(5,0,5, 3,1) X(6,0,6, 3,2) X(7,0,7, 3,3) X(8,0,8, 4,0) X(9,0,9, 4,1) X(10,0,10, 4,2) X(11,0,11, 5,0) X(12,0,12, 5,1) X(13,0,13, 6,0) X(14,0,14, 6,1) X(15,0,15, 7,0) X(16,1,0, 7,1) X(17,1,1, 8,0) X(18,1,2, 9,0) X(19,1,3, 10,0) X(20,1,4, 11,0) X(21,1,5, 12,0) X(22,1,6, 13,0) X(23,1,7, 14,0) X(24,2,0, 15,0)

#define PEER_KROW 272
__device__ __forceinline__ void topk_task(const bf16* QP, const char* ksl, const float* ssq, float* RSTD, int* LE, float* LG, int tg, int h, int lane, bf16x8 (&q0f)[8], int tg_next) {
  const int r32 = lane & 31, hi = lane >> 5; const int t = tg * 32 + r32;
  int A[16], B[16];
  bf16x8 q1f[8];
#pragma unroll
  for (int ks = 0; ks < 8; ++ks) q1f[ks] = *reinterpret_cast<const bf16x8*>(QP + (size_t)t * 2048 + h * 256 + 128 + ks * 16 + hi * 8);
#pragma unroll
  for (int p = 0; p < 2; ++p) {
    int L[16];
#pragma unroll
    for (int i = 0; i < 16; ++i) L[i] = (int)0x80000000;
    const char* kb = ksl + p * (128 * PEER_KROW) + r32 * PEER_KROW + hi * 16;
#pragma unroll 1
    for (int i = 0; i < 4; ++i) {
      f32x16 acc = {};
#pragma unroll
      for (int ks = 0; ks < 8; ++ks) { const bf16x8 a = *reinterpret_cast<const bf16x8*>(kb + i * (32 * PEER_KROW) + ks * 32); acc = __builtin_amdgcn_mfma_f32_32x32x16_bf16(a, p == 0 ? q0f[ks] : q1f[ks], acc, 0, 0, 0); }
      int S[16];
#pragma unroll
      for (int r = 0; r < 16; ++r) S[r] = (f2key(acc[r]) & ~127) | (i * 32 + crow(r, hi));
      PEER_SORT16(S);
      mergetop16(L, S);
    }
    merge16(L);
#pragma unroll
    for (int i = 0; i < 16; ++i) { if (p == 0) A[i] = L[i]; else B[i] = L[i]; }
    if (p == 0 && tg_next >= 0) {
#pragma unroll
      for (int ks = 0; ks < 8; ++ks) q0f[ks] = *reinterpret_cast<const bf16x8*>(QP + (size_t)(tg_next * 32 + r32) * 2048 + h * 256 + ks * 16 + hi * 8); }
  }
  float Af[16], Bf[16];
#pragma unroll
  for (int i = 0; i < 16; ++i) { Af[i] = key2f(A[i] & ~127); Bf[i] = key2f(B[i] & ~127); }
  float C[25];
#define X(c, i0, j0, i1, j1) C[c] = hi ? (Af[i1] + Bf[j1]) : (Af[i0] + Bf[j0]);
  PEER_CAND_LIST(X)
#undef X
  int L[16];
#pragma unroll
  for (int i = 0; i < 16; ++i) L[i] = (int)0x80000000;
#pragma unroll
  for (int c = 0; c < 25; ++c) ins16(L, f2key(C[c]));
  merge16(L);
  const int tau = L[15]; const float cmax = Af[0] + Bf[0];
  float s = 0.f;
#pragma unroll
  for (int i = 0; i < 16; ++i) s += ssq[(size_t)t * 16 + i];
  const float rstd = 1.0f / sqrtf(s * (1.0f / 1024.0f) + 1e-6f);
  const float k2 = rstd * 1.4426950408889634f;
  if (h == 0 && hi == 0) RSTD[t] = rstd;
  float E[25]; float den = 0.f; int cnt = 0; unsigned selm = 0u;
#pragma unroll
  for (int c = 0; c < 25; ++c) { const bool sl = f2key(C[c]) >= tau; E[c] = sl ? __builtin_amdgcn_exp2f((C[c] - cmax) * k2) : 0.f; den += E[c]; cnt += sl ? 1 : 0; selm |= sl ? (1u << c) : 0u; }
  den += __shfl_xor(den, 32);
  const int ocnt = __shfl_xor(cnt, 32);
  int pos = hi ? ocnt : 0;
  const float rden = 1.0f / den;
  int* le = LE + (size_t)t * 128 + h * 16; float* lg = LG + (size_t)t * 128 + h * 16;
#define X(c, i0, j0, i1, j1) { if (((selm >> c) & 1u) && pos < 16) { const int ka = (hi ? A[i1] : A[i0]) & 127, kb2 = (hi ? B[j1] : B[j0]) & 127; le[pos] = ka * 128 + kb2; lg[pos] = E[c] * rden; ++pos; } }
  PEER_CAND_LIST(X)
#undef X
}

__device__ __forceinline__ float gelu_erf(float v) { return 0.5f * v * (1.0f + erff(v * 0.70710678118654752f)); }
__device__ __forceinline__ void unpack8(const u32x4 w, float (&f)[8]) {
#pragma unroll
  for (int i = 0; i < 4; ++i) { f[2 * i] = __uint_as_float(w[i] << 16); f[2 * i + 1] = __uint_as_float(w[i] & 0xffff0000u); }
}
#define PEER_DPP(v, ctrl, rmask) __int_as_float(__builtin_amdgcn_update_dpp(0, __float_as_int(v), ctrl, rmask, 0xf, false))
__device__ __forceinline__ float wave_total(float v) {
  v += PEER_DPP(v, 0xB1, 0xf);
  v += PEER_DPP(v, 0x4E, 0xf);
  v += PEER_DPP(v, 0x141, 0xf);
  v += PEER_DPP(v, 0x140, 0xf);
  v += PEER_DPP(v, 0x142, 0xa);
  v += PEER_DPP(v, 0x143, 0xc);
  return __int_as_float(__builtin_amdgcn_readlane(__float_as_int(v), 63));
}
typedef float f32x4_t __attribute__((ext_vector_type(4)));
typedef float f32x2_t __attribute__((ext_vector_type(2)));
__device__ __forceinline__ float ub0(unsigned w) { return (float)(w & 255u); }
__device__ __forceinline__ float ub1(unsigned w) { return (float)((w >> 8) & 255u); }
__device__ __forceinline__ float ub2(unsigned w) { return (float)((w >> 16) & 255u); }
__device__ __forceinline__ float ub3(unsigned w) { return (float)(w >> 24); }
#define PEER_DPPI(v, ctrl, rmask) __builtin_amdgcn_update_dpp(0, v, ctrl, rmask, 0xf, false)
__device__ __forceinline__ int wave_total_i(int v) {
  v += PEER_DPPI(v, 0xB1, 0xf); v += PEER_DPPI(v, 0x4E, 0xf); v += PEER_DPPI(v, 0x141, 0xf); v += PEER_DPPI(v, 0x140, 0xf); v += PEER_DPPI(v, 0x142, 0xa); v += PEER_DPPI(v, 0x143, 0xc);
  return __builtin_amdgcn_readlane(v, 63);
}
__device__ __forceinline__ float quant_row16(const float (&v)[16], unsigned char* dst16  , int bias) {
  float m = 0.f;
#pragma unroll
  for (int i = 0; i < 16; ++i) m = fmaxf(m, fabsf(v[i]));
#pragma unroll
  for (int o = 1; o < 64; o <<= 1) m = fmaxf(m, __shfl_xor(m, o));
  const float inv = m > 0.f ? 127.0f / m : 0.f;
  u32x4 w;
#pragma unroll
  for (int q = 0; q < 4; ++q) { unsigned x = 0u;
#pragma unroll
    for (int i = 0; i < 4; ++i) { const int qi = (int)rintf(v[4 * q + i] * inv) + bias; x |= ((unsigned)qi & 255u) << (8 * i); }
    w[q] = x; }
  *reinterpret_cast<u32x4*>(dst16) = w;
  return m * (1.0f / 127.0f);
}
#define PEER_UFETCH(G_) do { const size_t tb_ = (size_t)(G_) * 4; _Pragma("unroll") for (int j = 0; j < 4; ++j) { \
    e0[j] = LE[(tb_ + j) * 128 + lane] & 16383; e1[j] = LE[(tb_ + j) * 128 + 64 + lane] & 16383; g0[j] = LG[(tb_ + j) * 128 + lane]; g1[j] = LG[(tb_ + j) * 128 + 64 + lane]; \
    xa[j] = *reinterpret_cast<const u32x4*>(XQ + (tb_ + j) * 1024 + lane * 16); } \
    rs4 = *reinterpret_cast<const f32x4_t*>(HS + tb_); } while (0)
__device__ __forceinline__ void expert_u_pass(const unsigned char* XQ, const unsigned char* U8, const float* HS, const float* SU, const float* SV, const int* LE, const float* LG, unsigned* PACK, int slice, int wx, int nwx, int lane, char* wl PROF_ARGS) {
  unsigned* list = (unsigned*)(wl + 4096);
  int e0[4], e1[4]; float g0[4], g1[4]; u32x4 xa[4]; f32x4_t rs4;
  int gi = wx;
  if (gi < 8192) PEER_UFETCH(gi);
  int flip = (wx >> 2) & 1;
  for (; gi < 8192; gi += nwx) {
    PROF_MARK(24);
    if (flip) __builtin_amdgcn_s_setprio(1); else __builtin_amdgcn_s_setprio(0);
    flip ^= 1;
    int n = 0;
    const f32x4_t rs = rs4;
#pragma unroll
    for (int j = 0; j < 4; ++j) {
      *reinterpret_cast<u32x4*>(wl + j * 1024 + lane * 16) = xa[j];
      { const bool in = (e0[j] >> 11) == slice; const unsigned long long m = __ballot(in);
        if (in) { const int pos = n + (int)__builtin_amdgcn_mbcnt_hi((unsigned)(m >> 32), __builtin_amdgcn_mbcnt_lo((unsigned)m, 0u)); list[2 * pos] = (unsigned)e0[j] | ((unsigned)lane << 14) | ((unsigned)j << 21); list[2 * pos + 1] = __float_as_uint(g0[j]); }
        n += __builtin_popcountll(m); }
      { const bool in = (e1[j] >> 11) == slice; const unsigned long long m = __ballot(in);
        if (in) { const int pos = n + (int)__builtin_amdgcn_mbcnt_hi((unsigned)(m >> 32), __builtin_amdgcn_mbcnt_lo((unsigned)m, 0u)); list[2 * pos] = (unsigned)e1[j] | ((unsigned)(64 + lane) << 14) | ((unsigned)j << 21); list[2 * pos + 1] = __float_as_uint(g1[j]); }
        n += __builtin_popcountll(m); }
    }
    n = __builtin_amdgcn_readfirstlane(n);
    PROF_MARK(20);
    const int gnext = gi + nwx;
#define PEER_UISSUE(UA_, WL_, GK_, SU_, SV_, B_) do { { const int i = ((B_) + (lane >> 2) < n) ? ((B_) + (lane >> 2)) : (n - 1); WL_ = list[2 * i]; GK_ = __uint_as_float(list[2 * i + 1]); } \
      _Pragma("unroll") for (int s = 0; s < 16; ++s) { const unsigned w = (unsigned)__builtin_amdgcn_readlane((int)WL_, 4 * s); \
        UA_[s] = *reinterpret_cast<const u32x4*>(U8 + (size_t)(w & 16383u) * 1024 + lane * 16); } \
      SU_ = SU[WL_ & 16383u]; SV_ = SV[WL_ & 16383u]; } while (0)
#define PEER_UCOMP(UA_, WL_, GK_, SU_, SV_, B_) do { int q[16]; \
      _Pragma("unroll") for (int s = 0; s < 16; ++s) { const unsigned js_ = ((unsigned)__builtin_amdgcn_readlane((int)WL_, 4 * s) >> 21) & 3u; const u32x4 xl = *reinterpret_cast<const u32x4*>(wl + js_ * 1024 + lane * 16); int q_ = 0; \
        _Pragma("unroll") for (int i = 0; i < 4; ++i) q_ = __builtin_amdgcn_sdot4((int)UA_[s][i], (int)xl[i], q_, false); q[s] = q_; if ((s & 3) == 3) __builtin_amdgcn_sched_barrier(0); } \
        \
      int r8[8], r4[4], r2[2], r1; \
      { const bool bb = (lane & 32) != 0; _Pragma("unroll") for (int i = 0; i < 8; ++i) { const int keep = bb ? q[8 + i] : q[i], send = bb ? q[i] : q[8 + i]; r8[i] = keep + __shfl_xor(send, 32); } } \
      { const bool bb = (lane & 16) != 0; _Pragma("unroll") for (int i = 0; i < 4; ++i) { const int keep = bb ? r8[4 + i] : r8[i], send = bb ? r8[i] : r8[4 + i]; r4[i] = keep + __shfl_xor(send, 16); } } \
      { const bool bb = (lane & 8) != 0; _Pragma("unroll") for (int i = 0; i < 2; ++i) { const int keep = bb ? r4[2 + i] : r4[i], send = bb ? r4[i] : r4[2 + i]; r2[i] = keep + __shfl_xor(send, 8); } } \
      { const bool bb = (lane & 4) != 0; const int keep = bb ? r2[1] : r2[0], send = bb ? r2[0] : r2[1]; r1 = keep + __shfl_xor(send, 4); } \
      r1 += PEER_DPPI(r1, 0xB1, 0xf); r1 += PEER_DPPI(r1, 0x4E, 0xf); \
      if ((lane & 3) == 0 && (B_) + (lane >> 2) < n) { const unsigned w = WL_; const float gk = GK_; const unsigned j = (w >> 21) & 3u; const unsigned e = w & 16383u; \
        const float r = j == 0 ? rs[0] : j == 1 ? rs[1] : j == 2 ? rs[2] : rs[3]; \
        const float a = gelu_erf((float)r1 * r * SU_) * gk * SV_; const unsigned ab = __float_as_uint(a); const unsigned rb = (ab + 0x7fffu + ((ab >> 16) & 1u)) & 0xffff0000u; \
        PACK[((size_t)gi * 4 + j) * 128 + ((w >> 14) & 127u)] = rb | e; } } while (0)
    if (gnext < 8192) PEER_UFETCH(gnext);
    PROF_MARK(23);
    if (n > 0) {
      u32x4 uA[16], uB[16]; unsigned wA, wB; float gA, gB, suA, svA, suB, svB;
      PEER_UISSUE(uA, wA, gA, suA, svA, 0);
      PROF_MARK(21);
      for (int b = 0; b < n; b += 32) {
        if (b + 16 < n) PEER_UISSUE(uB, wB, gB, suB, svB, b + 16);
        PROF_MARK(21);
        PEER_UCOMP(uA, wA, gA, suA, svA, b);
        PROF_MARK(22);
        if (b + 16 >= n) break;
        if (b + 32 < n) PEER_UISSUE(uA, wA, gA, suA, svA, b + 32);
        PROF_MARK(21);
        PEER_UCOMP(uB, wB, gB, suB, svB, b + 16);
        PROF_MARK(22);
      }
    }
  }
  __builtin_amdgcn_s_setprio(0);
}
#define PEER_VISSUE(S_, A_, P0_, P1_) do { _Pragma("unroll") for (int i = 0; i < 16; ++i) { const unsigned pk = (unsigned)__builtin_amdgcn_ds_bpermute(((8 * i + g) & 63) << 2, (int)(i < 8 ? P0_ : P1_)); \
    A_[i] = __uint_as_float(pk & 0xffff0000u); S_[i] = *reinterpret_cast<const u32x4*>(V8 + (size_t)slice * (16384 * 128) + (size_t)(pk & 16383u) * 128 + c * 16); } } while (0)
#define PEER_VFINISH(S_, A_, T_, O_) do { float acc[16]; float asum = 0.f; _Pragma("unroll") for (int i = 0; i < 16; ++i) acc[i] = 0.f; \
    _Pragma("unroll") for (int i = 0; i < 16; ++i) { const float a_ = A_[i]; asum += a_; _Pragma("unroll") for (int q = 0; q < 4; ++q) { const unsigned w_ = S_[i][q]; \
        acc[4 * q] += a_ * ub0(w_); acc[4 * q + 1] += a_ * ub1(w_); acc[4 * q + 2] += a_ * ub2(w_); acc[4 * q + 3] += a_ * ub3(w_); } } \
    _Pragma("unroll") for (int i = 0; i < 16; ++i) acc[i] -= 128.f * asum; \
    float m8[8], m4[4], m2[2]; \
    { const bool bb = (g & 4) != 0; _Pragma("unroll") for (int i = 0; i < 8; ++i) { const float keep = bb ? acc[8 + i] : acc[i], send = bb ? acc[i] : acc[8 + i]; m8[i] = keep + __shfl_xor(send, 32); } } \
    { const bool bb = (g & 2) != 0; _Pragma("unroll") for (int i = 0; i < 4; ++i) { const float keep = bb ? m8[4 + i] : m8[i], send = bb ? m8[i] : m8[4 + i]; m4[i] = keep + __shfl_xor(send, 16); } } \
    { const bool bb = (g & 1) != 0; _Pragma("unroll") for (int i = 0; i < 2; ++i) { const float keep = bb ? m4[2 + i] : m4[i], send = bb ? m4[i] : m4[2 + i]; m2[i] = keep + __shfl_xor(send, 8); } } \
    f32x2_t r_ = (O_); r_[0] += m2[0]; r_[1] += m2[1]; *reinterpret_cast<f32x2_t*>(out + (size_t)(T_) * 1024 + slice * 128 + 16 * c + 2 * g) = r_; } while (0)
__device__ __forceinline__ void expert_v_pass(const unsigned char* V8, const unsigned* PACK, float* out, int slice, int wx, int nwx, int lane PROF_ARGS) {
  const int g = lane >> 3, c = lane & 7;
  const int MT = 32768;
  u32x4 sA[16], sB[16]; float aA[16], aB[16];
  unsigned pA0 = 0, pA1 = 0, pB0 = 0, pB1 = 0, pC0 = 0, pC1 = 0, pD0 = 0, pD1 = 0; f32x2_t oA = {0.f, 0.f}, oB = oA, oC = oA, oD = oA;
#define PEER_OLD(T_) (*reinterpret_cast<const f32x2_t*>(out + (size_t)(T_) * 1024 + slice * 128 + 16 * c + 2 * g))
#define PEER_VMETA(P0_, P1_, O_, T_) do { if ((T_) < MT) { P0_ = PACK[(size_t)(T_) * 128 + lane]; P1_ = PACK[(size_t)(T_) * 128 + 64 + lane]; O_ = PEER_OLD(T_); } } while (0)
  int t = wx;
  PEER_VMETA(pA0, pA1, oA, t); PEER_VMETA(pB0, pB1, oB, t + nwx); PEER_VMETA(pC0, pC1, oC, t + 2 * nwx); PEER_VMETA(pD0, pD1, oD, t + 3 * nwx);
  if (t < MT) PEER_VISSUE(sA, aA, pA0, pA1);
  int flip = (wx >> 2) & 1;
  for (; t < MT; t += 2 * nwx) {
    if (flip) __builtin_amdgcn_s_setprio(1); else __builtin_amdgcn_s_setprio(0);
    flip ^= 1;
    const int t1 = t + nwx, t2 = t + 2 * nwx;
    PROF_MARK(34);
    if (t1 < MT) PEER_VISSUE(sB, aB, pB0, pB1);
    PROF_MARK(30);
    unsigned pE0 = 0, pE1 = 0, pF0 = 0, pF1 = 0; f32x2_t oE = {0.f, 0.f}, oF = oE;
    PEER_VMETA(pE0, pE1, oE, t + 4 * nwx);
    PROF_MARK(31);
    PEER_VFINISH(sA, aA, t, oA);
    PROF_MARK(32);
    if (t1 >= MT) break;
    if (t2 < MT) PEER_VISSUE(sA, aA, pC0, pC1);
    PROF_MARK(30);
    PEER_VMETA(pF0, pF1, oF, t + 5 * nwx);
    PROF_MARK(31);
    PEER_VFINISH(sB, aB, t1, oB);
    PROF_MARK(32);
    pA0 = pC0; pA1 = pC1; oA = oC; pB0 = pD0; pB1 = pD1; oB = oD; pC0 = pE0; pC1 = pE1; oC = oE; pD0 = pF0; pD1 = pF1; oD = oF;
  }
#undef PEER_OLD
#undef PEER_VMETA
  __builtin_amdgcn_s_setprio(0);
}
__device__ __forceinline__ void quant_token(const bf16* XMB, const float* ssq, unsigned char* XQ, float* HS, int t, int lane) {
  const u32x4 a = *reinterpret_cast<const u32x4*>(XMB + (size_t)t * 1024 + lane * 16), b = *reinterpret_cast<const u32x4*>(XMB + (size_t)t * 1024 + lane * 16 + 8);
  float fa[8], fb[8], v[16]; unpack8(a, fa); unpack8(b, fb);
#pragma unroll
  for (int i = 0; i < 8; ++i) { v[i] = fa[i]; v[8 + i] = fb[i]; }
  const float sx = quant_row16(v, XQ + (size_t)t * 1024 + lane * 16, 0);
  float s = 0.f;
#pragma unroll
  for (int i = 0; i < 16; ++i) s += ssq[(size_t)t * 16 + i];
  if (lane == 0) HS[t] = sx / sqrtf(s * (1.0f / 1024.0f) + 1e-6f);
}
}
constexpr int NWAVES = 8;
constexpr int BATCH = 16, SEQ = 2048, D = 1024, M = BATCH * SEQ, NPROJ = 3072, NQP = 2048, NEXP = 16384;
constexpr float RMS_EPS = 1e-6f;
constexpr float C2 = 0.125f * 1.4426950408889634f;
constexpr float LOG2E = 1.4426950408889634f;
constexpr size_t MiB = 1u << 20;
constexpr size_t WS_CTL = 0, CTL_ZERO_BYTES = 1 * MiB;
constexpr size_t WS_WIN = 1 * MiB;
constexpr size_t WS_WOUT = 7 * MiB;
constexpr size_t WS_WQ = 9 * MiB;
constexpr size_t WS_SK = 13 * MiB;
constexpr size_t WS_KPART = 13 * MiB + 512 * 1024;
constexpr size_t WS_SSQ = 14 * MiB;
constexpr size_t WS_MISC = 16 * MiB;
constexpr size_t WS_SU = WS_MISC + 65536, WS_SV = WS_MISC + 131072, WS_HS = WS_MISC + 262144;
constexpr size_t WS_U8 = 17 * MiB;
constexpr size_t WS_V8 = 33 * MiB;
constexpr size_t WS_XQ = 49 * MiB;
constexpr size_t WS_XN = 81 * MiB;
constexpr size_t WS_MIX = 145 * MiB;
constexpr size_t WS_DO = 209 * MiB;
constexpr size_t WS_PROJ = 273 * MiB;
constexpr size_t WS_QP = WS_PROJ;
constexpr size_t WS_LE = WS_PROJ + 128 * MiB;
constexpr size_t WS_LG = WS_PROJ + 144 * MiB;
constexpr size_t WS_PACK = WS_PROJ + 160 * MiB;
constexpr size_t WS_RSTD = WS_PROJ + 176 * MiB;
constexpr size_t WS_END = 465 * MiB;
constexpr int CW_BAR = 4096;
constexpr int RING_OFF = 0, RING_BYTES = 131072;
constexpr int LDSCTL_OFF = RING_BYTES, MISC_OFF = LDSCTL_OFF + 320;
constexpr int LDS_BYTES = 147456;
static_assert(att::LDS_BYTES <= RING_BYTES, "attention scratch fits the ring region");

#define GAS __attribute__((address_space(1)))
#define LAS __attribute__((address_space(3)))
typedef unsigned short bf16;
typedef unsigned v4u __attribute__((ext_vector_type(4)));
typedef unsigned v2u __attribute__((ext_vector_type(2)));
typedef float f32x4 __attribute__((ext_vector_type(4)));
typedef GAS unsigned gu32;
#define RLX_AGENT __ATOMIC_RELAXED, __HIP_MEMORY_SCOPE_AGENT
#define LDS_WAIT() asm volatile("s_waitcnt lgkmcnt(0)" ::: "memory")
#define VM_WAIT() asm volatile("s_waitcnt vmcnt(0)" ::: "memory")
__device__ __forceinline__ unsigned f2bf(float f) { unsigned u = __builtin_bit_cast(unsigned, f); return (u + 0x7fffu + ((u >> 16) & 1u)) >> 16; }
__device__ __forceinline__ unsigned pk2(float lo, float hi) { return f2bf(lo) | (f2bf(hi) << 16); }
#define XB_TMO      128
#define XB_XCNT(j)  (256  + 64 * (j))
#define XB_XSUB(j)  (1280 + 64 * (j))
#define XB_XGEN(j)  (2304 + 64 * (j))
#define XB_TOP      3328
#define XB_TOPGEN   3392
#define XCD_BAR_WORDS 3456
#define XB_SPIN_CAP (1u << 23)

__device__ __forceinline__ unsigned xb_ld(unsigned* p)              { return __hip_atomic_load(p, __ATOMIC_RELAXED, __HIP_MEMORY_SCOPE_AGENT); }
__device__ __forceinline__ unsigned xb_add(unsigned* p, unsigned v) { return __hip_atomic_fetch_add(p, v, __ATOMIC_RELAXED, __HIP_MEMORY_SCOPE_AGENT); }
__device__ __forceinline__ unsigned xb_xcc_id() { return (unsigned)__builtin_amdgcn_s_getreg((3 << 11) | 20) & 0xFu; }
#define XB_SPIN(cond, bar) do { unsigned _sp = 0; while (cond) { __builtin_amdgcn_s_sleep(1); \
    if ((++_sp & 255u) == 0u) { if (xb_ld(&(bar)[XB_TMO])) break; if (_sp > XB_SPIN_CAP) { atomicAdd(&(bar)[XB_TMO], 1u); break; } } } } while (0)

struct XcdBarrier {
    unsigned* bar; unsigned x;
    volatile LAS unsigned* st;
};

__device__ __forceinline__ XcdBarrier xcd_barrier_post(unsigned* bar, volatile LAS unsigned* st) {
    XcdBarrier b; b.bar = bar; b.x = xb_xcc_id(); b.st = st;
    if (threadIdx.x == 0) (void)xb_add(&bar[XB_XCNT(b.x)], 1u);
    return b;
}
__device__ __forceinline__ void xcd_barrier_complete(unsigned* bar, unsigned x, unsigned& nloc, unsigned& nx) {
    const unsigned G = gridDim.x * gridDim.y * gridDim.z;
    unsigned sum, cnt, mine, sp = 0u;
    for (;;) {
        sum = 0u; cnt = 0u; mine = 0u;
#pragma unroll
        for (unsigned j = 0; j < 16; ++j) { const unsigned c = xb_ld(&bar[XB_XCNT(j)]); sum += c; cnt += (c > 0u) ? 1u : 0u; mine = (j == x) ? c : mine; }
        if (sum == G) break;
        __builtin_amdgcn_s_sleep(1);
        if ((++sp & 255u) == 0u) { if (xb_ld(&bar[XB_TMO])) break; if (sp > XB_SPIN_CAP) { atomicAdd(&bar[XB_TMO], 1u); break; } }
    }
    nloc = mine > 0u ? mine : 1u; nx = cnt > 0u ? cnt : 1u;
}

__device__ __forceinline__ void xcd_barrier(const XcdBarrier& b) {
    asm volatile("s_waitcnt vmcnt(0)" ::: "memory");
    __syncthreads();
    if (threadIdx.x == 0) {
        unsigned* bar = b.bar;
        __builtin_amdgcn_s_waitcnt(0);
        unsigned nloc = b.st[0], nx = b.st[1];
        if (nloc == 0u) { xcd_barrier_complete(bar, b.x, nloc, nx); b.st[0] = nloc; b.st[1] = nx; }
        const unsigned old = xb_add(&bar[XB_XSUB(b.x)], 1u);
        const unsigned gen = old / nloc;
        if (old + 1u == (gen + 1u) * nloc) {
            __builtin_amdgcn_fence(__ATOMIC_RELEASE, "agent");
            asm volatile("s_waitcnt vmcnt(0)" ::: "memory");
            const unsigned og = xb_add(&bar[XB_TOP], 1u);
            const unsigned tg = og / nx;
            if (og + 1u == (tg + 1u) * nx) xb_add(&bar[XB_TOPGEN], 1u);
            else XB_SPIN(xb_ld(&bar[XB_TOPGEN]) == tg, bar);
            __builtin_amdgcn_fence(__ATOMIC_ACQUIRE, "agent");
            xb_add(&bar[XB_XGEN(b.x)], 1u);
            asm volatile("s_waitcnt vmcnt(0)" ::: "memory");
        } else {
            XB_SPIN(xb_ld(&bar[XB_XGEN(b.x)]) == gen, bar);
            __builtin_amdgcn_fence(__ATOMIC_ACQUIRE, "agent");
            asm volatile("s_waitcnt vmcnt(0)" ::: "memory");
        }
    }
    __syncthreads();
}
struct Frame {
    LAS unsigned char* lds;
    volatile LAS unsigned* MISC;
    gu32* ctl;
    int tid, lane, wave;
    int vcu, G;
};
__device__ __forceinline__ float wave_sum(float v) {
#pragma unroll
    for (int o = 1; o < 64; o <<= 1) v += __shfl_xor(v, o);
    return v;
}
template <bool PERMROWS>
__device__ __forceinline__ void p0_transpose_item(const float* W, int K, int N, bf16* WT, const float* kscale, LAS float* scr, int item, int lane) {
    const int nblk = N / 32, kb = item / nblk, nb = item % nblk, k0 = 64 * kb, n0 = 32 * nb;
#pragma unroll 8
    for (int i = 0; i < 32; ++i) { const int kk = 2 * i + (lane >> 5); float w = W[(size_t)(k0 + kk) * N + n0 + (lane & 31)]; if (kscale) w *= kscale[k0 + kk]; scr[kk * 33 + (lane & 31)] = w; }
    LDS_WAIT(); asm volatile("" ::: "memory");
    int r0 = n0;
    if (PERMROWS) { const int tl = n0 >> 8, np = n0 & 255; r0 = tl * 256 + ((np >> 5) & 1) * 128 + (np >> 6) * 32; }
    const int c = lane & 7;
#pragma unroll
    for (int j = 0; j < 4; ++j) { const int n = (lane >> 3) + 8 * j; const LAS float* s = scr + (8 * c) * 33 + n;
        v4u o; o.x = pk2(s[0 * 33], s[1 * 33]); o.y = pk2(s[2 * 33], s[3 * 33]); o.z = pk2(s[4 * 33], s[5 * 33]); o.w = pk2(s[6 * 33], s[7 * 33]);
        *(GAS v4u*)(WT + (size_t)(r0 + n) * K + k0 + 8 * c) = o; }
    LDS_WAIT(); asm volatile("" ::: "memory");
}
__device__ __forceinline__ void cvt8(const float* src, bf16* dst, size_t e, const float* cscale) {
    f32x4 a = *(const GAS f32x4*)(src + e), b = *(const GAS f32x4*)(src + e + 4);
    if (cscale) { const int c = (int)(e & 1023); const f32x4 ga = *(const f32x4*)(cscale + c), gb = *(const f32x4*)(cscale + c + 4); a = a * ga; b = b * gb; }
    v4u o; o.x = pk2(a[0], a[1]); o.y = pk2(a[2], a[3]); o.z = pk2(b[0], b[1]); o.w = pk2(b[2], b[3]);
    *(GAS v4u*)(dst + e) = o;
}
__device__ __forceinline__ void rms_row_to_bf16(const float* xrow, const float* g, bf16* orow, int lane) {
    const GAS f32x4* xr = (const GAS f32x4*)xrow + lane;
    f32x4 v[4]; float s = 0.f;
#pragma unroll
    for (int j = 0; j < 4; ++j) { v[j] = xr[64 * j]; s += (v[j].x * v[j].x + v[j].y * v[j].y) + (v[j].z * v[j].z + v[j].w * v[j].w); }
    const float rstd = 1.f / sqrtf(wave_sum(s) * (1.f / 1024.f) + RMS_EPS);
    GAS unsigned long long* o8 = (GAS unsigned long long*)orow + lane;
#pragma unroll
    for (int j = 0; j < 4; ++j) { const f32x4 gg = *((const f32x4*)g + lane + 64 * j);
        o8[64 * j] = (unsigned long long)pk2(v[j].x * rstd * gg.x, v[j].y * rstd * gg.y) | ((unsigned long long)pk2(v[j].z * rstd * gg.z, v[j].w * rstd * gg.w) << 32); }
}

#define P0_TLOAD(R_) do { const bool isu_ = (R_) < NEXP; const float* s_ = (isu_ ? peer_u : peer_v) + (size_t)(isu_ ? (R_) : (R_) - NEXP) * 1024 + F.lane * 16; \
                _Pragma("unroll") for (int q = 0; q < 4; ++q) nx[q] = *(const GAS f32x4*)(s_ + 4 * q); } while (0)
#define DEFERRED_WEIGHTS_BLOCK { LAS float* scr_ = (LAS float*)(F.lds + RING_OFF + F.wave * 16384); constexpr int IO_ = (D / 64) * (D / 32), IQ_ = (D / 64) * (NQP / 32); \
    for (int it = gw; it < IO_ + IQ_; it += NGW) { if (it < IO_) p0_transpose_item<false>(w_out, D, D, WOUT, nullptr, scr_, it, F.lane); else p0_transpose_item<false>(w_query, D, NQP, WQ, norm2_g, scr_, it - IO_, F.lane); } \
    for (size_t c = (size_t)gw * 64 + F.lane; c < (size_t)16 * 128 * 128 / 8; c += (size_t)NGW * 64) cvt8(sub_keys, SK, c * 8, nullptr); __syncthreads(); }
#define TABLE_QUANT_BLOCK { f32x4 nx[4]; int r = gw; if (r < 2 * NEXP) P0_TLOAD(r); f32x4 gq[4]; _Pragma("unroll") for (int q = 0; q < 4; ++q) gq[q] = *(const f32x4*)(norm2_g + F.lane * 16 + 4 * q); for (; r < 2 * NEXP; r += NGW) { const bool isu = r < NEXP; const int e = isu ? r : r - NEXP; float v[16]; _Pragma("unroll") for (int q = 0; q < 4; ++q) { const f32x4 a = isu ? nx[q] * gq[q] : nx[q]; v[4 * q] = a[0]; v[4 * q + 1] = a[1]; v[4 * q + 2] = a[2]; v[4 * q + 3] = a[3]; } if (r + NGW < 2 * NEXP) P0_TLOAD(r + NGW); const float sc = peer::quant_row16(v, isu ? U8 + (size_t)e * 1024 + F.lane * 16 : V8 + (size_t)(F.lane >> 3) * (16384 * 128) + (size_t)e * 128 + (F.lane & 7) * 16, isu ? 0 : 128); if (F.lane == 0) (isu ? SU : SV)[e] = sc; } }
struct Args { const float* in[13]; float* out; unsigned char* ws; int ph_lo, ph_hi; };
__global__ void __launch_bounds__(NWAVES * 64, 2) mega_fwd(Args args) {
    extern __shared__ __attribute__((aligned(16))) unsigned char lds[];
    Frame F;
    F.lds = (LAS unsigned char*)lds;
    F.MISC = (volatile LAS unsigned*)(F.lds + MISC_OFF);
    F.tid = threadIdx.x; F.lane = F.tid & 63; F.wave = __builtin_amdgcn_readfirstlane(F.tid >> 6);
    F.G = gridDim.x; { const int bx = blockIdx.x; F.vcu = (F.G % 8 == 0) ? (bx % 8) * (F.G / 8) + bx / 8 : bx; }
    unsigned char* ws = args.ws;
    F.ctl = (gu32*)(ws + WS_CTL);
    const float* x = args.in[0]; const float* norm1_g = args.in[1]; const float* w_in = args.in[2]; const float* moba_g = args.in[3]; const float* diff_g = args.in[4];
    const float* diff_lambda = args.in[5]; const float* subln_g = args.in[6]; const float* w_out = args.in[7]; const float* norm2_g = args.in[8]; const float* w_query = args.in[9];
    const float* sub_keys = args.in[10]; const float* peer_u = args.in[11]; const float* peer_v = args.in[12];
    float* out = args.out;
    bf16* WIN = (bf16*)(ws + WS_WIN); bf16* WOUT = (bf16*)(ws + WS_WOUT); bf16* WQ = (bf16*)(ws + WS_WQ); bf16* SK = (bf16*)(ws + WS_SK);
    float* KPART = (float*)(ws + WS_KPART); float* SSQ = (float*)(ws + WS_SSQ); float* MISCG = (float*)(ws + WS_MISC);
    unsigned char* U8 = ws + WS_U8; unsigned char* V8 = ws + WS_V8; float* SU = (float*)(ws + WS_SU); float* SV = (float*)(ws + WS_SV); unsigned char* XQ = ws + WS_XQ; float* HS = (float*)(ws + WS_HS); bf16* XN = (bf16*)(ws + WS_XN); bf16* MIX = (bf16*)(ws + WS_MIX); bf16* DOB = (bf16*)(ws + WS_DO);
    bf16* PROJ = (bf16*)(ws + WS_PROJ); bf16* QP = (bf16*)(ws + WS_QP); int* LE = (int*)(ws + WS_LE); float* LG = (float*)(ws + WS_LG); unsigned* PACK = (unsigned*)(ws + WS_PACK); float* RSTD = (float*)(ws + WS_RSTD);
    for (int u = F.tid; u < (LDS_BYTES - LDSCTL_OFF) / 4; u += NWAVES * 64) ((LAS unsigned*)(F.lds + LDSCTL_OFF))[u] = 0u;
    __syncthreads();
    XcdBarrier bar = xcd_barrier_post((unsigned*)(F.ctl + CW_BAR), F.MISC + 8);
    const int gw = F.vcu * NWAVES + F.wave, NGW = F.G * NWAVES;
    const int lo = args.ph_lo, hi = args.ph_hi;
#define IN(k) (lo <= (k) && (k) < hi)
#ifndef PROBE_DUP
#define PROBE_DUP -1
#endif
#define REP(k) for (int rep_ = 0; rep_ < ((PROBE_DUP == (k)) ? 2 : 1); ++rep_)
#define GRID_BAR() do { PROF_SPAN0(70); xcd_barrier(bar); PROF_SPAN1(70); } while (0)
#if PROFSEG >= 0
    unsigned long long prof_acc = 0ull, prof_t = __builtin_amdgcn_s_memrealtime(), prof_pt = prof_t; const unsigned long long prof_t0 = prof_t;
#endif

    if (IN(0)) {
        REP(0) {
        LAS float* scr = (LAS float*)(F.lds + RING_OFF + F.wave * 16384);
        constexpr int I_IN = (D / 64) * (NPROJ / 32), I_OUT = (D / 64) * (D / 32), I_Q = (D / 64) * (NQP / 32);
        for (int it = gw; it < I_IN; it += NGW) p0_transpose_item<true>(w_in, D, NPROJ, WIN, nullptr, scr, it, F.lane);
        {
            f32x4 cur[4], nxt[4]; f32x4 gg[4];
#pragma unroll
            for (int j = 0; j < 4; ++j) gg[j] = *((const f32x4*)norm1_g + F.lane + 64 * j);
            int m = gw;
            if (m < M) {
#pragma unroll
                for (int j = 0; j < 4; ++j) nxt[j] = *((const GAS f32x4*)(x + (size_t)m * D) + F.lane + 64 * j); }
            for (; m < M; m += NGW) {
#pragma unroll
                for (int j = 0; j < 4; ++j) cur[j] = nxt[j];
                if (m + NGW < M) {
#pragma unroll
                    for (int j = 0; j < 4; ++j) nxt[j] = *((const GAS f32x4*)(x + (size_t)(m + NGW) * D) + F.lane + 64 * j); }
                float s = 0.f;
#pragma unroll
                for (int j = 0; j < 4; ++j) s += (cur[j].x * cur[j].x + cur[j].y * cur[j].y) + (cur[j].z * cur[j].z + cur[j].w * cur[j].w);
                const float rstd = 1.f / sqrtf(wave_sum(s) * (1.f / 1024.f) + RMS_EPS);
                GAS unsigned long long* o8 = (GAS unsigned long long*)(XN + (size_t)m * D) + F.lane;
#pragma unroll
                for (int j = 0; j < 4; ++j) o8[64 * j] = (unsigned long long)pk2(cur[j].x * rstd * gg[j].x, cur[j].y * rstd * gg[j].y) | ((unsigned long long)pk2(cur[j].z * rstd * gg[j].z, cur[j].w * rstd * gg[j].w) << 32);
            }
        }
        if (gw == 0) { const float a = wave_sum(diff_lambda[F.lane] * diff_lambda[64 + F.lane]), b = wave_sum(diff_lambda[128 + F.lane] * diff_lambda[192 + F.lane]);
            if (F.lane == 0) MISCG[0] = expf(a) - expf(b) + 0.2f;
            float mq = fabsf(moba_g[F.lane]), mk = fabsf(moba_g[64 + F.lane]), dq = fabsf(diff_g[F.lane]), dk = fabsf(diff_g[64 + F.lane]);
#pragma unroll
            for (int o = 1; o < 64; o <<= 1) { mq = fmaxf(mq, __shfl_xor(mq, o)); mk = fmaxf(mk, __shfl_xor(mk, o)); dq = fmaxf(dq, __shfl_xor(dq, o)); dk = fmaxf(dk, __shfl_xor(dk, o)); }
            if (F.lane == 0) { MISCG[1] = 64.f * C2 * mq * mk * 1.02f; MISCG[2] = 64.f * C2 * dq * dk * 1.02f; } }
        }
        GRID_BAR(); PROF_PHASE(0);
    }
    if (IN(1)) {
        REP(1) {
        pg8::Gemm g{XN, WIN, M, NPROJ, D}; pg8::StaticOrder S; S.init(M, NPROJ, F.G, (int)blockIdx.x);
        pg8::EpiProj E{PROJ, moba_g, moba_g + 64, diff_g, diff_g + 64, KPART, C2};
        pg8::gemm_phase<pg8::EpiProj, pg8::StaticOrder, true, true>(F.lds + RING_OFF, g, S, E);
        }
        GRID_BAR(); PROF_PHASE(1);
    }
    if (IN(2)) {
        PROF_SPAN0(45); PROF_SPAN0(46);
        const float bnd_m = MISCG[1], bnd_d = MISCG[2];
        volatile LAS int* uq = (volatile LAS int*)(F.lds + MISC_OFF + 64);
        bool tq_done = false; int tq_cnt = 0;
        REP(2) {
#define ATT_QUEUE(QI_, ...) { gu32* ctr = F.ctl + 2048 + 128 * rep_ + 64 * (QI_); \
        if (F.tid == 0) uq[0] = (int)__hip_atomic_fetch_add(ctr, 1u, RLX_AGENT); \
        __syncthreads(); \
        for (;;) { const int u = uq[0]; __syncthreads(); if (u >= 1024) break; \
            if (F.tid == 0) uq[0] = (int)__hip_atomic_fetch_add(ctr, 1u, RLX_AGENT);       \
            const int nbq = 7 - (u >> 7), r = u & 127, b = r >> 3; const bf16* pb = PROJ + (size_t)b * SEQ * NPROJ; att::UnitDesc U; U.nb = nbq; __VA_ARGS__ \
            if ((QI_) == 1 && !tq_done && tq_cnt++ == ((int)blockIdx.x & 3)) { tq_done = true; TABLE_QUANT_BLOCK } } \
        __syncthreads(); }
        ATT_QUEUE(0, { const int dvh = r & 7, dh = dvh >> 1, j = dvh & 1;
                U.Q = (const att::bf16*)(pb + 1536 + dh * 128 + j * 64); U.K = (const att::bf16*)(pb + 2048 + dh * 128 + j * 64); U.V = (const att::bf16*)(pb + 2560 + dh * 128);
                U.O = (att::bf16*)(DOB + (size_t)b * SEQ * 1024 + (dh * 2 + j) * 128); U.slope2 = LOG2E * exp2f(-2.0f * (float)(dh + 1)); U.moba = 0; U.kpart = KPART; U.dmin = (2.f * bnd_d + 40.f) / U.slope2; U.bnd = bnd_d;
                att::attn_unit<128>(U, (char*)lds + RING_OFF PROF_PASS); })
        PROF_SPAN1(46);
        ATT_QUEUE(1, { const int vh = r & 7;
                U.Q = (const att::bf16*)(pb + vh * 64); U.K = (const att::bf16*)(pb + 512 + vh * 64); U.V = (const att::bf16*)(pb + 1024 + vh * 64);
                U.O = (att::bf16*)(MIX + (size_t)b * SEQ * 1024 + vh * 64); U.slope2 = LOG2E * exp2f(-(float)(vh + 1)); U.moba = 1; U.kpart = KPART + (size_t)(b * 8) * 1024 + vh * 64; U.dmin = (2.f * bnd_m + 40.f) / U.slope2; U.bnd = bnd_m;
                att::attn_unit<64>(U, (char*)lds + RING_OFF PROF_PASS); })
#undef ATT_QUEUE
        }
        if (!tq_done) { tq_done = true; TABLE_QUANT_BLOCK }
        DEFERRED_WEIGHTS_BLOCK
        PROF_SPAN1(45);
        GRID_BAR(); PROF_PHASE(2);
    }
    if (IN(3)) {
        const float lam = MISCG[0];
        const int hh = F.lane >> 4, cc = (F.lane & 15) * 8;
        float gs[8];
#pragma unroll
        for (int i = 0; i < 8; ++i) gs[i] = subln_g[cc + i] * 0.8f;
        v4u na = {}, nb2 = {};
        int t = gw;
        if (t < M) { na = *(const GAS v4u*)(DOB + (size_t)t * 1024 + hh * 256 + cc); nb2 = *(const GAS v4u*)(DOB + (size_t)t * 1024 + hh * 256 + 128 + cc); }
        for (; t < M; t += NGW) {
            const v4u a = na, b = nb2;
            if (t + NGW < M) { na = *(const GAS v4u*)(DOB + (size_t)(t + NGW) * 1024 + hh * 256 + cc); nb2 = *(const GAS v4u*)(DOB + (size_t)(t + NGW) * 1024 + hh * 256 + 128 + cc); }
            float d[8]; float ss = 0.f;
#pragma unroll
            for (int i = 0; i < 4; ++i) { d[2 * i] = __uint_as_float(a[i] << 16) - lam * __uint_as_float(b[i] << 16); d[2 * i + 1] = __uint_as_float(a[i] & 0xffff0000u) - lam * __uint_as_float(b[i] & 0xffff0000u);
                ss += d[2 * i] * d[2 * i] + d[2 * i + 1] * d[2 * i + 1]; }
#pragma unroll
            for (int o = 1; o < 16; o <<= 1) ss += __shfl_xor(ss, o);
            const float r = 1.0f / sqrtf(ss * (1.0f / 128.0f) + RMS_EPS);
            v4u w; w.x = pk2(d[0] * r * gs[0], d[1] * r * gs[1]); w.y = pk2(d[2] * r * gs[2], d[3] * r * gs[3]); w.z = pk2(d[4] * r * gs[4], d[5] * r * gs[5]); w.w = pk2(d[6] * r * gs[6], d[7] * r * gs[7]);
            *(GAS v4u*)(MIX + (size_t)t * 1024 + 512 + hh * 128 + cc) = w;
        }
        GRID_BAR(); PROF_PHASE(3);
    }
    if (IN(4)) {
        pg8::Gemm g{MIX, WOUT, M, D, D}; pg8::StaticOrder S; S.init(M, D, F.G, (int)blockIdx.x);
        pg8::EpiOut E{x, out, XN, SSQ};
        pg8::gemm_phase<pg8::EpiOut, pg8::StaticOrder, true, true>(F.lds + RING_OFF, g, S, E);
        GRID_BAR(); PROF_PHASE(4);
    }
    if (IN(5)) {
        REP(5) {
        pg8::Gemm g{XN, WQ, M, NQP, D}; pg8::StaticOrder S; S.init(M, NQP, F.G, (int)blockIdx.x);
        pg8::EpiBf16 E{QP, NQP};
        pg8::gemm_phase<pg8::EpiBf16, pg8::StaticOrder, true, true>(F.lds + RING_OFF, g, S, E);
        }
        GRID_BAR(); PROF_PHASE(5);
    }
    if (IN(6)) {
        PROF_SPAN0(64);
        for (int item = (int)blockIdx.x; item < 256; item += F.G) {
            const int h = item & 7, ch = item >> 3;
            PROF_SPAN0(60);
            __syncthreads();
            { const bf16* ksrc = SK + (size_t)h * 2 * 128 * 128;
              for (int c = F.tid; c < 4096; c += NWAVES * 64) { const int row = c >> 4, cc = c & 15; *(LAS v4u*)(F.lds + RING_OFF + row * PEER_KROW + cc * 16) = *(const GAS v4u*)(ksrc + (size_t)row * 128 + cc * 8); } }
            __syncthreads();
            PROF_SPAN1(60); PROF_SPAN0(61);
            const int tg0 = ch * 32 + F.wave * 4;
            peer::bf16x8 q0f[8];
            { const int r32 = F.lane & 31, hi5 = F.lane >> 5;
#pragma unroll
              for (int ks = 0; ks < 8; ++ks) q0f[ks] = *reinterpret_cast<const peer::bf16x8*>(QP + (size_t)(tg0 * 32 + r32) * 2048 + h * 256 + ks * 16 + hi5 * 8); }
            for (int i = 0; i < 4; ++i) peer::topk_task((const peer::bf16*)QP, (const char*)lds + RING_OFF, SSQ, RSTD, LE, LG, tg0 + i, h, F.lane, q0f, i < 3 ? tg0 + i + 1 : -1);
            PROF_SPAN1(61);
        }
        PROF_SPAN0(62);
        {
            v4u ca, cb_, na = {}, nb_ = {}; f32x4 cs[4], ns[4] = {};
#define P6_QLOAD(T_) do { na = *(const GAS v4u*)(XN + (size_t)(T_) * 1024 + F.lane * 16); nb_ = *(const GAS v4u*)(XN + (size_t)(T_) * 1024 + F.lane * 16 + 8); \
                _Pragma("unroll") for (int q = 0; q < 4; ++q) ns[q] = *(const GAS f32x4*)(SSQ + (size_t)(T_) * 16 + 4 * q); } while (0)
            int t = gw;
            if (t < M) P6_QLOAD(t);
            for (; t < M; t += NGW) {
                ca = na; cb_ = nb_;
#pragma unroll
                for (int q = 0; q < 4; ++q) cs[q] = ns[q];
                if (t + NGW < M) P6_QLOAD(t + NGW);
                float v[16];
#pragma unroll
                for (int i = 0; i < 4; ++i) { v[2 * i] = __uint_as_float(ca[i] << 16); v[2 * i + 1] = __uint_as_float(ca[i] & 0xffff0000u); v[8 + 2 * i] = __uint_as_float(cb_[i] << 16); v[9 + 2 * i] = __uint_as_float(cb_[i] & 0xffff0000u); }
                const float sx = peer::quant_row16(v, XQ + (size_t)t * 1024 + F.lane * 16, 0);
                float s = 0.f;
#pragma unroll
                for (int q = 0; q < 4; ++q) s += (cs[q][0] + cs[q][1]) + (cs[q][2] + cs[q][3]);
                if (F.lane == 0) HS[t] = sx / sqrtf(s * (1.0f / 1024.0f) + 1e-6f);
            }
#undef P6_QLOAD
        }
        PROF_SPAN1(62); PROF_SPAN1(64); PROF_SPAN0(63);
        GRID_BAR(); PROF_PHASE(6);
        PROF_SPAN1(63);
    }
    if (IN(7)) {
        const int xl = (int)blockIdx.x & 7, nwx = (F.G >> 3) * NWAVES, wx = ((int)blockIdx.x >> 3) * NWAVES + F.wave;
        PROF_SPAN0(25);
        REP(70) peer::expert_u_pass(XQ, U8, HS, SU, SV, LE, LG, PACK, xl, wx, nwx, F.lane, (char*)lds + RING_OFF + F.wave * 8192 PROF_PASS);
        PROF_SPAN1(25);
        GRID_BAR(); PROF_PHASE(7);
        PROF_SPAN0(35);
        if (PROBE_DUP == 71) peer::expert_v_pass(V8, PACK, (float*)QP, xl, wx, nwx, F.lane PROF_PASS);
        peer::expert_v_pass(V8, PACK, out, xl, wx, nwx, F.lane PROF_PASS);
        PROF_SPAN1(35);
        PROF_PHASE(8);
    }
#if PROFSEG >= 0
    if (PROFSEG == 200) prof_acc = __builtin_amdgcn_s_memrealtime() - prof_t0;
    if (blockIdx.x == PROFBLK && F.wave == PROFWAVE) { const unsigned long long t0_ = __builtin_amdgcn_s_memrealtime(); while (__builtin_amdgcn_s_memrealtime() - t0_ < 8ull * prof_acc) __builtin_amdgcn_s_sleep(8); }
#endif
#undef IN
#undef GRID_BAR
}

extern "C" void kernel_launch(void* const* d_in, const int* in_sizes, int n_in, void* d_out, int out_size, void* d_ws, size_t ws_size, hipStream_t stream) {
    static int grid = 0;
    if (grid == 0) {
        if (n_in != 13 || in_sizes[0] != M * D || out_size != M * D || ws_size < WS_END) { fprintf(stderr, "kernel_launch: unexpected shapes (n_in %d, in0 %d, out %d, ws %zu); nothing launched\n", n_in, n_in > 0 ? in_sizes[0] : -1, out_size, ws_size); grid = -1; return; }
        int dev = 0, cus = 0, per_cu = 0;
        if (hipGetDevice(&dev) != hipSuccess || hipDeviceGetAttribute(&cus, hipDeviceAttributeMultiprocessorCount, dev) != hipSuccess) { grid = -1; return; }
        if (hipFuncSetAttribute((const void*)mega_fwd, hipFuncAttributeMaxDynamicSharedMemorySize, LDS_BYTES) != hipSuccess) { fprintf(stderr, "kernel_launch: hipFuncSetAttribute failed\n"); grid = -1; return; }
        if (hipOccupancyMaxActiveBlocksPerMultiprocessor(&per_cu, (const void*)mega_fwd, NWAVES * 64, LDS_BYTES) != hipSuccess || per_cu < 1) { fprintf(stderr, "kernel_launch: occupancy query reports %d workgroups per CU\n", per_cu); }
        (void)hipGetLastError();
        grid = cus;
    }
    if (grid < 0) return;
    if (hipMemsetAsync((char*)d_ws + WS_CTL, 0, CTL_ZERO_BYTES, stream) != hipSuccess) return;
    Args a{};
    for (int i = 0; i < 13; ++i) a.in[i] = (const float*)d_in[i];
    a.out = (float*)d_out; a.ws = (unsigned char*)d_ws; a.ph_lo = 0; a.ph_hi = 8;
    hipLaunchKernelGGL(mega_fwd, dim3(grid), dim3(NWAVES * 64), LDS_BYTES, stream, a);
}
```

```cpp
#include <hip/hip_runtime.h>
#include <hip/hip_bf16.h>
#include <cstdio>
#include <cstdint>
#include <cmath>
#ifndef PROFSEG
#define PROFSEG -1
#endif
#ifndef PROFBLK
#define PROFBLK 0
#endif
#ifndef PROFWAVE
#define PROFWAVE 0
#endif
#if PROFSEG >= 0
#define PROF_ARGS , unsigned long long& prof_acc, unsigned long long& prof_t
#define PROF_PASS , prof_acc, prof_t
#define PROF_MARK(seg) do { if (PROFSEG != 25 && PROFSEG != 35 && PROFSEG != 45 && PROFSEG != 46 && !(PROFSEG >= 60 && PROFSEG <= 79)) { const unsigned long long n_ = __builtin_amdgcn_s_memrealtime(); if ((seg) == PROFSEG) prof_acc += n_ - prof_t; prof_t = n_; } } while (0)
#define PROF_SPAN0(seg) do { if ((seg) == PROFSEG) prof_t = __builtin_amdgcn_s_memrealtime(); } while (0)
#define PROF_SPAN1(seg) do { if ((seg) == PROFSEG) prof_acc += __builtin_amdgcn_s_memrealtime() - prof_t; } while (0)
#define PROF_PHASE(k) do { const unsigned long long n_ = __builtin_amdgcn_s_memrealtime(); if (100 + (k) == PROFSEG) prof_acc += n_ - prof_pt; prof_pt = n_; } while (0)
#else
#define PROF_PHASE(k) do { } while (0)
#define PROF_SPAN0(seg) do { } while (0)
#define PROF_SPAN1(seg) do { } while (0)
#define PROF_ARGS
#define PROF_PASS
#define PROF_MARK(seg) do { } while (0)
#endif
namespace pg8 {
#define PG8_LAS __attribute__((address_space(3)))
typedef unsigned short bf16_t;
typedef short bf16x8 __attribute__((ext_vector_type(8)));
typedef float f32x4 __attribute__((ext_vector_type(4)));
typedef unsigned u32x4 __attribute__((ext_vector_type(4)));
constexpr int BM = 256, BK = 64, HALF = 128, HTB = HALF * BK * 2  , STAGE_BYTES = 8 * HTB, NXCD = 8, WGM = 8;

__host__ __device__ __forceinline__ int lds_byte(int r, int c) { const int st = (r >> 4) * 2 + (c >> 5), rr = r & 15, cc = c & 31, ob = rr * 64 + cc * 2; return st * 1024 + (ob ^ (((ob >> 9) & 1) << 5)); }
__host__ __device__ __forceinline__ void stage_rc(int b, int& R, int& C) { const int st = b / 1024, sb = b % 1024, swz = sb ^ (((sb >> 9) & 1) << 5); R = (st >> 1) * 16 + swz / 64; C = (st & 1) * 32 + (swz % 64) / 2; }
__host__ __device__ __forceinline__ int perm32(int rho) { const int n = rho >> 4, i = rho & 15; return 8 * (i >> 2) + 4 * n + (i & 3); }

struct Unit { int pm, pn; };
struct Gemm { const bf16_t* A; const bf16_t* Bt; int M, N, K; };

struct StaticOrder {
    int nM, nN, nwg, G, c;
    __host__ __device__ void init(int M, int N, int G_, int c_) { nM = M / BM; nN = N / BM; nwg = nM * nN; G = G_; c = c_; }
    __host__ __device__ bool next(int i, Unit& u) const {
        const long L = (long)i * G + c; if (L >= nwg) return false;
        int wgid = (int)L; { const int q = nwg / NXCD, r = nwg % NXCD, xcd = wgid % NXCD, off = wgid / NXCD; wgid = (xcd < r ? xcd * (q + 1) : r * (q + 1) + (xcd - r) * q) + off; }
        const int nig = WGM * nN, gid = wgid / nig, fm = gid * WGM, gsz = (nM - fm) < WGM ? (nM - fm) : WGM;
        u.pm = fm + ((wgid % nig) % gsz); u.pn = (wgid % nig) / gsz; return true;
    }
    __device__ __forceinline__ void a_ready(const Unit&) const {}
    __device__ __forceinline__ void done(const Unit&) const {}
};

__device__ __forceinline__ unsigned cvt_pk_bf16(float lo, float hi) { unsigned r; asm volatile("v_cvt_pk_bf16_f32 %0, %1, %2" : "=v"(r) : "v"(lo), "v"(hi)); return r; }
typedef unsigned u32x2 __attribute__((ext_vector_type(2)));

struct EpiBf16 {
    static constexpr bool PERM = true, AFTER_DRAIN = false;
    bf16_t* O; int ldc;
    __device__ __forceinline__ void operator()(const f32x4 (&acc)[2][2][4][2], const Unit& u, int wr, int wc, int fr, int fq) const {
        const int row0 = u.pm * BM + wr * 64 + fr; const int col0 = u.pn * BM + wc * 32 + 8 * fq;
#pragma unroll
        for (int ai = 0; ai < 2; ++ai)
#pragma unroll
            for (int m = 0; m < 4; ++m) { bf16_t* rowp = O + (size_t)(row0 + ai * HALF + m * 16) * ldc + col0;
#pragma unroll
                for (int bj = 0; bj < 2; ++bj) { const f32x4 v0 = acc[ai][bj][m][0], v1 = acc[ai][bj][m][1];
                    u32x4 w; w.x = cvt_pk_bf16(v0[0], v0[1]); w.y = cvt_pk_bf16(v0[2], v0[3]); w.z = cvt_pk_bf16(v1[0], v1[1]); w.w = cvt_pk_bf16(v1[2], v1[3]);
                    *(u32x4*)(rowp + bj * HALF) = w; } }
    }
};

struct EpiProj {
    static constexpr bool PERM = true, AFTER_DRAIN = false;
    bf16_t* P; const float *gmq, *gmk, *gdq, *gdk; float* kpart; float c2;
    __device__ __forceinline__ void operator()(const f32x4 (&acc)[2][2][4][2], const Unit& u, int wr, int wc, int fr, int fq) const {
        const int type = u.pn >> 1;
        const float* g = type == 0 ? gmq : type == 1 ? gmk : type == 3 ? gdq : type == 4 ? gdk : nullptr;
        const float sc0 = (type == 0 || type == 3) ? c2 : 1.f;
        f32x4 gv[2][2];
#pragma unroll
        for (int bj = 0; bj < 2; ++bj)
#pragma unroll
            for (int n = 0; n < 2; ++n) gv[bj][n] = g ? (*(const f32x4*)(g + 32 * bj + 8 * fq + 4 * n)) * sc0 : (f32x4){1.f, 1.f, 1.f, 1.f};
        f32x4 cs[2][2];
#pragma unroll
        for (int bj = 0; bj < 2; ++bj)
#pragma unroll
            for (int n = 0; n < 2; ++n) cs[bj][n] = (f32x4){0.f, 0.f, 0.f, 0.f};
        const int row0 = u.pm * BM + wr * 64 + fr; const int col0 = u.pn * BM + wc * 64 + 8 * fq;
#pragma unroll
        for (int ai = 0; ai < 2; ++ai)
#pragma unroll
            for (int m = 0; m < 4; ++m) {
                f32x4 v[2][2];
#pragma unroll
                for (int bj = 0; bj < 2; ++bj)
#pragma unroll
                    for (int n = 0; n < 2; ++n) v[bj][n] = acc[ai][bj][m][n];
                if (g) {
                    float ss = 0.f;
#pragma unroll
                    for (int bj = 0; bj < 2; ++bj)
#pragma unroll
                        for (int n = 0; n < 2; ++n) { const f32x4 x = v[bj][n]; ss += (x[0] * x[0] + x[1] * x[1]) + (x[2] * x[2] + x[3] * x[3]); }
                    ss += __shfl_xor(ss, 16); ss += __shfl_xor(ss, 32);
                    const float r = 1.0f / sqrtf(ss * (1.0f / 64.0f) + 1e-6f);
#pragma unroll
                    for (int bj = 0; bj < 2; ++bj)
#pragma unroll
                        for (int n = 0; n < 2; ++n) { v[bj][n] = v[bj][n] * r * gv[bj][n]; cs[bj][n] += v[bj][n]; }
                }
                bf16_t* rowp = P + (size_t)(row0 + ai * HALF + m * 16) * 3072 + col0;
#pragma unroll
                for (int bj = 0; bj < 2; ++bj) { const f32x4 v0 = v[bj][0], v1 = v[bj][1];
                    u32x4 w; w.x = cvt_pk_bf16(v0[0], v0[1]); w.y = cvt_pk_bf16(v0[2], v0[3]); w.z = cvt_pk_bf16(v1[0], v1[1]); w.w = cvt_pk_bf16(v1[2], v1[3]);
                    *(u32x4*)(rowp + bj * 32) = w; }
            }
        if (type == 1) {
#pragma unroll
            for (int bj = 0; bj < 2; ++bj)
#pragma unroll
                for (int n = 0; n < 2; ++n) { f32x4 c = cs[bj][n];
#pragma unroll
                    for (int o = 1; o < 16; o <<= 1) { c[0] += __shfl_xor(c[0], o); c[1] += __shfl_xor(c[1], o); c[2] += __shfl_xor(c[2], o); c[3] += __shfl_xor(c[3], o); }
                    if (fr == 0) *(f32x4*)(kpart + (size_t)(u.pm * 2 + wr) * 512 + (u.pn - 2) * 256 + wc * 64 + bj * 32 + fq * 8 + n * 4) = c; }
        }
    }
};

struct EpiOut {
    static constexpr bool PERM = false, AFTER_DRAIN = false;
    const float* x; float* out; bf16_t* xmb; float* ssq;
    __device__ __forceinline__ void operator()(const f32x4 (&acc)[2][2][4][2], const Unit& u, int wr, int wc, int fr, int fq) const {
        const int row0 = u.pm * BM + wr * 64 + fr; const int col0 = u.pn * BM + wc * 32 + 4 * fq;
#pragma unroll
        for (int ai = 0; ai < 2; ++ai)
#pragma unroll
            for (int m = 0; m < 4; ++m) { const int row = row0 + ai * HALF + m * 16; const size_t off = (size_t)row * 1024 + col0; float s = 0.f;
#pragma unroll
                for (int bj = 0; bj < 2; ++bj)
#pragma unroll
                    for (int n = 0; n < 2; ++n) { const f32x4 xv = *(const f32x4*)(x + off + bj * HALF + n * 16); const f32x4 y = xv + acc[ai][bj][m][n];
                        *(f32x4*)(out + off + bj * HALF + n * 16) = y; u32x2 w; w.x = cvt_pk_bf16(y[0], y[1]); w.y = cvt_pk_bf16(y[2], y[3]); *(u32x2*)(xmb + off + bj * HALF + n * 16) = w;
                        s += (y[0] * y[0] + y[1] * y[1]) + (y[2] * y[2] + y[3] * y[3]); }
                s += __shfl_xor(s, 16); s += __shfl_xor(s, 32);
                if (fq == 0) ssq[(size_t)row * 16 + u.pn * 4 + wc] = s;
                if (m & 1) asm volatile("" ::: "memory"); }
    }
};
template <class Epi, class Sched, bool ALIGN_EPI = false, bool SP2 = false>
__device__ __forceinline__ void gemm_phase(PG8_LAS unsigned char* lds, const Gemm g, const Sched& S, const Epi& E) {
    const int tid = threadIdx.x, wid = __builtin_amdgcn_readfirstlane(tid >> 6), lane = tid & 63, wr = wid >> 2, wc = wid & 3, fr = lane & 15, fq = lane >> 4;
    const int K = g.K, nt = K / BK;
    unsigned voffA[2], voffB[2];
#pragma unroll
    for (int i = 0; i < 2; ++i) { int R, C; stage_rc(tid * 16 + i * 8192, R, C); const int Rb = Epi::PERM ? ((R & ~31) + perm32(R & 31)) : R;
        voffA[i] = (unsigned)(R * K + C) * 2u; voffB[i] = (unsigned)(Rb * K + C) * 2u; }
    const size_t kstep = (size_t)(BK * 2);
    const size_t hstep = (size_t)HALF * K * 2;
    const size_t tstep = 2 * hstep;
    const unsigned ldsw = (unsigned)wid * 1024u;
    const int aoff = lds_byte(wr * 64 + fr, fq * 8), boff = lds_byte(wc * 32 + fr, fq * 8);
#define PG8_SA(b, h) (((b) * 2 + (h)) * HTB)
#define PG8_SB(b, h) ((4 + (b) * 2 + (h)) * HTB)
#define PG8_STAGE(bufoff, gbase, voff) do { _Pragma("unroll") for (int _i = 0; _i < 2; ++_i) \
        __builtin_amdgcn_global_load_lds((const unsigned*)((const char*)(gbase) + (voff)[_i]), (PG8_LAS unsigned*)(lds + (bufoff) + ldsw + _i * 8192), 16, 0, 0); } while (0)
#define PG8_LDA(dst, b, h) do { _Pragma("unroll") for (int m = 0; m < 4; ++m) _Pragma("unroll") for (int k = 0; k < 2; ++k) dst[m][k] = *(const PG8_LAS bf16x8*)(lds + PG8_SA(b, h) + aoff + m * 2048 + k * 1024); } while (0)
#define PG8_LDB(dst, b, h) do { _Pragma("unroll") for (int n = 0; n < 2; ++n) _Pragma("unroll") for (int k = 0; k < 2; ++k) dst[n][k] = *(const PG8_LAS bf16x8*)(lds + PG8_SB(b, h) + boff + n * 2048 + k * 1024); } while (0)
#define PG8_MMA(ai, bj, At, Bt) do { __builtin_amdgcn_s_setprio(1); _Pragma("unroll") for (int m = 0; m < 4; ++m) _Pragma("unroll") for (int n = 0; n < 2; ++n) _Pragma("unroll") for (int k = 0; k < 2; ++k) \
        acc[ai][bj][m][n] = __builtin_amdgcn_mfma_f32_16x16x32_bf16(Bt[n][k], At[m][k], acc[ai][bj][m][n], 0, 0, 0); __builtin_amdgcn_s_setprio(0); } while (0)
#define PG8_WAIT_V(n) asm volatile("s_waitcnt vmcnt(" #n ")" ::: "memory")
#define PG8_WAIT_L(n) asm volatile("s_waitcnt lgkmcnt(" #n ")" ::: "memory")
#define PG8_BAR __builtin_amdgcn_s_barrier()
#define PG8_SCHED __builtin_amdgcn_sched_barrier(0)
    Unit cur, nxt; int ui = 0;
    if (!S.next(0, cur)) return;
    f32x4 acc[2][2][4][2];
#pragma unroll
    for (int a = 0; a < 2; ++a)
#pragma unroll
        for (int b = 0; b < 2; ++b)
#pragma unroll
            for (int m = 0; m < 4; ++m)
#pragma unroll
                for (int n = 0; n < 2; ++n) acc[a][b][m][n] = (f32x4){0.f, 0.f, 0.f, 0.f};
    bf16x8 At[4][2], B0[2][2], B1[2][2];
    const char* cA = (const char*)g.A + (size_t)cur.pm * tstep; const char* cB = (const char*)g.Bt + (size_t)cur.pn * tstep;
    S.a_ready(cur);
    if constexpr (SP2) {
        PG8_STAGE(PG8_SB(0, 0), cB, voffB); PG8_STAGE(PG8_SB(0, 1), cB + hstep, voffB); PG8_STAGE(PG8_SA(0, 0), cA, voffA); PG8_STAGE(PG8_SA(0, 1), cA + hstep, voffA);
        if (wr == 1) PG8_BAR;
        PG8_WAIT_V(2); PG8_BAR;
        PG8_STAGE(PG8_SB(1, 0), cB + kstep, voffB); PG8_STAGE(PG8_SA(1, 0), cA + kstep, voffA); PG8_STAGE(PG8_SB(1, 1), cB + hstep + kstep, voffB);
        PG8_WAIT_V(6); PG8_BAR;
    } else {
        PG8_STAGE(PG8_SB(0, 0), cB, voffB); PG8_STAGE(PG8_SA(0, 0), cA, voffA); PG8_STAGE(PG8_SB(0, 1), cB + hstep, voffB); PG8_STAGE(PG8_SA(0, 1), cA + hstep, voffA);
        if (wr == 1) PG8_BAR;
        PG8_WAIT_V(4); PG8_BAR;
        PG8_STAGE(PG8_SB(1, 0), cB + kstep, voffB); PG8_STAGE(PG8_SA(1, 0), cA + kstep, voffA); PG8_STAGE(PG8_SB(1, 1), cB + hstep + kstep, voffB);
        PG8_WAIT_V(6); PG8_BAR;
    }
    for (;;) {
        const bool has_next = S.next(ui + 1, nxt);
        const char* nA = has_next ? (const char*)g.A + (size_t)nxt.pm * tstep : cA; const char* nB = has_next ? (const char*)g.Bt + (size_t)nxt.pn * tstep : cB;
        for (int t = 0; t < nt; t += 2) {
            const bool last = (t == nt - 2);
            const char* a1 = cA + (size_t)(t + 1) * kstep;
            const char* a2 = last ? nA : cA + (size_t)(t + 2) * kstep; const char* b2 = last ? nB : cB + (size_t)(t + 2) * kstep;
            const char* a3 = a2 + kstep; const char* b3 = b2 + kstep;
            if (last && has_next) S.a_ready(nxt);
            if constexpr (SP2) {
            PG8_LDB(B0, 0, 0); PG8_LDB(B1, 0, 1); PG8_SCHED; PG8_LDA(At, 0, 0); PG8_STAGE(PG8_SA(1, 1), a1 + hstep, voffA);
            PG8_WAIT_V(8); PG8_WAIT_L(0); PG8_BAR; PG8_MMA(0, 0, At, B0); PG8_MMA(0, 1, At, B1); PG8_BAR; PG8_SCHED;
            PG8_LDA(At, 0, 1); PG8_STAGE(PG8_SB(0, 0), b2, voffB); PG8_STAGE(PG8_SB(0, 1), b2 + hstep, voffB); PG8_STAGE(PG8_SA(0, 0), a2, voffA);
            PG8_WAIT_V(8); PG8_WAIT_L(0); PG8_BAR; PG8_MMA(1, 0, At, B0); PG8_MMA(1, 1, At, B1); PG8_BAR; PG8_SCHED;
            PG8_LDB(B0, 1, 0); PG8_LDB(B1, 1, 1); PG8_SCHED; PG8_LDA(At, 1, 0); PG8_STAGE(PG8_SA(0, 1), a2 + hstep, voffA);
            PG8_WAIT_V(8); PG8_WAIT_L(0); PG8_BAR; PG8_MMA(0, 0, At, B0); PG8_MMA(0, 1, At, B1); PG8_BAR; PG8_SCHED;
            PG8_LDA(At, 1, 1); PG8_STAGE(PG8_SB(1, 0), b3, voffB); PG8_STAGE(PG8_SB(1, 1), b3 + hstep, voffB); PG8_STAGE(PG8_SA(1, 0), a3, voffA);
            PG8_WAIT_V(8); PG8_WAIT_L(0); PG8_BAR; PG8_MMA(1, 0, At, B0); PG8_MMA(1, 1, At, B1); PG8_BAR; PG8_SCHED;
            } else {
            PG8_LDB(B0, 0, 0); PG8_SCHED; PG8_LDA(At, 0, 0); PG8_STAGE(PG8_SA(1, 1), a1 + hstep, voffA);
            PG8_WAIT_L(8); PG8_BAR; PG8_WAIT_L(0); PG8_MMA(0, 0, At, B0); PG8_BAR; PG8_SCHED;
            PG8_LDB(B1, 0, 1); PG8_STAGE(PG8_SB(0, 0), b2, voffB);
            PG8_BAR; PG8_WAIT_L(0); PG8_MMA(0, 1, At, B1); PG8_BAR;
            PG8_LDA(At, 0, 1); PG8_STAGE(PG8_SA(0, 0), a2, voffA);
            PG8_BAR; PG8_WAIT_L(0); PG8_MMA(1, 0, At, B0); PG8_BAR; PG8_SCHED;
            PG8_STAGE(PG8_SB(0, 1), b2 + hstep, voffB);
            PG8_WAIT_V(6); PG8_BAR; PG8_MMA(1, 1, At, B1); PG8_BAR;
            PG8_LDB(B0, 1, 0); PG8_SCHED; PG8_LDA(At, 1, 0); PG8_STAGE(PG8_SA(0, 1), a2 + hstep, voffA);
            PG8_WAIT_L(8); PG8_BAR; PG8_WAIT_L(0); PG8_MMA(0, 0, At, B0); PG8_BAR; PG8_SCHED;
            PG8_LDB(B1, 1, 1); PG8_STAGE(PG8_SB(1, 0), b3, voffB);
            PG8_BAR; PG8_WAIT_L(0); PG8_MMA(0, 1, At, B1); PG8_BAR;
            PG8_LDA(At, 1, 1); PG8_STAGE(PG8_SA(1, 0), a3, voffA);
            PG8_BAR; PG8_WAIT_L(0); PG8_MMA(1, 0, At, B0); PG8_BAR; PG8_SCHED;
            PG8_STAGE(PG8_SB(1, 1), b3 + hstep, voffB);
            PG8_WAIT_V(6); PG8_BAR; PG8_MMA(1, 1, At, B1); PG8_BAR;
            }
        }
        if constexpr (ALIGN_EPI) { if (wr == 0) PG8_BAR; }
        if constexpr (!Epi::AFTER_DRAIN) { E(acc, cur, wr, wc, fr, fq); S.done(cur); }
        if (!has_next) break;
#pragma unroll
        for (int a = 0; a < 2; ++a)
#pragma unroll
            for (int b = 0; b < 2; ++b)
#pragma unroll
                for (int m = 0; m < 4; ++m)
#pragma unroll
                    for (int n = 0; n < 2; ++n) acc[a][b][m][n] = (f32x4){0.f, 0.f, 0.f, 0.f};
        cur = nxt; cA = nA; cB = nB; ++ui;
        if constexpr (ALIGN_EPI) { if (wr == 1) PG8_BAR; }
    }
    PG8_WAIT_V(0);
    if constexpr (!ALIGN_EPI) { if (wr == 0) PG8_BAR; }
    PG8_BAR;
    if constexpr (Epi::AFTER_DRAIN) { E.fused(acc, cur, wr, wc, fr, fq, lds, wid, lane); S.done(cur); }
#undef PG8_SA
#undef PG8_SB
#undef PG8_STAGE
#undef PG8_LDA
#undef PG8_LDB
#undef PG8_MMA
#undef PG8_WAIT_V
#undef PG8_WAIT_L
#undef PG8_BAR
#undef PG8_SCHED
}
}
namespace att {
using bf16 = __hip_bfloat16;
using bf16x8 = __attribute__((ext_vector_type(8))) short;
using s16x4 = __attribute__((ext_vector_type(4))) short;
using f32x16 = __attribute__((ext_vector_type(16))) float;
using u32x4 = __attribute__((ext_vector_type(4))) unsigned;
constexpr int PITCH = 3072, QB = 256, KVBLK = 64, NW = 8;
constexpr int SLOTB = 8192, VSLOTB = 16384, LDS_K = 0, LDS_V = 2 * SLOTB, LDS_WS = LDS_V + 2 * VSLOTB, LDS_OST = LDS_WS + NW * 64 * 4, LDS_BYTES = LDS_OST + NW * 8192;
__device__ __forceinline__ int crow(int r, int hi) { return (r & 3) + 8 * (r >> 2) + 4 * hi; }
typedef float f32x2_t __attribute__((ext_vector_type(2))); typedef __bf16 bf16x2_t __attribute__((ext_vector_type(2)));
__device__ __forceinline__ unsigned cvtpk_s(float lo, float hi) { f32x2_t v = {lo, hi}; bf16x2_t b = __builtin_convertvector(v, bf16x2_t); return __builtin_bit_cast(unsigned, b); }

__device__ __forceinline__ void qkt(f32x16& p0, f32x16& p1, const char* Kslot, const bf16x8* qr, const f32x16& c0, const f32x16& c1, int r32, int hi) {
  const char* kb = Kslot + hi * 1024 + r32 * 16;
#pragma unroll
  for (int d0 = 0; d0 < 4; ++d0) {
    const bf16x8 b0 = *reinterpret_cast<const bf16x8*>(kb + d0 * 2048);
    const bf16x8 b1 = *reinterpret_cast<const bf16x8*>(kb + d0 * 2048 + 512);
    if (d0 == 0) { p0 = __builtin_amdgcn_mfma_f32_32x32x16_bf16(b0, qr[0], c0, 0, 0, 0); p1 = __builtin_amdgcn_mfma_f32_32x32x16_bf16(b1, qr[0], c1, 0, 0, 0); }
    else { p0 = __builtin_amdgcn_mfma_f32_32x32x16_bf16(b0, qr[d0], p0, 0, 0, 0); p1 = __builtin_amdgcn_mfma_f32_32x32x16_bf16(b1, qr[d0], p1, 0, 0, 0); } }
}
template <int NDB> __device__ __forceinline__ void pv(f32x16* o, int vb, bf16x8 pa0, bf16x8 pa1, bf16x8 pa2, bf16x8 pa3) {
#pragma unroll
  for (int d0 = 0; d0 < NDB; ++d0) { s16x4 lo[4], hi[4];
#pragma unroll
    for (int ks = 0; ks < 4; ++ks) {
      asm volatile("ds_read_b64_tr_b16 %0,%1 offset:%c2" : "=&v"(lo[ks]) : "v"(vb), "i"(d0 * 4096 + ks * 1024) : "memory");
      asm volatile("ds_read_b64_tr_b16 %0,%1 offset:%c2" : "=&v"(hi[ks]) : "v"(vb), "i"(d0 * 4096 + ks * 1024 + 512) : "memory"); }
    asm volatile("s_waitcnt lgkmcnt(0)" ::: "memory"); __builtin_amdgcn_sched_barrier(0);
#define PK(k) (bf16x8){lo[k][0], lo[k][1], lo[k][2], lo[k][3], hi[k][0], hi[k][1], hi[k][2], hi[k][3]}
    o[d0] = __builtin_amdgcn_mfma_f32_32x32x16_bf16(pa0, PK(0), o[d0], 0, 0, 0);
    o[d0] = __builtin_amdgcn_mfma_f32_32x32x16_bf16(pa1, PK(1), o[d0], 0, 0, 0);
    o[d0] = __builtin_amdgcn_mfma_f32_32x32x16_bf16(pa2, PK(2), o[d0], 0, 0, 0);
    o[d0] = __builtin_amdgcn_mfma_f32_32x32x16_bf16(pa3, PK(3), o[d0], 0, 0, 0);
#undef PK
  }
}
struct UnitDesc { const bf16* Q; const bf16* K; const bf16* V; bf16* O; float slope2; int nb; int moba; const float* kpart; float dmin; float bnd; };
template <int DV> __device__ __forceinline__ void attn_unit(const UnitDesc& U, char* shm PROF_ARGS) {
  PROF_MARK(19);
  constexpr int NDB = DV / 32;
  const int tid = threadIdx.x, lane = tid & 63, r32 = lane & 31, hi = lane >> 5; const int wid = __builtin_amdgcn_readfirstlane(tid >> 6);
  const int nb = U.nb, q0 = nb * QB;
  const bf16* Qw = U.Q + (long)(q0 + wid * 32) * PITCH;
  const unsigned lds0 = (unsigned)(uintptr_t)shm;
  float* wsf = (float*)(shm + LDS_WS) + wid * 64;
  bf16x8 qr[4];
#pragma unroll
  for (int d0 = 0; d0 < 4; ++d0) qr[d0] = *reinterpret_cast<const bf16x8*>(&Qw[(long)r32 * PITCH + d0 * 16 + hi * 8]);
  unsigned sel = 0xffu;
  if (U.moba) {
    { const int n = tid >> 6, d = tid & 63; const float* k0 = U.kpart + (size_t)(n * 2) * 512 + d; const float km = k0[0] + k0[512];
      const __hip_bfloat16 h = __float2bfloat16(km); const __hip_bfloat16 l = __float2bfloat16(km - __bfloat162float(h));
      *reinterpret_cast<__hip_bfloat16*>(shm + LDS_K + (d >> 3) * 1024 + n * 16 + (d & 7) * 2) = h; *reinterpret_cast<__hip_bfloat16*>(shm + LDS_K + SLOTB + (d >> 3) * 1024 + n * 16 + (d & 7) * 2) = l; }
    __syncthreads();
    f32x16 gh = {};
    { const char* kb = shm + LDS_K + hi * 1024 + r32 * 16;
#pragma unroll
      for (int d0 = 0; d0 < 4; ++d0) { const bf16x8 bh = *reinterpret_cast<const bf16x8*>(kb + d0 * 2048), bl = *reinterpret_cast<const bf16x8*>(kb + SLOTB + d0 * 2048);
        gh = __builtin_amdgcn_mfma_f32_32x32x16_bf16(bh, qr[d0], gh, 0, 0, 0); gh = __builtin_amdgcn_mfma_f32_32x32x16_bf16(bl, qr[d0], gh, 0, 0, 0); } }
    float g[4] = {gh[0], gh[1], gh[2], gh[3]};
    __syncthreads();
    float ga[8];
#pragma unroll
    for (int j = 0; j < 4; ++j) { const float o = __shfl_xor(g[j], 32); ga[j] = hi ? o : g[j]; ga[4 + j] = hi ? g[j] : o; }
    sel = 0u;
#pragma unroll
    for (int n = 0; n < 8; ++n) { int rank = 0;
#pragma unroll
      for (int m = 0; m < 8; ++m) if (m != n) rank += (m < nb && (ga[m] > ga[n] || (ga[m] == ga[n] && m < n))) ? 1 : 0;
      if (n < nb && rank < 3) sel |= (1u << n); }
  }
  PROF_MARK(10);
  const int NT = 4 * (nb + 1);
  int ts = (int)floorf(((float)q0 - 63.f - U.dmin) * (1.0f / 64.0f)) + 1; ts = ts < 0 ? 0 : (ts > NT - 4 ? NT - 4 : ts);
  float mref = -U.bnd, lrun = 0.f; f32x16 o[NDB];
#pragma unroll
  for (int d = 0; d < NDB; ++d) o[d] = f32x16{};
  const int qrel = wid * 32 + r32;
  const bf16* ksrc = U.K + (long)lane * PITCH + wid * 8;
  const bf16* vsrc = U.V + (long)(16 * (wid & 3) + (lane >> 2)) * PITCH + (wid >> 2) * 32 + (lane & 3) * 8;
  char* kdst = shm + LDS_K + wid * 1024 + lane * 16; char* vdst = shm + LDS_V + wid * 1024 + lane * 16;
  const int vb0 = (int)(lds0 + LDS_V) + ((lane >> 4) & 1) * 32 + (lane & 3) * 8 + (4 * hi + ((lane & 15) >> 2)) * 64;
  u32x4 kreg = *reinterpret_cast<const u32x4*>(ksrc + (long)ts * KVBLK * PITCH), vreg = *reinterpret_cast<const u32x4*>(vsrc + (long)ts * KVBLK * PITCH), vreg2 = vreg;
  if (DV == 128) vreg2 = *reinterpret_cast<const u32x4*>(vsrc + (long)ts * KVBLK * PITCH + 64);
  const float s2 = U.slope2, s2x64 = 64.f * s2;
  f32x16 cb0, cb1;
#define ATT_REBUILD(T_) do { const float base_ = s2 * (float)(64 * (T_) - q0 + 4 * hi) - mref; const bool on_ = ((T_) >= NT - 4) || (((sel >> ((T_) >> 2)) & 1u) != 0u); \
    _Pragma("unroll") for (int r = 0; r < 16; ++r) { const float v_ = base_ + s2 * (float)((r & 3) + 8 * (r >> 2)); cb0[r] = on_ ? v_ : -INFINITY; cb1[r] = on_ ? v_ + 32.f * s2 : -INFINITY; } } while (0)
  ATT_REBUILD(ts);
  for (int t = ts; t < NT; ++t) {
    const int slot = (t & 1) * SLOTB, vslot = (t & 1) * VSLOTB;
    *reinterpret_cast<u32x4*>(kdst + slot) = kreg; *reinterpret_cast<u32x4*>(vdst + vslot) = vreg; if (DV == 128) *reinterpret_cast<u32x4*>(vdst + vslot + 8192) = vreg2;
    PROF_MARK(11);
    __syncthreads();
    PROF_MARK(12);
    if (t + 1 < NT) { kreg = *reinterpret_cast<const u32x4*>(ksrc + (long)(t + 1) * KVBLK * PITCH); vreg = *reinterpret_cast<const u32x4*>(vsrc + (long)(t + 1) * KVBLK * PITCH);
      if (DV == 128) vreg2 = *reinterpret_cast<const u32x4*>(vsrc + (long)(t + 1) * KVBLK * PITCH + 64); }
    f32x16 p0, p1; qkt(p0, p1, shm + LDS_K + slot, qr, cb0, cb1, r32, hi);
    PROF_MARK(13);
    const int jb = t - (NT - 4);
    if (jb >= 0) { const int kb = 64 * jb + 4 * hi;
#pragma unroll
      for (int r = 0; r < 16; ++r) { const int kv = kb + (r & 3) + 8 * (r >> 2); if (kv > qrel) p0[r] = -INFINITY; if (kv + 32 > qrel) p1[r] = -INFINITY; } }
    float rm = fmaxf(p0[0], p1[0]);
#pragma unroll
    for (int r = 1; r < 16; ++r) rm = fmaxf(rm, fmaxf(p0[r], p1[r]));
    rm = fmaxf(rm, __shfl_xor(rm, 32));
    bool resc = false;
    if (__any(rm > 8.0f)) { const float dl = fmaxf(rm, 0.f); mref += dl;
#pragma unroll
      for (int r = 0; r < 16; ++r) { p0[r] -= dl; p1[r] -= dl; cb0[r] -= dl; cb1[r] -= dl; }
      const float f = __builtin_amdgcn_exp2f(-dl); lrun *= f; if (hi == 0) wsf[r32] = f; resc = true; }
    float ps = 0.f;
#pragma unroll
    for (int r = 0; r < 16; ++r) { p0[r] = __builtin_amdgcn_exp2f(p0[r]); p1[r] = __builtin_amdgcn_exp2f(p1[r]); ps += p0[r] + p1[r]; }
    lrun += ps;
    u32x4 pw0, pw1, pw2, pw3;
#pragma unroll
    for (int i = 0; i < 4; ++i) { pw0[i] = cvtpk_s(p0[2 * i], p0[2 * i + 1]); pw1[i] = cvtpk_s(p0[8 + 2 * i], p0[9 + 2 * i]); pw2[i] = cvtpk_s(p1[2 * i], p1[2 * i + 1]); pw3[i] = cvtpk_s(p1[8 + 2 * i], p1[9 + 2 * i]); }
    PROF_MARK(14);
    if (resc) { asm volatile("s_waitcnt lgkmcnt(0)" ::: "memory");
#pragma unroll
      for (int r = 0; r < 16; ++r) { const float fr_ = wsf[crow(r, hi)];
#pragma unroll
        for (int d = 0; d < NDB; ++d) o[d][r] *= fr_; } }
    pv<NDB>(o, vb0 + vslot, __builtin_bit_cast(bf16x8, pw0), __builtin_bit_cast(bf16x8, pw1), __builtin_bit_cast(bf16x8, pw2), __builtin_bit_cast(bf16x8, pw3));
    PROF_MARK(15);
    if (((t + 1) & 3) == 0) { if (t + 1 < NT) ATT_REBUILD(t + 1); }
    else {
#pragma unroll
      for (int r = 0; r < 16; ++r) { cb0[r] += s2x64; cb1[r] += s2x64; } }
  }
#undef ATT_REBUILD
  PROF_MARK(16);
  lrun += __shfl_xor(lrun, 32);
  if (hi == 0) wsf[32 + r32] = lrun;
  asm volatile("s_waitcnt lgkmcnt(0)" ::: "memory");
  float rli[16];
#pragma unroll
  for (int r = 0; r < 16; ++r) rli[r] = 1.0f / wsf[32 + crow(r, hi)];
  bf16* Ow = U.O + (long)(q0 + wid * 32) * 1024;
  { bf16* stg = (bf16*)(shm + LDS_OST) + wid * 4096;
#pragma unroll
    for (int r = 0; r < 16; ++r) { const int orow = crow(r, hi);
#pragma unroll
      for (int d0 = 0; d0 < NDB; ++d0) stg[orow * DV + d0 * 32 + r32] = __float2bfloat16(o[d0][r] * rli[r]); }
    asm volatile("s_waitcnt lgkmcnt(0)" ::: "memory");
    constexpr int CPR = DV / 8, RPI = 64 / CPR;
#pragma unroll
    for (int i = 0; i < 32 / RPI; ++i) { const int row = i * RPI + lane / CPR, ch = lane % CPR; const u32x4 v = *(const u32x4*)(stg + row * DV + ch * 8); *(u32x4*)(Ow + (long)row * 1024 + ch * 8) = v; } }
  asm volatile("s_waitcnt lgkmcnt(0)" ::: "memory");
  __syncthreads();
  PROF_MARK(17);
}
}
namespace peer {
using bf16 = __hip_bfloat16;
using bf16x8 = __attribute__((ext_vector_type(8))) short;
using f32x16 = __attribute__((ext_vector_type(16))) float;
using u32x4 = __attribute__((ext_vector_type(4))) unsigned;
__device__ __forceinline__ int crow(int r, int hi) { return (r & 3) + 8 * (r >> 2) + 4 * hi; }
__device__ __forceinline__ int f2key(float f) { const int b = __float_as_int(f); return b ^ ((b >> 31) & 0x7fffffff); }
__device__ __forceinline__ float key2f(int k) { return __int_as_float(k ^ ((k >> 31) & 0x7fffffff)); }
__device__ __forceinline__ void ins16(int (&L)[16], int v) {
#pragma unroll
  for (int i = 0; i < 16; ++i) { const int a = L[i]; L[i] = a > v ? a : v; v = a > v ? v : a; }
}
#define PEER_CE(A_, B_) do { const int a_ = (A_), b_ = (B_); (A_) = a_ > b_ ? a_ : b_; (B_) = a_ > b_ ? b_ : a_; } while (0)
#define PEER_SORT16(V) do { PEER_CE(V[0], V[1]); PEER_CE(V[3], V[2]); PEER_CE(V[4], V[5]); PEER_CE(V[7], V[6]); PEER_CE(V[8], V[9]); PEER_CE(V[11], V[10]); PEER_CE(V[12], V[13]); PEER_CE(V[15], V[14]); PEER_CE(V[0], V[2]); PEER_CE(V[1], V[3]); PEER_CE(V[6], V[4]); PEER_CE(V[7], V[5]); PEER_CE(V[8], V[10]); PEER_CE(V[9], V[11]); PEER_CE(V[14], V[12]); PEER_CE(V[15], V[13]); PEER_CE(V[0], V[1]); PEER_CE(V[2], V[3]); PEER_CE(V[5], V[4]); PEER_CE(V[7], V[6]); PEER_CE(V[8], V[9]); PEER_CE(V[10], V[11]); PEER_CE(V[13], V[12]); PEER_CE(V[15], V[14]); PEER_CE(V[0], V[4]); PEER_CE(V[1], V[5]); PEER_CE(V[2], V[6]); PEER_CE(V[3], V[7]); PEER_CE(V[12], V[8]); PEER_CE(V[13], V[9]); PEER_CE(V[14], V[10]); PEER_CE(V[15], V[11]); PEER_CE(V[0], V[2]); PEER_CE(V[1], V[3]); PEER_CE(V[4], V[6]); PEER_CE(V[5], V[7]); PEER_CE(V[10], V[8]); PEER_CE(V[11], V[9]); PEER_CE(V[14], V[12]); PEER_CE(V[15], V[13]); PEER_CE(V[0], V[1]); PEER_CE(V[2], V[3]); PEER_CE(V[4], V[5]); PEER_CE(V[6], V[7]); PEER_CE(V[9], V[8]); PEER_CE(V[11], V[10]); PEER_CE(V[13], V[12]); PEER_CE(V[15], V[14]); PEER_CE(V[0], V[8]); PEER_CE(V[1], V[9]); PEER_CE(V[2], V[10]); PEER_CE(V[3], V[11]); PEER_CE(V[4], V[12]); PEER_CE(V[5], V[13]); PEER_CE(V[6], V[14]); PEER_CE(V[7], V[15]); PEER_CE(V[0], V[4]); PEER_CE(V[1], V[5]); PEER_CE(V[2], V[6]); PEER_CE(V[3], V[7]); PEER_CE(V[8], V[12]); PEER_CE(V[9], V[13]); PEER_CE(V[10], V[14]); PEER_CE(V[11], V[15]); PEER_CE(V[0], V[2]); PEER_CE(V[1], V[3]); PEER_CE(V[4], V[6]); PEER_CE(V[5], V[7]); PEER_CE(V[8], V[10]); PEER_CE(V[9], V[11]); PEER_CE(V[12], V[14]); PEER_CE(V[13], V[15]); PEER_CE(V[0], V[1]); PEER_CE(V[2], V[3]); PEER_CE(V[4], V[5]); PEER_CE(V[6], V[7]); PEER_CE(V[8], V[9]); PEER_CE(V[10], V[11]); PEER_CE(V[12], V[13]); PEER_CE(V[14], V[15]); } while (0)
__device__ __forceinline__ void mergetop16(int (&L)[16], const int (&S)[16]) {
  int M[16];
#pragma unroll
  for (int i = 0; i < 16; ++i) M[i] = L[i] > S[15 - i] ? L[i] : S[15 - i];
#pragma unroll
  for (int s = 8; s >= 1; s >>= 1)
#pragma unroll
    for (int i = 0; i < 16; ++i) if ((i & s) == 0) PEER_CE(M[i], M[i + s]);
#pragma unroll
  for (int i = 0; i < 16; ++i) L[i] = M[i];
}
__device__ __forceinline__ void merge16(int (&L)[16]) {
  int S[16];
#pragma unroll
  for (int i = 0; i < 16; ++i) S[i] = __shfl_xor(L[i], 32);
  mergetop16(L, S);
}
#define PEER_CAND_LIST(X) \
  X(0,0,0, 2,1) X(1,0,1, 2,2) X(2,0,2, 2,3) X(3,0,3, 2,4) X(4,0,4, 3,0) X(5,0,5, 3,1) X(6,0,6, 3,2) X(7,0,7, 3,3) X(8,0,8, 4,0) X(9,0,9, 4,1) X(10,0,10, 4,2) X(11,0,11, 5,0) X(12,0,12, 5,1) X(13,0,13, 6,0) X(14,0,14, 6,1) X(15,0,15, 7,0) X(16,1,0, 7,1) X(17,1,1, 8,0) X(18,1,2, 9,0) X(19,1,3, 10,0) X(20,1,4, 11,0) X(21,1,5, 12,0) X(22,1,6, 13,0) X(23,1,7, 14,0) X(24,2,0, 15,0)

#define PEER_KROW 272
__device__ __forceinline__ void topk_task(const bf16* QP, const char* ksl, const float* ssq, float* RSTD, int* LE, float* LG, int tg, int h, int lane, bf16x8 (&q0f)[8], int tg_next) {
  const int r32 = lane & 31, hi = lane >> 5; const int t = tg * 32 + r32;
  int A[16], B[16];
  bf16x8 q1f[8];
#pragma unroll
  for (int ks = 0; ks < 8; ++ks) q1f[ks] = *reinterpret_cast<const bf16x8*>(QP + (size_t)t * 2048 + h * 256 + 128 + ks * 16 + hi * 8);
#pragma unroll
  for (int p = 0; p < 2; ++p) {
    int L[16];
#pragma unroll
    for (int i = 0; i < 16; ++i) L[i] = (int)0x80000000;
    const char* kb = ksl + p * (128 * PEER_KROW) + r32 * PEER_KROW + hi * 16;
#pragma unroll 1
    for (int i = 0; i < 4; ++i) {
      f32x16 acc = {};
#pragma unroll
      for (int ks = 0; ks < 8; ++ks) { const bf16x8 a = *reinterpret_cast<const bf16x8*>(kb + i * (32 * PEER_KROW) + ks * 32); acc = __builtin_amdgcn_mfma_f32_32x32x16_bf16(a, p == 0 ? q0f[ks] : q1f[ks], acc, 0, 0, 0); }
      int S[16];
#pragma unroll
      for (int r = 0; r < 16; ++r) S[r] = (f2key(acc[r]) & ~127) | (i * 32 + crow(r, hi));
      PEER_SORT16(S);
      mergetop16(L, S);
    }
    merge16(L);
#pragma unroll
    for (int i = 0; i < 16; ++i) { if (p == 0) A[i] = L[i]; else B[i] = L[i]; }
    if (p == 0 && tg_next >= 0) {
#pragma unroll
      for (int ks = 0; ks < 8; ++ks) q0f[ks] = *reinterpret_cast<const bf16x8*>(QP + (size_t)(tg_next * 32 + r32) * 2048 + h * 256 + ks * 16 + hi * 8); }
  }
  float Af[16], Bf[16];
#pragma unroll
  for (int i = 0; i < 16; ++i) { Af[i] = key2f(A[i] & ~127); Bf[i] = key2f(B[i] & ~127); }
  float C[25];
#define X(c, i0, j0, i1, j1) C[c] = hi ? (Af[i1] + Bf[j1]) : (Af[i0] + Bf[j0]);
  PEER_CAND_LIST(X)
#undef X
  int L[16];
#pragma unroll
  for (int i = 0; i < 16; ++i) L[i] = (int)0x80000000;
#pragma unroll
  for (int c = 0; c < 25; ++c) ins16(L, f2key(C[c]));
  merge16(L);
  const int tau = L[15]; const float cmax = Af[0] + Bf[0];
  float s = 0.f;
#pragma unroll
  for (int i = 0; i < 16; ++i) s += ssq[(size_t)t * 16 + i];
  const float rstd = 1.0f / sqrtf(s * (1.0f / 1024.0f) + 1e-6f);
  const float k2 = rstd * 1.4426950408889634f;
  if (h == 0 && hi == 0) RSTD[t] = rstd;
  float E[25]; float den = 0.f; int cnt = 0; unsigned selm = 0u;
#pragma unroll
  for (int c = 0; c < 25; ++c) { const bool sl = f2key(C[c]) >= tau; E[c] = sl ? __builtin_amdgcn_exp2f((C[c] - cmax) * k2) : 0.f; den += E[c]; cnt += sl ? 1 : 0; selm |= sl ? (1u << c) : 0u; }
  den += __shfl_xor(den, 32);
  const int ocnt = __shfl_xor(cnt, 32);
  int pos = hi ? ocnt : 0;
  const float rden = 1.0f / den;
  int* le = LE + (size_t)t * 128 + h * 16; float* lg = LG + (size_t)t * 128 + h * 16;
#define X(c, i0, j0, i1, j1) { if (((selm >> c) & 1u) && pos < 16) { const int ka = (hi ? A[i1] : A[i0]) & 127, kb2 = (hi ? B[j1] : B[j0]) & 127; le[pos] = ka * 128 + kb2; lg[pos] = E[c] * rden; ++pos; } }
  PEER_CAND_LIST(X)
#undef X
}

__device__ __forceinline__ float gelu_erf(float v) { return 0.5f * v * (1.0f + erff(v * 0.70710678118654752f)); }
__device__ __forceinline__ void unpack8(const u32x4 w, float (&f)[8]) {
#pragma unroll
  for (int i = 0; i < 4; ++i) { f[2 * i] = __uint_as_float(w[i] << 16); f[2 * i + 1] = __uint_as_float(w[i] & 0xffff0000u); }
}
#define PEER_DPP(v, ctrl, rmask) __int_as_float(__builtin_amdgcn_update_dpp(0, __float_as_int(v), ctrl, rmask, 0xf, false))
__device__ __forceinline__ float wave_total(float v) {
  v += PEER_DPP(v, 0xB1, 0xf);
  v += PEER_DPP(v, 0x4E, 0xf);
  v += PEER_DPP(v, 0x141, 0xf);
  v += PEER_DPP(v, 0x140, 0xf);
  v += PEER_DPP(v, 0x142, 0xa);
  v += PEER_DPP(v, 0x143, 0xc);
  return __int_as_float(__builtin_amdgcn_readlane(__float_as_int(v), 63));
}
typedef float f32x4_t __attribute__((ext_vector_type(4)));
typedef float f32x2_t __attribute__((ext_vector_type(2)));
__device__ __forceinline__ float ub0(unsigned w) { return (float)(w & 255u); }
__device__ __forceinline__ float ub1(unsigned w) { return (float)((w >> 8) & 255u); }
__device__ __forceinline__ float ub2(unsigned w) { return (float)((w >> 16) & 255u); }
__device__ __forceinline__ float ub3(unsigned w) { return (float)(w >> 24); }
#define PEER_DPPI(v, ctrl, rmask) __builtin_amdgcn_update_dpp(0, v, ctrl, rmask, 0xf, false)
__device__ __forceinline__ int wave_total_i(int v) {
  v += PEER_DPPI(v, 0xB1, 0xf); v += PEER_DPPI(v, 0x4E, 0xf); v += PEER_DPPI(v, 0x141, 0xf); v += PEER_DPPI(v, 0x140, 0xf); v += PEER_DPPI(v, 0x142, 0xa); v += PEER_DPPI(v, 0x143, 0xc);
  return __builtin_amdgcn_readlane(v, 63);
}
__device__ __forceinline__ float quant_row16(const float (&v)[16], unsigned char* dst16  , int bias) {
  float m = 0.f;
#pragma unroll
  for (int i = 0; i < 16; ++i) m = fmaxf(m, fabsf(v[i]));
#pragma unroll
  for (int o = 1; o < 64; o <<= 1) m = fmaxf(m, __shfl_xor(m, o));
  const float inv = m > 0.f ? 127.0f / m : 0.f;
  u32x4 w;
#pragma unroll
  for (int q = 0; q < 4; ++q) { unsigned x = 0u;
#pragma unroll
    for (int i = 0; i < 4; ++i) { const int qi = (int)rintf(v[4 * q + i] * inv) + bias; x |= ((unsigned)qi & 255u) << (8 * i); }
    w[q] = x; }
  *reinterpret_cast<u32x4*>(dst16) = w;
  return m * (1.0f / 127.0f);
}
__device__ __forceinline__ float quant_row16_fp8(const float (&v)[16], unsigned char* dst16) {
  float m = 0.f;
#pragma unroll
  for (int i = 0; i < 16; ++i) m = fmaxf(m, fabsf(v[i]));
#pragma unroll
  for (int o = 1; o < 64; o <<= 1) m = fmaxf(m, __shfl_xor(m, o));
  const float inv = m > 0.f ? 448.0f / m : 0.f;
  u32x4 w;
#pragma unroll
  for (int q = 0; q < 4; ++q) { int x = 0; x = __builtin_amdgcn_cvt_pk_fp8_f32(v[4 * q] * inv, v[4 * q + 1] * inv, x, false); x = __builtin_amdgcn_cvt_pk_fp8_f32(v[4 * q + 2] * inv, v[4 * q + 3] * inv, x, true); w[q] = (unsigned)x; }
  *reinterpret_cast<u32x4*>(dst16) = w;
  return m * (1.0f / 448.0f);
}
#define PEER_UFETCH(G_) do { const size_t tb_ = (size_t)(G_) * 4; _Pragma("unroll") for (int j = 0; j < 4; ++j) { \
    e0[j] = LE[(tb_ + j) * 128 + lane] & 16383; e1[j] = LE[(tb_ + j) * 128 + 64 + lane] & 16383; g0[j] = LG[(tb_ + j) * 128 + lane]; g1[j] = LG[(tb_ + j) * 128 + 64 + lane]; \
    xa[j] = *reinterpret_cast<const u32x4*>(XQ + (tb_ + j) * 1024 + lane * 16); } \
    rs4 = *reinterpret_cast<const f32x4_t*>(HS + tb_); } while (0)
__device__ __forceinline__ void expert_u_pass(const unsigned char* XQ, const unsigned char* U8, const float* HS, const float* SU, const float* SV, const int* LE, const float* LG, unsigned* PACK, int slice, int wx, int nwx, int lane, char* wl PROF_ARGS) {
  unsigned* list = (unsigned*)(wl + 4096);
  int e0[4], e1[4]; float g0[4], g1[4]; u32x4 xa[4]; f32x4_t rs4;
  int gi = wx;
  if (gi < 8192) PEER_UFETCH(gi);
  int flip = (wx >> 2) & 1;
  for (; gi < 8192; gi += nwx) {
    PROF_MARK(24);
    if (flip) __builtin_amdgcn_s_setprio(1); else __builtin_amdgcn_s_setprio(0);
    flip ^= 1;
    int n = 0;
    const f32x4_t rs = rs4;
#pragma unroll
    for (int j = 0; j < 4; ++j) {
      *reinterpret_cast<u32x4*>(wl + j * 1024 + lane * 16) = xa[j];
      { const bool in = (e0[j] >> 11) == slice; const unsigned long long m = __ballot(in);
        if (in) { const int pos = n + (int)__builtin_amdgcn_mbcnt_hi((unsigned)(m >> 32), __builtin_amdgcn_mbcnt_lo((unsigned)m, 0u)); list[2 * pos] = (unsigned)e0[j] | ((unsigned)lane << 14) | ((unsigned)j << 21); list[2 * pos + 1] = __float_as_uint(g0[j]); }
        n += __builtin_popcountll(m); }
      { const bool in = (e1[j] >> 11) == slice; const unsigned long long m = __ballot(in);
        if (in) { const int pos = n + (int)__builtin_amdgcn_mbcnt_hi((unsigned)(m >> 32), __builtin_amdgcn_mbcnt_lo((unsigned)m, 0u)); list[2 * pos] = (unsigned)e1[j] | ((unsigned)(64 + lane) << 14) | ((unsigned)j << 21); list[2 * pos + 1] = __float_as_uint(g1[j]); }
        n += __builtin_popcountll(m); }
    }
    n = __builtin_amdgcn_readfirstlane(n);
    PROF_MARK(20);
    const int gnext = gi + nwx;
#define PEER_UISSUE(UA_, WL_, GK_, SU_, SV_, B_) do { { const int i = ((B_) + (lane >> 2) < n) ? ((B_) + (lane >> 2)) : (n - 1); WL_ = list[2 * i]; GK_ = __uint_as_float(list[2 * i + 1]); } \
      _Pragma("unroll") for (int s = 0; s < 16; ++s) { const unsigned w = (unsigned)__builtin_amdgcn_readlane((int)WL_, 4 * s); \
        UA_[s] = *reinterpret_cast<const u32x4*>(U8 + (size_t)(w & 16383u) * 1024 + lane * 16); } \
      SU_ = SU[WL_ & 16383u]; SV_ = SV[WL_ & 16383u]; } while (0)
#define PEER_UCOMP(UA_, WL_, GK_, SU_, SV_, B_) do { int q[16]; \
      _Pragma("unroll") for (int s = 0; s < 16; ++s) { const unsigned js_ = ((unsigned)__builtin_amdgcn_readlane((int)WL_, 4 * s) >> 21) & 3u; const u32x4 xl = *reinterpret_cast<const u32x4*>(wl + js_ * 1024 + lane * 16); int q_ = 0; \
        _Pragma("unroll") for (int i = 0; i < 4; ++i) q_ = __builtin_amdgcn_sdot4((int)UA_[s][i], (int)xl[i], q_, false); q[s] = q_; if ((s & 3) == 3) __builtin_amdgcn_sched_barrier(0); } \
        \
      int r8[8], r4[4], r2[2], r1; \
      { const bool bb = (lane & 32) != 0; _Pragma("unroll") for (int i = 0; i < 8; ++i) { const int keep = bb ? q[8 + i] : q[i], send = bb ? q[i] : q[8 + i]; r8[i] = keep + __shfl_xor(send, 32); } } \
      { const bool bb = (lane & 16) != 0; _Pragma("unroll") for (int i = 0; i < 4; ++i) { const int keep = bb ? r8[4 + i] : r8[i], send = bb ? r8[i] : r8[4 + i]; r4[i] = keep + __shfl_xor(send, 16); } } \
      { const bool bb = (lane & 8) != 0; _Pragma("unroll") for (int i = 0; i < 2; ++i) { const int keep = bb ? r4[2 + i] : r4[i], send = bb ? r4[i] : r4[2 + i]; r2[i] = keep + __shfl_xor(send, 8); } } \
      { const bool bb = (lane & 4) != 0; const int keep = bb ? r2[1] : r2[0], send = bb ? r2[0] : r2[1]; r1 = keep + __shfl_xor(send, 4); } \
      r1 += PEER_DPPI(r1, 0xB1, 0xf); r1 += PEER_DPPI(r1, 0x4E, 0xf); \
      if ((lane & 3) == 0 && (B_) + (lane >> 2) < n) { const unsigned w = WL_; const float gk = GK_; const unsigned j = (w >> 21) & 3u; const unsigned e = w & 16383u; \
        const float r = j == 0 ? rs[0] : j == 1 ? rs[1] : j == 2 ? rs[2] : rs[3]; \
        const float a = gelu_erf((float)r1 * r * SU_) * gk * SV_; const unsigned ab = __float_as_uint(a); const unsigned rb = (ab + 0x7fffu + ((ab >> 16) & 1u)) & 0xffff0000u; \
        PACK[((size_t)gi * 4 + j) * 128 + ((w >> 14) & 127u)] = rb | e; } } while (0)
    if (gnext < 8192) PEER_UFETCH(gnext);
    PROF_MARK(23);
    if (n > 0) {
      u32x4 uA[16], uB[16]; unsigned wA, wB; float gA, gB, suA, svA, suB, svB;
      PEER_UISSUE(uA, wA, gA, suA, svA, 0);
      PROF_MARK(21);
      for (int b = 0; b < n; b += 32) {
        if (b + 16 < n) PEER_UISSUE(uB, wB, gB, suB, svB, b + 16);
        PROF_MARK(21);
        PEER_UCOMP(uA, wA, gA, suA, svA, b);
        PROF_MARK(22);
        if (b + 16 >= n) break;
        if (b + 32 < n) PEER_UISSUE(uA, wA, gA, suA, svA, b + 32);
        PROF_MARK(21);
        PEER_UCOMP(uB, wB, gB, suB, svB, b + 16);
        PROF_MARK(22);
      }
    }
  }
  __builtin_amdgcn_s_setprio(0);
}
#define PEER_VISSUE(S_, A_, P0_, P1_) do { _Pragma("unroll") for (int i = 0; i < 16; ++i) { const unsigned pk = (unsigned)__builtin_amdgcn_ds_bpermute(((8 * i + g) & 63) << 2, (int)(i < 8 ? P0_ : P1_)); \
    A_[i] = __uint_as_float(pk & 0xffff0000u); S_[i] = *reinterpret_cast<const u32x4*>(V8 + (size_t)slice * (16384 * 128) + (size_t)(pk & 16383u) * 128 + c * 16); } } while (0)
#define PEER_VFINISH(S_, A_, T_, O_) do { f32x2_t acc2[8]; _Pragma("unroll") for (int i = 0; i < 8; ++i) acc2[i] = (f32x2_t){0.f, 0.f}; \
    _Pragma("unroll") for (int i = 0; i < 16; ++i) { const f32x2_t a2_ = {A_[i], A_[i]}; _Pragma("unroll") for (int q = 0; q < 4; ++q) { const int w_ = (int)S_[i][q]; \
        acc2[2 * q] = __builtin_elementwise_fma(a2_, __builtin_amdgcn_cvt_pk_f32_fp8(w_, false), acc2[2 * q]); acc2[2 * q + 1] = __builtin_elementwise_fma(a2_, __builtin_amdgcn_cvt_pk_f32_fp8(w_, true), acc2[2 * q + 1]); } } \
    float acc[16]; _Pragma("unroll") for (int i = 0; i < 8; ++i) { acc[2 * i] = acc2[i][0]; acc[2 * i + 1] = acc2[i][1]; } \
    float m8[8], m4[4], m2[2]; \
    { const bool bb = (g & 4) != 0; _Pragma("unroll") for (int i = 0; i < 8; ++i) { const float keep = bb ? acc[8 + i] : acc[i], send = bb ? acc[i] : acc[8 + i]; m8[i] = keep + __shfl_xor(send, 32); } } \
    { const bool bb = (g & 2) != 0; _Pragma("unroll") for (int i = 0; i < 4; ++i) { const float keep = bb ? m8[4 + i] : m8[i], send = bb ? m8[i] : m8[4 + i]; m4[i] = keep + __shfl_xor(send, 16); } } \
    { const bool bb = (g & 1) != 0; _Pragma("unroll") for (int i = 0; i < 2; ++i) { const float keep = bb ? m4[2 + i] : m4[i], send = bb ? m4[i] : m4[2 + i]; m2[i] = keep + __shfl_xor(send, 8); } } \
    f32x2_t r_ = (O_); r_[0] += m2[0]; r_[1] += m2[1]; *reinterpret_cast<f32x2_t*>(out + (size_t)(T_) * 1024 + slice * 128 + 16 * c + 2 * g) = r_; } while (0)
__device__ __forceinline__ void expert_v_pass(const unsigned char* V8, const unsigned* PACK, float* out, int slice, int wx, int nwx, int lane PROF_ARGS) {
  const int g = lane >> 3, c = lane & 7;
  const int MT = 32768;
  u32x4 sA[16], sB[16]; float aA[16], aB[16];
  unsigned pA0 = 0, pA1 = 0, pB0 = 0, pB1 = 0, pC0 = 0, pC1 = 0, pD0 = 0, pD1 = 0; f32x2_t oA = {0.f, 0.f}, oB = oA, oC = oA, oD = oA;
#define PEER_OLD(T_) (*reinterpret_cast<const f32x2_t*>(out + (size_t)(T_) * 1024 + slice * 128 + 16 * c + 2 * g))
#define PEER_VMETA(P0_, P1_, O_, T_) do { if ((T_) < MT) { P0_ = PACK[(size_t)(T_) * 128 + lane]; P1_ = PACK[(size_t)(T_) * 128 + 64 + lane]; O_ = PEER_OLD(T_); } } while (0)
  int t = wx;
  PEER_VMETA(pA0, pA1, oA, t); PEER_VMETA(pB0, pB1, oB, t + nwx); PEER_VMETA(pC0, pC1, oC, t + 2 * nwx); PEER_VMETA(pD0, pD1, oD, t + 3 * nwx);
  if (t < MT) PEER_VISSUE(sA, aA, pA0, pA1);
  int flip = (wx >> 2) & 1;
  for (; t < MT; t += 2 * nwx) {
    if (flip) __builtin_amdgcn_s_setprio(1); else __builtin_amdgcn_s_setprio(0);
    flip ^= 1;
    const int t1 = t + nwx, t2 = t + 2 * nwx;
    PROF_MARK(34);
    if (t1 < MT) PEER_VISSUE(sB, aB, pB0, pB1);
    PROF_MARK(30);
    unsigned pE0 = 0, pE1 = 0, pF0 = 0, pF1 = 0; f32x2_t oE = {0.f, 0.f}, oF = oE;
    PEER_VMETA(pE0, pE1, oE, t + 4 * nwx);
    PROF_MARK(31);
    PEER_VFINISH(sA, aA, t, oA);
    PROF_MARK(32);
    if (t1 >= MT) break;
    if (t2 < MT) PEER_VISSUE(sA, aA, pC0, pC1);
    PROF_MARK(30);
    PEER_VMETA(pF0, pF1, oF, t + 5 * nwx);
    PROF_MARK(31);
    PEER_VFINISH(sB, aB, t1, oB);
    PROF_MARK(32);
    pA0 = pC0; pA1 = pC1; oA = oC; pB0 = pD0; pB1 = pD1; oB = oD; pC0 = pE0; pC1 = pE1; oC = oE; pD0 = pF0; pD1 = pF1; oD = oF;
  }
#undef PEER_OLD
#undef PEER_VMETA
  __builtin_amdgcn_s_setprio(0);
}
__device__ __forceinline__ void quant_token(const bf16* XMB, const float* ssq, unsigned char* XQ, float* HS, int t, int lane) {
  const u32x4 a = *reinterpret_cast<const u32x4*>(XMB + (size_t)t * 1024 + lane * 16), b = *reinterpret_cast<const u32x4*>(XMB + (size_t)t * 1024 + lane * 16 + 8);
  float fa[8], fb[8], v[16]; unpack8(a, fa); unpack8(b, fb);
#pragma unroll
  for (int i = 0; i < 8; ++i) { v[i] = fa[i]; v[8 + i] = fb[i]; }
  const float sx = quant_row16(v, XQ + (size_t)t * 1024 + lane * 16, 0);
  float s = 0.f;
#pragma unroll
  for (int i = 0; i < 16; ++i) s += ssq[(size_t)t * 16 + i];
  if (lane == 0) HS[t] = sx / sqrtf(s * (1.0f / 1024.0f) + 1e-6f);
}
}
constexpr int NWAVES = 8;
constexpr int BATCH = 16, SEQ = 2048, D = 1024, M = BATCH * SEQ, NPROJ = 3072, NQP = 2048, NEXP = 16384;
constexpr float RMS_EPS = 1e-6f;
constexpr float C2 = 0.125f * 1.4426950408889634f;
constexpr float LOG2E = 1.4426950408889634f;
constexpr size_t MiB = 1u << 20;
constexpr size_t WS_CTL = 0, CTL_ZERO_BYTES = 1 * MiB;
constexpr size_t WS_WIN = 1 * MiB;
constexpr size_t WS_WOUT = 7 * MiB;
constexpr size_t WS_WQ = 9 * MiB;
constexpr size_t WS_SK = 13 * MiB;
constexpr size_t WS_KPART = 13 * MiB + 512 * 1024;
constexpr size_t WS_SSQ = 14 * MiB;
constexpr size_t WS_MISC = 16 * MiB;
constexpr size_t WS_SU = WS_MISC + 65536, WS_SV = WS_MISC + 131072, WS_HS = WS_MISC + 262144;
constexpr size_t WS_U8 = 17 * MiB;
constexpr size_t WS_V8 = 33 * MiB;
constexpr size_t WS_XQ = 49 * MiB;
constexpr size_t WS_XN = 81 * MiB;
constexpr size_t WS_MIX = 145 * MiB;
constexpr size_t WS_DO = 209 * MiB;
constexpr size_t WS_PROJ = 273 * MiB;
constexpr size_t WS_QP = WS_PROJ;
constexpr size_t WS_LE = WS_PROJ + 128 * MiB;
constexpr size_t WS_LG = WS_PROJ + 144 * MiB;
constexpr size_t WS_PACK = WS_PROJ + 160 * MiB;
constexpr size_t WS_RSTD = WS_PROJ + 176 * MiB;
constexpr size_t WS_END = 465 * MiB;
constexpr int CW_BAR = 4096;
constexpr int RING_OFF = 0, RING_BYTES = 131072;
constexpr int LDSCTL_OFF = RING_BYTES, MISC_OFF = LDSCTL_OFF + 320;
constexpr int LDS_BYTES = 147456;
static_assert(att::LDS_BYTES <= RING_BYTES, "attention scratch fits the ring region");

#define GAS __attribute__((address_space(1)))
#define LAS __attribute__((address_space(3)))
typedef unsigned short bf16;
typedef unsigned v4u __attribute__((ext_vector_type(4)));
typedef unsigned v2u __attribute__((ext_vector_type(2)));
typedef float f32x4 __attribute__((ext_vector_type(4)));
typedef GAS unsigned gu32;
#define RLX_AGENT __ATOMIC_RELAXED, __HIP_MEMORY_SCOPE_AGENT
#define LDS_WAIT() asm volatile("s_waitcnt lgkmcnt(0)" ::: "memory")
#define VM_WAIT() asm volatile("s_waitcnt vmcnt(0)" ::: "memory")
__device__ __forceinline__ unsigned f2bf(float f) { unsigned u = __builtin_bit_cast(unsigned, f); return (u + 0x7fffu + ((u >> 16) & 1u)) >> 16; }
__device__ __forceinline__ unsigned pk2(float lo, float hi) { return f2bf(lo) | (f2bf(hi) << 16); }
#define XB_TMO      128
#define XB_XCNT(j)  (256  + 64 * (j))
#define XB_XSUB(j)  (1280 + 64 * (j))
#define XB_XGEN(j)  (2304 + 64 * (j))
#define XB_TOP      3328
#define XB_TOPGEN   3392
#define XCD_BAR_WORDS 3456
#define XB_SPIN_CAP (1u << 23)

__device__ __forceinline__ unsigned xb_ld(unsigned* p)              { return __hip_atomic_load(p, __ATOMIC_RELAXED, __HIP_MEMORY_SCOPE_AGENT); }
__device__ __forceinline__ unsigned xb_add(unsigned* p, unsigned v) { return __hip_atomic_fetch_add(p, v, __ATOMIC_RELAXED, __HIP_MEMORY_SCOPE_AGENT); }
__device__ __forceinline__ unsigned xb_xcc_id() { return (unsigned)__builtin_amdgcn_s_getreg((3 << 11) | 20) & 0xFu; }
#define XB_SPIN(cond, bar) do { unsigned _sp = 0; while (cond) { __builtin_amdgcn_s_sleep(1); \
    if ((++_sp & 255u) == 0u) { if (xb_ld(&(bar)[XB_TMO])) break; if (_sp > XB_SPIN_CAP) { atomicAdd(&(bar)[XB_TMO], 1u); break; } } } } while (0)

struct XcdBarrier {
    unsigned* bar; unsigned x;
    volatile LAS unsigned* st;
};

__device__ __forceinline__ XcdBarrier xcd_barrier_post(unsigned* bar, volatile LAS unsigned* st) {
    XcdBarrier b; b.bar = bar; b.x = xb_xcc_id(); b.st = st;
    if (threadIdx.x == 0) (void)xb_add(&bar[XB_XCNT(b.x)], 1u);
    return b;
}
__device__ __forceinline__ void xcd_barrier_complete(unsigned* bar, unsigned x, unsigned& nloc, unsigned& nx) {
    const unsigned G = gridDim.x * gridDim.y * gridDim.z;
    unsigned sum, cnt, mine, sp = 0u;
    for (;;) {
        sum = 0u; cnt = 0u; mine = 0u;
#pragma unroll
        for (unsigned j = 0; j < 16; ++j) { const unsigned c = xb_ld(&bar[XB_XCNT(j)]); sum += c; cnt += (c > 0u) ? 1u : 0u; mine = (j == x) ? c : mine; }
        if (sum == G) break;
        __builtin_amdgcn_s_sleep(1);
        if ((++sp & 255u) == 0u) { if (xb_ld(&bar[XB_TMO])) break; if (sp > XB_SPIN_CAP) { atomicAdd(&bar[XB_TMO], 1u); break; } }
    }
    nloc = mine > 0u ? mine : 1u; nx = cnt > 0u ? cnt : 1u;
}

__device__ __forceinline__ void xcd_barrier(const XcdBarrier& b) {
    asm volatile("s_waitcnt vmcnt(0)" ::: "memory");
    __syncthreads();
    if (threadIdx.x == 0) {
        unsigned* bar = b.bar;
        __builtin_amdgcn_s_waitcnt(0);
        unsigned nloc = b.st[0], nx = b.st[1];
        if (nloc == 0u) { xcd_barrier_complete(bar, b.x, nloc, nx); b.st[0] = nloc; b.st[1] = nx; }
        const unsigned old = xb_add(&bar[XB_XSUB(b.x)], 1u);
        const unsigned gen = old / nloc;
        if (old + 1u == (gen + 1u) * nloc) {
            __builtin_amdgcn_fence(__ATOMIC_RELEASE, "agent");
            asm volatile("s_waitcnt vmcnt(0)" ::: "memory");
            const unsigned og = xb_add(&bar[XB_TOP], 1u);
            const unsigned tg = og / nx;
            if (og + 1u == (tg + 1u) * nx) xb_add(&bar[XB_TOPGEN], 1u);
            else XB_SPIN(xb_ld(&bar[XB_TOPGEN]) == tg, bar);
            __builtin_amdgcn_fence(__ATOMIC_ACQUIRE, "agent");
            xb_add(&bar[XB_XGEN(b.x)], 1u);
            asm volatile("s_waitcnt vmcnt(0)" ::: "memory");
        } else {
            XB_SPIN(xb_ld(&bar[XB_XGEN(b.x)]) == gen, bar);
            __builtin_amdgcn_fence(__ATOMIC_ACQUIRE, "agent");
            asm volatile("s_waitcnt vmcnt(0)" ::: "memory");
        }
    }
    __syncthreads();
}
struct Frame {
    LAS unsigned char* lds;
    volatile LAS unsigned* MISC;
    gu32* ctl;
    int tid, lane, wave;
    int vcu, G;
};
__device__ __forceinline__ float wave_sum(float v) {
#pragma unroll
    for (int o = 1; o < 64; o <<= 1) v += __shfl_xor(v, o);
    return v;
}
template <bool PERMROWS>
__device__ __forceinline__ void p0_transpose_item(const float* W, int K, int N, bf16* WT, const float* kscale, LAS float* scr, int item, int lane) {
    const int nblk = N / 32, kb = item / nblk, nb = item % nblk, k0 = 64 * kb, n0 = 32 * nb;
#pragma unroll 8
    for (int i = 0; i < 32; ++i) { const int kk = 2 * i + (lane >> 5); float w = W[(size_t)(k0 + kk) * N + n0 + (lane & 31)]; if (kscale) w *= kscale[k0 + kk]; scr[kk * 33 + (lane & 31)] = w; }
    LDS_WAIT(); asm volatile("" ::: "memory");
    int r0 = n0;
    if (PERMROWS) { const int tl = n0 >> 8, np = n0 & 255; r0 = tl * 256 + ((np >> 5) & 1) * 128 + (np >> 6) * 32; }
    const int c = lane & 7;
#pragma unroll
    for (int j = 0; j < 4; ++j) { const int n = (lane >> 3) + 8 * j; const LAS float* s = scr + (8 * c) * 33 + n;
        v4u o; o.x = pk2(s[0 * 33], s[1 * 33]); o.y = pk2(s[2 * 33], s[3 * 33]); o.z = pk2(s[4 * 33], s[5 * 33]); o.w = pk2(s[6 * 33], s[7 * 33]);
        *(GAS v4u*)(WT + (size_t)(r0 + n) * K + k0 + 8 * c) = o; }
    LDS_WAIT(); asm volatile("" ::: "memory");
}
__device__ __forceinline__ void cvt8(const float* src, bf16* dst, size_t e, const float* cscale) {
    f32x4 a = *(const GAS f32x4*)(src + e), b = *(const GAS f32x4*)(src + e + 4);
    if (cscale) { const int c = (int)(e & 1023); const f32x4 ga = *(const f32x4*)(cscale + c), gb = *(const f32x4*)(cscale + c + 4); a = a * ga; b = b * gb; }
    v4u o; o.x = pk2(a[0], a[1]); o.y = pk2(a[2], a[3]); o.z = pk2(b[0], b[1]); o.w = pk2(b[2], b[3]);
    *(GAS v4u*)(dst + e) = o;
}
__device__ __forceinline__ void rms_row_to_bf16(const float* xrow, const float* g, bf16* orow, int lane) {
    const GAS f32x4* xr = (const GAS f32x4*)xrow + lane;
    f32x4 v[4]; float s = 0.f;
#pragma unroll
    for (int j = 0; j < 4; ++j) { v[j] = xr[64 * j]; s += (v[j].x * v[j].x + v[j].y * v[j].y) + (v[j].z * v[j].z + v[j].w * v[j].w); }
    const float rstd = 1.f / sqrtf(wave_sum(s) * (1.f / 1024.f) + RMS_EPS);
    GAS unsigned long long* o8 = (GAS unsigned long long*)orow + lane;
#pragma unroll
    for (int j = 0; j < 4; ++j) { const f32x4 gg = *((const f32x4*)g + lane + 64 * j);
        o8[64 * j] = (unsigned long long)pk2(v[j].x * rstd * gg.x, v[j].y * rstd * gg.y) | ((unsigned long long)pk2(v[j].z * rstd * gg.z, v[j].w * rstd * gg.w) << 32); }
}

#define P0_TLOAD(R_) do { const bool isu_ = (R_) < NEXP; const float* s_ = (isu_ ? peer_u : peer_v) + (size_t)(isu_ ? (R_) : (R_) - NEXP) * 1024 + F.lane * 16; \
                _Pragma("unroll") for (int q = 0; q < 4; ++q) nx[q] = *(const GAS f32x4*)(s_ + 4 * q); } while (0)
#define DEFERRED_WEIGHTS_BLOCK { LAS float* scr_ = (LAS float*)(F.lds + RING_OFF + F.wave * 16384); constexpr int IO_ = (D / 64) * (D / 32), IQ_ = (D / 64) * (NQP / 32); \
    for (int it = gw; it < IO_ + IQ_; it += NGW) { if (it < IO_) p0_transpose_item<false>(w_out, D, D, WOUT, nullptr, scr_, it, F.lane); else p0_transpose_item<false>(w_query, D, NQP, WQ, norm2_g, scr_, it - IO_, F.lane); } \
    for (size_t c = (size_t)gw * 64 + F.lane; c < (size_t)16 * 128 * 128 / 8; c += (size_t)NGW * 64) cvt8(sub_keys, SK, c * 8, nullptr); __syncthreads(); }
#define TABLE_QUANT_BLOCK { f32x4 nx[4]; int r = gw; if (r < 2 * NEXP) P0_TLOAD(r); f32x4 gq[4]; _Pragma("unroll") for (int q = 0; q < 4; ++q) gq[q] = *(const f32x4*)(norm2_g + F.lane * 16 + 4 * q); for (; r < 2 * NEXP; r += NGW) { const bool isu = r < NEXP; const int e = isu ? r : r - NEXP; float v[16]; _Pragma("unroll") for (int q = 0; q < 4; ++q) { const f32x4 a = isu ? nx[q] * gq[q] : nx[q]; v[4 * q] = a[0]; v[4 * q + 1] = a[1]; v[4 * q + 2] = a[2]; v[4 * q + 3] = a[3]; } if (r + NGW < 2 * NEXP) P0_TLOAD(r + NGW); const float sc = isu ? peer::quant_row16(v, U8 + (size_t)e * 1024 + F.lane * 16, 0) : peer::quant_row16_fp8(v, V8 + (size_t)(F.lane >> 3) * (16384 * 128) + (size_t)e * 128 + (F.lane & 7) * 16); if (F.lane == 0) (isu ? SU : SV)[e] = sc; } }
struct Args { const float* in[13]; float* out; unsigned char* ws; int ph_lo, ph_hi; };
__global__ void __launch_bounds__(NWAVES * 64, 2) mega_fwd(Args args) {
    extern __shared__ __attribute__((aligned(16))) unsigned char lds[];
    Frame F;
    F.lds = (LAS unsigned char*)lds;
    F.MISC = (volatile LAS unsigned*)(F.lds + MISC_OFF);
    F.tid = threadIdx.x; F.lane = F.tid & 63; F.wave = __builtin_amdgcn_readfirstlane(F.tid >> 6);
    F.G = gridDim.x; { const int bx = blockIdx.x; F.vcu = (F.G % 8 == 0) ? (bx % 8) * (F.G / 8) + bx / 8 : bx; }
    unsigned char* ws = args.ws;
    F.ctl = (gu32*)(ws + WS_CTL);
    const float* x = args.in[0]; const float* norm1_g = args.in[1]; const float* w_in = args.in[2]; const float* moba_g = args.in[3]; const float* diff_g = args.in[4];
    const float* diff_lambda = args.in[5]; const float* subln_g = args.in[6]; const float* w_out = args.in[7]; const float* norm2_g = args.in[8]; const float* w_query = args.in[9];
    const float* sub_keys = args.in[10]; const float* peer_u = args.in[11]; const float* peer_v = args.in[12];
    float* out = args.out;
    bf16* WIN = (bf16*)(ws + WS_WIN); bf16* WOUT = (bf16*)(ws + WS_WOUT); bf16* WQ = (bf16*)(ws + WS_WQ); bf16* SK = (bf16*)(ws + WS_SK);
    float* KPART = (float*)(ws + WS_KPART); float* SSQ = (float*)(ws + WS_SSQ); float* MISCG = (float*)(ws + WS_MISC);
    unsigned char* U8 = ws + WS_U8; unsigned char* V8 = ws + WS_V8; float* SU = (float*)(ws + WS_SU); float* SV = (float*)(ws + WS_SV); unsigned char* XQ = ws + WS_XQ; float* HS = (float*)(ws + WS_HS); bf16* XN = (bf16*)(ws + WS_XN); bf16* MIX = (bf16*)(ws + WS_MIX); bf16* DOB = (bf16*)(ws + WS_DO);
    bf16* PROJ = (bf16*)(ws + WS_PROJ); bf16* QP = (bf16*)(ws + WS_QP); int* LE = (int*)(ws + WS_LE); float* LG = (float*)(ws + WS_LG); unsigned* PACK = (unsigned*)(ws + WS_PACK); float* RSTD = (float*)(ws + WS_RSTD);
    for (int u = F.tid; u < (LDS_BYTES - LDSCTL_OFF) / 4; u += NWAVES * 64) ((LAS unsigned*)(F.lds + LDSCTL_OFF))[u] = 0u;
    __syncthreads();
    XcdBarrier bar = xcd_barrier_post((unsigned*)(F.ctl + CW_BAR), F.MISC + 8);
    const int gw = F.vcu * NWAVES + F.wave, NGW = F.G * NWAVES;
    const int lo = args.ph_lo, hi = args.ph_hi;
#define IN(k) (lo <= (k) && (k) < hi)
#ifndef PROBE_DUP
#define PROBE_DUP -1
#endif
#define REP(k) for (int rep_ = 0; rep_ < ((PROBE_DUP == (k)) ? 2 : 1); ++rep_)
#define GRID_BAR() do { PROF_SPAN0(70); xcd_barrier(bar); PROF_SPAN1(70); } while (0)
#if PROFSEG >= 0
    unsigned long long prof_acc = 0ull, prof_t = __builtin_amdgcn_s_memrealtime(), prof_pt = prof_t; const unsigned long long prof_t0 = prof_t;
#endif

    if (IN(0)) {
        REP(0) {
        LAS float* scr = (LAS float*)(F.lds + RING_OFF + F.wave * 16384);
        constexpr int I_IN = (D / 64) * (NPROJ / 32), I_OUT = (D / 64) * (D / 32), I_Q = (D / 64) * (NQP / 32);
        for (int it = gw; it < I_IN; it += NGW) p0_transpose_item<true>(w_in, D, NPROJ, WIN, nullptr, scr, it, F.lane);
        {
            f32x4 cur[4], nxt[4]; f32x4 gg[4];
#pragma unroll
            for (int j = 0; j < 4; ++j) gg[j] = *((const f32x4*)norm1_g + F.lane + 64 * j);
            int m = gw;
            if (m < M) {
#pragma unroll
                for (int j = 0; j < 4; ++j) nxt[j] = *((const GAS f32x4*)(x + (size_t)m * D) + F.lane + 64 * j); }
            for (; m < M; m += NGW) {
#pragma unroll
                for (int j = 0; j < 4; ++j) cur[j] = nxt[j];
                if (m + NGW < M) {
#pragma unroll
                    for (int j = 0; j < 4; ++j) nxt[j] = *((const GAS f32x4*)(x + (size_t)(m + NGW) * D) + F.lane + 64 * j); }
                float s = 0.f;
#pragma unroll
                for (int j = 0; j < 4; ++j) s += (cur[j].x * cur[j].x + cur[j].y * cur[j].y) + (cur[j].z * cur[j].z + cur[j].w * cur[j].w);
                const float rstd = 1.f / sqrtf(wave_sum(s) * (1.f / 1024.f) + RMS_EPS);
                GAS unsigned long long* o8 = (GAS unsigned long long*)(XN + (size_t)m * D) + F.lane;
#pragma unroll
                for (int j = 0; j < 4; ++j) o8[64 * j] = (unsigned long long)pk2(cur[j].x * rstd * gg[j].x, cur[j].y * rstd * gg[j].y) | ((unsigned long long)pk2(cur[j].z * rstd * gg[j].z, cur[j].w * rstd * gg[j].w) << 32);
            }
        }
        if (gw == 0) { const float a = wave_sum(diff_lambda[F.lane] * diff_lambda[64 + F.lane]), b = wave_sum(diff_lambda[128 + F.lane] * diff_lambda[192 + F.lane]);
            if (F.lane == 0) MISCG[0] = expf(a) - expf(b) + 0.2f;
            float mq = fabsf(moba_g[F.lane]), mk = fabsf(moba_g[64 + F.lane]), dq = fabsf(diff_g[F.lane]), dk = fabsf(diff_g[64 + F.lane]);
#pragma unroll
            for (int o = 1; o < 64; o <<= 1) { mq = fmaxf(mq, __shfl_xor(mq, o)); mk = fmaxf(mk, __shfl_xor(mk, o)); dq = fmaxf(dq, __shfl_xor(dq, o)); dk = fmaxf(dk, __shfl_xor(dk, o)); }
            if (F.lane == 0) { MISCG[1] = 64.f * C2 * mq * mk * 1.02f; MISCG[2] = 64.f * C2 * dq * dk * 1.02f; } }
        }
        GRID_BAR(); PROF_PHASE(0);
    }
    if (IN(1)) {
        REP(1) {
        pg8::Gemm g{XN, WIN, M, NPROJ, D}; pg8::StaticOrder S; S.init(M, NPROJ, F.G, (int)blockIdx.x);
        pg8::EpiProj E{PROJ, moba_g, moba_g + 64, diff_g, diff_g + 64, KPART, C2};
        pg8::gemm_phase<pg8::EpiProj, pg8::StaticOrder, true, true>(F.lds + RING_OFF, g, S, E);
        }
        GRID_BAR(); PROF_PHASE(1);
    }
    if (IN(2)) {
        PROF_SPAN0(45); PROF_SPAN0(46);
        const float bnd_m = MISCG[1], bnd_d = MISCG[2];
        volatile LAS int* uq = (volatile LAS int*)(F.lds + MISC_OFF + 64);
        bool tq_done = false; int tq_cnt = 0;
        REP(2) {
#define ATT_QUEUE(QI_, ...) { gu32* ctr = F.ctl + 2048 + 128 * rep_ + 64 * (QI_); \
        if (F.tid == 0) uq[0] = (int)__hip_atomic_fetch_add(ctr, 1u, RLX_AGENT); \
        __syncthreads(); \
        for (;;) { const int u = uq[0]; __syncthreads(); if (u >= 1024) break; \
            if (F.tid == 0) uq[0] = (int)__hip_atomic_fetch_add(ctr, 1u, RLX_AGENT);       \
            const int nbq = 7 - (u >> 7), r = u & 127, b = r >> 3; const bf16* pb = PROJ + (size_t)b * SEQ * NPROJ; att::UnitDesc U; U.nb = nbq; __VA_ARGS__ \
            if ((QI_) == 1 && !tq_done && tq_cnt++ == ((int)blockIdx.x & 3)) { tq_done = true; TABLE_QUANT_BLOCK } } \
        __syncthreads(); }
        ATT_QUEUE(0, { const int dvh = r & 7, dh = dvh >> 1, j = dvh & 1;
                U.Q = (const att::bf16*)(pb + 1536 + dh * 128 + j * 64); U.K = (const att::bf16*)(pb + 2048 + dh * 128 + j * 64); U.V = (const att::bf16*)(pb + 2560 + dh * 128);
                U.O = (att::bf16*)(DOB + (size_t)b * SEQ * 1024 + (dh * 2 + j) * 128); U.slope2 = LOG2E * exp2f(-2.0f * (float)(dh + 1)); U.moba = 0; U.kpart = KPART; U.dmin = (2.f * bnd_d + 40.f) / U.slope2; U.bnd = bnd_d;
                att::attn_unit<128>(U, (char*)lds + RING_OFF PROF_PASS); })
        PROF_SPAN1(46);
        ATT_QUEUE(1, { const int vh = r & 7;
                U.Q = (const att::bf16*)(pb + vh * 64); U.K = (const att::bf16*)(pb + 512 + vh * 64); U.V = (const att::bf16*)(pb + 1024 + vh * 64);
                U.O = (att::bf16*)(MIX + (size_t)b * SEQ * 1024 + vh * 64); U.slope2 = LOG2E * exp2f(-(float)(vh + 1)); U.moba = 1; U.kpart = KPART + (size_t)(b * 8) * 1024 + vh * 64; U.dmin = (2.f * bnd_m + 40.f) / U.slope2; U.bnd = bnd_m;
                att::attn_unit<64>(U, (char*)lds + RING_OFF PROF_PASS); })
#undef ATT_QUEUE
        }
        if (!tq_done) { tq_done = true; TABLE_QUANT_BLOCK }
        DEFERRED_WEIGHTS_BLOCK
        PROF_SPAN1(45);
        GRID_BAR(); PROF_PHASE(2);
    }
    if (IN(3)) {
        const float lam = MISCG[0];
        const int hh = F.lane >> 4, cc = (F.lane & 15) * 8;
        float gs[8];
#pragma unroll
        for (int i = 0; i < 8; ++i) gs[i] = subln_g[cc + i] * 0.8f;
        v4u na = {}, nb2 = {};
        int t = gw;
        if (t < M) { na = *(const GAS v4u*)(DOB + (size_t)t * 1024 + hh * 256 + cc); nb2 = *(const GAS v4u*)(DOB + (size_t)t * 1024 + hh * 256 + 128 + cc); }
        for (; t < M; t += NGW) {
            const v4u a = na, b = nb2;
            if (t + NGW < M) { na = *(const GAS v4u*)(DOB + (size_t)(t + NGW) * 1024 + hh * 256 + cc); nb2 = *(const GAS v4u*)(DOB + (size_t)(t + NGW) * 1024 + hh * 256 + 128 + cc); }
            float d[8]; float ss = 0.f;
#pragma unroll
            for (int i = 0; i < 4; ++i) { d[2 * i] = __uint_as_float(a[i] << 16) - lam * __uint_as_float(b[i] << 16); d[2 * i + 1] = __uint_as_float(a[i] & 0xffff0000u) - lam * __uint_as_float(b[i] & 0xffff0000u);
                ss += d[2 * i] * d[2 * i] + d[2 * i + 1] * d[2 * i + 1]; }
#pragma unroll
            for (int o = 1; o < 16; o <<= 1) ss += __shfl_xor(ss, o);
            const float r = 1.0f / sqrtf(ss * (1.0f / 128.0f) + RMS_EPS);
            v4u w; w.x = pk2(d[0] * r * gs[0], d[1] * r * gs[1]); w.y = pk2(d[2] * r * gs[2], d[3] * r * gs[3]); w.z = pk2(d[4] * r * gs[4], d[5] * r * gs[5]); w.w = pk2(d[6] * r * gs[6], d[7] * r * gs[7]);
            *(GAS v4u*)(MIX + (size_t)t * 1024 + 512 + hh * 128 + cc) = w;
        }
        GRID_BAR(); PROF_PHASE(3);
    }
    if (IN(4)) {
        pg8::Gemm g{MIX, WOUT, M, D, D}; pg8::StaticOrder S; S.init(M, D, F.G, (int)blockIdx.x);
        pg8::EpiOut E{x, out, XN, SSQ};
        pg8::gemm_phase<pg8::EpiOut, pg8::StaticOrder, true, true>(F.lds + RING_OFF, g, S, E);
        GRID_BAR(); PROF_PHASE(4);
    }
    if (IN(5)) {
        REP(5) {
        pg8::Gemm g{XN, WQ, M, NQP, D}; pg8::StaticOrder S; S.init(M, NQP, F.G, (int)blockIdx.x);
        pg8::EpiBf16 E{QP, NQP};
        pg8::gemm_phase<pg8::EpiBf16, pg8::StaticOrder, true, true>(F.lds + RING_OFF, g, S, E);
        }
        GRID_BAR(); PROF_PHASE(5);
    }
    if (IN(6)) {
        PROF_SPAN0(64);
        for (int item = (int)blockIdx.x; item < 256; item += F.G) {
            const int h = item & 7, ch = item >> 3;
            PROF_SPAN0(60);
            __syncthreads();
            { const bf16* ksrc = SK + (size_t)h * 2 * 128 * 128;
              for (int c = F.tid; c < 4096; c += NWAVES * 64) { const int row = c >> 4, cc = c & 15; *(LAS v4u*)(F.lds + RING_OFF + row * PEER_KROW + cc * 16) = *(const GAS v4u*)(ksrc + (size_t)row * 128 + cc * 8); } }
            __syncthreads();
            PROF_SPAN1(60); PROF_SPAN0(61);
            const int tg0 = ch * 32 + F.wave * 4;
            peer::bf16x8 q0f[8];
            { const int r32 = F.lane & 31, hi5 = F.lane >> 5;
#pragma unroll
              for (int ks = 0; ks < 8; ++ks) q0f[ks] = *reinterpret_cast<const peer::bf16x8*>(QP + (size_t)(tg0 * 32 + r32) * 2048 + h * 256 + ks * 16 + hi5 * 8); }
            for (int i = 0; i < 4; ++i) peer::topk_task((const peer::bf16*)QP, (const char*)lds + RING_OFF, SSQ, RSTD, LE, LG, tg0 + i, h, F.lane, q0f, i < 3 ? tg0 + i + 1 : -1);
            PROF_SPAN1(61);
        }
        PROF_SPAN0(62);
        {
            v4u ca, cb_, na = {}, nb_ = {}; f32x4 cs[4], ns[4] = {};
#define P6_QLOAD(T_) do { na = *(const GAS v4u*)(XN + (size_t)(T_) * 1024 + F.lane * 16); nb_ = *(const GAS v4u*)(XN + (size_t)(T_) * 1024 + F.lane * 16 + 8); \
                _Pragma("unroll") for (int q = 0; q < 4; ++q) ns[q] = *(const GAS f32x4*)(SSQ + (size_t)(T_) * 16 + 4 * q); } while (0)
            int t = gw;
            if (t < M) P6_QLOAD(t);
            for (; t < M; t += NGW) {
                ca = na; cb_ = nb_;
#pragma unroll
                for (int q = 0; q < 4; ++q) cs[q] = ns[q];
                if (t + NGW < M) P6_QLOAD(t + NGW);
                float v[16];
#pragma unroll
                for (int i = 0; i < 4; ++i) { v[2 * i] = __uint_as_float(ca[i] << 16); v[2 * i + 1] = __uint_as_float(ca[i] & 0xffff0000u); v[8 + 2 * i] = __uint_as_float(cb_[i] << 16); v[9 + 2 * i] = __uint_as_float(cb_[i] & 0xffff0000u); }
                const float sx = peer::quant_row16(v, XQ + (size_t)t * 1024 + F.lane * 16, 0);
                float s = 0.f;
#pragma unroll
                for (int q = 0; q < 4; ++q) s += (cs[q][0] + cs[q][1]) + (cs[q][2] + cs[q][3]);
                if (F.lane == 0) HS[t] = sx / sqrtf(s * (1.0f / 1024.0f) + 1e-6f);
            }
#undef P6_QLOAD
        }
        PROF_SPAN1(62); PROF_SPAN1(64); PROF_SPAN0(63);
        GRID_BAR(); PROF_PHASE(6);
        PROF_SPAN1(63);
    }
    if (IN(7)) {
        const int xl = (int)blockIdx.x & 7, nwx = (F.G >> 3) * NWAVES, wx = ((int)blockIdx.x >> 3) * NWAVES + F.wave;
        PROF_SPAN0(25);
        REP(70) peer::expert_u_pass(XQ, U8, HS, SU, SV, LE, LG, PACK, xl, wx, nwx, F.lane, (char*)lds + RING_OFF + F.wave * 8192 PROF_PASS);
        PROF_SPAN1(25);
        GRID_BAR(); PROF_PHASE(7);
        PROF_SPAN0(35);
        if (PROBE_DUP == 71) peer::expert_v_pass(V8, PACK, (float*)QP, xl, wx, nwx, F.lane PROF_PASS);
        peer::expert_v_pass(V8, PACK, out, xl, wx, nwx, F.lane PROF_PASS);
        PROF_SPAN1(35);
        PROF_PHASE(8);
    }
#if PROFSEG >= 0
    if (PROFSEG == 200) prof_acc = __builtin_amdgcn_s_memrealtime() - prof_t0;
    if (blockIdx.x == PROFBLK && F.wave == PROFWAVE) { const unsigned long long t0_ = __builtin_amdgcn_s_memrealtime(); while (__builtin_amdgcn_s_memrealtime() - t0_ < 8ull * prof_acc) __builtin_amdgcn_s_sleep(8); }
#endif
#undef IN
#undef GRID_BAR
}

extern "C" void kernel_launch(void* const* d_in, const int* in_sizes, int n_in, void* d_out, int out_size, void* d_ws, size_t ws_size, hipStream_t stream) {
    static int grid = 0;
    if (grid == 0) {
        if (n_in != 13 || in_sizes[0] != M * D || out_size != M * D || ws_size < WS_END) { fprintf(stderr, "kernel_launch: unexpected shapes (n_in %d, in0 %d, out %d, ws %zu); nothing launched\n", n_in, n_in > 0 ? in_sizes[0] : -1, out_size, ws_size); grid = -1; return; }
        int dev = 0, cus = 0, per_cu = 0;
        if (hipGetDevice(&dev) != hipSuccess || hipDeviceGetAttribute(&cus, hipDeviceAttributeMultiprocessorCount, dev) != hipSuccess) { grid = -1; return; }
        if (hipFuncSetAttribute((const void*)mega_fwd, hipFuncAttributeMaxDynamicSharedMemorySize, LDS_BYTES) != hipSuccess) { fprintf(stderr, "kernel_launch: hipFuncSetAttribute failed\n"); grid = -1; return; }
        if (hipOccupancyMaxActiveBlocksPerMultiprocessor(&per_cu, (const void*)mega_fwd, NWAVES * 64, LDS_BYTES) != hipSuccess || per_cu < 1) { fprintf(stderr, "kernel_launch: occupancy query reports %d workgroups per CU\n", per_cu); }
        (void)hipGetLastError();
        grid = cus;
    }
    if (grid < 0) return;
    if (hipMemsetAsync((char*)d_ws + WS_CTL, 0, CTL_ZERO_BYTES, stream) != hipSuccess) return;
    Args a{};
    for (int i = 0; i < 13; ++i) a.in[i] = (const float*)d_in[i];
    a.out = (float*)d_out; a.ws = (unsigned char*)d_ws; a.ph_lo = 0; a.ph_hi = 8;
    hipLaunchKernelGGL(mega_fwd, dim3(grid), dim3(NWAVES * 64), LDS_BYTES, stream, a);
}
```
